# Optimizing an MI355X kernel written in HIP

```python
import jax, jax.numpy as jnp
from jax import lax
import numpy as np

D_MODEL = 1024
BATCH = 8
SEQ = 2048
DEPTH = 4

EXPAND = 2
E_INNER = EXPAND * D_MODEL
HEAD_DIM = 128
E_A = E_INNER // 2
E_B = E_INNER - E_A
H_A = E_A // HEAD_DIM
H_B = E_B // HEAD_DIM
CONV_WIDTH = 3
CHUNK = 128
AB_SPLITS = (E_A, E_A, E_A, E_A, E_B, E_B, E_B)
AB_IN = sum(AB_SPLITS)
E_C = E_INNER
POOL_WINDOWS = (2, 4, 8, 16)
N_POOL_GROUPS = len(POOL_WINDOWS)
G_C = E_C // N_POOL_GROUPS
N_EVEN = (DEPTH + 1) // 2
N_ODD = DEPTH // 2
EPS = 1e-6

kernel_name = "hybrid_shortconv_sgu_pool_adaln_trunk"


def rmsnorm(x, g):
    x32 = x.astype(jnp.float32)
    y = x32 * lax.rsqrt(jnp.mean(x32 * x32, axis=-1, keepdims=True) + EPS)
    return (y * g.astype(jnp.float32)).astype(x.dtype)


def modulate(h, shift, scale):
    return h * (1 + scale[:, None, :]) + shift[:, None, :]


def causal_short_conv(x, w):
    S = x.shape[1]
    xp = jnp.pad(x, ((0, 0), (CONV_WIDTH - 1, 0), (0, 0)))
    y = xp[:, 0:S] * w[0]
    for k in range(1, CONV_WIDTH):
        y = y + xp[:, k:k + S] * w[k]
    return y


def chunked_sgu(u, v, ln_g, ln_b, w_s, b_s):
    Bn, S, _ = v.shape
    n_chunks = S // CHUNK
    v32 = v.astype(jnp.float32).reshape(Bn, S, H_B, HEAD_DIM)
    mu = jnp.mean(v32, axis=-1, keepdims=True)
    var = jnp.mean(jnp.square(v32 - mu), axis=-1, keepdims=True)
    vn = ((v32 - mu) * lax.rsqrt(var + EPS)).reshape(Bn, S, E_B)
    vn = (vn * ln_g.astype(jnp.float32) + ln_b.astype(jnp.float32)).astype(v.dtype)
    vn = vn.reshape(Bn, n_chunks, CHUNK, H_B, HEAD_DIM)
    causal = jnp.tril(jnp.ones((CHUNK, CHUNK), dtype=bool))
    w_masked = jnp.where(causal[None], w_s, jnp.zeros_like(w_s))
    mixed = jnp.einsum('hts,bnshd->bnthd', w_masked, vn) + b_s.T[None, None, :, :, None]
    return u * mixed.reshape(Bn, S, E_B)


def multiscale_pool(p):
    S = p.shape[1]
    p32 = p.astype(jnp.float32)
    cs = jnp.cumsum(p32, axis=1)
    outs = []
    for gi, win in enumerate(POOL_WINDOWS):
        sl = slice(gi * G_C, (gi + 1) * G_C)
        csg = cs[..., sl]
        prev = jnp.pad(csg, ((0, 0), (win, 0), (0, 0)))[:, :S]
        cnt = jnp.minimum(jnp.arange(1, S + 1), win).astype(jnp.float32)[None, :, None]
        outs.append((csg - prev) / cnt - p32[..., sl])
    return jnp.stack(outs, axis=2).astype(p.dtype)


def even_mixer(h, w_in, conv_w, ln_g, ln_b, w_s, b_s, w_out):
    proj = h @ w_in
    idx = [int(i) for i in np.cumsum(AB_SPLITS)[:-1]]
    a_h, a_b, a_c, a_z, b_u, b_v, b_z = jnp.split(proj, idx, axis=-1)
    y_a = a_b * causal_short_conv(a_c * a_h, conv_w)
    y_a = y_a * jax.nn.silu(a_z)
    y_b = chunked_sgu(b_u, b_v, ln_g, ln_b, w_s, b_s)
    y_b = y_b * jax.nn.silu(b_z)
    return jnp.concatenate([y_a, y_b], axis=-1) @ w_out


def odd_mixer(h, w_in, pool_w, pool_scale, w_out):
    Bn, S, _ = h.shape
    proj = h @ w_in
    p, z = jnp.split(proj, 2, axis=-1)
    pooled = multiscale_pool(p)
    y = jnp.einsum('bsgi,gio->bsgo', pooled, pool_w).reshape(Bn, S, E_C)
    y = y * pool_scale * jax.nn.silu(z)
    return y @ w_out


def setup_inputs(seed: int = 0) -> dict:
    key = jax.random.key(seed)
    ks = jax.random.split(key, 20)
    nrm = jax.random.normal
    f32 = jnp.float32
    return {
        "x": nrm(ks[0], (BATCH, SEQ, D_MODEL), f32),
        "c": nrm(ks[1], (BATCH, D_MODEL), f32),
        "norm_g": 1.0 + 0.1 * nrm(ks[2], (DEPTH, D_MODEL), f32),
        "ada_w": nrm(ks[3], (DEPTH, D_MODEL, 3 * D_MODEL), f32) * D_MODEL ** -0.5,
        "ada_b": 0.01 * nrm(ks[4], (DEPTH, 3 * D_MODEL), f32),
        "ab_w_in": nrm(ks[5], (N_EVEN, D_MODEL, AB_IN), f32) * D_MODEL ** -0.5,
        "ab_conv_w": nrm(ks[6], (N_EVEN, CONV_WIDTH, E_A), f32) * CONV_WIDTH ** -0.5,
        "ab_ln_g": 1.0 + 0.1 * nrm(ks[7], (N_EVEN, E_B), f32),
        "ab_ln_b": 0.02 * nrm(ks[8], (N_EVEN, E_B), f32),
        "ab_sgu_w": nrm(ks[9], (N_EVEN, H_B, CHUNK, CHUNK), f32) * CHUNK ** -0.5,
        "ab_sgu_b": 1.0 + 0.1 * nrm(ks[10], (N_EVEN, H_B, CHUNK), f32),
        "ab_w_out": nrm(ks[11], (N_EVEN, E_A + E_B, D_MODEL), f32) * (E_A + E_B) ** -0.5,
        "c_w_in": nrm(ks[12], (N_ODD, D_MODEL, 2 * E_C), f32) * D_MODEL ** -0.5,
        "c_pool_w": nrm(ks[13], (N_ODD, N_POOL_GROUPS, G_C, G_C), f32) * G_C ** -0.5,
        "c_pool_scale": 1.0 + 0.1 * nrm(ks[14], (N_ODD, E_C), f32),
        "c_w_out": nrm(ks[15], (N_ODD, E_C, D_MODEL), f32) * E_C ** -0.5,
        "final_g": 1.0 + 0.1 * nrm(ks[16], (D_MODEL,), f32),
    }


def reference(x, c, norm_g, ada_w, ada_b, ab_w_in, ab_conv_w, ab_ln_g, ab_ln_b,
              ab_sgu_w, ab_sgu_b, ab_w_out, c_w_in, c_pool_w, c_pool_scale,
              c_w_out, final_g):
    c_act = jax.nn.silu(c)
    for i in range(DEPTH):
        mod = c_act @ ada_w[i] + ada_b[i]
        shift, scale, gate = jnp.split(mod, 3, axis=-1)
        h = modulate(rmsnorm(x, norm_g[i]), shift, scale)
        j = i // 2
        if i % 2 == 0:
            out = even_mixer(h, ab_w_in[j], ab_conv_w[j], ab_ln_g[j], ab_ln_b[j],
                             ab_sgu_w[j], ab_sgu_b[j], ab_w_out[j])
        else:
            out = odd_mixer(h, c_w_in[j], c_pool_w[j], c_pool_scale[j], c_w_out[j])
        x = x + gate[:, None, :] * out
    return rmsnorm(x, final_g)
```

```cpp
#include <hip/hip_runtime.h>
#include <hip/hip_cooperative_groups.h>
#include <cstdio>
namespace cg = cooperative_groups;

#define LAS __attribute__((address_space(3)))
typedef unsigned short bf16_t;
typedef short bf16x8 __attribute__((ext_vector_type(8)));
typedef float f32x4 __attribute__((ext_vector_type(4)));
typedef unsigned u32x4 __attribute__((ext_vector_type(4)));
typedef unsigned u32x2 __attribute__((ext_vector_type(2)));

constexpr int DM = 1024, NB = 8, SEQ = 2048, MTOK = NB * SEQ;
constexpr int BM = 256, BK = 64, HALF = 128, HTB = HALF * BK * 2, STAGE_BYTES = 8 * HTB, NXCD = 8, WGM = 8;
constexpr int LDS_BYTES = STAGE_BYTES;
constexpr float EPS = 1e-6f;

constexpr size_t WS_MOD = 0;
constexpr size_t WS_WIN = 524288;
constexpr size_t WS_WOUT = WS_WIN + (size_t)7168 * 1024 * 2;
constexpr size_t WS_AUX = WS_WOUT + (size_t)1024 * 2048 * 2;
constexpr size_t WS_RA = WS_AUX + (size_t)4 * 512 * 512 * 2;
constexpr size_t WS_RP = WS_RA + (size_t)MTOK * 2048 * 2;
constexpr size_t WS_END = WS_RP + (size_t)MTOK * 4096 * 2;

struct Params {
    const float *x, *c, *norm_g, *ada_w, *ada_b, *ab_w_in, *ab_conv_w, *ab_ln_g, *ab_ln_b, *ab_sgu_w, *ab_sgu_b, *ab_w_out,
        *c_w_in, *c_pool_w, *c_pool_scale, *c_w_out, *final_g;
    float* out;
    unsigned char* ws;
};

__host__ __device__ __forceinline__ int lds_byte(int r, int c) { const int st = (r >> 4) * 2 + (c >> 5), rr = r & 15, cc = c & 31, ob = rr * 64 + cc * 2; return st * 1024 + (ob ^ (((ob >> 9) & 1) << 5)); }
__host__ __device__ __forceinline__ void stage_rc(int b, int& R, int& C) { const int st = b / 1024, sb = b % 1024, swz = sb ^ (((sb >> 9) & 1) << 5); R = (st >> 1) * 16 + swz / 64; C = (st & 1) * 32 + (swz % 64) / 2; }
__host__ __device__ __forceinline__ int perm32(int rho) { const int n = rho >> 4, i = rho & 15; return 8 * (i >> 2) + 4 * n + (i & 3); }
__device__ __forceinline__ unsigned cvt_pk_bf16(float lo, float hi) { unsigned r; asm volatile("v_cvt_pk_bf16_f32 %0, %1, %2" : "=v"(r) : "v"(lo), "v"(hi)); return r; }
__device__ __forceinline__ float bf_lo(unsigned w) { return __uint_as_float(w << 16); }
__device__ __forceinline__ float bf_hi(unsigned w) { return __uint_as_float(w & 0xffff0000u); }
__device__ __forceinline__ float silu_f(float v) { return v * __builtin_amdgcn_rcpf(1.f + __expf(-v)); }
__device__ __forceinline__ float wave_sum(float v) {
#pragma unroll
    for (int o = 1; o < 64; o <<= 1) v += __shfl_xor(v, o);
    return v;
}

__device__ __forceinline__ int opaque_tid() { int t = threadIdx.x; asm volatile("" : "+v"(t)); return t; }
__device__ __forceinline__ int opaque_bid() { int b = blockIdx.x; asm volatile("" : "+s"(b)); return b; }
struct Unit { int pm, pn; };
struct Gemm { const bf16_t* A; const bf16_t* Bt; int lda, ldb, K, nM, nN, gk; };

__device__ __forceinline__ bool next_unit(const Gemm& g, int bid, int i, Unit& u) {
    const int nwg = g.nM * g.nN;
    const long L = (long)i * gridDim.x + bid; if (L >= nwg) return false;
    int wgid = (int)L; { const int q = nwg / NXCD, r = nwg % NXCD, xcd = wgid % NXCD, off = wgid / NXCD; wgid = (xcd < r ? xcd * (q + 1) : r * (q + 1) + (xcd - r) * q) + off; }
    const int nig = WGM * g.nN, gid = wgid / nig, fm = gid * WGM, gsz = (g.nM - fm) < WGM ? (g.nM - fm) : WGM;
    u.pm = fm + ((wgid % nig) % gsz); u.pn = (wgid % nig) / gsz; return true;
}

struct EpiEven {
    static constexpr bool PERM = true;
    bf16_t* P;
    __device__ __forceinline__ void operator()(const f32x4 (&acc)[2][2][4][2], const Unit& u, int wr, int wc, int fr, int fq) const {
        const int row0 = u.pm * BM + wr * 64 + fr, T = u.pn;
        if (T < 24) {
            const int kind = T >> 3, Tl = T & 7;
            bf16_t* base = P + (size_t)kind * MTOK * 1024 + Tl * 128 + wc * 32 + 8 * fq;
#pragma unroll
            for (int ai = 0; ai < 2; ++ai)
#pragma unroll
                for (int m = 0; m < 4; ++m) {
                    bf16_t* rowp = base + (size_t)(row0 + ai * HALF + m * 16) * 1024;
                    f32x4 x0 = acc[ai][0][m][0], x1 = acc[ai][0][m][1], y0 = acc[ai][1][m][0], y1 = acc[ai][1][m][1];
                    if (kind != 0) {
#pragma unroll
                        for (int j = 0; j < 4; ++j) { y0[j] = silu_f(y0[j]); y1[j] = silu_f(y1[j]); }
                    }
                    x0 = x0 * y0; x1 = x1 * y1;
                    u32x4 w; w.x = cvt_pk_bf16(x0[0], x0[1]); w.y = cvt_pk_bf16(x0[2], x0[3]); w.z = cvt_pk_bf16(x1[0], x1[1]); w.w = cvt_pk_bf16(x1[2], x1[3]);
                    *(u32x4*)rowp = w;
                }
        } else {
            bf16_t* base = P + (size_t)3 * MTOK * 1024 + (T - 24) * 256 + wc * 32 + 8 * fq;
#pragma unroll
            for (int ai = 0; ai < 2; ++ai)
#pragma unroll
                for (int m = 0; m < 4; ++m) {
                    bf16_t* rowp = base + (size_t)(row0 + ai * HALF + m * 16) * 1024;
#pragma unroll
                    for (int bj = 0; bj < 2; ++bj) {
                        const f32x4 v0 = acc[ai][bj][m][0], v1 = acc[ai][bj][m][1];
                        u32x4 w; w.x = cvt_pk_bf16(v0[0], v0[1]); w.y = cvt_pk_bf16(v0[2], v0[3]); w.z = cvt_pk_bf16(v1[0], v1[1]); w.w = cvt_pk_bf16(v1[2], v1[3]);
                        *(u32x4*)(rowp + bj * HALF) = w;
                    }
                }
        }
    }
};
struct EpiOdd {
    static constexpr bool PERM = true;
    bf16_t* P; const float* pscale;
    __device__ __forceinline__ void operator()(const f32x4 (&acc)[2][2][4][2], const Unit& u, int wr, int wc, int fr, int fq) const {
        const int row0 = u.pm * BM + wr * 64 + fr, T = u.pn;
        const bool isz = T >= 8; const int Tl = T & 7, col0 = Tl * 256 + wc * 32 + 8 * fq;
        bf16_t* base = P + (isz ? (size_t)MTOK * 2048 : (size_t)0) + col0;
        f32x4 sc[2][2];
#pragma unroll
        for (int bj = 0; bj < 2; ++bj)
#pragma unroll
            for (int n = 0; n < 2; ++n) sc[bj][n] = isz ? *(const f32x4*)(pscale + col0 + bj * HALF + 4 * n) : (f32x4){1.f, 1.f, 1.f, 1.f};
#pragma unroll
        for (int ai = 0; ai < 2; ++ai)
#pragma unroll
            for (int m = 0; m < 4; ++m) {
                bf16_t* rowp = base + (size_t)(row0 + ai * HALF + m * 16) * 2048;
#pragma unroll
                for (int bj = 0; bj < 2; ++bj) {
                    f32x4 v0 = acc[ai][bj][m][0], v1 = acc[ai][bj][m][1];
                    if (isz) {
#pragma unroll
                        for (int j = 0; j < 4; ++j) { v0[j] = silu_f(v0[j]); v1[j] = silu_f(v1[j]); }
                        v0 = v0 * sc[bj][0]; v1 = v1 * sc[bj][1];
                    }
                    u32x4 w; w.x = cvt_pk_bf16(v0[0], v0[1]); w.y = cvt_pk_bf16(v0[2], v0[3]); w.z = cvt_pk_bf16(v1[0], v1[1]); w.w = cvt_pk_bf16(v1[2], v1[3]);
                    *(u32x4*)(rowp + bj * HALF) = w;
                }
            }
    }
};
struct EpiPool {
    static constexpr bool PERM = true;
    const bf16_t* SZ; bf16_t* Y;
    __device__ __forceinline__ void operator()(const f32x4 (&acc)[2][2][4][2], const Unit& u, int wr, int wc, int fr, int fq) const {
        const int row0 = u.pm * BM + wr * 64 + fr, col0 = u.pn * BM + wc * 32 + 8 * fq;
#pragma unroll
        for (int ai = 0; ai < 2; ++ai)
#pragma unroll
            for (int m = 0; m < 4; ++m) {
                const size_t ro = (size_t)(row0 + ai * HALF + m * 16) * 2048 + col0;
#pragma unroll
                for (int bj = 0; bj < 2; ++bj) {
                    const u32x4 s = *(const u32x4*)(SZ + ro + bj * HALF);
                    const f32x4 v0 = acc[ai][bj][m][0], v1 = acc[ai][bj][m][1];
                    u32x4 w; w.x = cvt_pk_bf16(v0[0] * bf_lo(s.x), v0[1] * bf_hi(s.x)); w.y = cvt_pk_bf16(v0[2] * bf_lo(s.y), v0[3] * bf_hi(s.y));
                    w.z = cvt_pk_bf16(v1[0] * bf_lo(s.z), v1[1] * bf_hi(s.z)); w.w = cvt_pk_bf16(v1[2] * bf_lo(s.w), v1[3] * bf_hi(s.w));
                    *(u32x4*)(Y + ro + bj * HALF) = w;
                }
            }
    }
};
struct EpiRes {
    static constexpr bool PERM = false;
    const float* xin; float* xout; const float* gate;
    __device__ __forceinline__ void operator()(const f32x4 (&acc)[2][2][4][2], const Unit& u, int wr, int wc, int fr, int fq) const {
        const int row0 = u.pm * BM + wr * 64 + fr, col0 = u.pn * BM + wc * 32 + 4 * fq;
        const float* gp = gate + (size_t)(u.pm >> 3) * 3072 + col0;
        f32x4 gv[2][2];
#pragma unroll
        for (int bj = 0; bj < 2; ++bj)
#pragma unroll
            for (int n = 0; n < 2; ++n) gv[bj][n] = *(const f32x4*)(gp + bj * HALF + n * 16);
#pragma unroll
        for (int ai = 0; ai < 2; ++ai)
#pragma unroll
            for (int m = 0; m < 4; ++m) {
                const size_t ro = (size_t)(row0 + ai * HALF + m * 16) * DM + col0;
#pragma unroll
                for (int bj = 0; bj < 2; ++bj)
#pragma unroll
                    for (int n = 0; n < 2; ++n) {
                        const f32x4 xv = *(const f32x4*)(xin + ro + bj * HALF + n * 16);
                        *(f32x4*)(xout + ro + bj * HALF + n * 16) = xv + gv[bj][n] * acc[ai][bj][m][n];
                    }
            }
    }
};

template <class Epi>
__device__ __forceinline__ void gemm_phase(LAS unsigned char* lds, const Gemm g, const Epi& E) {
    const int tid = opaque_tid(), wid = __builtin_amdgcn_readfirstlane(tid >> 6), lane = tid & 63, wr = wid >> 2, wc = wid & 3, fr = lane & 15, fq = lane >> 4;
    const int nt = g.K / BK;
    unsigned voffA[2], voffB[2];
#pragma unroll
    for (int i = 0; i < 2; ++i) { int R, C; stage_rc(tid * 16 + i * 8192, R, C); const int Rb = Epi::PERM ? ((R & ~31) + perm32(R & 31)) : R;
        voffA[i] = (unsigned)(R * g.lda + C) * 2u; voffB[i] = (unsigned)(Rb * g.ldb + C) * 2u; }
    const size_t kstep = (size_t)(BK * 2);
    const size_t hstepA = (size_t)HALF * g.lda * 2, hstepB = (size_t)HALF * g.ldb * 2;
    const unsigned ldsw = (unsigned)wid * 1024u;
    const int aoff = lds_byte(wr * 64 + fr, fq * 8), boff = lds_byte(wc * 32 + fr, fq * 8);
#define PG8_SA(b, h) (((b) * 2 + (h)) * HTB)
#define PG8_SB(b, h) ((4 + (b) * 2 + (h)) * HTB)
#define PG8_STAGE(bufoff, gbase, voff) do { _Pragma("unroll") for (int _i = 0; _i < 2; ++_i) \
        __builtin_amdgcn_global_load_lds((const unsigned*)((const char*)(gbase) + (voff)[_i]), (LAS unsigned*)(lds + (bufoff) + ldsw + _i * 8192), 16, 0, 0); } while (0)
#define PG8_LDA(dst, b, h) do { _Pragma("unroll") for (int m = 0; m < 4; ++m) _Pragma("unroll") for (int k = 0; k < 2; ++k) dst[m][k] = *(const LAS bf16x8*)(lds + PG8_SA(b, h) + aoff + m * 2048 + k * 1024); } while (0)
#define PG8_LDB(dst, b, h) do { _Pragma("unroll") for (int n = 0; n < 2; ++n) _Pragma("unroll") for (int k = 0; k < 2; ++k) dst[n][k] = *(const LAS bf16x8*)(lds + PG8_SB(b, h) + boff + n * 2048 + k * 1024); } while (0)
#define PG8_MMA(ai, bj, At, Bt) do { __builtin_amdgcn_s_setprio(1); _Pragma("unroll") for (int m = 0; m < 4; ++m) _Pragma("unroll") for (int n = 0; n < 2; ++n) _Pragma("unroll") for (int k = 0; k < 2; ++k) \
        acc[ai][bj][m][n] = __builtin_amdgcn_mfma_f32_16x16x32_bf16(Bt[n][k], At[m][k], acc[ai][bj][m][n], 0, 0, 0); __builtin_amdgcn_s_setprio(0); } while (0)
#define PG8_WAIT_V(n) asm volatile("s_waitcnt vmcnt(" #n ")" ::: "memory")
#define PG8_WAIT_L(n) asm volatile("s_waitcnt lgkmcnt(" #n ")" ::: "memory")
#define PG8_BAR __builtin_amdgcn_s_barrier()
#define PG8_SCHED __builtin_amdgcn_sched_barrier(0)
    Unit cur, nxt; int ui = 0;
    const int bid = opaque_bid();
    if (!next_unit(g, bid, 0, cur)) return;
    f32x4 acc[2][2][4][2];
#pragma unroll
    for (int a = 0; a < 2; ++a)
#pragma unroll
        for (int b = 0; b < 2; ++b)
#pragma unroll
            for (int m = 0; m < 4; ++m)
#pragma unroll
                for (int n = 0; n < 2; ++n) acc[a][b][m][n] = (f32x4){0.f, 0.f, 0.f, 0.f};
    bf16x8 At[4][2], B0[2][2], B1[2][2];
    const char* cA = (const char*)g.A + (size_t)cur.pm * 2 * hstepA + (size_t)(cur.pn >> 1) * g.gk * 2; const char* cB = (const char*)g.Bt + (size_t)cur.pn * 2 * hstepB;
    PG8_STAGE(PG8_SB(0, 0), cB, voffB); PG8_STAGE(PG8_SA(0, 0), cA, voffA); PG8_STAGE(PG8_SB(0, 1), cB + hstepB, voffB); PG8_STAGE(PG8_SA(0, 1), cA + hstepA, voffA);
    if (wr == 1) PG8_BAR;
    PG8_WAIT_V(4); PG8_BAR;
    PG8_STAGE(PG8_SB(1, 0), cB + kstep, voffB); PG8_STAGE(PG8_SA(1, 0), cA + kstep, voffA); PG8_STAGE(PG8_SB(1, 1), cB + hstepB + kstep, voffB);
    PG8_WAIT_V(6); PG8_BAR;
    for (;;) {
        const bool has_next = next_unit(g, bid, ui + 1, nxt);
        const char* nA = has_next ? (const char*)g.A + (size_t)nxt.pm * 2 * hstepA + (size_t)(nxt.pn >> 1) * g.gk * 2 : cA;
        const char* nB = has_next ? (const char*)g.Bt + (size_t)nxt.pn * 2 * hstepB : cB;
        for (int t = 0; t < nt; t += 2) {
            const bool last = (t == nt - 2);
            const char* a1 = cA + (size_t)(t + 1) * kstep;
            const char* a2 = last ? nA : cA + (size_t)(t + 2) * kstep; const char* b2 = last ? nB : cB + (size_t)(t + 2) * kstep;
            const char* a3 = a2 + kstep; const char* b3 = b2 + kstep;
            PG8_LDB(B0, 0, 0); PG8_SCHED; PG8_LDA(At, 0, 0); PG8_STAGE(PG8_SA(1, 1), a1 + hstepA, voffA);
            PG8_WAIT_L(8); PG8_BAR; PG8_WAIT_L(0); PG8_MMA(0, 0, At, B0); PG8_BAR; PG8_SCHED;
            PG8_LDB(B1, 0, 1); PG8_STAGE(PG8_SB(0, 0), b2, voffB);
            PG8_BAR; PG8_WAIT_L(0); PG8_MMA(0, 1, At, B1); PG8_BAR;
            PG8_LDA(At, 0, 1); PG8_STAGE(PG8_SA(0, 0), a2, voffA);
            PG8_BAR; PG8_WAIT_L(0); PG8_MMA(1, 0, At, B0); PG8_BAR; PG8_SCHED;
            PG8_STAGE(PG8_SB(0, 1), b2 + hstepB, voffB);
            PG8_WAIT_V(6); PG8_BAR; PG8_MMA(1, 1, At, B1); PG8_BAR;
            PG8_LDB(B0, 1, 0); PG8_SCHED; PG8_LDA(At, 1, 0); PG8_STAGE(PG8_SA(0, 1), a2 + hstepA, voffA);
            PG8_WAIT_L(8); PG8_BAR; PG8_WAIT_L(0); PG8_MMA(0, 0, At, B0); PG8_BAR; PG8_SCHED;
            PG8_LDB(B1, 1, 1); PG8_STAGE(PG8_SB(1, 0), b3, voffB);
            PG8_BAR; PG8_WAIT_L(0); PG8_MMA(0, 1, At, B1); PG8_BAR;
            PG8_LDA(At, 1, 1); PG8_STAGE(PG8_SA(1, 0), a3, voffA);
            PG8_BAR; PG8_WAIT_L(0); PG8_MMA(1, 0, At, B0); PG8_BAR; PG8_SCHED;
            PG8_STAGE(PG8_SB(1, 1), b3 + hstepB, voffB);
            PG8_WAIT_V(6); PG8_BAR; PG8_MMA(1, 1, At, B1); PG8_BAR;
        }
        E(acc, cur, wr, wc, fr, fq);
        if (!has_next) break;
#pragma unroll
        for (int a = 0; a < 2; ++a)
#pragma unroll
            for (int b = 0; b < 2; ++b)
#pragma unroll
                for (int m = 0; m < 4; ++m)
#pragma unroll
                    for (int n = 0; n < 2; ++n) acc[a][b][m][n] = (f32x4){0.f, 0.f, 0.f, 0.f};
        cur = nxt; cA = nA; cB = nB; ++ui;
    }
    PG8_WAIT_V(0);
    if (wr == 0) PG8_BAR;
    PG8_BAR;
#undef PG8_SA
#undef PG8_SB
#undef PG8_STAGE
#undef PG8_LDA
#undef PG8_LDB
#undef PG8_MMA
#undef PG8_WAIT_V
#undef PG8_WAIT_L
#undef PG8_BAR
#undef PG8_SCHED
}

__device__ __forceinline__ void phase_mod(const Params& p, LAS unsigned char* lds) {
    const int tid = opaque_tid(), wid = tid >> 6, lane = tid & 63;
    LAS float* sc = (LAS float*)lds;
    LAS float* red = (LAS float*)(lds + 32768);
    float* mod = (float*)(p.ws + WS_MOD);
    for (int t = tid; t < NB * DM; t += 512) sc[t] = silu_f(p.c[t]);
    __syncthreads();
    for (int it = opaque_bid(); it < 192; it += gridDim.x) {
        const int col = it * 64 + lane, i = col / 3072, j = col - i * 3072;
        const float* w = p.ada_w + ((size_t)i * DM + wid * 128) * 3072 + j;
        float a[8];
#pragma unroll
        for (int b = 0; b < 8; ++b) a[b] = 0.f;
#pragma unroll 4
        for (int k = 0; k < 128; ++k) {
            const float wv = w[(size_t)k * 3072];
#pragma unroll
            for (int b = 0; b < 8; ++b) a[b] += sc[b * DM + wid * 128 + k] * wv;
        }
#pragma unroll
        for (int b = 0; b < 8; ++b) red[(wid * 8 + b) * 64 + lane] = a[b];
        __syncthreads();
        {
            const int b = tid >> 6; float s = 0.f;
#pragma unroll
            for (int w8 = 0; w8 < 8; ++w8) s += red[(w8 * 8 + b) * 64 + lane];
            mod[((size_t)i * NB + b) * 3072 + j] = s + p.ada_b[i * 3072 + j];
        }
        __syncthreads();
    }
}

__device__ __forceinline__ void conv_tile(const float* __restrict__ src, int srcN, int c0, bf16_t* __restrict__ dstrow, int K, int k0, LAS float* T) {
    const int tid = opaque_tid();
#pragma unroll
    for (int ps = 0; ps < 4; ++ps) {
        const int k = ps * 32 + (tid >> 4), c = (tid & 15) * 4;
        const f32x4 v = *(const f32x4*)(src + (size_t)(k0 + k) * srcN + c0 + c);
        LAS float* t = T + k * 65 + c; t[0] = v[0]; t[1] = v[1]; t[2] = v[2]; t[3] = v[3];
    }
    __syncthreads();
#pragma unroll
    for (int q = 0; q < 2; ++q) {
        const int item = tid + 512 * q, n = item >> 4, kg = item & 15; const LAS float* s = T + (kg * 8) * 65 + n;
        u32x4 o; o.x = cvt_pk_bf16(s[0], s[65]); o.y = cvt_pk_bf16(s[130], s[195]); o.z = cvt_pk_bf16(s[260], s[325]); o.w = cvt_pk_bf16(s[390], s[455]);
        *(u32x4*)(dstrow + (size_t)n * K + k0 + kg * 8) = o;
    }
    __syncthreads();
}

__device__ __forceinline__ void phase_norm(const Params& p, int layer, const float* xin, LAS unsigned char* lds) {
    const int tid = opaque_tid(), wid = tid >> 6, lane = tid & 63, j = layer >> 1;
    const bool even = (layer & 1) == 0;
    bf16_t* WIN = (bf16_t*)(p.ws + WS_WIN); bf16_t* WOUT = (bf16_t*)(p.ws + WS_WOUT); bf16_t* AUX = (bf16_t*)(p.ws + WS_AUX);
    bf16_t* H = (bf16_t*)(p.ws + WS_RA);
    const float* mod = (const float*)(p.ws + WS_MOD) + (size_t)layer * NB * 3072;
    const int n_in = even ? 896 : 512, n_out = 256, n_aux = even ? 32 : 128, n_conv = n_in + n_out + n_aux;
    const int total = n_conv + MTOK / 8;
    for (int it = opaque_bid(); it < total; it += gridDim.x) {
        if (it < n_in) {
            const int rt = it >> 3, kt = it & 7, r0 = rt * 64;
            int c0 = r0; const float* src; int srcN;
            if (even) {
                const int T = r0 >> 8, q = r0 & 255;
                if (T < 8) c0 = (q < 128) ? (2048 + 128 * T + q) : (128 * T + q - 128);
                else if (T < 16) c0 = (q < 128) ? (1024 + 128 * (T - 8) + q) : (3072 + 128 * (T - 8) + q - 128);
                else if (T < 24) c0 = (q < 128) ? (4096 + 128 * (T - 16) + q) : (6144 + 128 * (T - 16) + q - 128);
                else c0 = 5120 + 256 * (T - 24) + q;
                src = p.ab_w_in + (size_t)j * DM * 7168; srcN = 7168;
            } else { src = p.c_w_in + (size_t)j * DM * 4096; srcN = 4096; }
            conv_tile(src, srcN, c0, WIN + (size_t)r0 * DM, DM, kt * 128, (LAS float*)lds);
        } else if (it < n_in + n_out) {
            const int i2 = it - n_in, rt = i2 >> 4, kt = i2 & 15, r0 = rt * 64;
            const float* src = (even ? p.ab_w_out : p.c_w_out) + (size_t)j * 2048 * DM;
            conv_tile(src, DM, r0, WOUT + (size_t)r0 * 2048, 2048, kt * 128, (LAS float*)lds);
        } else if (it < n_conv) {
            const int i3 = it - n_in - n_out;
            if (even) {
                const int e0 = i3 * 4096 + tid * 8, t = (e0 >> 7) & 127, s0 = e0 & 127;
                const float* src = p.ab_sgu_w + (size_t)j * 8 * 128 * 128 + e0;
                const f32x4 a = *(const f32x4*)src, b = *(const f32x4*)(src + 4);
                float v[8] = {a[0], a[1], a[2], a[3], b[0], b[1], b[2], b[3]};
#pragma unroll
                for (int e = 0; e < 8; ++e) v[e] = (s0 + e <= t) ? v[e] : 0.f;
                u32x4 o; o.x = cvt_pk_bf16(v[0], v[1]); o.y = cvt_pk_bf16(v[2], v[3]); o.z = cvt_pk_bf16(v[4], v[5]); o.w = cvt_pk_bf16(v[6], v[7]);
                *(u32x4*)(AUX + e0) = o;
            } else {
                const int g = i3 >> 5, r = i3 & 31, rt = r >> 2, kt = r & 3, r0 = rt * 64;
                const float* src = p.c_pool_w + ((size_t)j * 4 + g) * 512 * 512;
                conv_tile(src, 512, r0, AUX + (size_t)g * 512 * 512 + (size_t)r0 * 512, 512, kt * 128, (LAS float*)lds);
            }
        } else {
            const int row = (it - n_conv) * 8 + wid, b = row >> 11;
            const f32x4* xr = (const f32x4*)(xin + (size_t)row * DM) + lane;
            f32x4 v[4]; float ss = 0.f;
#pragma unroll
            for (int q = 0; q < 4; ++q) { v[q] = xr[64 * q]; ss += (v[q][0] * v[q][0] + v[q][1] * v[q][1]) + (v[q][2] * v[q][2] + v[q][3] * v[q][3]); }
            const float rstd = rsqrtf(wave_sum(ss) * (1.f / DM) + EPS);
            const float* gp = p.norm_g + (size_t)layer * DM; const float* mb = mod + (size_t)b * 3072;
            u32x2* o8 = (u32x2*)(H + (size_t)row * DM) + lane;
#pragma unroll
            for (int q = 0; q < 4; ++q) {
                const int k = (lane + 64 * q) * 4;
                const f32x4 gv = *(const f32x4*)(gp + k), sh = *(const f32x4*)(mb + k), scl = *(const f32x4*)(mb + 1024 + k);
                const f32x4 hv = (v[q] * rstd * gv) * (scl + 1.f) + sh;
                u32x2 w; w.x = cvt_pk_bf16(hv[0], hv[1]); w.y = cvt_pk_bf16(hv[2], hv[3]);
                o8[64 * q] = w;
            }
        }
    }
}

__device__ __forceinline__ void phase_final(const Params& p) {
    const int tid = opaque_tid(), wid = tid >> 6, lane = tid & 63;
    for (int it = opaque_bid(); it < MTOK / 8; it += gridDim.x) {
        const int row = it * 8 + wid;
        f32x4* xr = (f32x4*)(p.out + (size_t)row * DM) + lane;
        f32x4 v[4]; float ss = 0.f;
#pragma unroll
        for (int q = 0; q < 4; ++q) { v[q] = xr[64 * q]; ss += (v[q][0] * v[q][0] + v[q][1] * v[q][1]) + (v[q][2] * v[q][2] + v[q][3] * v[q][3]); }
        const float rstd = rsqrtf(wave_sum(ss) * (1.f / DM) + EPS);
#pragma unroll
        for (int q = 0; q < 4; ++q) { const f32x4 gv = *(const f32x4*)(p.final_g + (lane + 64 * q) * 4); xr[64 * q] = v[q] * rstd * gv; }
    }
}

__device__ __forceinline__ void unpack8(const u32x4 w, float (&f)[8]) {
    f[0] = bf_lo(w.x); f[1] = bf_hi(w.x); f[2] = bf_lo(w.y); f[3] = bf_hi(w.y); f[4] = bf_lo(w.z); f[5] = bf_hi(w.z); f[6] = bf_lo(w.w); f[7] = bf_hi(w.w);
}

__device__ __forceinline__ void phase_mix(const Params& p, int j, LAS unsigned char* lds) {
    const int tid = opaque_tid(), wid = tid >> 6, lane = tid & 63;
    const bf16_t* CH2 = (const bf16_t*)(p.ws + WS_RP); const bf16_t* BZ = CH2 + (size_t)MTOK * 1024; const bf16_t* UZ = BZ + (size_t)MTOK * 1024; const bf16_t* V = UZ + (size_t)MTOK * 1024;
    bf16_t* Y = (bf16_t*)(p.ws + WS_RA);
    {
        const bf16_t* Wm = (const bf16_t*)(p.ws + WS_AUX);
        LAS bf16_t* vnT = (LAS bf16_t*)lds;
        LAS float* red = (LAS float*)(lds + 36864);
        const int fr = lane & 15, fq = lane >> 4;
        for (int it = opaque_bid(); it < 1024; it += gridDim.x) {
            const int hh = it & 7, cn = it >> 3;
            const int s = lane + 64 * (wid & 1), q = wid >> 1;
            const bf16_t* vp = V + (size_t)(cn * 128 + s) * 1024 + hh * 128 + 32 * q;
            float f[32];
#pragma unroll
            for (int i = 0; i < 4; ++i) { const u32x4 w = *(const u32x4*)(vp + 8 * i); float t8[8]; unpack8(w, t8);
#pragma unroll
                for (int e = 0; e < 8; ++e) f[8 * i + e] = t8[e]; }
            float s1 = 0.f, s2 = 0.f;
#pragma unroll
            for (int i = 0; i < 32; ++i) { s1 += f[i]; s2 += f[i] * f[i]; }
            red[(s * 4 + q) * 2] = s1; red[(s * 4 + q) * 2 + 1] = s2;
            __syncthreads();
            float S1 = 0.f, S2 = 0.f;
#pragma unroll
            for (int qq = 0; qq < 4; ++qq) { S1 += red[(s * 4 + qq) * 2]; S2 += red[(s * 4 + qq) * 2 + 1]; }
            const float mu = S1 * (1.f / 128.f), var = fmaxf(S2 * (1.f / 128.f) - mu * mu, 0.f), rstd = rsqrtf(var + EPS);
            const float* lg = p.ab_ln_g + (size_t)j * 1024 + hh * 128 + 32 * q; const float* lb = p.ab_ln_b + (size_t)j * 1024 + hh * 128 + 32 * q;
#pragma unroll
            for (int i = 0; i < 32; ++i) {
                const float vn = (f[i] - mu) * rstd * lg[i] + lb[i];
                vnT[(32 * q + i) * 136 + s] = (bf16_t)(cvt_pk_bf16(vn, 0.f) & 0xffffu);
            }
            __syncthreads();
            f32x4 acc[8];
#pragma unroll
            for (int n = 0; n < 8; ++n) acc[n] = (f32x4){0.f, 0.f, 0.f, 0.f};
            const bf16_t* wrow = Wm + ((size_t)hh * 128 + 16 * wid + fr) * 128 + 8 * fq;
#pragma unroll
            for (int kk = 0; kk < 4; ++kk) {
                if (32 * kk <= 16 * wid + 15) {
                    const bf16x8 af = *(const bf16x8*)(wrow + 32 * kk);
#pragma unroll
                    for (int n = 0; n < 8; ++n) {
                        const bf16x8 bfm = *(const LAS bf16x8*)(vnT + (16 * n + fr) * 136 + 32 * kk + 8 * fq);
                        acc[n] = __builtin_amdgcn_mfma_f32_16x16x32_bf16(bfm, af, acc[n], 0, 0, 0);
                    }
                }
            }
            const int t = 16 * wid + fr; const size_t row = (size_t)cn * 128 + t;
            const float bias = p.ab_sgu_b[(size_t)j * 1024 + hh * 128 + t];
#pragma unroll
            for (int n = 0; n < 8; ++n) {
                const int d = 16 * n + 4 * fq;
                const u32x2 uz = *(const u32x2*)(UZ + row * 1024 + hh * 128 + d);
                u32x2 w; w.x = cvt_pk_bf16(bf_lo(uz.x) * (acc[n][0] + bias), bf_hi(uz.x) * (acc[n][1] + bias));
                w.y = cvt_pk_bf16(bf_lo(uz.y) * (acc[n][2] + bias), bf_hi(uz.y) * (acc[n][3] + bias));
                *(u32x2*)(Y + row * 2048 + 1024 + hh * 128 + d) = w;
            }
        }
    }
    {
        const float* cw = p.ab_conv_w + (size_t)j * 3 * 1024;
        for (int it = opaque_bid(); it < 256; it += gridDim.x) {
            const int rg = it * 4 + (tid >> 7), c0 = (tid & 127) * 8, t0 = rg * 16;
            float w0[8], w1[8], w2[8], p2[8], p1[8];
#pragma unroll
            for (int h4 = 0; h4 < 2; ++h4) {
                const f32x4 a = *(const f32x4*)(cw + c0 + 4 * h4), b = *(const f32x4*)(cw + 1024 + c0 + 4 * h4), c = *(const f32x4*)(cw + 2048 + c0 + 4 * h4);
#pragma unroll
                for (int e = 0; e < 4; ++e) { w0[4 * h4 + e] = a[e]; w1[4 * h4 + e] = b[e]; w2[4 * h4 + e] = c[e]; }
            }
            if ((t0 & (SEQ - 1)) != 0) {
                unpack8(*(const u32x4*)(CH2 + (size_t)(t0 - 2) * 1024 + c0), p2);
                unpack8(*(const u32x4*)(CH2 + (size_t)(t0 - 1) * 1024 + c0), p1);
            } else {
#pragma unroll
                for (int e = 0; e < 8; ++e) { p2[e] = 0.f; p1[e] = 0.f; }
            }
#pragma unroll 4
            for (int r = 0; r < 16; ++r) {
                float cur[8], bz[8], o[8];
                unpack8(*(const u32x4*)(CH2 + (size_t)(t0 + r) * 1024 + c0), cur);
                unpack8(*(const u32x4*)(BZ + (size_t)(t0 + r) * 1024 + c0), bz);
#pragma unroll
                for (int e = 0; e < 8; ++e) { o[e] = bz[e] * (w0[e] * p2[e] + w1[e] * p1[e] + w2[e] * cur[e]); p2[e] = p1[e]; p1[e] = cur[e]; }
                u32x4 w; w.x = cvt_pk_bf16(o[0], o[1]); w.y = cvt_pk_bf16(o[2], o[3]); w.z = cvt_pk_bf16(o[4], o[5]); w.w = cvt_pk_bf16(o[6], o[7]);
                *(u32x4*)(Y + (size_t)(t0 + r) * 2048 + c0) = w;
            }
        }
    }
}

__device__ __forceinline__ void phase_pool(const Params& p) {
    const int tid = opaque_tid();
    const bf16_t* PP = (const bf16_t*)(p.ws + WS_RP); bf16_t* PO = (bf16_t*)(p.ws + WS_RA);
    for (int it = opaque_bid(); it < 256; it += gridDim.x) {
        const int rg = it * 2 + (tid >> 8), ct = tid & 255, c0 = ct * 8, win = 2 << (ct >> 6), t0 = rg * 32, tl0 = t0 & (SEQ - 1);
        float S[8];
#pragma unroll
        for (int e = 0; e < 8; ++e) S[e] = 0.f;
        for (int i = 1; i < win; ++i) {
            if (tl0 - i >= 0) { float v[8]; unpack8(*(const u32x4*)(PP + (size_t)(t0 - i) * 2048 + c0), v);
#pragma unroll
                for (int e = 0; e < 8; ++e) S[e] += v[e]; }
        }
#pragma unroll 4
        for (int r = 0; r < 32; ++r) {
            const int tl = tl0 + r;
            float cur[8], o[8];
            unpack8(*(const u32x4*)(PP + (size_t)(t0 + r) * 2048 + c0), cur);
            const float inv = 1.f / (float)min(tl + 1, win);
#pragma unroll
            for (int e = 0; e < 8; ++e) { S[e] += cur[e]; o[e] = S[e] * inv - cur[e]; }
            u32x4 w; w.x = cvt_pk_bf16(o[0], o[1]); w.y = cvt_pk_bf16(o[2], o[3]); w.z = cvt_pk_bf16(o[4], o[5]); w.w = cvt_pk_bf16(o[6], o[7]);
            *(u32x4*)(PO + (size_t)(t0 + r) * 2048 + c0) = w;
            if (tl - win + 1 >= 0) { float old[8]; unpack8(*(const u32x4*)(PP + (size_t)(t0 + r - win + 1) * 2048 + c0), old);
#pragma unroll
                for (int e = 0; e < 8; ++e) S[e] -= old[e]; }
        }
    }
}

__global__ void __launch_bounds__(512, 2) mega_fwd(Params p, int ph_lo, int ph_hi) {
    extern __shared__ __attribute__((aligned(16))) unsigned char smem[];
    LAS unsigned char* lds = (LAS unsigned char*)smem;
    cg::grid_group grid = cg::this_grid();
    int ph = 0;
#define PHASE(...) do { if (ph >= ph_lo && ph < ph_hi) { __VA_ARGS__; if (ph + 1 < ph_hi) grid.sync(); } ++ph; } while (0)
    bf16_t* RA = (bf16_t*)(p.ws + WS_RA); bf16_t* RP = (bf16_t*)(p.ws + WS_RP);
    const bf16_t* WIN = (const bf16_t*)(p.ws + WS_WIN); const bf16_t* WOUT = (const bf16_t*)(p.ws + WS_WOUT); const bf16_t* AUX = (const bf16_t*)(p.ws + WS_AUX);
    const float* mod = (const float*)(p.ws + WS_MOD);
    PHASE(phase_mod(p, lds));
#pragma unroll 1
    for (int lp = 0; lp < 2; ++lp) {
        {
            const int layer = 2 * lp; const float* xin = (lp == 0) ? p.x : p.out;
            PHASE(phase_norm(p, layer, xin, lds));
            PHASE({ Gemm g{RA, WIN, DM, DM, DM, MTOK / BM, 7168 / BM, 0}; EpiEven E{RP}; gemm_phase(lds, g, E); });
            PHASE(phase_mix(p, lp, lds));
            PHASE({ Gemm g{RA, WOUT, 2048, 2048, 2048, MTOK / BM, DM / BM, 0}; EpiRes E{xin, p.out, mod + (size_t)layer * NB * 3072 + 2048}; gemm_phase(lds, g, E); });
        }
        {
            const int layer = 2 * lp + 1;
            PHASE(phase_norm(p, layer, p.out, lds));
            PHASE({ Gemm g{RA, WIN, DM, DM, DM, MTOK / BM, 4096 / BM, 0}; EpiOdd E{RP, p.c_pool_scale + (size_t)lp * 2048}; gemm_phase(lds, g, E); });
            PHASE(phase_pool(p));
            PHASE({ Gemm g{RA, AUX, 2048, 512, 512, MTOK / BM, 2048 / BM, 512}; EpiPool E{RP + (size_t)MTOK * 2048, RP}; gemm_phase(lds, g, E); });
            PHASE({ Gemm g{RP, WOUT, 2048, 2048, 2048, MTOK / BM, DM / BM, 0}; EpiRes E{p.out, p.out, mod + (size_t)layer * NB * 3072 + 2048}; gemm_phase(lds, g, E); });
        }
    }
    PHASE(phase_final(p));
#undef PHASE
}

extern "C" void kernel_launch(void* const* d_in, const int* in_sizes, int n_in, void* d_out, int out_size, void* d_ws, size_t ws_size, hipStream_t stream) {
    static int grid = 0;
    if (grid == 0) {
        if (n_in != 17 || out_size != MTOK * DM || ws_size < WS_END) { fprintf(stderr, "kernel_launch: unexpected shapes (n_in %d out %d ws %zu need %zu)\n", n_in, out_size, ws_size, (size_t)WS_END); grid = -1; return; }
        int dev = 0, cus = 0, per_cu = 0;
        hipGetDevice(&dev);
        hipDeviceGetAttribute(&cus, hipDeviceAttributeMultiprocessorCount, dev);
        if (hipFuncSetAttribute((const void*)mega_fwd, hipFuncAttributeMaxDynamicSharedMemorySize, LDS_BYTES) != hipSuccess) { fprintf(stderr, "kernel_launch: hipFuncSetAttribute failed\n"); grid = -1; return; }
        hipOccupancyMaxActiveBlocksPerMultiprocessor(&per_cu, (const void*)mega_fwd, 512, LDS_BYTES);
        if (per_cu < 1) { fprintf(stderr, "kernel_launch: occupancy query says %d blocks per CU\n", per_cu); per_cu = 1; }
        (void)hipGetLastError();
        grid = cus;
    }
    if (grid < 0) return;
    Params p{};
    p.x = (const float*)d_in[0]; p.c = (const float*)d_in[1]; p.norm_g = (const float*)d_in[2]; p.ada_w = (const float*)d_in[3]; p.ada_b = (const float*)d_in[4];
    p.ab_w_in = (const float*)d_in[5]; p.ab_conv_w = (const float*)d_in[6]; p.ab_ln_g = (const float*)d_in[7]; p.ab_ln_b = (const float*)d_in[8];
    p.ab_sgu_w = (const float*)d_in[9]; p.ab_sgu_b = (const float*)d_in[10]; p.ab_w_out = (const float*)d_in[11];
    p.c_w_in = (const float*)d_in[12]; p.c_pool_w = (const float*)d_in[13]; p.c_pool_scale = (const float*)d_in[14]; p.c_w_out = (const float*)d_in[15]; p.final_g = (const float*)d_in[16];
    p.out = (float*)d_out; p.ws = (unsigned char*)d_ws;
    int lo = 0, hi = 1000;
    void* args[] = {&p, &lo, &hi};
    hipError_t e = hipLaunchCooperativeKernel((const void*)mega_fwd, dim3(grid), dim3(512), args, LDS_BYTES, stream);
    if (e != hipSuccess) fprintf(stderr, "kernel_launch: cooperative launch failed: %s (grid %d)\n", hipGetErrorString(e), grid);
}
```

```cpp
#include <hip/hip_runtime.h>
#include <hip/hip_cooperative_groups.h>
#include <cstdio>
namespace cg = cooperative_groups;

#define LAS __attribute__((address_space(3)))
typedef unsigned short bf16_t;
typedef short bf16x8 __attribute__((ext_vector_type(8)));
typedef float f32x4 __attribute__((ext_vector_type(4)));
typedef unsigned u32x4 __attribute__((ext_vector_type(4)));
typedef unsigned u32x2 __attribute__((ext_vector_type(2)));

constexpr int DM = 1024, NB = 8, SEQ = 2048, MTOK = NB * SEQ;
constexpr int BM = 256, BK = 64, HALF = 128, HTB = HALF * BK * 2, STAGE_BYTES = 8 * HTB, NXCD = 8, WGM = 8;
constexpr int LDS_BYTES = STAGE_BYTES + 16;
constexpr float EPS = 1e-6f;

constexpr size_t WS_MOD = 0;
constexpr size_t WS_BAR = 393216;
constexpr size_t WS_WIN = 524288;
constexpr size_t WS_WOUT = WS_WIN + (size_t)7168 * 1024 * 2;
constexpr size_t WS_AUX = WS_WOUT + (size_t)1024 * 2048 * 2;
constexpr size_t WS_RA = WS_AUX + (size_t)4 * 512 * 512 * 2;
constexpr size_t WS_RP = WS_RA + (size_t)MTOK * 2048 * 2;
constexpr size_t WS_END = WS_RP + (size_t)MTOK * 4096 * 2;

struct Params {
    const float *x, *c, *norm_g, *ada_w, *ada_b, *ab_w_in, *ab_conv_w, *ab_ln_g, *ab_ln_b, *ab_sgu_w, *ab_sgu_b, *ab_w_out,
        *c_w_in, *c_pool_w, *c_pool_scale, *c_w_out, *final_g;
    float* out;
    unsigned char* ws;
};

__host__ __device__ __forceinline__ int lds_byte(int r, int c) { const int st = (r >> 4) * 2 + (c >> 5), rr = r & 15, cc = c & 31, ob = rr * 64 + cc * 2; return st * 1024 + (ob ^ (((ob >> 9) & 1) << 5)); }
__host__ __device__ __forceinline__ void stage_rc(int b, int& R, int& C) { const int st = b / 1024, sb = b % 1024, swz = sb ^ (((sb >> 9) & 1) << 5); R = (st >> 1) * 16 + swz / 64; C = (st & 1) * 32 + (swz % 64) / 2; }
__host__ __device__ __forceinline__ int perm32(int rho) { const int n = rho >> 4, i = rho & 15; return 8 * (i >> 2) + 4 * n + (i & 3); }
__device__ __forceinline__ unsigned cvt_pk_bf16(float lo, float hi) { unsigned r; asm volatile("v_cvt_pk_bf16_f32 %0, %1, %2" : "=v"(r) : "v"(lo), "v"(hi)); return r; }
__device__ __forceinline__ float bf_lo(unsigned w) { return __uint_as_float(w << 16); }
__device__ __forceinline__ float bf_hi(unsigned w) { return __uint_as_float(w & 0xffff0000u); }
__device__ __forceinline__ float silu_f(float v) { return v * __builtin_amdgcn_rcpf(1.f + __expf(-v)); }
__device__ __forceinline__ float wave_sum(float v) {
#pragma unroll
    for (int o = 1; o < 64; o <<= 1) v += __shfl_xor(v, o);
    return v;
}

__device__ __forceinline__ int opaque_tid() { int t = threadIdx.x; asm volatile("" : "+v"(t)); return t; }
__device__ __forceinline__ int opaque_bid() { int b = blockIdx.x; asm volatile("" : "+s"(b)); return b; }
struct Unit { int pm, pn; };
struct Gemm { const bf16_t* A; const bf16_t* Bt; int lda, ldb, K, nM, nN, gk; };

__device__ __forceinline__ bool next_unit(const Gemm& g, int bid, int i, Unit& u) {
    const int nwg = g.nM * g.nN;
    const long L = (long)i * gridDim.x + bid; if (L >= nwg) return false;
    int wgid = (int)L; { const int q = nwg / NXCD, r = nwg % NXCD, xcd = wgid % NXCD, off = wgid / NXCD; wgid = (xcd < r ? xcd * (q + 1) : r * (q + 1) + (xcd - r) * q) + off; }
    const int nig = WGM * g.nN, gid = wgid / nig, fm = gid * WGM, gsz = (g.nM - fm) < WGM ? (g.nM - fm) : WGM;
    u.pm = fm + ((wgid % nig) % gsz); u.pn = (wgid % nig) / gsz; return true;
}

struct EpiEven {
    static constexpr bool PERM = true;
    bf16_t* P;
    __device__ __forceinline__ void operator()(const f32x4 (&acc)[2][2][4][2], const Unit& u, int wr, int wc, int fr, int fq) const {
        const int row0 = u.pm * BM + wr * 64 + fr, T = u.pn;
        if (T < 24) {
            const int kind = T >> 3, Tl = T & 7;
            bf16_t* base = P + (size_t)kind * MTOK * 1024 + Tl * 128 + wc * 32 + 8 * fq;
#pragma unroll
            for (int ai = 0; ai < 2; ++ai)
#pragma unroll
                for (int m = 0; m < 4; ++m) {
                    bf16_t* rowp = base + (size_t)(row0 + ai * HALF + m * 16) * 1024;
                    f32x4 x0 = acc[ai][0][m][0], x1 = acc[ai][0][m][1], y0 = acc[ai][1][m][0], y1 = acc[ai][1][m][1];
                    if (kind != 0) {
#pragma unroll
                        for (int j = 0; j < 4; ++j) { y0[j] = silu_f(y0[j]); y1[j] = silu_f(y1[j]); }
                    }
                    x0 = x0 * y0; x1 = x1 * y1;
                    u32x4 w; w.x = cvt_pk_bf16(x0[0], x0[1]); w.y = cvt_pk_bf16(x0[2], x0[3]); w.z = cvt_pk_bf16(x1[0], x1[1]); w.w = cvt_pk_bf16(x1[2], x1[3]);
                    *(u32x4*)rowp = w;
                }
        } else {
            bf16_t* base = P + (size_t)3 * MTOK * 1024 + (T - 24) * 256 + wc * 32 + 8 * fq;
#pragma unroll
            for (int ai = 0; ai < 2; ++ai)
#pragma unroll
                for (int m = 0; m < 4; ++m) {
                    bf16_t* rowp = base + (size_t)(row0 + ai * HALF + m * 16) * 1024;
#pragma unroll
                    for (int bj = 0; bj < 2; ++bj) {
                        const f32x4 v0 = acc[ai][bj][m][0], v1 = acc[ai][bj][m][1];
                        u32x4 w; w.x = cvt_pk_bf16(v0[0], v0[1]); w.y = cvt_pk_bf16(v0[2], v0[3]); w.z = cvt_pk_bf16(v1[0], v1[1]); w.w = cvt_pk_bf16(v1[2], v1[3]);
                        *(u32x4*)(rowp + bj * HALF) = w;
                    }
                }
        }
    }
};
struct EpiOdd {
    static constexpr bool PERM = true;
    bf16_t* P; const float* pscale;
    __device__ __forceinline__ void operator()(const f32x4 (&acc)[2][2][4][2], const Unit& u, int wr, int wc, int fr, int fq) const {
        const int row0 = u.pm * BM + wr * 64 + fr, T = u.pn;
        const bool isz = T >= 8; const int Tl = T & 7, col0 = Tl * 256 + wc * 32 + 8 * fq;
        bf16_t* base = P + (isz ? (size_t)MTOK * 2048 : (size_t)0) + col0;
        f32x4 sc[2][2];
#pragma unroll
        for (int bj = 0; bj < 2; ++bj)
#pragma unroll
            for (int n = 0; n < 2; ++n) sc[bj][n] = isz ? *(const f32x4*)(pscale + col0 + bj * HALF + 4 * n) : (f32x4){1.f, 1.f, 1.f, 1.f};
#pragma unroll
        for (int ai = 0; ai < 2; ++ai)
#pragma unroll
            for (int m = 0; m < 4; ++m) {
                bf16_t* rowp = base + (size_t)(row0 + ai * HALF + m * 16) * 2048;
#pragma unroll
                for (int bj = 0; bj < 2; ++bj) {
                    f32x4 v0 = acc[ai][bj][m][0], v1 = acc[ai][bj][m][1];
                    if (isz) {
#pragma unroll
                        for (int j = 0; j < 4; ++j) { v0[j] = silu_f(v0[j]); v1[j] = silu_f(v1[j]); }
                        v0 = v0 * sc[bj][0]; v1 = v1 * sc[bj][1];
                    }
                    u32x4 w; w.x = cvt_pk_bf16(v0[0], v0[1]); w.y = cvt_pk_bf16(v0[2], v0[3]); w.z = cvt_pk_bf16(v1[0], v1[1]); w.w = cvt_pk_bf16(v1[2], v1[3]);
                    *(u32x4*)(rowp + bj * HALF) = w;
                }
            }
    }
};
struct EpiPool {
    static constexpr bool PERM = true;
    const bf16_t* SZ; bf16_t* Y;
    __device__ __forceinline__ void operator()(const f32x4 (&acc)[2][2][4][2], const Unit& u, int wr, int wc, int fr, int fq) const {
        const int row0 = u.pm * BM + wr * 64 + fr, col0 = u.pn * BM + wc * 32 + 8 * fq;
#pragma unroll
        for (int ai = 0; ai < 2; ++ai)
#pragma unroll
            for (int m = 0; m < 4; ++m) {
                const size_t ro = (size_t)(row0 + ai * HALF + m * 16) * 2048 + col0;
#pragma unroll
                for (int bj = 0; bj < 2; ++bj) {
                    const u32x4 s = *(const u32x4*)(SZ + ro + bj * HALF);
                    const f32x4 v0 = acc[ai][bj][m][0], v1 = acc[ai][bj][m][1];
                    u32x4 w; w.x = cvt_pk_bf16(v0[0] * bf_lo(s.x), v0[1] * bf_hi(s.x)); w.y = cvt_pk_bf16(v0[2] * bf_lo(s.y), v0[3] * bf_hi(s.y));
                    w.z = cvt_pk_bf16(v1[0] * bf_lo(s.z), v1[1] * bf_hi(s.z)); w.w = cvt_pk_bf16(v1[2] * bf_lo(s.w), v1[3] * bf_hi(s.w));
                    *(u32x4*)(Y + ro + bj * HALF) = w;
                }
            }
    }
};
struct EpiRes {
    static constexpr bool PERM = false;
    const float* xin; float* xout; const float* gate;
    __device__ __forceinline__ void operator()(const f32x4 (&acc)[2][2][4][2], const Unit& u, int wr, int wc, int fr, int fq) const {
        const int row0 = u.pm * BM + wr * 64 + fr, col0 = u.pn * BM + wc * 32 + 4 * fq;
        const float* gp = gate + (size_t)(u.pm >> 3) * 3072 + col0;
        f32x4 gv[2][2];
#pragma unroll
        for (int bj = 0; bj < 2; ++bj)
#pragma unroll
            for (int n = 0; n < 2; ++n) gv[bj][n] = *(const f32x4*)(gp + bj * HALF + n * 16);
#pragma unroll
        for (int ai = 0; ai < 2; ++ai)
#pragma unroll
            for (int m = 0; m < 4; ++m) {
                const size_t ro = (size_t)(row0 + ai * HALF + m * 16) * DM + col0;
#pragma unroll
                for (int bj = 0; bj < 2; ++bj)
#pragma unroll
                    for (int n = 0; n < 2; ++n) {
                        const f32x4 xv = *(const f32x4*)(xin + ro + bj * HALF + n * 16);
                        *(f32x4*)(xout + ro + bj * HALF + n * 16) = xv + gv[bj][n] * acc[ai][bj][m][n];
                    }
            }
    }
};

template <class Epi>
__device__ __forceinline__ void gemm_phase(LAS unsigned char* lds, const Gemm g, const Epi& E) {
    const int tid = opaque_tid(), wid = __builtin_amdgcn_readfirstlane(tid >> 6), lane = tid & 63, wr = wid >> 2, wc = wid & 3, fr = lane & 15, fq = lane >> 4;
    const int nt = g.K / BK;
    unsigned voffA[2], voffB[2];
#pragma unroll
    for (int i = 0; i < 2; ++i) { int R, C; stage_rc(tid * 16 + i * 8192, R, C); const int Rb = Epi::PERM ? ((R & ~31) + perm32(R & 31)) : R;
        voffA[i] = (unsigned)(R * g.lda + C) * 2u; voffB[i] = (unsigned)(Rb * g.ldb + C) * 2u; }
    const size_t kstep = (size_t)(BK * 2);
    const size_t hstepA = (size_t)HALF * g.lda * 2, hstepB = (size_t)HALF * g.ldb * 2;
    const unsigned ldsw = (unsigned)wid * 1024u;
    const int aoff = lds_byte(wr * 64 + fr, fq * 8), boff = lds_byte(wc * 32 + fr, fq * 8);
#define PG8_SA(b, h) (((b) * 2 + (h)) * HTB)
#define PG8_SB(b, h) ((4 + (b) * 2 + (h)) * HTB)
#define PG8_STAGE(bufoff, gbase, voff) do { _Pragma("unroll") for (int _i = 0; _i < 2; ++_i) \
        __builtin_amdgcn_global_load_lds((const unsigned*)((const char*)(gbase) + (voff)[_i]), (LAS unsigned*)(lds + (bufoff) + ldsw + _i * 8192), 16, 0, 0); } while (0)
#define PG8_LDA(dst, b, h) do { _Pragma("unroll") for (int m = 0; m < 4; ++m) _Pragma("unroll") for (int k = 0; k < 2; ++k) dst[m][k] = *(const LAS bf16x8*)(lds + PG8_SA(b, h) + aoff + m * 2048 + k * 1024); } while (0)
#define PG8_LDB(dst, b, h) do { _Pragma("unroll") for (int n = 0; n < 2; ++n) _Pragma("unroll") for (int k = 0; k < 2; ++k) dst[n][k] = *(const LAS bf16x8*)(lds + PG8_SB(b, h) + boff + n * 2048 + k * 1024); } while (0)
#define PG8_MMA(ai, bj, At, Bt) do { __builtin_amdgcn_s_setprio(1); _Pragma("unroll") for (int m = 0; m < 4; ++m) _Pragma("unroll") for (int n = 0; n < 2; ++n) _Pragma("unroll") for (int k = 0; k < 2; ++k) \
        acc[ai][bj][m][n] = __builtin_amdgcn_mfma_f32_16x16x32_bf16(Bt[n][k], At[m][k], acc[ai][bj][m][n], 0, 0, 0); __builtin_amdgcn_s_setprio(0); } while (0)
#define PG8_WAIT_V(n) asm volatile("s_waitcnt vmcnt(" #n ")" ::: "memory")
#define PG8_WAIT_L(n) asm volatile("s_waitcnt lgkmcnt(" #n ")" ::: "memory")
#define PG8_BAR __builtin_amdgcn_s_barrier()
#define PG8_SCHED __builtin_amdgcn_sched_barrier(0)
    Unit cur, nxt; int ui = 0;
    const int bid = opaque_bid();
    if (!next_unit(g, bid, 0, cur)) return;
    f32x4 acc[2][2][4][2];
#pragma unroll
    for (int a = 0; a < 2; ++a)
#pragma unroll
        for (int b = 0; b < 2; ++b)
#pragma unroll
            for (int m = 0; m < 4; ++m)
#pragma unroll
                for (int n = 0; n < 2; ++n) acc[a][b][m][n] = (f32x4){0.f, 0.f, 0.f, 0.f};
    bf16x8 At[4][2], B0[2][2], B1[2][2];
    const char* cA = (const char*)g.A + (size_t)cur.pm * 2 * hstepA + (size_t)(cur.pn >> 1) * g.gk * 2; const char* cB = (const char*)g.Bt + (size_t)cur.pn * 2 * hstepB;
    PG8_STAGE(PG8_SB(0, 0), cB, voffB); PG8_STAGE(PG8_SA(0, 0), cA, voffA); PG8_STAGE(PG8_SB(0, 1), cB + hstepB, voffB); PG8_STAGE(PG8_SA(0, 1), cA + hstepA, voffA);
    if (wr == 1) PG8_BAR;
    PG8_WAIT_V(4); PG8_BAR;
    PG8_STAGE(PG8_SB(1, 0), cB + kstep, voffB); PG8_STAGE(PG8_SA(1, 0), cA + kstep, voffA); PG8_STAGE(PG8_SB(1, 1), cB + hstepB + kstep, voffB);
    PG8_WAIT_V(6); PG8_BAR;
    for (;;) {
        const bool has_next = next_unit(g, bid, ui + 1, nxt);
        const char* nA = has_next ? (const char*)g.A + (size_t)nxt.pm * 2 * hstepA + (size_t)(nxt.pn >> 1) * g.gk * 2 : cA;
        const char* nB = has_next ? (const char*)g.Bt + (size_t)nxt.pn * 2 * hstepB : cB;
        for (int t = 0; t < nt; t += 2) {
            const bool last = (t == nt - 2);
            const char* a1 = cA + (size_t)(t + 1) * kstep;
            const char* a2 = last ? nA : cA + (size_t)(t + 2) * kstep; const char* b2 = last ? nB : cB + (size_t)(t + 2) * kstep;
            const char* a3 = a2 + kstep; const char* b3 = b2 + kstep;
            PG8_LDB(B0, 0, 0); PG8_SCHED; PG8_LDA(At, 0, 0); PG8_STAGE(PG8_SA(1, 1), a1 + hstepA, voffA);
            PG8_WAIT_L(8); PG8_BAR; PG8_WAIT_L(0); PG8_MMA(0, 0, At, B0); PG8_BAR; PG8_SCHED;
            PG8_LDB(B1, 0, 1); PG8_STAGE(PG8_SB(0, 0), b2, voffB);
            PG8_BAR; PG8_WAIT_L(0); PG8_MMA(0, 1, At, B1); PG8_BAR;
            PG8_LDA(At, 0, 1); PG8_STAGE(PG8_SA(0, 0), a2, voffA);
            PG8_BAR; PG8_WAIT_L(0); PG8_MMA(1, 0, At, B0); PG8_BAR; PG8_SCHED;
            PG8_STAGE(PG8_SB(0, 1), b2 + hstepB, voffB);
            PG8_WAIT_V(6); PG8_BAR; PG8_MMA(1, 1, At, B1); PG8_BAR;
            PG8_LDB(B0, 1, 0); PG8_SCHED; PG8_LDA(At, 1, 0); PG8_STAGE(PG8_SA(0, 1), a2 + hstepA, voffA);
            PG8_WAIT_L(8); PG8_BAR; PG8_WAIT_L(0); PG8_MMA(0, 0, At, B0); PG8_BAR; PG8_SCHED;
            PG8_LDB(B1, 1, 1); PG8_STAGE(PG8_SB(1, 0), b3, voffB);
            PG8_BAR; PG8_WAIT_L(0); PG8_MMA(0, 1, At, B1); PG8_BAR;
            PG8_LDA(At, 1, 1); PG8_STAGE(PG8_SA(1, 0), a3, voffA);
            PG8_BAR; PG8_WAIT_L(0); PG8_MMA(1, 0, At, B0); PG8_BAR; PG8_SCHED;
            PG8_STAGE(PG8_SB(1, 1), b3 + hstepB, voffB);
            PG8_WAIT_V(6); PG8_BAR; PG8_MMA(1, 1, At, B1); PG8_BAR;
        }
        E(acc, cur, wr, wc, fr, fq);
        if (!has_next) break;
#pragma unroll
        for (int a = 0; a < 2; ++a)
#pragma unroll
            for (int b = 0; b < 2; ++b)
#pragma unroll
                for (int m = 0; m < 4; ++m)
#pragma unroll
                    for (int n = 0; n < 2; ++n) acc[a][b][m][n] = (f32x4){0.f, 0.f, 0.f, 0.f};
        cur = nxt; cA = nA; cB = nB; ++ui;
    }
    PG8_WAIT_V(0);
    if (wr == 0) PG8_BAR;
    PG8_BAR;
#undef PG8_SA
#undef PG8_SB
#undef PG8_STAGE
#undef PG8_LDA
#undef PG8_LDB
#undef PG8_MMA
#undef PG8_WAIT_V
#undef PG8_WAIT_L
#undef PG8_BAR
#undef PG8_SCHED
}

__device__ __forceinline__ void phase_mod(const Params& p, LAS unsigned char* lds) {
    const int tid = opaque_tid(), wid = tid >> 6, lane = tid & 63;
    LAS float* sc = (LAS float*)lds;
    LAS float* red = (LAS float*)(lds + 32768);
    float* mod = (float*)(p.ws + WS_MOD);
    for (int t = tid; t < NB * DM; t += 512) sc[t] = silu_f(p.c[t]);
    __syncthreads();
    for (int it = opaque_bid(); it < 192; it += gridDim.x) {
        const int col = it * 64 + lane, i = col / 3072, j = col - i * 3072;
        const float* w = p.ada_w + ((size_t)i * DM + wid * 128) * 3072 + j;
        float a[8];
#pragma unroll
        for (int b = 0; b < 8; ++b) a[b] = 0.f;
#pragma unroll 4
        for (int k = 0; k < 128; ++k) {
            const float wv = w[(size_t)k * 3072];
#pragma unroll
            for (int b = 0; b < 8; ++b) a[b] += sc[b * DM + wid * 128 + k] * wv;
        }
#pragma unroll
        for (int b = 0; b < 8; ++b) red[(wid * 8 + b) * 64 + lane] = a[b];
        __syncthreads();
        {
            const int b = tid >> 6; float s = 0.f;
#pragma unroll
            for (int w8 = 0; w8 < 8; ++w8) s += red[(w8 * 8 + b) * 64 + lane];
            mod[((size_t)i * NB + b) * 3072 + j] = s + p.ada_b[i * 3072 + j];
        }
        __syncthreads();
    }
}

__device__ __forceinline__ void conv_tile(const float* __restrict__ src, int srcN, int c0, bf16_t* __restrict__ dstrow, int K, int k0, LAS float* T) {
    const int tid = opaque_tid();
#pragma unroll
    for (int ps = 0; ps < 4; ++ps) {
        const int k = ps * 32 + (tid >> 4), c = (tid & 15) * 4;
        const f32x4 v = *(const f32x4*)(src + (size_t)(k0 + k) * srcN + c0 + c);
        LAS float* t = T + k * 65 + c; t[0] = v[0]; t[1] = v[1]; t[2] = v[2]; t[3] = v[3];
    }
    __syncthreads();
#pragma unroll
    for (int q = 0; q < 2; ++q) {
        const int item = tid + 512 * q, n = item >> 4, kg = item & 15; const LAS float* s = T + (kg * 8) * 65 + n;
        u32x4 o; o.x = cvt_pk_bf16(s[0], s[65]); o.y = cvt_pk_bf16(s[130], s[195]); o.z = cvt_pk_bf16(s[260], s[325]); o.w = cvt_pk_bf16(s[390], s[455]);
        *(u32x4*)(dstrow + (size_t)n * K + k0 + kg * 8) = o;
    }
    __syncthreads();
}

__device__ __forceinline__ void phase_norm(const Params& p, int layer, const float* xin, LAS unsigned char* lds) {
    const int tid = opaque_tid(), wid = tid >> 6, lane = tid & 63, j = layer >> 1;
    const bool even = (layer & 1) == 0;
    bf16_t* WIN = (bf16_t*)(p.ws + WS_WIN); bf16_t* WOUT = (bf16_t*)(p.ws + WS_WOUT); bf16_t* AUX = (bf16_t*)(p.ws + WS_AUX);
    bf16_t* H = (bf16_t*)(p.ws + WS_RA);
    const float* mod = (const float*)(p.ws + WS_MOD) + (size_t)layer * NB * 3072;
    const int n_in = even ? 896 : 512, n_out = 256, n_aux = even ? 32 : 128, n_conv = n_in + n_out + n_aux;
    const int total = n_conv + MTOK / 8;
    for (int it = opaque_bid(); it < total; it += gridDim.x) {
        if (it < n_in) {
            const int rt = it >> 3, kt = it & 7, r0 = rt * 64;
            int c0 = r0; const float* src; int srcN;
            if (even) {
                const int T = r0 >> 8, q = r0 & 255;
                if (T < 8) c0 = (q < 128) ? (2048 + 128 * T + q) : (128 * T + q - 128);
                else if (T < 16) c0 = (q < 128) ? (1024 + 128 * (T - 8) + q) : (3072 + 128 * (T - 8) + q - 128);
                else if (T < 24) c0 = (q < 128) ? (4096 + 128 * (T - 16) + q) : (6144 + 128 * (T - 16) + q - 128);
                else c0 = 5120 + 256 * (T - 24) + q;
                src = p.ab_w_in + (size_t)j * DM * 7168; srcN = 7168;
            } else { src = p.c_w_in + (size_t)j * DM * 4096; srcN = 4096; }
            conv_tile(src, srcN, c0, WIN + (size_t)r0 * DM, DM, kt * 128, (LAS float*)lds);
        } else if (it < n_in + n_out) {
            const int i2 = it - n_in, rt = i2 >> 4, kt = i2 & 15, r0 = rt * 64;
            const float* src = (even ? p.ab_w_out : p.c_w_out) + (size_t)j * 2048 * DM;
            conv_tile(src, DM, r0, WOUT + (size_t)r0 * 2048, 2048, kt * 128, (LAS float*)lds);
        } else if (it < n_conv) {
            const int i3 = it - n_in - n_out;
            if (even) {
                const int e0 = i3 * 4096 + tid * 8, t = (e0 >> 7) & 127, s0 = e0 & 127;
                const float* src = p.ab_sgu_w + (size_t)j * 8 * 128 * 128 + e0;
                const f32x4 a = *(const f32x4*)src, b = *(const f32x4*)(src + 4);
                float v[8] = {a[0], a[1], a[2], a[3], b[0], b[1], b[2], b[3]};
#pragma unroll
                for (int e = 0; e < 8; ++e) v[e] = (s0 + e <= t) ? v[e] : 0.f;
                u32x4 o; o.x = cvt_pk_bf16(v[0], v[1]); o.y = cvt_pk_bf16(v[2], v[3]); o.z = cvt_pk_bf16(v[4], v[5]); o.w = cvt_pk_bf16(v[6], v[7]);
                *(u32x4*)(AUX + e0) = o;
            } else {
                const int g = i3 >> 5, r = i3 & 31, rt = r >> 2, kt = r & 3, r0 = rt * 64;
                const float* src = p.c_pool_w + ((size_t)j * 4 + g) * 512 * 512;
                conv_tile(src, 512, r0, AUX + (size_t)g * 512 * 512 + (size_t)r0 * 512, 512, kt * 128, (LAS float*)lds);
            }
        } else {
            const int row = (it - n_conv) * 8 + wid, b = row >> 11;
            const f32x4* xr = (const f32x4*)(xin + (size_t)row * DM) + lane;
            f32x4 v[4]; float ss = 0.f;
#pragma unroll
            for (int q = 0; q < 4; ++q) { v[q] = xr[64 * q]; ss += (v[q][0] * v[q][0] + v[q][1] * v[q][1]) + (v[q][2] * v[q][2] + v[q][3] * v[q][3]); }
            const float rstd = rsqrtf(wave_sum(ss) * (1.f / DM) + EPS);
            const float* gp = p.norm_g + (size_t)layer * DM; const float* mb = mod + (size_t)b * 3072;
            u32x2* o8 = (u32x2*)(H + (size_t)row * DM) + lane;
#pragma unroll
            for (int q = 0; q < 4; ++q) {
                const int k = (lane + 64 * q) * 4;
                const f32x4 gv = *(const f32x4*)(gp + k), sh = *(const f32x4*)(mb + k), scl = *(const f32x4*)(mb + 1024 + k);
                const f32x4 hv = (v[q] * rstd * gv) * (scl + 1.f) + sh;
                u32x2 w; w.x = cvt_pk_bf16(hv[0], hv[1]); w.y = cvt_pk_bf16(hv[2], hv[3]);
                o8[64 * q] = w;
            }
        }
    }
}

__device__ __forceinline__ void phase_final(const Params& p) {
    const int tid = opaque_tid(), wid = tid >> 6, lane = tid & 63;
    for (int it = opaque_bid(); it < MTOK / 8; it += gridDim.x) {
        const int row = it * 8 + wid;
        f32x4* xr = (f32x4*)(p.out + (size_t)row * DM) + lane;
        f32x4 v[4]; float ss = 0.f;
#pragma unroll
        for (int q = 0; q < 4; ++q) { v[q] = xr[64 * q]; ss += (v[q][0] * v[q][0] + v[q][1] * v[q][1]) + (v[q][2] * v[q][2] + v[q][3] * v[q][3]); }
        const float rstd = rsqrtf(wave_sum(ss) * (1.f / DM) + EPS);
#pragma unroll
        for (int q = 0; q < 4; ++q) { const f32x4 gv = *(const f32x4*)(p.final_g + (lane + 64 * q) * 4); xr[64 * q] = v[q] * rstd * gv; }
    }
}

__device__ __forceinline__ void unpack8(const u32x4 w, float (&f)[8]) {
    f[0] = bf_lo(w.x); f[1] = bf_hi(w.x); f[2] = bf_lo(w.y); f[3] = bf_hi(w.y); f[4] = bf_lo(w.z); f[5] = bf_hi(w.z); f[6] = bf_lo(w.w); f[7] = bf_hi(w.w);
}

__device__ __forceinline__ void phase_mix(const Params& p, int j, LAS unsigned char* lds) {
    const int tid = opaque_tid(), wid = tid >> 6, lane = tid & 63;
    const bf16_t* CH2 = (const bf16_t*)(p.ws + WS_RP); const bf16_t* BZ = CH2 + (size_t)MTOK * 1024; const bf16_t* UZ = BZ + (size_t)MTOK * 1024; const bf16_t* V = UZ + (size_t)MTOK * 1024;
    bf16_t* Y = (bf16_t*)(p.ws + WS_RA);
    {
        const bf16_t* Wm = (const bf16_t*)(p.ws + WS_AUX);
        LAS bf16_t* vnT = (LAS bf16_t*)lds;
        LAS float* red = (LAS float*)(lds + 36864);
        const int fr = lane & 15, fq = lane >> 4;
        for (int it = opaque_bid(); it < 1024; it += gridDim.x) {
            const int hh = it & 7, cn = it >> 3;
            const int s = lane + 64 * (wid & 1), q = wid >> 1;
            const bf16_t* vp = V + (size_t)(cn * 128 + s) * 1024 + hh * 128 + 32 * q;
            float f[32];
#pragma unroll
            for (int i = 0; i < 4; ++i) { const u32x4 w = *(const u32x4*)(vp + 8 * i); float t8[8]; unpack8(w, t8);
#pragma unroll
                for (int e = 0; e < 8; ++e) f[8 * i + e] = t8[e]; }
            float s1 = 0.f, s2 = 0.f;
#pragma unroll
            for (int i = 0; i < 32; ++i) { s1 += f[i]; s2 += f[i] * f[i]; }
            red[(s * 4 + q) * 2] = s1; red[(s * 4 + q) * 2 + 1] = s2;
            __syncthreads();
            float S1 = 0.f, S2 = 0.f;
#pragma unroll
            for (int qq = 0; qq < 4; ++qq) { S1 += red[(s * 4 + qq) * 2]; S2 += red[(s * 4 + qq) * 2 + 1]; }
            const float mu = S1 * (1.f / 128.f), var = fmaxf(S2 * (1.f / 128.f) - mu * mu, 0.f), rstd = rsqrtf(var + EPS);
            const float* lg = p.ab_ln_g + (size_t)j * 1024 + hh * 128 + 32 * q; const float* lb = p.ab_ln_b + (size_t)j * 1024 + hh * 128 + 32 * q;
#pragma unroll
            for (int i = 0; i < 32; ++i) {
                const float vn = (f[i] - mu) * rstd * lg[i] + lb[i];
                vnT[(32 * q + i) * 136 + s] = (bf16_t)(cvt_pk_bf16(vn, 0.f) & 0xffffu);
            }
            __syncthreads();
            f32x4 acc[8];
#pragma unroll
            for (int n = 0; n < 8; ++n) acc[n] = (f32x4){0.f, 0.f, 0.f, 0.f};
            const bf16_t* wrow = Wm + ((size_t)hh * 128 + 16 * wid + fr) * 128 + 8 * fq;
#pragma unroll
            for (int kk = 0; kk < 4; ++kk) {
                if (32 * kk <= 16 * wid + 15) {
                    const bf16x8 af = *(const bf16x8*)(wrow + 32 * kk);
#pragma unroll
                    for (int n = 0; n < 8; ++n) {
                        const bf16x8 bfm = *(const LAS bf16x8*)(vnT + (16 * n + fr) * 136 + 32 * kk + 8 * fq);
                        acc[n] = __builtin_amdgcn_mfma_f32_16x16x32_bf16(bfm, af, acc[n], 0, 0, 0);
                    }
                }
            }
            const int t = 16 * wid + fr; const size_t row = (size_t)cn * 128 + t;
            const float bias = p.ab_sgu_b[(size_t)j * 1024 + hh * 128 + t];
#pragma unroll
            for (int n = 0; n < 8; ++n) {
                const int d = 16 * n + 4 * fq;
                const u32x2 uz = *(const u32x2*)(UZ + row * 1024 + hh * 128 + d);
                u32x2 w; w.x = cvt_pk_bf16(bf_lo(uz.x) * (acc[n][0] + bias), bf_hi(uz.x) * (acc[n][1] + bias));
                w.y = cvt_pk_bf16(bf_lo(uz.y) * (acc[n][2] + bias), bf_hi(uz.y) * (acc[n][3] + bias));
                *(u32x2*)(Y + row * 2048 + 1024 + hh * 128 + d) = w;
            }
        }
    }
    {
        const float* cw = p.ab_conv_w + (size_t)j * 3 * 1024;
        for (int it = opaque_bid(); it < 256; it += gridDim.x) {
            const int rg = it * 4 + (tid >> 7), c0 = (tid & 127) * 8, t0 = rg * 16;
            float w0[8], w1[8], w2[8], p2[8], p1[8];
#pragma unroll
            for (int h4 = 0; h4 < 2; ++h4) {
                const f32x4 a = *(const f32x4*)(cw + c0 + 4 * h4), b = *(const f32x4*)(cw + 1024 + c0 + 4 * h4), c = *(const f32x4*)(cw + 2048 + c0 + 4 * h4);
#pragma unroll
                for (int e = 0; e < 4; ++e) { w0[4 * h4 + e] = a[e]; w1[4 * h4 + e] = b[e]; w2[4 * h4 + e] = c[e]; }
            }
            if ((t0 & (SEQ - 1)) != 0) {
                unpack8(*(const u32x4*)(CH2 + (size_t)(t0 - 2) * 1024 + c0), p2);
                unpack8(*(const u32x4*)(CH2 + (size_t)(t0 - 1) * 1024 + c0), p1);
            } else {
#pragma unroll
                for (int e = 0; e < 8; ++e) { p2[e] = 0.f; p1[e] = 0.f; }
            }
#pragma unroll 4
            for (int r = 0; r < 16; ++r) {
                float cur[8], bz[8], o[8];
                unpack8(*(const u32x4*)(CH2 + (size_t)(t0 + r) * 1024 + c0), cur);
                unpack8(*(const u32x4*)(BZ + (size_t)(t0 + r) * 1024 + c0), bz);
#pragma unroll
                for (int e = 0; e < 8; ++e) { o[e] = bz[e] * (w0[e] * p2[e] + w1[e] * p1[e] + w2[e] * cur[e]); p2[e] = p1[e]; p1[e] = cur[e]; }
                u32x4 w; w.x = cvt_pk_bf16(o[0], o[1]); w.y = cvt_pk_bf16(o[2], o[3]); w.z = cvt_pk_bf16(o[4], o[5]); w.w = cvt_pk_bf16(o[6], o[7]);
                *(u32x4*)(Y + (size_t)(t0 + r) * 2048 + c0) = w;
            }
        }
    }
}

__device__ __forceinline__ void phase_pool(const Params& p) {
    const int tid = opaque_tid();
    const bf16_t* PP = (const bf16_t*)(p.ws + WS_RP); bf16_t* PO = (bf16_t*)(p.ws + WS_RA);
    for (int it = opaque_bid(); it < 256; it += gridDim.x) {
        const int rg = it * 2 + (tid >> 8), ct = tid & 255, c0 = ct * 8, win = 2 << (ct >> 6), t0 = rg * 32, tl0 = t0 & (SEQ - 1);
        float S[8];
#pragma unroll
        for (int e = 0; e < 8; ++e) S[e] = 0.f;
        for (int i = 1; i < win; ++i) {
            if (tl0 - i >= 0) { float v[8]; unpack8(*(const u32x4*)(PP + (size_t)(t0 - i) * 2048 + c0), v);
#pragma unroll
                for (int e = 0; e < 8; ++e) S[e] += v[e]; }
        }
#pragma unroll 4
        for (int r = 0; r < 32; ++r) {
            const int tl = tl0 + r;
            float cur[8], o[8];
            unpack8(*(const u32x4*)(PP + (size_t)(t0 + r) * 2048 + c0), cur);
            const float inv = 1.f / (float)min(tl + 1, win);
#pragma unroll
            for (int e = 0; e < 8; ++e) { S[e] += cur[e]; o[e] = S[e] * inv - cur[e]; }
            u32x4 w; w.x = cvt_pk_bf16(o[0], o[1]); w.y = cvt_pk_bf16(o[2], o[3]); w.z = cvt_pk_bf16(o[4], o[5]); w.w = cvt_pk_bf16(o[6], o[7]);
            *(u32x4*)(PO + (size_t)(t0 + r) * 2048 + c0) = w;
            if (tl - win + 1 >= 0) { float old[8]; unpack8(*(const u32x4*)(PP + (size_t)(t0 + r - win + 1) * 2048 + c0), old);
#pragma unroll
                for (int e = 0; e < 8; ++e) S[e] -= old[e]; }
        }
    }
}

#define XB_TMO      128
#define XB_XCNT(j)  (256  + 64 * (j))
#define XB_XSUB(j)  (1280 + 64 * (j))
#define XB_XGEN(j)  (2304 + 64 * (j))
#define XB_TOP      3328
#define XB_TOPGEN   3392
#define XCD_BAR_WORDS 3456
#define XB_SPIN_CAP (1u << 18)
__device__ __forceinline__ unsigned xb_ld(unsigned* p)              { return __hip_atomic_load(p, __ATOMIC_RELAXED, __HIP_MEMORY_SCOPE_AGENT); }
__device__ __forceinline__ unsigned xb_add(unsigned* p, unsigned v) { return __hip_atomic_fetch_add(p, v, __ATOMIC_RELAXED, __HIP_MEMORY_SCOPE_AGENT); }
__device__ __forceinline__ unsigned xb_xcc_id() { return (unsigned)__builtin_amdgcn_s_getreg((3 << 11) | 20) & 0xFu; }
#define XB_SPIN(cond, bar) do { unsigned _sp = 0; while (cond) { __builtin_amdgcn_s_sleep(1); \
    if ((++_sp & 255u) == 0u) { if (xb_ld(&(bar)[XB_TMO])) break; if (_sp > XB_SPIN_CAP) { atomicAdd(&(bar)[XB_TMO], 1u); break; } } } } while (0)
struct XcdBarrier { unsigned* bar; unsigned x; volatile LAS unsigned* st; };
__device__ __forceinline__ XcdBarrier xcd_barrier_post(unsigned* bar, volatile LAS unsigned* st) {
    XcdBarrier b; b.bar = bar; b.x = xb_xcc_id(); b.st = st;
    if (threadIdx.x == 0) (void)xb_add(&bar[XB_XCNT(b.x)], 1u);
    return b;
}
__device__ __forceinline__ void xcd_barrier_complete(unsigned* bar, unsigned x, unsigned& nloc, unsigned& nx) {
    const unsigned G = gridDim.x * gridDim.y * gridDim.z;
    unsigned sum, cnt, mine, sp = 0u;
    for (;;) {
        sum = 0u; cnt = 0u; mine = 0u;
#pragma unroll
        for (unsigned j = 0; j < 16; ++j) { const unsigned c = xb_ld(&bar[XB_XCNT(j)]); sum += c; cnt += (c > 0u) ? 1u : 0u; mine = (j == x) ? c : mine; }
        if (sum == G) break;
        __builtin_amdgcn_s_sleep(1);
        if ((++sp & 255u) == 0u) { if (xb_ld(&bar[XB_TMO])) break; if (sp > XB_SPIN_CAP) { atomicAdd(&bar[XB_TMO], 1u); break; } }
    }
    nloc = mine > 0u ? mine : 1u; nx = cnt > 0u ? cnt : 1u;
}
__device__ __forceinline__ void xcd_barrier(const XcdBarrier& b) {
    asm volatile("s_waitcnt vmcnt(0)" ::: "memory");
    __syncthreads();
    if (threadIdx.x == 0) {
        unsigned* bar = b.bar;
        __builtin_amdgcn_s_waitcnt(0);
        unsigned nloc = b.st[0], nx = b.st[1];
        if (nloc == 0u) { xcd_barrier_complete(bar, b.x, nloc, nx); b.st[0] = nloc; b.st[1] = nx; }
        const unsigned old = xb_add(&bar[XB_XSUB(b.x)], 1u);
        const unsigned gen = old / nloc;
        if (old + 1u == (gen + 1u) * nloc) {
            __builtin_amdgcn_fence(__ATOMIC_RELEASE, "agent");
            asm volatile("s_waitcnt vmcnt(0)" ::: "memory");
            const unsigned og = xb_add(&bar[XB_TOP], 1u);
            const unsigned tg = og / nx;
            if (og + 1u == (tg + 1u) * nx) xb_add(&bar[XB_TOPGEN], 1u);
            else XB_SPIN(xb_ld(&bar[XB_TOPGEN]) == tg, bar);
            __builtin_amdgcn_fence(__ATOMIC_ACQUIRE, "agent");
            xb_add(&bar[XB_XGEN(b.x)], 1u);
            asm volatile("s_waitcnt vmcnt(0)" ::: "memory");
        } else {
            XB_SPIN(xb_ld(&bar[XB_XGEN(b.x)]) == gen, bar);
            __builtin_amdgcn_fence(__ATOMIC_ACQUIRE, "agent");
            asm volatile("s_waitcnt vmcnt(0)" ::: "memory");
        }
    }
    __syncthreads();
}

__global__ void __launch_bounds__(512, 2) mega_fwd(Params p, int ph_lo, int ph_hi) {
    extern __shared__ __attribute__((aligned(16))) unsigned char smem[];
    LAS unsigned char* lds = (LAS unsigned char*)smem;
    cg::grid_group grid = cg::this_grid();
    if (ph_hi < 0) grid.sync();
    volatile LAS unsigned* st = (volatile LAS unsigned*)(lds + STAGE_BYTES);
    if (threadIdx.x < 4) st[threadIdx.x] = 0u;
    __syncthreads();
    const XcdBarrier xb = xcd_barrier_post((unsigned*)(p.ws + WS_BAR), st);
    int ph = 0;
#define PHASE(...) do { if (ph >= ph_lo && ph < ph_hi) { __VA_ARGS__; if (ph + 1 < ph_hi) xcd_barrier(xb); } ++ph; } while (0)
    bf16_t* RA = (bf16_t*)(p.ws + WS_RA); bf16_t* RP = (bf16_t*)(p.ws + WS_RP);
    const bf16_t* WIN = (const bf16_t*)(p.ws + WS_WIN); const bf16_t* WOUT = (const bf16_t*)(p.ws + WS_WOUT); const bf16_t* AUX = (const bf16_t*)(p.ws + WS_AUX);
    const float* mod = (const float*)(p.ws + WS_MOD);
    PHASE(phase_mod(p, lds));
#pragma unroll 1
    for (int lp = 0; lp < 2; ++lp) {
        {
            const int layer = 2 * lp; const float* xin = (lp == 0) ? p.x : p.out;
            PHASE(phase_norm(p, layer, xin, lds));
            PHASE({ Gemm g{RA, WIN, DM, DM, DM, MTOK / BM, 7168 / BM, 0}; EpiEven E{RP}; gemm_phase(lds, g, E); });
            PHASE(phase_mix(p, lp, lds));
            PHASE({ Gemm g{RA, WOUT, 2048, 2048, 2048, MTOK / BM, DM / BM, 0}; EpiRes E{xin, p.out, mod + (size_t)layer * NB * 3072 + 2048}; gemm_phase(lds, g, E); });
        }
        {
            const int layer = 2 * lp + 1;
            PHASE(phase_norm(p, layer, p.out, lds));
            PHASE({ Gemm g{RA, WIN, DM, DM, DM, MTOK / BM, 4096 / BM, 0}; EpiOdd E{RP, p.c_pool_scale + (size_t)lp * 2048}; gemm_phase(lds, g, E); });
            PHASE(phase_pool(p));
            PHASE({ Gemm g{RA, AUX, 2048, 512, 512, MTOK / BM, 2048 / BM, 512}; EpiPool E{RP + (size_t)MTOK * 2048, RP}; gemm_phase(lds, g, E); });
            PHASE({ Gemm g{RP, WOUT, 2048, 2048, 2048, MTOK / BM, DM / BM, 0}; EpiRes E{p.out, p.out, mod + (size_t)layer * NB * 3072 + 2048}; gemm_phase(lds, g, E); });
        }
    }
    PHASE(phase_final(p));
#undef PHASE
}

extern "C" void kernel_launch(void* const* d_in, const int* in_sizes, int n_in, void* d_out, int out_size, void* d_ws, size_t ws_size, hipStream_t stream) {
    static int grid = 0;
    if (grid == 0) {
        if (n_in != 17 || out_size != MTOK * DM || ws_size < WS_END) { fprintf(stderr, "kernel_launch: unexpected shapes (n_in %d out %d ws %zu need %zu)\n", n_in, out_size, ws_size, (size_t)WS_END); grid = -1; return; }
        int dev = 0, cus = 0, per_cu = 0;
        hipGetDevice(&dev);
        hipDeviceGetAttribute(&cus, hipDeviceAttributeMultiprocessorCount, dev);
        if (hipFuncSetAttribute((const void*)mega_fwd, hipFuncAttributeMaxDynamicSharedMemorySize, LDS_BYTES) != hipSuccess) { fprintf(stderr, "kernel_launch: hipFuncSetAttribute failed\n"); grid = -1; return; }
        hipOccupancyMaxActiveBlocksPerMultiprocessor(&per_cu, (const void*)mega_fwd, 512, LDS_BYTES);
        if (per_cu < 1) { fprintf(stderr, "kernel_launch: occupancy query says %d blocks per CU\n", per_cu); per_cu = 1; }
        (void)hipGetLastError();
        grid = cus;
    }
    if (grid < 0) return;
    Params p{};
    p.x = (const float*)d_in[0]; p.c = (const float*)d_in[1]; p.norm_g = (const float*)d_in[2]; p.ada_w = (const float*)d_in[3]; p.ada_b = (const float*)d_in[4];
    p.ab_w_in = (const float*)d_in[5]; p.ab_conv_w = (const float*)d_in[6]; p.ab_ln_g = (const float*)d_in[7]; p.ab_ln_b = (const float*)d_in[8];
    p.ab_sgu_w = (const float*)d_in[9]; p.ab_sgu_b = (const float*)d_in[10]; p.ab_w_out = (const float*)d_in[11];
    p.c_w_in = (const float*)d_in[12]; p.c_pool_w = (const float*)d_in[13]; p.c_pool_scale = (const float*)d_in[14]; p.c_w_out = (const float*)d_in[15]; p.final_g = (const float*)d_in[16];
    p.out = (float*)d_out; p.ws = (unsigned char*)d_ws;
    if (hipMemsetAsync((unsigned char*)d_ws + WS_BAR, 0, XCD_BAR_WORDS * 4, stream) != hipSuccess) { fprintf(stderr, "kernel_launch: barrier memset failed\n"); return; }
    int lo = 0, hi = 20;
    void* args[] = {&p, &lo, &hi};
    hipError_t e = hipLaunchCooperativeKernel((const void*)mega_fwd, dim3(grid), dim3(512), args, LDS_BYTES, stream);
    if (e != hipSuccess) fprintf(stderr, "kernel_launch: cooperative launch failed: %s (grid %d)\n", hipGetErrorString(e), grid);
}
```

```cpp
#include <hip/hip_runtime.h>
#include <hip/hip_cooperative_groups.h>
#include <cstdio>
namespace cg = cooperative_groups;

#define LAS __attribute__((address_space(3)))
typedef unsigned short bf16_t;
typedef short bf16x8 __attribute__((ext_vector_type(8)));
typedef float f32x4 __attribute__((ext_vector_type(4)));
typedef unsigned u32x4 __attribute__((ext_vector_type(4)));
typedef unsigned u32x2 __attribute__((ext_vector_type(2)));

constexpr int DM = 1024, NB = 8, SEQ = 2048, MTOK = NB * SEQ;
constexpr int BM = 256, BK = 64, HALF = 128, HTB = HALF * BK * 2, STAGE_BYTES = 8 * HTB, NXCD = 8, WGM = 8;
constexpr int LDS_BYTES = STAGE_BYTES + 16;
constexpr float EPS = 1e-6f;
constexpr int REP_G1 = 1, REP_THIN = 1, REP_G2L0 = 1;

constexpr size_t WS_MOD = 0;
constexpr size_t WS_BAR = 393216;
constexpr size_t WS_WIN_E = 524288;
constexpr size_t WS_WIN_O = WS_WIN_E + (size_t)7168 * 1024 * 2;
constexpr size_t WS_WOUT_E = WS_WIN_O + (size_t)4096 * 1024 * 2;
constexpr size_t WS_WOUT_O = WS_WOUT_E + (size_t)1024 * 2048 * 2;
constexpr size_t WS_SGU = WS_WOUT_O + (size_t)1024 * 2048 * 2;
constexpr size_t WS_POOLT = WS_SGU + (size_t)8 * 128 * 128 * 2;
constexpr size_t WS_WINP = WS_POOLT + (size_t)4 * 512 * 512 * 2;
constexpr size_t WS_RA = WS_WINP + (size_t)1024 * 2048 * 2;
constexpr size_t WS_RP = WS_RA + (size_t)MTOK * 2048 * 2;
constexpr size_t WS_END = WS_RP + (size_t)MTOK * 4096 * 2;

struct Params {
    const float *x, *c, *norm_g, *ada_w, *ada_b, *ab_w_in, *ab_conv_w, *ab_ln_g, *ab_ln_b, *ab_sgu_w, *ab_sgu_b, *ab_w_out,
        *c_w_in, *c_pool_w, *c_pool_scale, *c_w_out, *final_g;
    float* out;
    unsigned char* ws;
};

__host__ __device__ __forceinline__ int lds_byte(int r, int c) { const int st = (r >> 4) * 2 + (c >> 5), rr = r & 15, cc = c & 31, ob = rr * 64 + cc * 2; return st * 1024 + (ob ^ (((ob >> 9) & 1) << 5)); }
__host__ __device__ __forceinline__ void stage_rc(int b, int& R, int& C) { const int st = b / 1024, sb = b % 1024, swz = sb ^ (((sb >> 9) & 1) << 5); R = (st >> 1) * 16 + swz / 64; C = (st & 1) * 32 + (swz % 64) / 2; }
__host__ __device__ __forceinline__ int perm32(int rho) { const int n = rho >> 4, i = rho & 15; return 8 * (i >> 2) + 4 * n + (i & 3); }
__device__ __forceinline__ unsigned cvt_pk_bf16(float lo, float hi) { unsigned r; asm volatile("v_cvt_pk_bf16_f32 %0, %1, %2" : "=v"(r) : "v"(lo), "v"(hi)); return r; }
__device__ __forceinline__ float bf_lo(unsigned w) { return __uint_as_float(w << 16); }
__device__ __forceinline__ float bf_hi(unsigned w) { return __uint_as_float(w & 0xffff0000u); }
__device__ __forceinline__ float silu_f(float v) { return v * __builtin_amdgcn_rcpf(1.f + __expf(-v)); }
__device__ __forceinline__ float wave_sum(float v) {
#pragma unroll
    for (int o = 1; o < 64; o <<= 1) v += __shfl_xor(v, o);
    return v;
}

__device__ __forceinline__ int opaque_tid() { int t = threadIdx.x; asm volatile("" : "+v"(t)); return t; }
__device__ __forceinline__ int opaque_bid() { int b = blockIdx.x; asm volatile("" : "+s"(b)); return b; }
struct Unit { int pm, pn; };
struct Gemm { const bf16_t* A; const bf16_t* Bt; int lda, ldb, K, nM, nN, bk; };

__device__ __forceinline__ bool next_unit(const Gemm& g, int bid, int i, Unit& u) {
    const int nwg = g.nM * g.nN;
    const long L = (long)i * gridDim.x + bid; if (L >= nwg) return false;
    int wgid = (int)L; { const int q = nwg / NXCD, r = nwg % NXCD, xcd = wgid % NXCD, off = wgid / NXCD; wgid = (xcd < r ? xcd * (q + 1) : r * (q + 1) + (xcd - r) * q) + off; }
    const int nig = WGM * g.nN, gid = wgid / nig, fm = gid * WGM, gsz = (g.nM - fm) < WGM ? (g.nM - fm) : WGM;
    u.pm = fm + ((wgid % nig) % gsz); u.pn = (wgid % nig) / gsz; return true;
}

struct EpiEven {
    static constexpr bool PERM = true;
    bf16_t* P;
    __device__ __forceinline__ void operator()(const f32x4 (&acc)[2][2][4][2], const Unit& u, int wr, int wc, int fr, int fq) const {
        const int row0 = u.pm * BM + wr * 64 + fr, T = u.pn;
        if (T < 24) {
            const int kind = T >> 3, Tl = T & 7;
            bf16_t* base = P + (size_t)kind * MTOK * 1024 + Tl * 128 + wc * 32 + 8 * fq;
#pragma unroll
            for (int ai = 0; ai < 2; ++ai)
#pragma unroll
                for (int m = 0; m < 4; ++m) {
                    bf16_t* rowp = base + (size_t)(row0 + ai * HALF + m * 16) * 1024;
                    f32x4 x0 = acc[ai][0][m][0], x1 = acc[ai][0][m][1], y0 = acc[ai][1][m][0], y1 = acc[ai][1][m][1];
                    if (kind != 0) {
#pragma unroll
                        for (int j = 0; j < 4; ++j) { y0[j] = silu_f(y0[j]); y1[j] = silu_f(y1[j]); }
                    }
                    x0 = x0 * y0; x1 = x1 * y1;
                    u32x4 w; w.x = cvt_pk_bf16(x0[0], x0[1]); w.y = cvt_pk_bf16(x0[2], x0[3]); w.z = cvt_pk_bf16(x1[0], x1[1]); w.w = cvt_pk_bf16(x1[2], x1[3]);
                    *(u32x4*)rowp = w;
                }
        } else {
            bf16_t* base = P + (size_t)3 * MTOK * 1024 + (T - 24) * 256 + wc * 32 + 8 * fq;
#pragma unroll
            for (int ai = 0; ai < 2; ++ai)
#pragma unroll
                for (int m = 0; m < 4; ++m) {
                    bf16_t* rowp = base + (size_t)(row0 + ai * HALF + m * 16) * 1024;
#pragma unroll
                    for (int bj = 0; bj < 2; ++bj) {
                        const f32x4 v0 = acc[ai][bj][m][0], v1 = acc[ai][bj][m][1];
                        u32x4 w; w.x = cvt_pk_bf16(v0[0], v0[1]); w.y = cvt_pk_bf16(v0[2], v0[3]); w.z = cvt_pk_bf16(v1[0], v1[1]); w.w = cvt_pk_bf16(v1[2], v1[3]);
                        *(u32x4*)(rowp + bj * HALF) = w;
                    }
                }
        }
    }
};
struct EpiOdd {
    static constexpr bool PERM = true;
    bf16_t* P; const float* pscale;
    __device__ __forceinline__ void operator()(const f32x4 (&acc)[2][2][4][2], const Unit& u, int wr, int wc, int fr, int fq) const {
        const int row0 = u.pm * BM + wr * 64 + fr, T = u.pn;
        const bool isz = T >= 8; const int Tl = T & 7, col0 = Tl * 256 + wc * 32 + 8 * fq;
        bf16_t* base = P + (isz ? (size_t)MTOK * 2048 : (size_t)0) + col0;
        f32x4 sc[2][2];
#pragma unroll
        for (int bj = 0; bj < 2; ++bj)
#pragma unroll
            for (int n = 0; n < 2; ++n) sc[bj][n] = isz ? *(const f32x4*)(pscale + col0 + bj * HALF + 4 * n) : (f32x4){1.f, 1.f, 1.f, 1.f};
#pragma unroll
        for (int ai = 0; ai < 2; ++ai)
#pragma unroll
            for (int m = 0; m < 4; ++m) {
                bf16_t* rowp = base + (size_t)(row0 + ai * HALF + m * 16) * 2048;
#pragma unroll
                for (int bj = 0; bj < 2; ++bj) {
                    f32x4 v0 = acc[ai][bj][m][0], v1 = acc[ai][bj][m][1];
                    if (isz) {
#pragma unroll
                        for (int j = 0; j < 4; ++j) { v0[j] = silu_f(v0[j]); v1[j] = silu_f(v1[j]); }
                        v0 = v0 * sc[bj][0]; v1 = v1 * sc[bj][1];
                    }
                    u32x4 w; w.x = cvt_pk_bf16(v0[0], v0[1]); w.y = cvt_pk_bf16(v0[2], v0[3]); w.z = cvt_pk_bf16(v1[0], v1[1]); w.w = cvt_pk_bf16(v1[2], v1[3]);
                    *(u32x4*)(rowp + bj * HALF) = w;
                }
            }
    }
};
struct EpiBf {
    static constexpr bool PERM = true;
    bf16_t* O; int ld;
    __device__ __forceinline__ void operator()(const f32x4 (&acc)[2][2][4][2], const Unit& u, int wr, int wc, int fr, int fq) const {
        const int row0 = u.pm * BM + wr * 64 + fr, col0 = u.pn * BM + wc * 32 + 8 * fq;
#pragma unroll
        for (int ai = 0; ai < 2; ++ai)
#pragma unroll
            for (int m = 0; m < 4; ++m) {
                bf16_t* rowp = O + (size_t)(row0 + ai * HALF + m * 16) * ld + col0;
#pragma unroll
                for (int bj = 0; bj < 2; ++bj) {
                    const f32x4 v0 = acc[ai][bj][m][0], v1 = acc[ai][bj][m][1];
                    u32x4 w; w.x = cvt_pk_bf16(v0[0], v0[1]); w.y = cvt_pk_bf16(v0[2], v0[3]); w.z = cvt_pk_bf16(v1[0], v1[1]); w.w = cvt_pk_bf16(v1[2], v1[3]);
                    *(u32x4*)(rowp + bj * HALF) = w;
                }
            }
    }
};
struct EpiRes {
    static constexpr bool PERM = false;
    const float* xin; float* xout; const float* gate;
    __device__ __forceinline__ void operator()(const f32x4 (&acc)[2][2][4][2], const Unit& u, int wr, int wc, int fr, int fq) const {
        const int row0 = u.pm * BM + wr * 64 + fr, col0 = u.pn * BM + wc * 32 + 4 * fq;
        const float* gp = gate + (size_t)(u.pm >> 3) * 3072 + col0;
        f32x4 gv[2][2];
#pragma unroll
        for (int bj = 0; bj < 2; ++bj)
#pragma unroll
            for (int n = 0; n < 2; ++n) gv[bj][n] = *(const f32x4*)(gp + bj * HALF + n * 16);
#pragma unroll
        for (int ai = 0; ai < 2; ++ai)
#pragma unroll
            for (int m = 0; m < 4; ++m) {
                const size_t ro = (size_t)(row0 + ai * HALF + m * 16) * DM + col0;
#pragma unroll
                for (int bj = 0; bj < 2; ++bj)
#pragma unroll
                    for (int n = 0; n < 2; ++n) {
                        const f32x4 xv = *(const f32x4*)(xin + ro + bj * HALF + n * 16);
                        *(f32x4*)(xout + ro + bj * HALF + n * 16) = xv + gv[bj][n] * acc[ai][bj][m][n];
                    }
            }
    }
};

template <class Epi>
__device__ __forceinline__ void gemm_phase(LAS unsigned char* lds, const Gemm g, const Epi& E) {
    const int tid = opaque_tid(), wid = __builtin_amdgcn_readfirstlane(tid >> 6), lane = tid & 63, wr = wid >> 2, wc = wid & 3, fr = lane & 15, fq = lane >> 4;
    const int nt = g.K / BK;
    unsigned voffA[2], voffB[2];
#pragma unroll
    for (int i = 0; i < 2; ++i) { int R, C; stage_rc(tid * 16 + i * 8192, R, C); const int Rb = Epi::PERM ? ((R & ~31) + perm32(R & 31)) : R;
        voffA[i] = (unsigned)(R * g.lda + C) * 2u; voffB[i] = (unsigned)(Rb * g.ldb + C) * 2u; }
    const size_t kstep = (size_t)(BK * 2);
    const size_t hstepA = (size_t)HALF * g.lda * 2, hstepB = (size_t)HALF * g.ldb * 2;
    const unsigned ldsw = (unsigned)wid * 1024u;
    const int aoff = lds_byte(wr * 64 + fr, fq * 8), boff = lds_byte(wc * 32 + fr, fq * 8);
#define PG8_SA(b, h) (((b) * 2 + (h)) * HTB)
#define PG8_SB(b, h) ((4 + (b) * 2 + (h)) * HTB)
#define PG8_STAGE(bufoff, gbase, voff) do { _Pragma("unroll") for (int _i = 0; _i < 2; ++_i) \
        __builtin_amdgcn_global_load_lds((const unsigned*)((const char*)(gbase) + (voff)[_i]), (LAS unsigned*)(lds + (bufoff) + ldsw + _i * 8192), 16, 0, 0); } while (0)
#define PG8_LDA(dst, b, h) do { _Pragma("unroll") for (int m = 0; m < 4; ++m) _Pragma("unroll") for (int k = 0; k < 2; ++k) dst[m][k] = *(const LAS bf16x8*)(lds + PG8_SA(b, h) + aoff + m * 2048 + k * 1024); } while (0)
#define PG8_LDB(dst, b, h) do { _Pragma("unroll") for (int n = 0; n < 2; ++n) _Pragma("unroll") for (int k = 0; k < 2; ++k) dst[n][k] = *(const LAS bf16x8*)(lds + PG8_SB(b, h) + boff + n * 2048 + k * 1024); } while (0)
#define PG8_MMA(ai, bj, At, Bt) do { __builtin_amdgcn_s_setprio(1); _Pragma("unroll") for (int m = 0; m < 4; ++m) _Pragma("unroll") for (int n = 0; n < 2; ++n) _Pragma("unroll") for (int k = 0; k < 2; ++k) \
        acc[ai][bj][m][n] = __builtin_amdgcn_mfma_f32_16x16x32_bf16(Bt[n][k], At[m][k], acc[ai][bj][m][n], 0, 0, 0); __builtin_amdgcn_s_setprio(0); } while (0)
#define PG8_WAIT_V(n) asm volatile("s_waitcnt vmcnt(" #n ")" ::: "memory")
#define PG8_WAIT_L(n) asm volatile("s_waitcnt lgkmcnt(" #n ")" ::: "memory")
#define PG8_BAR __builtin_amdgcn_s_barrier()
#define PG8_SCHED __builtin_amdgcn_sched_barrier(0)
    Unit cur, nxt; int ui = 0;
    const int bid = opaque_bid();
    if (!next_unit(g, bid, 0, cur)) return;
    f32x4 acc[2][2][4][2];
#pragma unroll
    for (int a = 0; a < 2; ++a)
#pragma unroll
        for (int b = 0; b < 2; ++b)
#pragma unroll
            for (int m = 0; m < 4; ++m)
#pragma unroll
                for (int n = 0; n < 2; ++n) acc[a][b][m][n] = (f32x4){0.f, 0.f, 0.f, 0.f};
    bf16x8 At[4][2], B0[2][2], B1[2][2];
    const char* cA = (const char*)g.A + (size_t)cur.pm * 2 * hstepA; const char* cB = (const char*)g.Bt + (size_t)cur.pn * 2 * hstepB + (size_t)(cur.pm >> 1) * g.bk * 2;
    PG8_STAGE(PG8_SB(0, 0), cB, voffB); PG8_STAGE(PG8_SA(0, 0), cA, voffA); PG8_STAGE(PG8_SB(0, 1), cB + hstepB, voffB); PG8_STAGE(PG8_SA(0, 1), cA + hstepA, voffA);
    if (wr == 1) PG8_BAR;
    PG8_WAIT_V(4); PG8_BAR;
    PG8_STAGE(PG8_SB(1, 0), cB + kstep, voffB); PG8_STAGE(PG8_SA(1, 0), cA + kstep, voffA); PG8_STAGE(PG8_SB(1, 1), cB + hstepB + kstep, voffB);
    PG8_WAIT_V(6); PG8_BAR;
    for (;;) {
        const bool has_next = next_unit(g, bid, ui + 1, nxt);
        const char* nA = has_next ? (const char*)g.A + (size_t)nxt.pm * 2 * hstepA : cA;
        const char* nB = has_next ? (const char*)g.Bt + (size_t)nxt.pn * 2 * hstepB + (size_t)(nxt.pm >> 1) * g.bk * 2 : cB;
        for (int t = 0; t < nt; t += 2) {
            const bool last = (t == nt - 2);
            const char* a1 = cA + (size_t)(t + 1) * kstep;
            const char* a2 = last ? nA : cA + (size_t)(t + 2) * kstep; const char* b2 = last ? nB : cB + (size_t)(t + 2) * kstep;
            const char* a3 = a2 + kstep; const char* b3 = b2 + kstep;
            PG8_LDB(B0, 0, 0); PG8_SCHED; PG8_LDA(At, 0, 0); PG8_STAGE(PG8_SA(1, 1), a1 + hstepA, voffA);
            PG8_WAIT_L(8); PG8_BAR; PG8_WAIT_L(0); PG8_MMA(0, 0, At, B0); PG8_BAR; PG8_SCHED;
            PG8_LDB(B1, 0, 1); PG8_STAGE(PG8_SB(0, 0), b2, voffB);
            PG8_BAR; PG8_WAIT_L(0); PG8_MMA(0, 1, At, B1); PG8_BAR;
            PG8_LDA(At, 0, 1); PG8_STAGE(PG8_SA(0, 0), a2, voffA);
            PG8_BAR; PG8_WAIT_L(0); PG8_MMA(1, 0, At, B0); PG8_BAR; PG8_SCHED;
            PG8_STAGE(PG8_SB(0, 1), b2 + hstepB, voffB);
            PG8_WAIT_V(6); PG8_BAR; PG8_MMA(1, 1, At, B1); PG8_BAR;
            PG8_LDB(B0, 1, 0); PG8_SCHED; PG8_LDA(At, 1, 0); PG8_STAGE(PG8_SA(0, 1), a2 + hstepA, voffA);
            PG8_WAIT_L(8); PG8_BAR; PG8_WAIT_L(0); PG8_MMA(0, 0, At, B0); PG8_BAR; PG8_SCHED;
            PG8_LDB(B1, 1, 1); PG8_STAGE(PG8_SB(1, 0), b3, voffB);
            PG8_BAR; PG8_WAIT_L(0); PG8_MMA(0, 1, At, B1); PG8_BAR;
            PG8_LDA(At, 1, 1); PG8_STAGE(PG8_SA(1, 0), a3, voffA);
            PG8_BAR; PG8_WAIT_L(0); PG8_MMA(1, 0, At, B0); PG8_BAR; PG8_SCHED;
            PG8_STAGE(PG8_SB(1, 1), b3 + hstepB, voffB);
            PG8_WAIT_V(6); PG8_BAR; PG8_MMA(1, 1, At, B1); PG8_BAR;
        }
        E(acc, cur, wr, wc, fr, fq);
        if (!has_next) break;
#pragma unroll
        for (int a = 0; a < 2; ++a)
#pragma unroll
            for (int b = 0; b < 2; ++b)
#pragma unroll
                for (int m = 0; m < 4; ++m)
#pragma unroll
                    for (int n = 0; n < 2; ++n) acc[a][b][m][n] = (f32x4){0.f, 0.f, 0.f, 0.f};
        cur = nxt; cA = nA; cB = nB; ++ui;
    }
    PG8_WAIT_V(0);
    if (wr == 0) PG8_BAR;
    PG8_BAR;
#undef PG8_SA
#undef PG8_SB
#undef PG8_STAGE
#undef PG8_LDA
#undef PG8_LDB
#undef PG8_MMA
#undef PG8_WAIT_V
#undef PG8_WAIT_L
#undef PG8_BAR
#undef PG8_SCHED
}

__device__ __forceinline__ void phase_mod(const Params& p, LAS unsigned char* lds) {
    const int tid = opaque_tid(), wid = tid >> 6, lane = tid & 63;
    LAS float* sc = (LAS float*)lds;
    LAS float* red = (LAS float*)(lds + 32768);
    float* mod = (float*)(p.ws + WS_MOD);
    for (int t = tid; t < NB * DM; t += 512) sc[t] = silu_f(p.c[t]);
    __syncthreads();
    for (int it = opaque_bid(); it < 192; it += gridDim.x) {
        const int col = it * 64 + lane, i = col / 3072, j = col - i * 3072;
        const float* w = p.ada_w + ((size_t)i * DM + wid * 128) * 3072 + j;
        float a[8];
#pragma unroll
        for (int b = 0; b < 8; ++b) a[b] = 0.f;
#pragma unroll 16
        for (int k = 0; k < 128; ++k) {
            const float wv = w[(size_t)k * 3072];
#pragma unroll
            for (int b = 0; b < 8; ++b) a[b] += sc[b * DM + wid * 128 + k] * wv;
        }
#pragma unroll
        for (int b = 0; b < 8; ++b) red[(wid * 8 + b) * 64 + lane] = a[b];
        __syncthreads();
        {
            const int b = tid >> 6; float s = 0.f;
#pragma unroll
            for (int w8 = 0; w8 < 8; ++w8) s += red[(w8 * 8 + b) * 64 + lane];
            mod[((size_t)i * NB + b) * 3072 + j] = s + p.ada_b[i * 3072 + j];
        }
        __syncthreads();
    }
}

__device__ __forceinline__ void conv_tile(const float* __restrict__ src, int srcN, int c0, bf16_t* __restrict__ dstrow, int K, int k0, LAS float* T) {
    const int tid = opaque_tid();
#pragma unroll
    for (int ps = 0; ps < 4; ++ps) {
        const int k = ps * 32 + (tid >> 4), c = (tid & 15) * 4;
        const f32x4 v = *(const f32x4*)(src + (size_t)(k0 + k) * srcN + c0 + c);
        LAS float* t = T + k * 65 + c; t[0] = v[0]; t[1] = v[1]; t[2] = v[2]; t[3] = v[3];
    }
    __syncthreads();
#pragma unroll
    for (int q = 0; q < 2; ++q) {
        const int item = tid + 512 * q, n = item >> 4, kg = item & 15; const LAS float* s = T + (kg * 8) * 65 + n;
        u32x4 o; o.x = cvt_pk_bf16(s[0], s[65]); o.y = cvt_pk_bf16(s[130], s[195]); o.z = cvt_pk_bf16(s[260], s[325]); o.w = cvt_pk_bf16(s[390], s[455]);
        *(u32x4*)(dstrow + (size_t)n * K + k0 + kg * 8) = o;
    }
    __syncthreads();
}

__device__ __forceinline__ void norm_rows(const Params& p, int layer, const float* xin, int item) {
    const int tid = opaque_tid(), wid = tid >> 6, lane = tid & 63;
    bf16_t* H = (bf16_t*)(p.ws + WS_RA);
    const float* mod = (const float*)(p.ws + WS_MOD) + (size_t)layer * NB * 3072;
    const float* gp = p.norm_g + (size_t)layer * DM;
#pragma unroll
    for (int h2 = 0; h2 < 2; ++h2) {
        const int row = item * 16 + h2 * 8 + wid, b = row >> 11;
        const f32x4* xr = (const f32x4*)(xin + (size_t)row * DM) + lane;
        f32x4 v[4]; float ss = 0.f;
#pragma unroll
        for (int q = 0; q < 4; ++q) { v[q] = xr[64 * q]; ss += (v[q][0] * v[q][0] + v[q][1] * v[q][1]) + (v[q][2] * v[q][2] + v[q][3] * v[q][3]); }
        const float rstd = rsqrtf(wave_sum(ss) * (1.f / DM) + EPS);
        const float* mb = mod + (size_t)b * 3072;
        u32x2* o8 = (u32x2*)(H + (size_t)row * DM) + lane;
#pragma unroll
        for (int q = 0; q < 4; ++q) {
            const int k = (lane + 64 * q) * 4;
            const f32x4 gv = *(const f32x4*)(gp + k), sh = *(const f32x4*)(mb + k), scl = *(const f32x4*)(mb + 1024 + k);
            const f32x4 hv = (v[q] * rstd * gv) * (scl + 1.f) + sh;
            u32x2 w; w.x = cvt_pk_bf16(hv[0], hv[1]); w.y = cvt_pk_bf16(hv[2], hv[3]);
            o8[64 * q] = w;
        }
    }
}
__device__ __forceinline__ void phase_norm_even(const Params& p, int j, const float* xin, LAS unsigned char* lds) {
    const int tid = opaque_tid();
    bf16_t* WIN_E = (bf16_t*)(p.ws + WS_WIN_E); bf16_t* WIN_O = (bf16_t*)(p.ws + WS_WIN_O); bf16_t* WOUT_E = (bf16_t*)(p.ws + WS_WOUT_E); bf16_t* WOUT_O = (bf16_t*)(p.ws + WS_WOUT_O);
    bf16_t* SGU = (bf16_t*)(p.ws + WS_SGU); bf16_t* POOLT = (bf16_t*)(p.ws + WS_POOLT); bf16_t* WINP = (bf16_t*)(p.ws + WS_WINP);
    constexpr int N0 = 896, N1 = N0 + 256, N2 = N1 + 256, N3 = N2 + 256, N4 = N3 + 128, N5 = N4 + 32, N6 = N5 + 512, TOTAL = N6 + MTOK / 16;
    for (int it = opaque_bid(); it < TOTAL; it += gridDim.x) {
        if (it < N0) {
            const int rt = it >> 3, kt = it & 7, r0 = rt * 64, T = r0 >> 8, q = r0 & 255; int c0;
            if (T < 8) c0 = (q < 128) ? (2048 + 128 * T + q) : (128 * T + q - 128);
            else if (T < 16) c0 = (q < 128) ? (1024 + 128 * (T - 8) + q) : (3072 + 128 * (T - 8) + q - 128);
            else if (T < 24) c0 = (q < 128) ? (4096 + 128 * (T - 16) + q) : (6144 + 128 * (T - 16) + q - 128);
            else c0 = 5120 + 256 * (T - 24) + q;
            conv_tile(p.ab_w_in + (size_t)j * DM * 7168, 7168, c0, WIN_E + (size_t)r0 * DM, DM, kt * 128, (LAS float*)lds);
        } else if (it < N1) {
            const int i2 = it - N0, rt = i2 >> 4, kt = i2 & 15, r0 = rt * 64;
            conv_tile(p.ab_w_out + (size_t)j * 2048 * DM, DM, r0, WOUT_E + (size_t)r0 * 2048, 2048, kt * 128, (LAS float*)lds);
        } else if (it < N2) {
            const int i2 = it - N1, rt = i2 >> 3, kt = i2 & 7, r0 = rt * 64;
            conv_tile(p.c_w_in + (size_t)j * DM * 4096, 4096, 2048 + r0, WIN_O + (size_t)(2048 + r0) * DM, DM, kt * 128, (LAS float*)lds);
        } else if (it < N3) {
            const int i2 = it - N2, rt = i2 >> 4, kt = i2 & 15, r0 = rt * 64;
            conv_tile(p.c_w_out + (size_t)j * 2048 * DM, DM, r0, WOUT_O + (size_t)r0 * 2048, 2048, kt * 128, (LAS float*)lds);
        } else if (it < N4) {
            const int i3 = it - N3, g = i3 >> 5, r = i3 & 31, rt = r >> 2, kt = r & 3, r0 = rt * 64;
            conv_tile(p.c_pool_w + ((size_t)j * 4 + g) * 512 * 512, 512, r0, POOLT + (size_t)g * 512 * 512 + (size_t)r0 * 512, 512, kt * 128, (LAS float*)lds);
        } else if (it < N5) {
            const int e0 = (it - N4) * 4096 + tid * 8, t = (e0 >> 7) & 127, s0 = e0 & 127;
            const float* src = p.ab_sgu_w + (size_t)j * 8 * 128 * 128 + e0;
            const f32x4 a = *(const f32x4*)src, b = *(const f32x4*)(src + 4);
            float v[8] = {a[0], a[1], a[2], a[3], b[0], b[1], b[2], b[3]};
#pragma unroll
            for (int e = 0; e < 8; ++e) v[e] = (s0 + e <= t) ? v[e] : 0.f;
            u32x4 o; o.x = cvt_pk_bf16(v[0], v[1]); o.y = cvt_pk_bf16(v[2], v[3]); o.z = cvt_pk_bf16(v[4], v[5]); o.w = cvt_pk_bf16(v[6], v[7]);
            *(u32x4*)(SGU + e0) = o;
        } else if (it < N6) {
            const int e0 = (it - N5) * 4096 + tid * 8, k = e0 >> 11, c = e0 & 2047;
            const float* src = p.c_w_in + ((size_t)j * DM + k) * 4096 + c;
            const f32x4 a = *(const f32x4*)src, b = *(const f32x4*)(src + 4);
            u32x4 o; o.x = cvt_pk_bf16(a[0], a[1]); o.y = cvt_pk_bf16(a[2], a[3]); o.z = cvt_pk_bf16(b[0], b[1]); o.w = cvt_pk_bf16(b[2], b[3]);
            *(u32x4*)(WINP + e0) = o;
        } else norm_rows(p, 2 * j, xin, it - N6);
    }
}
__device__ __forceinline__ void phase_norm_odd(const Params& p, int j, LAS unsigned char* lds) {
    if (blockIdx.x < 32) {
        Gemm g{(const bf16_t*)(p.ws + WS_POOLT), (const bf16_t*)(p.ws + WS_WINP), 512, 2048, 512, 8, 4, 512}; EpiBf E{(bf16_t*)(p.ws + WS_WIN_O), DM};
        gemm_phase(lds, g, E);
    } else {
        for (int it = opaque_bid() - 32; it < MTOK / 16; it += gridDim.x - 32) norm_rows(p, 2 * j + 1, p.out, it);
    }
}

__device__ __forceinline__ void phase_final(const Params& p) {
    const int tid = opaque_tid(), wid = tid >> 6, lane = tid & 63;
    for (int it = opaque_bid(); it < MTOK / 8; it += gridDim.x) {
        const int row = it * 8 + wid;
        f32x4* xr = (f32x4*)(p.out + (size_t)row * DM) + lane;
        f32x4 v[4]; float ss = 0.f;
#pragma unroll
        for (int q = 0; q < 4; ++q) { v[q] = xr[64 * q]; ss += (v[q][0] * v[q][0] + v[q][1] * v[q][1]) + (v[q][2] * v[q][2] + v[q][3] * v[q][3]); }
        const float rstd = rsqrtf(wave_sum(ss) * (1.f / DM) + EPS);
#pragma unroll
        for (int q = 0; q < 4; ++q) { const f32x4 gv = *(const f32x4*)(p.final_g + (lane + 64 * q) * 4); xr[64 * q] = v[q] * rstd * gv; }
    }
}

__device__ __forceinline__ void unpack8(const u32x4 w, float (&f)[8]) {
    f[0] = bf_lo(w.x); f[1] = bf_hi(w.x); f[2] = bf_lo(w.y); f[3] = bf_hi(w.y); f[4] = bf_lo(w.z); f[5] = bf_hi(w.z); f[6] = bf_lo(w.w); f[7] = bf_hi(w.w);
}

__device__ __forceinline__ void phase_mix(const Params& p, int j, LAS unsigned char* lds) {
    const int tid = opaque_tid(), wid = tid >> 6, lane = tid & 63;
    const bf16_t* CH2 = (const bf16_t*)(p.ws + WS_RP); const bf16_t* BZ = CH2 + (size_t)MTOK * 1024; const bf16_t* UZ = BZ + (size_t)MTOK * 1024; const bf16_t* V = UZ + (size_t)MTOK * 1024;
    bf16_t* Y = (bf16_t*)(p.ws + WS_RA);
    {
        const bf16_t* Wm = (const bf16_t*)(p.ws + WS_SGU);
        LAS bf16_t* vnT = (LAS bf16_t*)lds;
        LAS float* red = (LAS float*)(lds + 36864);
        const int fr = lane & 15, fq = lane >> 4;
        for (int it = opaque_bid(); it < 1024; it += gridDim.x) {
            const int hh = it & 7, cn = it >> 3;
            const int s = lane + 64 * (wid & 1), q = wid >> 1;
            const bf16_t* vp = V + (size_t)(cn * 128 + s) * 1024 + hh * 128 + 32 * q;
            float f[32];
#pragma unroll
            for (int i = 0; i < 4; ++i) { const u32x4 w = *(const u32x4*)(vp + 8 * i); float t8[8]; unpack8(w, t8);
#pragma unroll
                for (int e = 0; e < 8; ++e) f[8 * i + e] = t8[e]; }
            float s1 = 0.f, s2 = 0.f;
#pragma unroll
            for (int i = 0; i < 32; ++i) { s1 += f[i]; s2 += f[i] * f[i]; }
            red[(s * 4 + q) * 2] = s1; red[(s * 4 + q) * 2 + 1] = s2;
            __syncthreads();
            float S1 = 0.f, S2 = 0.f;
#pragma unroll
            for (int qq = 0; qq < 4; ++qq) { S1 += red[(s * 4 + qq) * 2]; S2 += red[(s * 4 + qq) * 2 + 1]; }
            const float mu = S1 * (1.f / 128.f), var = fmaxf(S2 * (1.f / 128.f) - mu * mu, 0.f), rstd = rsqrtf(var + EPS);
            const float* lg = p.ab_ln_g + (size_t)j * 1024 + hh * 128 + 32 * q; const float* lb = p.ab_ln_b + (size_t)j * 1024 + hh * 128 + 32 * q;
#pragma unroll
            for (int i = 0; i < 32; ++i) {
                const float vn = (f[i] - mu) * rstd * lg[i] + lb[i];
                vnT[(32 * q + i) * 136 + s] = (bf16_t)(cvt_pk_bf16(vn, 0.f) & 0xffffu);
            }
            __syncthreads();
            f32x4 acc[8];
#pragma unroll
            for (int n = 0; n < 8; ++n) acc[n] = (f32x4){0.f, 0.f, 0.f, 0.f};
            const bf16_t* wrow = Wm + ((size_t)hh * 128 + 16 * wid + fr) * 128 + 8 * fq;
#pragma unroll
            for (int kk = 0; kk < 4; ++kk) {
                if (32 * kk <= 16 * wid + 15) {
                    const bf16x8 af = *(const bf16x8*)(wrow + 32 * kk);
#pragma unroll
                    for (int n = 0; n < 8; ++n) {
                        const bf16x8 bfm = *(const LAS bf16x8*)(vnT + (16 * n + fr) * 136 + 32 * kk + 8 * fq);
                        acc[n] = __builtin_amdgcn_mfma_f32_16x16x32_bf16(bfm, af, acc[n], 0, 0, 0);
                    }
                }
            }
            const int t = 16 * wid + fr; const size_t row = (size_t)cn * 128 + t;
            const float bias = p.ab_sgu_b[(size_t)j * 1024 + hh * 128 + t];
#pragma unroll
            for (int n = 0; n < 8; ++n) {
                const int d = 16 * n + 4 * fq;
                const u32x2 uz = *(const u32x2*)(UZ + row * 1024 + hh * 128 + d);
                u32x2 w; w.x = cvt_pk_bf16(bf_lo(uz.x) * (acc[n][0] + bias), bf_hi(uz.x) * (acc[n][1] + bias));
                w.y = cvt_pk_bf16(bf_lo(uz.y) * (acc[n][2] + bias), bf_hi(uz.y) * (acc[n][3] + bias));
                *(u32x2*)(Y + row * 2048 + 1024 + hh * 128 + d) = w;
            }
        }
    }
    {
        const float* cw = p.ab_conv_w + (size_t)j * 3 * 1024;
        for (int it = opaque_bid(); it < 256; it += gridDim.x) {
            const int rg = it * 4 + (tid >> 7), c0 = (tid & 127) * 8, t0 = rg * 16;
            float w0[8], w1[8], w2[8], p2[8], p1[8];
#pragma unroll
            for (int h4 = 0; h4 < 2; ++h4) {
                const f32x4 a = *(const f32x4*)(cw + c0 + 4 * h4), b = *(const f32x4*)(cw + 1024 + c0 + 4 * h4), c = *(const f32x4*)(cw + 2048 + c0 + 4 * h4);
#pragma unroll
                for (int e = 0; e < 4; ++e) { w0[4 * h4 + e] = a[e]; w1[4 * h4 + e] = b[e]; w2[4 * h4 + e] = c[e]; }
            }
            if ((t0 & (SEQ - 1)) != 0) {
                unpack8(*(const u32x4*)(CH2 + (size_t)(t0 - 2) * 1024 + c0), p2);
                unpack8(*(const u32x4*)(CH2 + (size_t)(t0 - 1) * 1024 + c0), p1);
            } else {
#pragma unroll
                for (int e = 0; e < 8; ++e) { p2[e] = 0.f; p1[e] = 0.f; }
            }
#pragma unroll 8
            for (int r = 0; r < 16; ++r) {
                float cur[8], bz[8], o[8];
                unpack8(*(const u32x4*)(CH2 + (size_t)(t0 + r) * 1024 + c0), cur);
                unpack8(*(const u32x4*)(BZ + (size_t)(t0 + r) * 1024 + c0), bz);
#pragma unroll
                for (int e = 0; e < 8; ++e) { o[e] = bz[e] * (w0[e] * p2[e] + w1[e] * p1[e] + w2[e] * cur[e]); p2[e] = p1[e]; p1[e] = cur[e]; }
                u32x4 w; w.x = cvt_pk_bf16(o[0], o[1]); w.y = cvt_pk_bf16(o[2], o[3]); w.z = cvt_pk_bf16(o[4], o[5]); w.w = cvt_pk_bf16(o[6], o[7]);
                *(u32x4*)(Y + (size_t)(t0 + r) * 2048 + c0) = w;
            }
        }
    }
}

__device__ __forceinline__ void phase_pool(const Params& p) {
    const int tid = opaque_tid();
    const bf16_t* Q = (const bf16_t*)(p.ws + WS_RP); const bf16_t* SZ = Q + (size_t)MTOK * 2048; bf16_t* Y = (bf16_t*)(p.ws + WS_RA);
    for (int it = opaque_bid(); it < 256; it += gridDim.x) {
        const int rg = it * 2 + (tid >> 8), ct = tid & 255, c0 = ct * 8, win = 2 << (ct >> 6), t0 = rg * 32, tl0 = t0 & (SEQ - 1);
        float S[8];
#pragma unroll
        for (int e = 0; e < 8; ++e) S[e] = 0.f;
        for (int i = 1; i < win; ++i) {
            if (tl0 - i >= 0) { float v[8]; unpack8(*(const u32x4*)(Q + (size_t)(t0 - i) * 2048 + c0), v);
#pragma unroll
                for (int e = 0; e < 8; ++e) S[e] += v[e]; }
        }
#pragma unroll 8
        for (int r = 0; r < 32; ++r) {
            const int tl = tl0 + r;
            float cur[8], sz[8], o[8];
            unpack8(*(const u32x4*)(Q + (size_t)(t0 + r) * 2048 + c0), cur);
            unpack8(*(const u32x4*)(SZ + (size_t)(t0 + r) * 2048 + c0), sz);
            const float inv = 1.f / (float)min(tl + 1, win);
#pragma unroll
            for (int e = 0; e < 8; ++e) { S[e] += cur[e]; o[e] = (S[e] * inv - cur[e]) * sz[e]; }
            u32x4 w; w.x = cvt_pk_bf16(o[0], o[1]); w.y = cvt_pk_bf16(o[2], o[3]); w.z = cvt_pk_bf16(o[4], o[5]); w.w = cvt_pk_bf16(o[6], o[7]);
            *(u32x4*)(Y + (size_t)(t0 + r) * 2048 + c0) = w;
            if (tl - win + 1 >= 0) { float old[8]; unpack8(*(const u32x4*)(Q + (size_t)(t0 + r - win + 1) * 2048 + c0), old);
#pragma unroll
                for (int e = 0; e < 8; ++e) S[e] -= old[e]; }
        }
    }
}

#define XB_TMO      128
#define XB_XCNT(j)  (256  + 64 * (j))
#define XB_XSUB(j)  (1280 + 64 * (j))
#define XB_XGEN(j)  (2304 + 64 * (j))
#define XB_TOP      3328
#define XB_TOPGEN   3392
#define XCD_BAR_WORDS 3456
#define XB_SPIN_CAP (1u << 18)
__device__ __forceinline__ unsigned xb_ld(unsigned* p)              { return __hip_atomic_load(p, __ATOMIC_RELAXED, __HIP_MEMORY_SCOPE_AGENT); }
__device__ __forceinline__ unsigned xb_add(unsigned* p, unsigned v) { return __hip_atomic_fetch_add(p, v, __ATOMIC_RELAXED, __HIP_MEMORY_SCOPE_AGENT); }
__device__ __forceinline__ unsigned xb_xcc_id() { return (unsigned)__builtin_amdgcn_s_getreg((3 << 11) | 20) & 0xFu; }
#define XB_SPIN(cond, bar) do { unsigned _sp = 0; while (cond) { __builtin_amdgcn_s_sleep(1); \
    if ((++_sp & 255u) == 0u) { if (xb_ld(&(bar)[XB_TMO])) break; if (_sp > XB_SPIN_CAP) { atomicAdd(&(bar)[XB_TMO], 1u); break; } } } } while (0)
struct XcdBarrier { unsigned* bar; unsigned x; volatile LAS unsigned* st; };
__device__ __forceinline__ XcdBarrier xcd_barrier_post(unsigned* bar, volatile LAS unsigned* st) {
    XcdBarrier b; b.bar = bar; b.x = xb_xcc_id(); b.st = st;
    if (threadIdx.x == 0) (void)xb_add(&bar[XB_XCNT(b.x)], 1u);
    return b;
}
__device__ __forceinline__ void xcd_barrier_complete(unsigned* bar, unsigned x, unsigned& nloc, unsigned& nx) {
    const unsigned G = gridDim.x * gridDim.y * gridDim.z;
    unsigned sum, cnt, mine, sp = 0u;
    for (;;) {
        sum = 0u; cnt = 0u; mine = 0u;
#pragma unroll
        for (unsigned j = 0; j < 16; ++j) { const unsigned c = xb_ld(&bar[XB_XCNT(j)]); sum += c; cnt += (c > 0u) ? 1u : 0u; mine = (j == x) ? c : mine; }
        if (sum == G) break;
        __builtin_amdgcn_s_sleep(1);
        if ((++sp & 255u) == 0u) { if (xb_ld(&bar[XB_TMO])) break; if (sp > XB_SPIN_CAP) { atomicAdd(&bar[XB_TMO], 1u); break; } }
    }
    nloc = mine > 0u ? mine : 1u; nx = cnt > 0u ? cnt : 1u;
}
__device__ __forceinline__ void xcd_barrier(const XcdBarrier& b) {
    asm volatile("s_waitcnt vmcnt(0)" ::: "memory");
    __syncthreads();
    if (threadIdx.x == 0) {
        unsigned* bar = b.bar;
        __builtin_amdgcn_s_waitcnt(0);
        unsigned nloc = b.st[0], nx = b.st[1];
        if (nloc == 0u) { xcd_barrier_complete(bar, b.x, nloc, nx); b.st[0] = nloc; b.st[1] = nx; }
        const unsigned old = xb_add(&bar[XB_XSUB(b.x)], 1u);
        const unsigned gen = old / nloc;
        if (old + 1u == (gen + 1u) * nloc) {
            __builtin_amdgcn_fence(__ATOMIC_RELEASE, "agent");
            asm volatile("s_waitcnt vmcnt(0)" ::: "memory");
            const unsigned og = xb_add(&bar[XB_TOP], 1u);
            const unsigned tg = og / nx;
            if (og + 1u == (tg + 1u) * nx) xb_add(&bar[XB_TOPGEN], 1u);
            else XB_SPIN(xb_ld(&bar[XB_TOPGEN]) == tg, bar);
            __builtin_amdgcn_fence(__ATOMIC_ACQUIRE, "agent");
            xb_add(&bar[XB_XGEN(b.x)], 1u);
            asm volatile("s_waitcnt vmcnt(0)" ::: "memory");
        } else {
            XB_SPIN(xb_ld(&bar[XB_XGEN(b.x)]) == gen, bar);
            __builtin_amdgcn_fence(__ATOMIC_ACQUIRE, "agent");
            asm volatile("s_waitcnt vmcnt(0)" ::: "memory");
        }
    }
    __syncthreads();
}

__global__ void __launch_bounds__(512, 2) mega_fwd(Params p, int ph_lo, int ph_hi) {
    extern __shared__ __attribute__((aligned(16))) unsigned char smem[];
    LAS unsigned char* lds = (LAS unsigned char*)smem;
    cg::grid_group grid = cg::this_grid();
    if (ph_hi < 0) grid.sync();
    volatile LAS unsigned* st = (volatile LAS unsigned*)(lds + STAGE_BYTES);
    if (threadIdx.x < 4) st[threadIdx.x] = 0u;
    __syncthreads();
    const XcdBarrier xb = xcd_barrier_post((unsigned*)(p.ws + WS_BAR), st);
    int ph = 0;
#define PHASE(REP, ...) do { if (ph >= ph_lo && ph < ph_hi) { for (int _r = 0; _r < (REP); ++_r) { __VA_ARGS__; if (ph + 1 < ph_hi) xcd_barrier(xb); } } ++ph; } while (0)
    bf16_t* RA = (bf16_t*)(p.ws + WS_RA); bf16_t* RP = (bf16_t*)(p.ws + WS_RP);
    const bf16_t* WIN_E = (const bf16_t*)(p.ws + WS_WIN_E); const bf16_t* WIN_O = (const bf16_t*)(p.ws + WS_WIN_O);
    const bf16_t* WOUT_E = (const bf16_t*)(p.ws + WS_WOUT_E); const bf16_t* WOUT_O = (const bf16_t*)(p.ws + WS_WOUT_O);
    const float* mod = (const float*)(p.ws + WS_MOD);
    PHASE(REP_THIN, phase_mod(p, lds));
#pragma unroll 1
    for (int lp = 0; lp < 2; ++lp) {
        {
            const int layer = 2 * lp; const float* xin = (lp == 0) ? p.x : p.out;
            PHASE(REP_THIN, phase_norm_even(p, lp, xin, lds));
            PHASE(REP_G1, { Gemm g{RA, WIN_E, DM, DM, DM, MTOK / BM, 7168 / BM, 0}; EpiEven E{RP}; gemm_phase(lds, g, E); });
            PHASE(REP_THIN, phase_mix(p, lp, lds));
            PHASE((lp == 0 ? REP_G2L0 : 1), { Gemm g{RA, WOUT_E, 2048, 2048, 2048, MTOK / BM, DM / BM, 0}; EpiRes E{xin, p.out, mod + (size_t)layer * NB * 3072 + 2048}; gemm_phase(lds, g, E); });
        }
        {
            const int layer = 2 * lp + 1;
            PHASE(REP_THIN, phase_norm_odd(p, lp, lds));
            PHASE(REP_G1, { Gemm g{RA, WIN_O, DM, DM, DM, MTOK / BM, 4096 / BM, 0}; EpiOdd E{RP, p.c_pool_scale + (size_t)lp * 2048}; gemm_phase(lds, g, E); });
            PHASE(REP_THIN, phase_pool(p));
            PHASE(1, { Gemm g{RA, WOUT_O, 2048, 2048, 2048, MTOK / BM, DM / BM, 0}; EpiRes E{p.out, p.out, mod + (size_t)layer * NB * 3072 + 2048}; gemm_phase(lds, g, E); });
        }
    }
    PHASE(1, phase_final(p));
#undef PHASE
}

extern "C" void kernel_launch(void* const* d_in, const int* in_sizes, int n_in, void* d_out, int out_size, void* d_ws, size_t ws_size, hipStream_t stream) {
    static int grid = 0;
    if (grid == 0) {
        if (n_in != 17 || out_size != MTOK * DM || ws_size < WS_END) { fprintf(stderr, "kernel_launch: unexpected shapes (n_in %d out %d ws %zu need %zu)\n", n_in, out_size, ws_size, (size_t)WS_END); grid = -1; return; }
        int dev = 0, cus = 0, per_cu = 0;
        hipGetDevice(&dev);
        hipDeviceGetAttribute(&cus, hipDeviceAttributeMultiprocessorCount, dev);
        if (hipFuncSetAttribute((const void*)mega_fwd, hipFuncAttributeMaxDynamicSharedMemorySize, LDS_BYTES) != hipSuccess) { fprintf(stderr, "kernel_launch: hipFuncSetAttribute failed\n"); grid = -1; return; }
        hipOccupancyMaxActiveBlocksPerMultiprocessor(&per_cu, (const void*)mega_fwd, 512, LDS_BYTES);
        if (per_cu < 1) { fprintf(stderr, "kernel_launch: occupancy query says %d blocks per CU\n", per_cu); per_cu = 1; }
        (void)hipGetLastError();
        grid = cus;
    }
    if (grid < 0) return;
    Params p{};
    p.x = (const float*)d_in[0]; p.c = (const float*)d_in[1]; p.norm_g = (const float*)d_in[2]; p.ada_w = (const float*)d_in[3]; p.ada_b = (const float*)d_in[4];
    p.ab_w_in = (const float*)d_in[5]; p.ab_conv_w = (const float*)d_in[6]; p.ab_ln_g = (const float*)d_in[7]; p.ab_ln_b = (const float*)d_in[8];
    p.ab_sgu_w = (const float*)d_in[9]; p.ab_sgu_b = (const float*)d_in[10]; p.ab_w_out = (const float*)d_in[11];
    p.c_w_in = (const float*)d_in[12]; p.c_pool_w = (const float*)d_in[13]; p.c_pool_scale = (const float*)d_in[14]; p.c_w_out = (const float*)d_in[15]; p.final_g = (const float*)d_in[16];
    p.out = (float*)d_out; p.ws = (unsigned char*)d_ws;
    if (hipMemsetAsync((unsigned char*)d_ws + WS_BAR, 0, XCD_BAR_WORDS * 4, stream) != hipSuccess) { fprintf(stderr, "kernel_launch: barrier memset failed\n"); return; }
    int lo = 0, hi = 18;
    void* args[] = {&p, &lo, &hi};
    hipError_t e = hipLaunchCooperativeKernel((const void*)mega_fwd, dim3(grid), dim3(512), args, LDS_BYTES, stream);
    if (e != hipSuccess) fprintf(stderr, "kernel_launch: cooperative launch failed: %s (grid %d)\n", hipGetErrorString(e), grid);
}
```

```cpp
#include <hip/hip_runtime.h>
#include <hip/hip_cooperative_groups.h>
#include <cstdio>
namespace cg = cooperative_groups;

#define LAS __attribute__((address_space(3)))
typedef unsigned short bf16_t;
typedef short bf16x8 __attribute__((ext_vector_type(8)));
typedef float f32x4 __attribute__((ext_vector_type(4)));
typedef unsigned u32x4 __attribute__((ext_vector_type(4)));
typedef unsigned u32x2 __attribute__((ext_vector_type(2)));

constexpr int DM = 1024, NB = 8, SEQ = 2048, MTOK = NB * SEQ;
constexpr int BM = 256, BK = 64, HALF = 128, HTB = HALF * BK * 2, STAGE_BYTES = 8 * HTB, NXCD = 8, WGM = 8;
constexpr int LDS_BYTES = STAGE_BYTES + 16;
constexpr float EPS = 1e-6f;
constexpr int REP_G1 = 1, REP_THIN = 1, REP_G2L0 = 1;

constexpr size_t WS_MOD = 0;
constexpr size_t WS_BAR = 393216;
constexpr size_t WS_WIN_E = 524288;
constexpr size_t WS_WIN_O = WS_WIN_E + (size_t)7168 * 1024 * 2;
constexpr size_t WS_WOUT_E = WS_WIN_O + (size_t)4096 * 1024 * 2;
constexpr size_t WS_WOUT_O = WS_WOUT_E + (size_t)1024 * 2048 * 2;
constexpr size_t WS_SGU = WS_WOUT_O + (size_t)1024 * 2048 * 2;
constexpr size_t WS_POOLT = WS_SGU + (size_t)8 * 128 * 128 * 2;
constexpr size_t WS_WINP = WS_POOLT + (size_t)4 * 512 * 512 * 2;
constexpr size_t WS_RA = WS_WINP + (size_t)1024 * 2048 * 2;
constexpr size_t WS_RP = WS_RA + (size_t)MTOK * 2048 * 2;
constexpr size_t WS_END = WS_RP + (size_t)MTOK * 4096 * 2;

constexpr size_t WS_PART = WS_END;
constexpr size_t WS_END2 = WS_PART + (size_t)4 * 4 * MTOK * 4;
constexpr int CNT_WORD0 = 3584;
constexpr int CTL_WORDS = CNT_WORD0 + 256;
__device__ unsigned short g_h[(size_t)MTOK * DM];

struct Params {
    const float *x, *c, *norm_g, *ada_w, *ada_b, *ab_w_in, *ab_conv_w, *ab_ln_g, *ab_ln_b, *ab_sgu_w, *ab_sgu_b, *ab_w_out,
        *c_w_in, *c_pool_w, *c_pool_scale, *c_w_out, *final_g;
    float* out;
    unsigned char* ws;
};

__host__ __device__ __forceinline__ int lds_byte(int r, int c) { const int st = (r >> 4) * 2 + (c >> 5), rr = r & 15, cc = c & 31, ob = rr * 64 + cc * 2; return st * 1024 + (ob ^ (((ob >> 9) & 1) << 5)); }
__host__ __device__ __forceinline__ void stage_rc(int b, int& R, int& C) { const int st = b / 1024, sb = b % 1024, swz = sb ^ (((sb >> 9) & 1) << 5); R = (st >> 1) * 16 + swz / 64; C = (st & 1) * 32 + (swz % 64) / 2; }
__host__ __device__ __forceinline__ int perm32(int rho) { const int n = rho >> 4, i = rho & 15; return 8 * (i >> 2) + 4 * n + (i & 3); }
__device__ __forceinline__ unsigned cvt_pk_bf16(float lo, float hi) { unsigned r; asm volatile("v_cvt_pk_bf16_f32 %0, %1, %2" : "=v"(r) : "v"(lo), "v"(hi)); return r; }
__device__ __forceinline__ float bf_lo(unsigned w) { return __uint_as_float(w << 16); }
__device__ __forceinline__ float bf_hi(unsigned w) { return __uint_as_float(w & 0xffff0000u); }
__device__ __forceinline__ float silu_f(float v) { return v * __builtin_amdgcn_rcpf(1.f + __expf(-v)); }
__device__ __forceinline__ float wave_sum(float v) {
#pragma unroll
    for (int o = 1; o < 64; o <<= 1) v += __shfl_xor(v, o);
    return v;
}

__device__ __forceinline__ int opaque_tid() { int t = threadIdx.x; asm volatile("" : "+v"(t)); return t; }
__device__ __forceinline__ int opaque_bid() { int b = blockIdx.x; asm volatile("" : "+s"(b)); return b; }
struct Unit { int pm, pn; };
struct Gemm { const bf16_t* A; const bf16_t* Bt; int lda, ldb, K, nM, nN, bk; };

__device__ __forceinline__ bool next_unit(const Gemm& g, int bid, int i, Unit& u) {
    const int nwg = g.nM * g.nN;
    const long L = (long)i * gridDim.x + bid; if (L >= nwg) return false;
    int wgid = (int)L; { const int q = nwg / NXCD, r = nwg % NXCD, xcd = wgid % NXCD, off = wgid / NXCD; wgid = (xcd < r ? xcd * (q + 1) : r * (q + 1) + (xcd - r) * q) + off; }
    const int nig = WGM * g.nN, gid = wgid / nig, fm = gid * WGM, gsz = (g.nM - fm) < WGM ? (g.nM - fm) : WGM;
    u.pm = fm + ((wgid % nig) % gsz); u.pn = (wgid % nig) / gsz; return true;
}

struct EpiEven {
    static constexpr bool PERM = true, AFTER_DRAIN = false;
    bf16_t* P;
    __device__ __forceinline__ void operator()(const f32x4 (&acc)[2][2][4][2], const Unit& u, int wr, int wc, int fr, int fq) const {
        const int row0 = u.pm * BM + wr * 64 + fr, T = u.pn;
        if (T < 24) {
            const int kind = T >> 3, Tl = T & 7;
            bf16_t* base = P + (size_t)kind * MTOK * 1024 + Tl * 128 + wc * 32 + 8 * fq;
#pragma unroll
            for (int ai = 0; ai < 2; ++ai)
#pragma unroll
                for (int m = 0; m < 4; ++m) {
                    bf16_t* rowp = base + (size_t)(row0 + ai * HALF + m * 16) * 1024;
                    f32x4 x0 = acc[ai][0][m][0], x1 = acc[ai][0][m][1], y0 = acc[ai][1][m][0], y1 = acc[ai][1][m][1];
                    if (kind != 0) {
#pragma unroll
                        for (int j = 0; j < 4; ++j) { y0[j] = silu_f(y0[j]); y1[j] = silu_f(y1[j]); }
                    }
                    x0 = x0 * y0; x1 = x1 * y1;
                    u32x4 w; w.x = cvt_pk_bf16(x0[0], x0[1]); w.y = cvt_pk_bf16(x0[2], x0[3]); w.z = cvt_pk_bf16(x1[0], x1[1]); w.w = cvt_pk_bf16(x1[2], x1[3]);
                    *(u32x4*)rowp = w;
                }
        } else {
            bf16_t* base = P + (size_t)3 * MTOK * 1024 + (T - 24) * 256 + wc * 32 + 8 * fq;
#pragma unroll
            for (int ai = 0; ai < 2; ++ai)
#pragma unroll
                for (int m = 0; m < 4; ++m) {
                    bf16_t* rowp = base + (size_t)(row0 + ai * HALF + m * 16) * 1024;
#pragma unroll
                    for (int bj = 0; bj < 2; ++bj) {
                        const f32x4 v0 = acc[ai][bj][m][0], v1 = acc[ai][bj][m][1];
                        u32x4 w; w.x = cvt_pk_bf16(v0[0], v0[1]); w.y = cvt_pk_bf16(v0[2], v0[3]); w.z = cvt_pk_bf16(v1[0], v1[1]); w.w = cvt_pk_bf16(v1[2], v1[3]);
                        *(u32x4*)(rowp + bj * HALF) = w;
                    }
                }
        }
    }
};
struct EpiOdd {
    static constexpr bool PERM = true, AFTER_DRAIN = false;
    bf16_t* P; const float* pscale;
    __device__ __forceinline__ void operator()(const f32x4 (&acc)[2][2][4][2], const Unit& u, int wr, int wc, int fr, int fq) const {
        const int row0 = u.pm * BM + wr * 64 + fr, T = u.pn;
        const bool isz = T >= 8; const int Tl = T & 7, col0 = Tl * 256 + wc * 32 + 8 * fq;
        bf16_t* base = P + (isz ? (size_t)MTOK * 2048 : (size_t)0) + col0;
        f32x4 sc[2][2];
#pragma unroll
        for (int bj = 0; bj < 2; ++bj)
#pragma unroll
            for (int n = 0; n < 2; ++n) sc[bj][n] = isz ? *(const f32x4*)(pscale + col0 + bj * HALF + 4 * n) : (f32x4){1.f, 1.f, 1.f, 1.f};
#pragma unroll
        for (int ai = 0; ai < 2; ++ai)
#pragma unroll
            for (int m = 0; m < 4; ++m) {
                bf16_t* rowp = base + (size_t)(row0 + ai * HALF + m * 16) * 2048;
#pragma unroll
                for (int bj = 0; bj < 2; ++bj) {
                    f32x4 v0 = acc[ai][bj][m][0], v1 = acc[ai][bj][m][1];
                    if (isz) {
#pragma unroll
                        for (int j = 0; j < 4; ++j) { v0[j] = silu_f(v0[j]); v1[j] = silu_f(v1[j]); }
                        v0 = v0 * sc[bj][0]; v1 = v1 * sc[bj][1];
                    }
                    u32x4 w; w.x = cvt_pk_bf16(v0[0], v0[1]); w.y = cvt_pk_bf16(v0[2], v0[3]); w.z = cvt_pk_bf16(v1[0], v1[1]); w.w = cvt_pk_bf16(v1[2], v1[3]);
                    *(u32x4*)(rowp + bj * HALF) = w;
                }
            }
    }
};
struct EpiBf {
    static constexpr bool PERM = true, AFTER_DRAIN = false;
    bf16_t* O; int ld;
    __device__ __forceinline__ void operator()(const f32x4 (&acc)[2][2][4][2], const Unit& u, int wr, int wc, int fr, int fq) const {
        const int row0 = u.pm * BM + wr * 64 + fr, col0 = u.pn * BM + wc * 32 + 8 * fq;
#pragma unroll
        for (int ai = 0; ai < 2; ++ai)
#pragma unroll
            for (int m = 0; m < 4; ++m) {
                bf16_t* rowp = O + (size_t)(row0 + ai * HALF + m * 16) * ld + col0;
#pragma unroll
                for (int bj = 0; bj < 2; ++bj) {
                    const f32x4 v0 = acc[ai][bj][m][0], v1 = acc[ai][bj][m][1];
                    u32x4 w; w.x = cvt_pk_bf16(v0[0], v0[1]); w.y = cvt_pk_bf16(v0[2], v0[3]); w.z = cvt_pk_bf16(v1[0], v1[1]); w.w = cvt_pk_bf16(v1[2], v1[3]);
                    *(u32x4*)(rowp + bj * HALF) = w;
                }
            }
    }
};
struct EpiRes {
    static constexpr bool PERM = false, AFTER_DRAIN = false;
    const float* xin; float* xout; const float* gate;
    __device__ __forceinline__ void operator()(const f32x4 (&acc)[2][2][4][2], const Unit& u, int wr, int wc, int fr, int fq) const {
        const int row0 = u.pm * BM + wr * 64 + fr, col0 = u.pn * BM + wc * 32 + 4 * fq;
        const float* gp = gate + (size_t)(u.pm >> 3) * 3072 + col0;
        f32x4 gv[2][2];
#pragma unroll
        for (int bj = 0; bj < 2; ++bj)
#pragma unroll
            for (int n = 0; n < 2; ++n) gv[bj][n] = *(const f32x4*)(gp + bj * HALF + n * 16);
#pragma unroll
        for (int ai = 0; ai < 2; ++ai)
#pragma unroll
            for (int m = 0; m < 4; ++m) {
                const size_t ro = (size_t)(row0 + ai * HALF + m * 16) * DM + col0;
#pragma unroll
                for (int bj = 0; bj < 2; ++bj)
#pragma unroll
                    for (int n = 0; n < 2; ++n) {
                        const f32x4 xv = *(const f32x4*)(xin + ro + bj * HALF + n * 16);
                        *(f32x4*)(xout + ro + bj * HALF + n * 16) = xv + gv[bj][n] * acc[ai][bj][m][n];
                    }
            }
    }
};

struct EpiResNorm {
    static constexpr bool PERM = true, AFTER_DRAIN = true;
    const float* xin; float* xout; const float* gate; bf16_t* H; const float* ng; const float* modn; float* part; unsigned* cnt; int last;
    __device__ __forceinline__ void fused(f32x4 (&acc)[2][2][4][2], const Unit& u, int wr, int wc, int fr, int fq, LAS unsigned char* lds, int tid) const {
        const int row0 = u.pm * BM + wr * 64 + fr, col0 = u.pn * BM + wc * 32 + 8 * fq, b = u.pm >> 3;
        LAS float* lss = (LAS float*)lds;
        LAS float* lrs = (LAS float*)(lds + 4096);
        {
            const float* gp = gate + (size_t)b * 3072 + col0;
            f32x4 gv[2][2];
#pragma unroll
            for (int bj = 0; bj < 2; ++bj)
#pragma unroll
                for (int n = 0; n < 2; ++n) gv[bj][n] = *(const f32x4*)(gp + bj * HALF + 4 * n);
#pragma unroll
            for (int ai = 0; ai < 2; ++ai)
#pragma unroll
                for (int m = 0; m < 4; ++m) {
                    const size_t ro = (size_t)(row0 + ai * HALF + m * 16) * DM + col0;
                    float ss = 0.f;
#pragma unroll
                    for (int bj = 0; bj < 2; ++bj)
#pragma unroll
                        for (int n = 0; n < 2; ++n) {
                            const f32x4 xv = *(const f32x4*)(xin + ro + bj * HALF + 4 * n);
                            const f32x4 v = xv + gv[bj][n] * acc[ai][bj][m][n];
                            acc[ai][bj][m][n] = v;
                            ss += (v[0] * v[0] + v[1] * v[1]) + (v[2] * v[2] + v[3] * v[3]);
                            if (!last) *(f32x4*)(xout + ro + bj * HALF + 4 * n) = v;
                        }
                    ss += __shfl_xor(ss, 16); ss += __shfl_xor(ss, 32);
                    if (fq == 0) lss[(ai * HALF + wr * 64 + m * 16 + fr) * 4 + wc] = ss;
                }
        }
        __syncthreads();
        if (tid < 256) {
            const float t = (lss[tid * 4] + lss[tid * 4 + 1]) + (lss[tid * 4 + 2] + lss[tid * 4 + 3]);
            __hip_atomic_store(part + (size_t)u.pn * MTOK + u.pm * BM + tid, t, __ATOMIC_RELAXED, __HIP_MEMORY_SCOPE_AGENT);
        }
        asm volatile("s_waitcnt vmcnt(0)" ::: "memory");
        __syncthreads();
        if (tid == 0) {
            unsigned* c = cnt + u.pm;
            __hip_atomic_fetch_add(c, 1u, __ATOMIC_RELAXED, __HIP_MEMORY_SCOPE_AGENT);
            unsigned spins = 0;
            while (__hip_atomic_load(c, __ATOMIC_RELAXED, __HIP_MEMORY_SCOPE_AGENT) < 4u && ++spins < (1u << 22)) __builtin_amdgcn_s_sleep(1);
            __builtin_amdgcn_fence(__ATOMIC_ACQUIRE, "agent");
            asm volatile("s_waitcnt vmcnt(0)" ::: "memory");
        }
        __syncthreads();
        if (tid < 256) {
            float t = 0.f;
#pragma unroll
            for (int q = 0; q < 4; ++q) t += __hip_atomic_load(part + (size_t)q * MTOK + u.pm * BM + tid, __ATOMIC_RELAXED, __HIP_MEMORY_SCOPE_AGENT);
            lrs[tid] = rsqrtf(t * (1.f / DM) + EPS);
        }
        __syncthreads();
        const float* mb = modn + (size_t)b * 3072;
#pragma unroll
        for (int bj = 0; bj < 2; ++bj) {
            const int c = col0 + bj * HALF;
            const f32x4 g0 = *(const f32x4*)(ng + c), g1 = *(const f32x4*)(ng + c + 4);
            f32x4 sh0 = {0.f, 0.f, 0.f, 0.f}, sh1 = sh0, sc0 = sh0, sc1 = sh0;
            if (!last) { sh0 = *(const f32x4*)(mb + c); sh1 = *(const f32x4*)(mb + c + 4); sc0 = *(const f32x4*)(mb + 1024 + c); sc1 = *(const f32x4*)(mb + 1024 + c + 4); }
            const f32x4 a0 = g0 * (sc0 + 1.f), a1 = g1 * (sc1 + 1.f);
#pragma unroll
            for (int ai = 0; ai < 2; ++ai)
#pragma unroll
                for (int m = 0; m < 4; ++m) {
                    const int rl = ai * HALF + wr * 64 + m * 16 + fr;
                    const float rstd = lrs[rl];
                    const size_t ro = (size_t)(u.pm * BM + rl) * DM + c;
                    const f32x4 h0 = (acc[ai][bj][m][0] * rstd) * a0 + sh0, h1 = (acc[ai][bj][m][1] * rstd) * a1 + sh1;
                    if (last) { *(f32x4*)(xout + ro) = h0; *(f32x4*)(xout + ro + 4) = h1; }
                    else { u32x4 w; w.x = cvt_pk_bf16(h0[0], h0[1]); w.y = cvt_pk_bf16(h0[2], h0[3]); w.z = cvt_pk_bf16(h1[0], h1[1]); w.w = cvt_pk_bf16(h1[2], h1[3]); *(u32x4*)(H + ro) = w; }
                }
        }
    }
};

template <class Epi>
__device__ __forceinline__ void gemm_phase(LAS unsigned char* lds, const Gemm g, const Epi& E) {
    const int tid = opaque_tid(), wid = __builtin_amdgcn_readfirstlane(tid >> 6), lane = tid & 63, wr = wid >> 2, wc = wid & 3, fr = lane & 15, fq = lane >> 4;
    const int nt = g.K / BK;
    unsigned voffA[2], voffB[2];
#pragma unroll
    for (int i = 0; i < 2; ++i) { int R, C; stage_rc(tid * 16 + i * 8192, R, C); const int Rb = Epi::PERM ? ((R & ~31) + perm32(R & 31)) : R;
        voffA[i] = (unsigned)(R * g.lda + C) * 2u; voffB[i] = (unsigned)(Rb * g.ldb + C) * 2u; }
    const size_t kstep = (size_t)(BK * 2);
    const size_t hstepA = (size_t)HALF * g.lda * 2, hstepB = (size_t)HALF * g.ldb * 2;
    const unsigned ldsw = (unsigned)wid * 1024u;
    const int aoff = lds_byte(wr * 64 + fr, fq * 8), boff = lds_byte(wc * 32 + fr, fq * 8);
#define PG8_SA(b, h) (((b) * 2 + (h)) * HTB)
#define PG8_SB(b, h) ((4 + (b) * 2 + (h)) * HTB)
#define PG8_STAGE(bufoff, gbase, voff) do { _Pragma("unroll") for (int _i = 0; _i < 2; ++_i) \
        __builtin_amdgcn_global_load_lds((const unsigned*)((const char*)(gbase) + (voff)[_i]), (LAS unsigned*)(lds + (bufoff) + ldsw + _i * 8192), 16, 0, 0); } while (0)
#define PG8_LDA(dst, b, h) do { _Pragma("unroll") for (int m = 0; m < 4; ++m) _Pragma("unroll") for (int k = 0; k < 2; ++k) dst[m][k] = *(const LAS bf16x8*)(lds + PG8_SA(b, h) + aoff + m * 2048 + k * 1024); } while (0)
#define PG8_LDB(dst, b, h) do { _Pragma("unroll") for (int n = 0; n < 2; ++n) _Pragma("unroll") for (int k = 0; k < 2; ++k) dst[n][k] = *(const LAS bf16x8*)(lds + PG8_SB(b, h) + boff + n * 2048 + k * 1024); } while (0)
#define PG8_MMA(ai, bj, At, Bt) do { __builtin_amdgcn_s_setprio(1); _Pragma("unroll") for (int m = 0; m < 4; ++m) _Pragma("unroll") for (int n = 0; n < 2; ++n) _Pragma("unroll") for (int k = 0; k < 2; ++k) \
        acc[ai][bj][m][n] = __builtin_amdgcn_mfma_f32_16x16x32_bf16(Bt[n][k], At[m][k], acc[ai][bj][m][n], 0, 0, 0); __builtin_amdgcn_s_setprio(0); } while (0)
#define PG8_WAIT_V(n) asm volatile("s_waitcnt vmcnt(" #n ")" ::: "memory")
#define PG8_WAIT_L(n) asm volatile("s_waitcnt lgkmcnt(" #n ")" ::: "memory")
#define PG8_BAR __builtin_amdgcn_s_barrier()
#define PG8_SCHED __builtin_amdgcn_sched_barrier(0)
    Unit cur, nxt; int ui = 0;
    const int bid = opaque_bid();
    if (!next_unit(g, bid, 0, cur)) return;
    f32x4 acc[2][2][4][2];
#pragma unroll
    for (int a = 0; a < 2; ++a)
#pragma unroll
        for (int b = 0; b < 2; ++b)
#pragma unroll
            for (int m = 0; m < 4; ++m)
#pragma unroll
                for (int n = 0; n < 2; ++n) acc[a][b][m][n] = (f32x4){0.f, 0.f, 0.f, 0.f};
    bf16x8 At[4][2], B0[2][2], B1[2][2];
    const char* cA = (const char*)g.A + (size_t)cur.pm * 2 * hstepA; const char* cB = (const char*)g.Bt + (size_t)cur.pn * 2 * hstepB + (size_t)(cur.pm >> 1) * g.bk * 2;
    PG8_STAGE(PG8_SB(0, 0), cB, voffB); PG8_STAGE(PG8_SA(0, 0), cA, voffA); PG8_STAGE(PG8_SB(0, 1), cB + hstepB, voffB); PG8_STAGE(PG8_SA(0, 1), cA + hstepA, voffA);
    if (wr == 1) PG8_BAR;
    PG8_WAIT_V(4); PG8_BAR;
    PG8_STAGE(PG8_SB(1, 0), cB + kstep, voffB); PG8_STAGE(PG8_SA(1, 0), cA + kstep, voffA); PG8_STAGE(PG8_SB(1, 1), cB + hstepB + kstep, voffB);
    PG8_WAIT_V(6); PG8_BAR;
    for (;;) {
        const bool has_next = next_unit(g, bid, ui + 1, nxt);
        const char* nA = has_next ? (const char*)g.A + (size_t)nxt.pm * 2 * hstepA : cA;
        const char* nB = has_next ? (const char*)g.Bt + (size_t)nxt.pn * 2 * hstepB + (size_t)(nxt.pm >> 1) * g.bk * 2 : cB;
        for (int t = 0; t < nt; t += 2) {
            const bool last = (t == nt - 2);
            const char* a1 = cA + (size_t)(t + 1) * kstep;
            const char* a2 = last ? nA : cA + (size_t)(t + 2) * kstep; const char* b2 = last ? nB : cB + (size_t)(t + 2) * kstep;
            const char* a3 = a2 + kstep; const char* b3 = b2 + kstep;
            PG8_LDB(B0, 0, 0); PG8_SCHED; PG8_LDA(At, 0, 0); PG8_STAGE(PG8_SA(1, 1), a1 + hstepA, voffA);
            PG8_WAIT_L(8); PG8_BAR; PG8_WAIT_L(0); PG8_MMA(0, 0, At, B0); PG8_BAR; PG8_SCHED;
            PG8_LDB(B1, 0, 1); PG8_STAGE(PG8_SB(0, 0), b2, voffB);
            PG8_BAR; PG8_WAIT_L(0); PG8_MMA(0, 1, At, B1); PG8_BAR;
            PG8_LDA(At, 0, 1); PG8_STAGE(PG8_SA(0, 0), a2, voffA);
            PG8_BAR; PG8_WAIT_L(0); PG8_MMA(1, 0, At, B0); PG8_BAR; PG8_SCHED;
            PG8_STAGE(PG8_SB(0, 1), b2 + hstepB, voffB);
            PG8_WAIT_V(6); PG8_BAR; PG8_MMA(1, 1, At, B1); PG8_BAR;
            PG8_LDB(B0, 1, 0); PG8_SCHED; PG8_LDA(At, 1, 0); PG8_STAGE(PG8_SA(0, 1), a2 + hstepA, voffA);
            PG8_WAIT_L(8); PG8_BAR; PG8_WAIT_L(0); PG8_MMA(0, 0, At, B0); PG8_BAR; PG8_SCHED;
            PG8_LDB(B1, 1, 1); PG8_STAGE(PG8_SB(1, 0), b3, voffB);
            PG8_BAR; PG8_WAIT_L(0); PG8_MMA(0, 1, At, B1); PG8_BAR;
            PG8_LDA(At, 1, 1); PG8_STAGE(PG8_SA(1, 0), a3, voffA);
            PG8_BAR; PG8_WAIT_L(0); PG8_MMA(1, 0, At, B0); PG8_BAR; PG8_SCHED;
            PG8_STAGE(PG8_SB(1, 1), b3 + hstepB, voffB);
            PG8_WAIT_V(6); PG8_BAR; PG8_MMA(1, 1, At, B1); PG8_BAR;
        }
        if constexpr (!Epi::AFTER_DRAIN) E(acc, cur, wr, wc, fr, fq);
        if (!has_next) break;
#pragma unroll
        for (int a = 0; a < 2; ++a)
#pragma unroll
            for (int b = 0; b < 2; ++b)
#pragma unroll
                for (int m = 0; m < 4; ++m)
#pragma unroll
                    for (int n = 0; n < 2; ++n) acc[a][b][m][n] = (f32x4){0.f, 0.f, 0.f, 0.f};
        cur = nxt; cA = nA; cB = nB; ++ui;
    }
    PG8_WAIT_V(0);
    if (wr == 0) PG8_BAR;
    PG8_BAR;
    if constexpr (Epi::AFTER_DRAIN) E.fused(acc, cur, wr, wc, fr, fq, lds, tid);
#undef PG8_SA
#undef PG8_SB
#undef PG8_STAGE
#undef PG8_LDA
#undef PG8_LDB
#undef PG8_MMA
#undef PG8_WAIT_V
#undef PG8_WAIT_L
#undef PG8_BAR
#undef PG8_SCHED
}

__device__ __forceinline__ void phase_mod(const Params& p, LAS unsigned char* lds) {
    const int tid = opaque_tid(), wid = tid >> 6, lane = tid & 63;
    LAS float* sc = (LAS float*)lds;
    LAS float* red = (LAS float*)(lds + 32768);
    float* mod = (float*)(p.ws + WS_MOD);
    for (int t = tid; t < NB * DM; t += 512) sc[t] = silu_f(p.c[t]);
    __syncthreads();
    for (int it = opaque_bid(); it < 192; it += gridDim.x) {
        const int col = it * 64 + lane, i = col / 3072, j = col - i * 3072;
        const float* w = p.ada_w + ((size_t)i * DM + wid * 128) * 3072 + j;
        float a[8];
#pragma unroll
        for (int b = 0; b < 8; ++b) a[b] = 0.f;
#pragma unroll 16
        for (int k = 0; k < 128; ++k) {
            const float wv = w[(size_t)k * 3072];
#pragma unroll
            for (int b = 0; b < 8; ++b) a[b] += sc[b * DM + wid * 128 + k] * wv;
        }
#pragma unroll
        for (int b = 0; b < 8; ++b) red[(wid * 8 + b) * 64 + lane] = a[b];
        __syncthreads();
        {
            const int b = tid >> 6; float s = 0.f;
#pragma unroll
            for (int w8 = 0; w8 < 8; ++w8) s += red[(w8 * 8 + b) * 64 + lane];
            mod[((size_t)i * NB + b) * 3072 + j] = s + p.ada_b[i * 3072 + j];
        }
        __syncthreads();
    }
}

__device__ __forceinline__ void conv_tile(const float* __restrict__ src, int srcN, int c0, bf16_t* __restrict__ dstrow, int K, int k0, LAS float* T) {
    const int tid = opaque_tid();
    f32x4 v[8];
#pragma unroll
    for (int ps = 0; ps < 8; ++ps) v[ps] = *(const f32x4*)(src + (size_t)(k0 + ps * 32 + (tid >> 4)) * srcN + c0 + (tid & 15) * 4);
#pragma unroll
    for (int ps = 0; ps < 8; ++ps) { LAS float* t = T + (ps * 32 + (tid >> 4)) * 65 + (tid & 15) * 4; t[0] = v[ps][0]; t[1] = v[ps][1]; t[2] = v[ps][2]; t[3] = v[ps][3]; }
    __syncthreads();
#pragma unroll
    for (int q = 0; q < 4; ++q) {
        const int item = tid + 512 * q, n = item >> 5, kg = item & 31; const LAS float* s = T + (kg * 8) * 65 + n;
        u32x4 o; o.x = cvt_pk_bf16(s[0], s[65]); o.y = cvt_pk_bf16(s[130], s[195]); o.z = cvt_pk_bf16(s[260], s[325]); o.w = cvt_pk_bf16(s[390], s[455]);
        *(u32x4*)(dstrow + (size_t)n * K + k0 + kg * 8) = o;
    }
    __syncthreads();
}

__device__ __forceinline__ void norm_rows(const Params& p, int layer, const float* xin, int item) {
    const int tid = opaque_tid(), wid = tid >> 6, lane = tid & 63;
    bf16_t* H = (bf16_t*)g_h;
    const float* mod = (const float*)(p.ws + WS_MOD) + (size_t)layer * NB * 3072;
    const float* gp = p.norm_g + (size_t)layer * DM;
#pragma unroll
    for (int h2 = 0; h2 < 2; ++h2) {
        const int row = item * 16 + h2 * 8 + wid, b = row >> 11;
        const f32x4* xr = (const f32x4*)(xin + (size_t)row * DM) + lane;
        f32x4 v[4]; float ss = 0.f;
#pragma unroll
        for (int q = 0; q < 4; ++q) { v[q] = xr[64 * q]; ss += (v[q][0] * v[q][0] + v[q][1] * v[q][1]) + (v[q][2] * v[q][2] + v[q][3] * v[q][3]); }
        const float rstd = rsqrtf(wave_sum(ss) * (1.f / DM) + EPS);
        const float* mb = mod + (size_t)b * 3072;
        u32x2* o8 = (u32x2*)(H + (size_t)row * DM) + lane;
#pragma unroll
        for (int q = 0; q < 4; ++q) {
            const int k = (lane + 64 * q) * 4;
            const f32x4 gv = *(const f32x4*)(gp + k), sh = *(const f32x4*)(mb + k), scl = *(const f32x4*)(mb + 1024 + k);
            const f32x4 hv = (v[q] * rstd * gv) * (scl + 1.f) + sh;
            u32x2 w; w.x = cvt_pk_bf16(hv[0], hv[1]); w.y = cvt_pk_bf16(hv[2], hv[3]);
            o8[64 * q] = w;
        }
    }
}
__device__ __forceinline__ void phase_norm_even(const Params& p, int j, const float* xin, LAS unsigned char* lds) {
    const int tid = opaque_tid();
    bf16_t* WIN_E = (bf16_t*)(p.ws + WS_WIN_E); bf16_t* WIN_O = (bf16_t*)(p.ws + WS_WIN_O); bf16_t* WOUT_E = (bf16_t*)(p.ws + WS_WOUT_E); bf16_t* WOUT_O = (bf16_t*)(p.ws + WS_WOUT_O);
    bf16_t* SGU = (bf16_t*)(p.ws + WS_SGU); bf16_t* POOLT = (bf16_t*)(p.ws + WS_POOLT); bf16_t* WINP = (bf16_t*)(p.ws + WS_WINP);
    constexpr int N0 = 448, N1 = N0 + 128, N2 = N1 + 128, N3 = N2 + 128, N4 = N3 + 64, N5 = N4 + 32, N6 = N5 + 512;
    const int TOTAL = N6 + (j == 0 ? MTOK / 16 : 0);
    for (int it = opaque_bid(); it < TOTAL; it += gridDim.x) {
        if (it < N0) {
            const int rt = it >> 2, kt = it & 3, r0 = rt * 64, T = r0 >> 8, q = r0 & 255; int c0;
            if (T < 8) c0 = (q < 128) ? (2048 + 128 * T + q) : (128 * T + q - 128);
            else if (T < 16) c0 = (q < 128) ? (1024 + 128 * (T - 8) + q) : (3072 + 128 * (T - 8) + q - 128);
            else if (T < 24) c0 = (q < 128) ? (4096 + 128 * (T - 16) + q) : (6144 + 128 * (T - 16) + q - 128);
            else c0 = 5120 + 256 * (T - 24) + q;
            conv_tile(p.ab_w_in + (size_t)j * DM * 7168, 7168, c0, WIN_E + (size_t)r0 * DM, DM, kt * 256, (LAS float*)lds);
        } else if (it < N1) {
            const int i2 = it - N0, rt = i2 >> 3, kt = i2 & 7, r0 = rt * 64;
            conv_tile(p.ab_w_out + (size_t)j * 2048 * DM, DM, r0, WOUT_E + (size_t)r0 * 2048, 2048, kt * 256, (LAS float*)lds);
        } else if (it < N2) {
            const int i2 = it - N1, rt = i2 >> 2, kt = i2 & 3, r0 = rt * 64;
            conv_tile(p.c_w_in + (size_t)j * DM * 4096, 4096, 2048 + r0, WIN_O + (size_t)(2048 + r0) * DM, DM, kt * 256, (LAS float*)lds);
        } else if (it < N3) {
            const int i2 = it - N2, rt = i2 >> 3, kt = i2 & 7, r0 = rt * 64;
            conv_tile(p.c_w_out + (size_t)j * 2048 * DM, DM, r0, WOUT_O + (size_t)r0 * 2048, 2048, kt * 256, (LAS float*)lds);
        } else if (it < N4) {
            const int i3 = it - N3, g = i3 >> 4, r = i3 & 15, rt = r >> 1, kt = r & 1, r0 = rt * 64;
            conv_tile(p.c_pool_w + ((size_t)j * 4 + g) * 512 * 512, 512, r0, POOLT + (size_t)g * 512 * 512 + (size_t)r0 * 512, 512, kt * 256, (LAS float*)lds);
        } else if (it < N5) {
            const int e0 = (it - N4) * 4096 + tid * 8, t = (e0 >> 7) & 127, s0 = e0 & 127;
            const float* src = p.ab_sgu_w + (size_t)j * 8 * 128 * 128 + e0;
            const f32x4 a = *(const f32x4*)src, b = *(const f32x4*)(src + 4);
            float v[8] = {a[0], a[1], a[2], a[3], b[0], b[1], b[2], b[3]};
#pragma unroll
            for (int e = 0; e < 8; ++e) v[e] = (s0 + e <= t) ? v[e] : 0.f;
            u32x4 o; o.x = cvt_pk_bf16(v[0], v[1]); o.y = cvt_pk_bf16(v[2], v[3]); o.z = cvt_pk_bf16(v[4], v[5]); o.w = cvt_pk_bf16(v[6], v[7]);
            *(u32x4*)(SGU + e0) = o;
        } else if (it < N6) {
            const int e0 = (it - N5) * 4096 + tid * 8, k = e0 >> 11, c = e0 & 2047;
            const float* src = p.c_w_in + ((size_t)j * DM + k) * 4096 + c;
            const f32x4 a = *(const f32x4*)src, b = *(const f32x4*)(src + 4);
            u32x4 o; o.x = cvt_pk_bf16(a[0], a[1]); o.y = cvt_pk_bf16(a[2], a[3]); o.z = cvt_pk_bf16(b[0], b[1]); o.w = cvt_pk_bf16(b[2], b[3]);
            *(u32x4*)(WINP + e0) = o;
        } else norm_rows(p, 2 * j, xin, it - N6);
    }
}
__device__ __forceinline__ void phase_final(const Params& p) {
    const int tid = opaque_tid(), wid = tid >> 6, lane = tid & 63;
    for (int it = opaque_bid(); it < MTOK / 8; it += gridDim.x) {
        const int row = it * 8 + wid;
        f32x4* xr = (f32x4*)(p.out + (size_t)row * DM) + lane;
        f32x4 v[4]; float ss = 0.f;
#pragma unroll
        for (int q = 0; q < 4; ++q) { v[q] = xr[64 * q]; ss += (v[q][0] * v[q][0] + v[q][1] * v[q][1]) + (v[q][2] * v[q][2] + v[q][3] * v[q][3]); }
        const float rstd = rsqrtf(wave_sum(ss) * (1.f / DM) + EPS);
#pragma unroll
        for (int q = 0; q < 4; ++q) { const f32x4 gv = *(const f32x4*)(p.final_g + (lane + 64 * q) * 4); xr[64 * q] = v[q] * rstd * gv; }
    }
}

__device__ __forceinline__ void unpack8(const u32x4 w, float (&f)[8]) {
    f[0] = bf_lo(w.x); f[1] = bf_hi(w.x); f[2] = bf_lo(w.y); f[3] = bf_hi(w.y); f[4] = bf_lo(w.z); f[5] = bf_hi(w.z); f[6] = bf_lo(w.w); f[7] = bf_hi(w.w);
}

__device__ __forceinline__ void phase_mix(const Params& p, int j, LAS unsigned char* lds) {
    const int tid = opaque_tid(), wid = tid >> 6, lane = tid & 63;
    const bf16_t* CH2 = (const bf16_t*)(p.ws + WS_RP); const bf16_t* BZ = CH2 + (size_t)MTOK * 1024; const bf16_t* UZ = BZ + (size_t)MTOK * 1024; const bf16_t* V = UZ + (size_t)MTOK * 1024;
    bf16_t* Y = (bf16_t*)(p.ws + WS_RA);
    if (blockIdx.x < 32) {
        Gemm g{(const bf16_t*)(p.ws + WS_POOLT), (const bf16_t*)(p.ws + WS_WINP), 512, 2048, 512, 8, 4, 512}; EpiBf E{(bf16_t*)(p.ws + WS_WIN_O), DM};
        gemm_phase(lds, g, E);
        __syncthreads();
    }
    {
        const bf16_t* Wm = (const bf16_t*)(p.ws + WS_SGU);
        LAS bf16_t* vnT = (LAS bf16_t*)lds;
        LAS float* red = (LAS float*)(lds + 36864);
        const int fr = lane & 15, fq = lane >> 4;
        const int s = lane + 64 * (wid & 1), q = wid >> 1;
        int it = opaque_bid();
        u32x4 vraw[4];
        if (it < 1024) { const bf16_t* vp = V + (size_t)((it >> 3) * 128 + s) * 1024 + (it & 7) * 128 + 32 * q;
#pragma unroll
            for (int i = 0; i < 4; ++i) vraw[i] = *(const u32x4*)(vp + 8 * i); }
        for (; it < 1024; it += gridDim.x) {
            const int hh = it & 7, cn = it >> 3;
            const int t = 16 * wid + fr; const size_t row = (size_t)cn * 128 + t;
            u32x2 uz[8];
#pragma unroll
            for (int n = 0; n < 8; ++n) uz[n] = *(const u32x2*)(UZ + row * 1024 + hh * 128 + 16 * n + 4 * fq);
            const float bias = p.ab_sgu_b[(size_t)j * 1024 + hh * 128 + t];
            const bf16_t* wrow = Wm + ((size_t)hh * 128 + 16 * wid + fr) * 128 + 8 * fq;
            bf16x8 af[4];
#pragma unroll
            for (int kk = 0; kk < 4; ++kk) af[kk] = *(const bf16x8*)(wrow + 32 * kk);
            float f[32];
#pragma unroll
            for (int i = 0; i < 4; ++i) { float t8[8]; unpack8(vraw[i], t8);
#pragma unroll
                for (int e = 0; e < 8; ++e) f[8 * i + e] = t8[e]; }
            float s1 = 0.f, s2 = 0.f;
#pragma unroll
            for (int i = 0; i < 32; ++i) { s1 += f[i]; s2 += f[i] * f[i]; }
            red[(s * 4 + q) * 2] = s1; red[(s * 4 + q) * 2 + 1] = s2;
            __syncthreads();
            {
                const int itn = it + gridDim.x;
                if (itn < 1024) { const bf16_t* vp = V + (size_t)((itn >> 3) * 128 + s) * 1024 + (itn & 7) * 128 + 32 * q;
#pragma unroll
                    for (int i = 0; i < 4; ++i) vraw[i] = *(const u32x4*)(vp + 8 * i); }
            }
            float S1 = 0.f, S2 = 0.f;
#pragma unroll
            for (int qq = 0; qq < 4; ++qq) { S1 += red[(s * 4 + qq) * 2]; S2 += red[(s * 4 + qq) * 2 + 1]; }
            const float mu = S1 * (1.f / 128.f), var = fmaxf(S2 * (1.f / 128.f) - mu * mu, 0.f), rstd = rsqrtf(var + EPS);
            const float* lg = p.ab_ln_g + (size_t)j * 1024 + hh * 128 + 32 * q; const float* lb = p.ab_ln_b + (size_t)j * 1024 + hh * 128 + 32 * q;
#pragma unroll
            for (int i = 0; i < 32; ++i) {
                const float vn = (f[i] - mu) * rstd * lg[i] + lb[i];
                vnT[(32 * q + i) * 136 + s] = (bf16_t)(cvt_pk_bf16(vn, 0.f) & 0xffffu);
            }
            __syncthreads();
            f32x4 acc[8];
#pragma unroll
            for (int n = 0; n < 8; ++n) acc[n] = (f32x4){0.f, 0.f, 0.f, 0.f};
#pragma unroll
            for (int kk = 0; kk < 4; ++kk) {
                if (32 * kk <= 16 * wid + 15) {
#pragma unroll
                    for (int n = 0; n < 8; ++n) {
                        const bf16x8 bfm = *(const LAS bf16x8*)(vnT + (16 * n + fr) * 136 + 32 * kk + 8 * fq);
                        acc[n] = __builtin_amdgcn_mfma_f32_16x16x32_bf16(bfm, af[kk], acc[n], 0, 0, 0);
                    }
                }
            }
#pragma unroll
            for (int n = 0; n < 8; ++n) {
                const int d = 16 * n + 4 * fq;
                u32x2 w; w.x = cvt_pk_bf16(bf_lo(uz[n].x) * (acc[n][0] + bias), bf_hi(uz[n].x) * (acc[n][1] + bias));
                w.y = cvt_pk_bf16(bf_lo(uz[n].y) * (acc[n][2] + bias), bf_hi(uz[n].y) * (acc[n][3] + bias));
                *(u32x2*)(Y + row * 2048 + 1024 + hh * 128 + d) = w;
            }
        }
    }
    {
        const float* cw = p.ab_conv_w + (size_t)j * 3 * 1024;
        for (int it = opaque_bid(); it < 256; it += gridDim.x) {
            const int rg = it * 4 + (tid >> 7), c0 = (tid & 127) * 8, t0 = rg * 16;
            float w0[8], w1[8], w2[8], p2[8], p1[8];
#pragma unroll
            for (int h4 = 0; h4 < 2; ++h4) {
                const f32x4 a = *(const f32x4*)(cw + c0 + 4 * h4), b = *(const f32x4*)(cw + 1024 + c0 + 4 * h4), c = *(const f32x4*)(cw + 2048 + c0 + 4 * h4);
#pragma unroll
                for (int e = 0; e < 4; ++e) { w0[4 * h4 + e] = a[e]; w1[4 * h4 + e] = b[e]; w2[4 * h4 + e] = c[e]; }
            }
            if ((t0 & (SEQ - 1)) != 0) {
                unpack8(*(const u32x4*)(CH2 + (size_t)(t0 - 2) * 1024 + c0), p2);
                unpack8(*(const u32x4*)(CH2 + (size_t)(t0 - 1) * 1024 + c0), p1);
            } else {
#pragma unroll
                for (int e = 0; e < 8; ++e) { p2[e] = 0.f; p1[e] = 0.f; }
            }
#pragma unroll 8
            for (int r = 0; r < 16; ++r) {
                float cur[8], bz[8], o[8];
                unpack8(*(const u32x4*)(CH2 + (size_t)(t0 + r) * 1024 + c0), cur);
                unpack8(*(const u32x4*)(BZ + (size_t)(t0 + r) * 1024 + c0), bz);
#pragma unroll
                for (int e = 0; e < 8; ++e) { o[e] = bz[e] * (w0[e] * p2[e] + w1[e] * p1[e] + w2[e] * cur[e]); p2[e] = p1[e]; p1[e] = cur[e]; }
                u32x4 w; w.x = cvt_pk_bf16(o[0], o[1]); w.y = cvt_pk_bf16(o[2], o[3]); w.z = cvt_pk_bf16(o[4], o[5]); w.w = cvt_pk_bf16(o[6], o[7]);
                *(u32x4*)(Y + (size_t)(t0 + r) * 2048 + c0) = w;
            }
        }
    }
}

__device__ __forceinline__ void phase_pool(const Params& p) {
    const int tid = opaque_tid();
    const bf16_t* Q = (const bf16_t*)(p.ws + WS_RP); const bf16_t* SZ = Q + (size_t)MTOK * 2048; bf16_t* Y = (bf16_t*)(p.ws + WS_RA);
    for (int it = opaque_bid(); it < 256; it += gridDim.x) {
        const int rg = it * 2 + (tid >> 8), ct = tid & 255, c0 = ct * 8, win = 2 << (ct >> 6), t0 = rg * 32, tl0 = t0 & (SEQ - 1);
        float S[8];
#pragma unroll
        for (int e = 0; e < 8; ++e) S[e] = 0.f;
        if (tl0 != 0) {
#pragma unroll
            for (int i = 1; i < 16; ++i) {
                if (i < win) { float v[8]; unpack8(*(const u32x4*)(Q + (size_t)(t0 - i) * 2048 + c0), v);
#pragma unroll
                    for (int e = 0; e < 8; ++e) S[e] += v[e]; }
            }
        }
#pragma unroll 8
        for (int r = 0; r < 32; ++r) {
            const int tl = tl0 + r;
            float cur[8], sz[8], o[8];
            unpack8(*(const u32x4*)(Q + (size_t)(t0 + r) * 2048 + c0), cur);
            unpack8(*(const u32x4*)(SZ + (size_t)(t0 + r) * 2048 + c0), sz);
            const float inv = 1.f / (float)min(tl + 1, win);
#pragma unroll
            for (int e = 0; e < 8; ++e) { S[e] += cur[e]; o[e] = (S[e] * inv - cur[e]) * sz[e]; }
            u32x4 w; w.x = cvt_pk_bf16(o[0], o[1]); w.y = cvt_pk_bf16(o[2], o[3]); w.z = cvt_pk_bf16(o[4], o[5]); w.w = cvt_pk_bf16(o[6], o[7]);
            *(u32x4*)(Y + (size_t)(t0 + r) * 2048 + c0) = w;
            if (tl - win + 1 >= 0) { float old[8]; unpack8(*(const u32x4*)(Q + (size_t)(t0 + r - win + 1) * 2048 + c0), old);
#pragma unroll
                for (int e = 0; e < 8; ++e) S[e] -= old[e]; }
        }
    }
}

#define XB_TMO      128
#define XB_XCNT(j)  (256  + 64 * (j))
#define XB_XSUB(j)  (1280 + 64 * (j))
#define XB_XGEN(j)  (2304 + 64 * (j))
#define XB_TOP      3328
#define XB_TOPGEN   3392
#define XCD_BAR_WORDS 3456
#define XB_SPIN_CAP (1u << 18)
__device__ __forceinline__ unsigned xb_ld(unsigned* p)              { return __hip_atomic_load(p, __ATOMIC_RELAXED, __HIP_MEMORY_SCOPE_AGENT); }
__device__ __forceinline__ unsigned xb_add(unsigned* p, unsigned v) { return __hip_atomic_fetch_add(p, v, __ATOMIC_RELAXED, __HIP_MEMORY_SCOPE_AGENT); }
__device__ __forceinline__ unsigned xb_xcc_id() { return (unsigned)__builtin_amdgcn_s_getreg((3 << 11) | 20) & 0xFu; }
#define XB_SPIN(cond, bar) do { unsigned _sp = 0; while (cond) { __builtin_amdgcn_s_sleep(1); \
    if ((++_sp & 255u) == 0u) { if (xb_ld(&(bar)[XB_TMO])) break; if (_sp > XB_SPIN_CAP) { atomicAdd(&(bar)[XB_TMO], 1u); break; } } } } while (0)
struct XcdBarrier { unsigned* bar; unsigned x; volatile LAS unsigned* st; };
__device__ __forceinline__ XcdBarrier xcd_barrier_post(unsigned* bar, volatile LAS unsigned* st) {
    XcdBarrier b; b.bar = bar; b.x = xb_xcc_id(); b.st = st;
    if (threadIdx.x == 0) (void)xb_add(&bar[XB_XCNT(b.x)], 1u);
    return b;
}
__device__ __forceinline__ void xcd_barrier_complete(unsigned* bar, unsigned x, unsigned& nloc, unsigned& nx) {
    const unsigned G = gridDim.x * gridDim.y * gridDim.z;
    unsigned sum, cnt, mine, sp = 0u;
    for (;;) {
        sum = 0u; cnt = 0u; mine = 0u;
#pragma unroll
        for (unsigned j = 0; j < 16; ++j) { const unsigned c = xb_ld(&bar[XB_XCNT(j)]); sum += c; cnt += (c > 0u) ? 1u : 0u; mine = (j == x) ? c : mine; }
        if (sum == G) break;
        __builtin_amdgcn_s_sleep(1);
        if ((++sp & 255u) == 0u) { if (xb_ld(&bar[XB_TMO])) break; if (sp > XB_SPIN_CAP) { atomicAdd(&bar[XB_TMO], 1u); break; } }
    }
    nloc = mine > 0u ? mine : 1u; nx = cnt > 0u ? cnt : 1u;
}
__device__ __forceinline__ void xcd_barrier(const XcdBarrier& b) {
    asm volatile("s_waitcnt vmcnt(0)" ::: "memory");
    __syncthreads();
    if (threadIdx.x == 0) {
        unsigned* bar = b.bar;
        __builtin_amdgcn_s_waitcnt(0);
        unsigned nloc = b.st[0], nx = b.st[1];
        if (nloc == 0u) { xcd_barrier_complete(bar, b.x, nloc, nx); b.st[0] = nloc; b.st[1] = nx; }
        const unsigned old = xb_add(&bar[XB_XSUB(b.x)], 1u);
        const unsigned gen = old / nloc;
        if (old + 1u == (gen + 1u) * nloc) {
            __builtin_amdgcn_fence(__ATOMIC_RELEASE, "agent");
            asm volatile("s_waitcnt vmcnt(0)" ::: "memory");
            const unsigned og = xb_add(&bar[XB_TOP], 1u);
            const unsigned tg = og / nx;
            if (og + 1u == (tg + 1u) * nx) xb_add(&bar[XB_TOPGEN], 1u);
            else XB_SPIN(xb_ld(&bar[XB_TOPGEN]) == tg, bar);
            __builtin_amdgcn_fence(__ATOMIC_ACQUIRE, "agent");
            xb_add(&bar[XB_XGEN(b.x)], 1u);
            asm volatile("s_waitcnt vmcnt(0)" ::: "memory");
        } else {
            XB_SPIN(xb_ld(&bar[XB_XGEN(b.x)]) == gen, bar);
            __builtin_amdgcn_fence(__ATOMIC_ACQUIRE, "agent");
            asm volatile("s_waitcnt vmcnt(0)" ::: "memory");
        }
    }
    __syncthreads();
}

__global__ void __launch_bounds__(512, 2) mega_fwd(Params p, int ph_lo, int ph_hi) {
    extern __shared__ __attribute__((aligned(16))) unsigned char smem[];
    LAS unsigned char* lds = (LAS unsigned char*)smem;
    cg::grid_group grid = cg::this_grid();
    if (ph_hi < 0) grid.sync();
    volatile LAS unsigned* st = (volatile LAS unsigned*)(lds + STAGE_BYTES);
    if (threadIdx.x < 4) st[threadIdx.x] = 0u;
    __syncthreads();
    const XcdBarrier xb = xcd_barrier_post((unsigned*)(p.ws + WS_BAR), st);
    int ph = 0;
#define PHASE(REP, ...) do { if (ph >= ph_lo && ph < ph_hi) { for (int _r = 0; _r < (REP); ++_r) { __VA_ARGS__; if (ph + 1 < ph_hi) xcd_barrier(xb); } } ++ph; } while (0)
    bf16_t* RA = (bf16_t*)(p.ws + WS_RA); bf16_t* RP = (bf16_t*)(p.ws + WS_RP);
    const bf16_t* WIN_E = (const bf16_t*)(p.ws + WS_WIN_E); const bf16_t* WIN_O = (const bf16_t*)(p.ws + WS_WIN_O);
    const bf16_t* WOUT_E = (const bf16_t*)(p.ws + WS_WOUT_E); const bf16_t* WOUT_O = (const bf16_t*)(p.ws + WS_WOUT_O);
    const float* mod = (const float*)(p.ws + WS_MOD);
    float* part = (float*)(p.ws + WS_PART); unsigned* cnt = (unsigned*)(p.ws + WS_BAR) + CNT_WORD0;
    PHASE(REP_THIN, phase_mod(p, lds));
#pragma unroll 1
    for (int lp = 0; lp < 2; ++lp) {
        {
            const int layer = 2 * lp; const float* xin = (lp == 0) ? p.x : p.out;
            PHASE(REP_THIN, phase_norm_even(p, lp, xin, lds));
            PHASE(REP_G1, { Gemm g{(const bf16_t*)g_h, WIN_E, DM, DM, DM, MTOK / BM, 7168 / BM, 0}; EpiEven E{RP}; gemm_phase(lds, g, E); });
            PHASE(REP_THIN, phase_mix(p, lp, lds));
            PHASE(1, { Gemm g{RA, WOUT_E, 2048, 2048, 2048, MTOK / BM, DM / BM, 0};
                       EpiResNorm E{xin, p.out, mod + (size_t)layer * NB * 3072 + 2048, (bf16_t*)g_h, p.norm_g + (size_t)(layer + 1) * DM, mod + (size_t)(layer + 1) * NB * 3072,
                                    part + (size_t)layer * 4 * MTOK, cnt + layer * 64, 0};
                       gemm_phase(lds, g, E); });
        }
        {
            const int layer = 2 * lp + 1; const int last = (lp == 1) ? 1 : 0;
            PHASE(REP_G1, { Gemm g{(const bf16_t*)g_h, WIN_O, DM, DM, DM, MTOK / BM, 4096 / BM, 0}; EpiOdd E{RP, p.c_pool_scale + (size_t)lp * 2048}; gemm_phase(lds, g, E); });
            PHASE(REP_THIN, phase_pool(p));
            PHASE(1, { Gemm g{RA, WOUT_O, 2048, 2048, 2048, MTOK / BM, DM / BM, 0};
                       EpiResNorm E{p.out, p.out, mod + (size_t)layer * NB * 3072 + 2048, (bf16_t*)g_h, last ? p.final_g : p.norm_g + (size_t)(layer + 1) * DM, mod + (size_t)(last ? layer : layer + 1) * NB * 3072,
                                    part + (size_t)layer * 4 * MTOK, cnt + layer * 64, last};
                       gemm_phase(lds, g, E); });
        }
    }
#undef PHASE
}

extern "C" void kernel_launch(void* const* d_in, const int* in_sizes, int n_in, void* d_out, int out_size, void* d_ws, size_t ws_size, hipStream_t stream) {
    static int grid = 0;
    if (grid == 0) {
        if (n_in != 17 || out_size != MTOK * DM || ws_size < WS_END2) { fprintf(stderr, "kernel_launch: unexpected shapes (n_in %d out %d ws %zu need %zu)\n", n_in, out_size, ws_size, (size_t)WS_END2); grid = -1; return; }
        int dev = 0, cus = 0, per_cu = 0;
        hipGetDevice(&dev);
        hipDeviceGetAttribute(&cus, hipDeviceAttributeMultiprocessorCount, dev);
        if (hipFuncSetAttribute((const void*)mega_fwd, hipFuncAttributeMaxDynamicSharedMemorySize, LDS_BYTES) != hipSuccess) { fprintf(stderr, "kernel_launch: hipFuncSetAttribute failed\n"); grid = -1; return; }
        hipOccupancyMaxActiveBlocksPerMultiprocessor(&per_cu, (const void*)mega_fwd, 512, LDS_BYTES);
        if (per_cu < 1) { fprintf(stderr, "kernel_launch: occupancy query says %d blocks per CU\n", per_cu); per_cu = 1; }
        (void)hipGetLastError();
        grid = cus;
        if (grid != 256) { fprintf(stderr, "kernel_launch: built for 256 CUs (one out-projection tile per workgroup), got %d\n", grid); grid = -1; return; }
    }
    if (grid < 0) return;
    Params p{};
    p.x = (const float*)d_in[0]; p.c = (const float*)d_in[1]; p.norm_g = (const float*)d_in[2]; p.ada_w = (const float*)d_in[3]; p.ada_b = (const float*)d_in[4];
    p.ab_w_in = (const float*)d_in[5]; p.ab_conv_w = (const float*)d_in[6]; p.ab_ln_g = (const float*)d_in[7]; p.ab_ln_b = (const float*)d_in[8];
    p.ab_sgu_w = (const float*)d_in[9]; p.ab_sgu_b = (const float*)d_in[10]; p.ab_w_out = (const float*)d_in[11];
    p.c_w_in = (const float*)d_in[12]; p.c_pool_w = (const float*)d_in[13]; p.c_pool_scale = (const float*)d_in[14]; p.c_w_out = (const float*)d_in[15]; p.final_g = (const float*)d_in[16];
    p.out = (float*)d_out; p.ws = (unsigned char*)d_ws;
    if (hipMemsetAsync((unsigned char*)d_ws + WS_BAR, 0, CTL_WORDS * 4, stream) != hipSuccess) { fprintf(stderr, "kernel_launch: barrier memset failed\n"); return; }
    int lo = 0, hi = 15;
    void* args[] = {&p, &lo, &hi};
    hipError_t e = hipLaunchCooperativeKernel((const void*)mega_fwd, dim3(grid), dim3(512), args, LDS_BYTES, stream);
    if (e != hipSuccess) fprintf(stderr, "kernel_launch: cooperative launch failed: %s (grid %d)\n", hipGetErrorString(e), grid);
}
```

```cpp
#include <hip/hip_runtime.h>
#include <hip/hip_cooperative_groups.h>
#include <cstdio>
namespace cg = cooperative_groups;

#define LAS __attribute__((address_space(3)))
typedef unsigned short bf16_t;
typedef short bf16x8 __attribute__((ext_vector_type(8)));
typedef float f32x4 __attribute__((ext_vector_type(4)));
typedef unsigned u32x4 __attribute__((ext_vector_type(4)));
typedef unsigned u32x2 __attribute__((ext_vector_type(2)));

constexpr int DM = 1024, NB = 8, SEQ = 2048, MTOK = NB * SEQ;
constexpr int BM = 256, BK = 64, HALF = 128, HTB = HALF * BK * 2, STAGE_BYTES = 8 * HTB, NXCD = 8, WGM = 8;
constexpr int LDS_BYTES = STAGE_BYTES + 16;
constexpr float EPS = 1e-6f;
constexpr int REP_G1 = 1, REP_THIN = 1, REP_G2L0 = 1;

constexpr size_t WS_MOD = 0;
constexpr size_t WS_BAR = 393216;
constexpr size_t WS_WIN_E = 524288;
constexpr size_t WS_WIN_O = WS_WIN_E + (size_t)7168 * 1024 * 2;
constexpr size_t WS_WOUT_E = WS_WIN_O + (size_t)4096 * 1024 * 2;
constexpr size_t WS_WOUT_O = WS_WOUT_E + (size_t)1024 * 2048 * 2;
constexpr size_t WS_SGU = WS_WOUT_O + (size_t)1024 * 2048 * 2;
constexpr size_t WS_POOLT = WS_SGU + (size_t)8 * 128 * 128 * 2;
constexpr size_t WS_WINP = WS_POOLT + (size_t)4 * 512 * 512 * 2;
constexpr size_t WS_RA = WS_WINP + (size_t)1024 * 2048 * 2;
constexpr size_t WS_RP = WS_RA + (size_t)MTOK * 2048 * 2;
constexpr size_t WS_END = WS_RP + (size_t)MTOK * 4096 * 2;

constexpr size_t WS_PART = WS_END;
constexpr size_t WS_END2 = WS_PART + (size_t)4 * 4 * MTOK * 4;
constexpr int CNT_WORD0 = 3584;
constexpr int CTL_WORDS = CNT_WORD0 + 256;
__device__ unsigned short g_x[(size_t)MTOK * DM];
__device__ unsigned short g_h[(size_t)MTOK * DM];

struct Params {
    const float *x, *c, *norm_g, *ada_w, *ada_b, *ab_w_in, *ab_conv_w, *ab_ln_g, *ab_ln_b, *ab_sgu_w, *ab_sgu_b, *ab_w_out,
        *c_w_in, *c_pool_w, *c_pool_scale, *c_w_out, *final_g;
    float* out;
    unsigned char* ws;
};

__host__ __device__ __forceinline__ int lds_byte(int r, int c) { const int st = (r >> 4) * 2 + (c >> 5), rr = r & 15, cc = c & 31, ob = rr * 64 + cc * 2; return st * 1024 + (ob ^ (((ob >> 9) & 1) << 5)); }
__host__ __device__ __forceinline__ void stage_rc(int b, int& R, int& C) { const int st = b / 1024, sb = b % 1024, swz = sb ^ (((sb >> 9) & 1) << 5); R = (st >> 1) * 16 + swz / 64; C = (st & 1) * 32 + (swz % 64) / 2; }
__host__ __device__ __forceinline__ int perm32(int rho) { const int n = rho >> 4, i = rho & 15; return 8 * (i >> 2) + 4 * n + (i & 3); }
__device__ __forceinline__ unsigned cvt_pk_bf16(float lo, float hi) { unsigned r; asm volatile("v_cvt_pk_bf16_f32 %0, %1, %2" : "=v"(r) : "v"(lo), "v"(hi)); return r; }
__device__ __forceinline__ float bf_lo(unsigned w) { return __uint_as_float(w << 16); }
__device__ __forceinline__ float bf_hi(unsigned w) { return __uint_as_float(w & 0xffff0000u); }
__device__ __forceinline__ float silu_f(float v) { return v * __builtin_amdgcn_rcpf(1.f + __expf(-v)); }
__device__ __forceinline__ float wave_sum(float v) {
#pragma unroll
    for (int o = 1; o < 64; o <<= 1) v += __shfl_xor(v, o);
    return v;
}

__device__ __forceinline__ int opaque_tid() { int t = threadIdx.x; asm volatile("" : "+v"(t)); return t; }
__device__ __forceinline__ int opaque_bid() { int b = blockIdx.x; asm volatile("" : "+s"(b)); return b; }
struct Unit { int pm, pn; };
struct Gemm { const bf16_t* A; const bf16_t* Bt; int lda, ldb, K, nM, nN, bk; };

__device__ __forceinline__ bool next_unit(const Gemm& g, int bid, int i, Unit& u) {
    const int nwg = g.nM * g.nN;
    const long L = (long)i * gridDim.x + bid; if (L >= nwg) return false;
    int wgid = (int)L; { const int q = nwg / NXCD, r = nwg % NXCD, xcd = wgid % NXCD, off = wgid / NXCD; wgid = (xcd < r ? xcd * (q + 1) : r * (q + 1) + (xcd - r) * q) + off; }
    const int nig = WGM * g.nN, gid = wgid / nig, fm = gid * WGM, gsz = (g.nM - fm) < WGM ? (g.nM - fm) : WGM;
    u.pm = fm + ((wgid % nig) % gsz); u.pn = (wgid % nig) / gsz; return true;
}

struct EpiEven {
    static constexpr bool PERM = true, AFTER_DRAIN = false;
    bf16_t* P;
    __device__ __forceinline__ void operator()(const f32x4 (&acc)[2][2][4][2], const Unit& u, int wr, int wc, int fr, int fq) const {
        const int row0 = u.pm * BM + wr * 64 + fr, T = u.pn;
        if (T < 24) {
            const int kind = T >> 3, Tl = T & 7;
            bf16_t* base = P + (size_t)kind * MTOK * 1024 + Tl * 128 + wc * 32 + 8 * fq;
#pragma unroll
            for (int ai = 0; ai < 2; ++ai)
#pragma unroll
                for (int m = 0; m < 4; ++m) {
                    bf16_t* rowp = base + (size_t)(row0 + ai * HALF + m * 16) * 1024;
                    f32x4 x0 = acc[ai][0][m][0], x1 = acc[ai][0][m][1], y0 = acc[ai][1][m][0], y1 = acc[ai][1][m][1];
                    if (kind != 0) {
#pragma unroll
                        for (int j = 0; j < 4; ++j) { y0[j] = silu_f(y0[j]); y1[j] = silu_f(y1[j]); }
                    }
                    x0 = x0 * y0; x1 = x1 * y1;
                    u32x4 w; w.x = cvt_pk_bf16(x0[0], x0[1]); w.y = cvt_pk_bf16(x0[2], x0[3]); w.z = cvt_pk_bf16(x1[0], x1[1]); w.w = cvt_pk_bf16(x1[2], x1[3]);
                    *(u32x4*)rowp = w;
                }
        } else {
            bf16_t* base = P + (size_t)3 * MTOK * 1024 + (T - 24) * 256 + wc * 32 + 8 * fq;
#pragma unroll
            for (int ai = 0; ai < 2; ++ai)
#pragma unroll
                for (int m = 0; m < 4; ++m) {
                    bf16_t* rowp = base + (size_t)(row0 + ai * HALF + m * 16) * 1024;
#pragma unroll
                    for (int bj = 0; bj < 2; ++bj) {
                        const f32x4 v0 = acc[ai][bj][m][0], v1 = acc[ai][bj][m][1];
                        u32x4 w; w.x = cvt_pk_bf16(v0[0], v0[1]); w.y = cvt_pk_bf16(v0[2], v0[3]); w.z = cvt_pk_bf16(v1[0], v1[1]); w.w = cvt_pk_bf16(v1[2], v1[3]);
                        *(u32x4*)(rowp + bj * HALF) = w;
                    }
                }
        }
    }
};
struct EpiOdd {
    static constexpr bool PERM = true, AFTER_DRAIN = false;
    bf16_t* P; const float* pscale;
    __device__ __forceinline__ void operator()(const f32x4 (&acc)[2][2][4][2], const Unit& u, int wr, int wc, int fr, int fq) const {
        const int row0 = u.pm * BM + wr * 64 + fr, T = u.pn;
        const bool isz = T >= 8; const int Tl = T & 7, col0 = Tl * 256 + wc * 32 + 8 * fq;
        bf16_t* base = P + (isz ? (size_t)MTOK * 2048 : (size_t)0) + col0;
        f32x4 sc[2][2];
#pragma unroll
        for (int bj = 0; bj < 2; ++bj)
#pragma unroll
            for (int n = 0; n < 2; ++n) sc[bj][n] = isz ? *(const f32x4*)(pscale + col0 + bj * HALF + 4 * n) : (f32x4){1.f, 1.f, 1.f, 1.f};
#pragma unroll
        for (int ai = 0; ai < 2; ++ai)
#pragma unroll
            for (int m = 0; m < 4; ++m) {
                bf16_t* rowp = base + (size_t)(row0 + ai * HALF + m * 16) * 2048;
#pragma unroll
                for (int bj = 0; bj < 2; ++bj) {
                    f32x4 v0 = acc[ai][bj][m][0], v1 = acc[ai][bj][m][1];
                    if (isz) {
#pragma unroll
                        for (int j = 0; j < 4; ++j) { v0[j] = silu_f(v0[j]); v1[j] = silu_f(v1[j]); }
                        v0 = v0 * sc[bj][0]; v1 = v1 * sc[bj][1];
                    }
                    u32x4 w; w.x = cvt_pk_bf16(v0[0], v0[1]); w.y = cvt_pk_bf16(v0[2], v0[3]); w.z = cvt_pk_bf16(v1[0], v1[1]); w.w = cvt_pk_bf16(v1[2], v1[3]);
                    *(u32x4*)(rowp + bj * HALF) = w;
                }
            }
    }
};
struct EpiBf {
    static constexpr bool PERM = true, AFTER_DRAIN = false;
    bf16_t* O; int ld;
    __device__ __forceinline__ void operator()(const f32x4 (&acc)[2][2][4][2], const Unit& u, int wr, int wc, int fr, int fq) const {
        const int row0 = u.pm * BM + wr * 64 + fr, col0 = u.pn * BM + wc * 32 + 8 * fq;
#pragma unroll
        for (int ai = 0; ai < 2; ++ai)
#pragma unroll
            for (int m = 0; m < 4; ++m) {
                bf16_t* rowp = O + (size_t)(row0 + ai * HALF + m * 16) * ld + col0;
#pragma unroll
                for (int bj = 0; bj < 2; ++bj) {
                    const f32x4 v0 = acc[ai][bj][m][0], v1 = acc[ai][bj][m][1];
                    u32x4 w; w.x = cvt_pk_bf16(v0[0], v0[1]); w.y = cvt_pk_bf16(v0[2], v0[3]); w.z = cvt_pk_bf16(v1[0], v1[1]); w.w = cvt_pk_bf16(v1[2], v1[3]);
                    *(u32x4*)(rowp + bj * HALF) = w;
                }
            }
    }
};
struct EpiRes {
    static constexpr bool PERM = false, AFTER_DRAIN = false;
    const float* xin; float* xout; const float* gate;
    __device__ __forceinline__ void operator()(const f32x4 (&acc)[2][2][4][2], const Unit& u, int wr, int wc, int fr, int fq) const {
        const int row0 = u.pm * BM + wr * 64 + fr, col0 = u.pn * BM + wc * 32 + 4 * fq;
        const float* gp = gate + (size_t)(u.pm >> 3) * 3072 + col0;
        f32x4 gv[2][2];
#pragma unroll
        for (int bj = 0; bj < 2; ++bj)
#pragma unroll
            for (int n = 0; n < 2; ++n) gv[bj][n] = *(const f32x4*)(gp + bj * HALF + n * 16);
#pragma unroll
        for (int ai = 0; ai < 2; ++ai)
#pragma unroll
            for (int m = 0; m < 4; ++m) {
                const size_t ro = (size_t)(row0 + ai * HALF + m * 16) * DM + col0;
#pragma unroll
                for (int bj = 0; bj < 2; ++bj)
#pragma unroll
                    for (int n = 0; n < 2; ++n) {
                        const f32x4 xv = *(const f32x4*)(xin + ro + bj * HALF + n * 16);
                        *(f32x4*)(xout + ro + bj * HALF + n * 16) = xv + gv[bj][n] * acc[ai][bj][m][n];
                    }
            }
    }
};

struct EpiResNorm {
    static constexpr bool PERM = true, AFTER_DRAIN = true;
    const float* xin32; const bf16_t* xin16; bf16_t* xout16; float* out32; const float* gate; bf16_t* H; const float* ng; const float* modn; float* part; unsigned* cnt; int last;
    __device__ __forceinline__ void fused(f32x4 (&acc)[2][2][4][2], const Unit& u, int wr, int wc, int fr, int fq, LAS unsigned char* lds, int tid) const {
        const int row0 = u.pm * BM + wr * 64 + fr, col0 = u.pn * BM + wc * 32 + 8 * fq, b = u.pm >> 3;
        LAS float* lss = (LAS float*)lds;
        LAS float* lrs = (LAS float*)(lds + 4096);
        {
            const float* gp = gate + (size_t)b * 3072 + col0;
            f32x4 gv[2][2];
#pragma unroll
            for (int bj = 0; bj < 2; ++bj)
#pragma unroll
                for (int n = 0; n < 2; ++n) gv[bj][n] = *(const f32x4*)(gp + bj * HALF + 4 * n);
#pragma unroll
            for (int ai = 0; ai < 2; ++ai)
#pragma unroll
                for (int m = 0; m < 4; ++m) {
                    const size_t ro = (size_t)(row0 + ai * HALF + m * 16) * DM + col0;
                    float ss = 0.f;
#pragma unroll
                    for (int bj = 0; bj < 2; ++bj) {
                        f32x4 x0, x1;
                        if (xin32) { x0 = *(const f32x4*)(xin32 + ro + bj * HALF); x1 = *(const f32x4*)(xin32 + ro + bj * HALF + 4); }
                        else { const u32x4 w = *(const u32x4*)(xin16 + ro + bj * HALF); x0 = (f32x4){bf_lo(w.x), bf_hi(w.x), bf_lo(w.y), bf_hi(w.y)}; x1 = (f32x4){bf_lo(w.z), bf_hi(w.z), bf_lo(w.w), bf_hi(w.w)}; }
                        const f32x4 v0 = x0 + gv[bj][0] * acc[ai][bj][m][0], v1 = x1 + gv[bj][1] * acc[ai][bj][m][1];
                        acc[ai][bj][m][0] = v0; acc[ai][bj][m][1] = v1;
                        ss += ((v0[0] * v0[0] + v0[1] * v0[1]) + (v0[2] * v0[2] + v0[3] * v0[3])) + ((v1[0] * v1[0] + v1[1] * v1[1]) + (v1[2] * v1[2] + v1[3] * v1[3]));
                        if (!last) { u32x4 w; w.x = cvt_pk_bf16(v0[0], v0[1]); w.y = cvt_pk_bf16(v0[2], v0[3]); w.z = cvt_pk_bf16(v1[0], v1[1]); w.w = cvt_pk_bf16(v1[2], v1[3]); *(u32x4*)(xout16 + ro + bj * HALF) = w; }
                    }
                    ss += __shfl_xor(ss, 16); ss += __shfl_xor(ss, 32);
                    if (fq == 0) lss[(ai * HALF + wr * 64 + m * 16 + fr) * 4 + wc] = ss;
                }
        }
        __syncthreads();
        if (tid < 256) {
            const float t = (lss[tid * 4] + lss[tid * 4 + 1]) + (lss[tid * 4 + 2] + lss[tid * 4 + 3]);
            __hip_atomic_store(part + (size_t)u.pn * MTOK + u.pm * BM + tid, t, __ATOMIC_RELAXED, __HIP_MEMORY_SCOPE_AGENT);
        }
        asm volatile("s_waitcnt vmcnt(0)" ::: "memory");
        __syncthreads();
        if (tid == 0) {
            unsigned* c = cnt + u.pm;
            __hip_atomic_fetch_add(c, 1u, __ATOMIC_RELAXED, __HIP_MEMORY_SCOPE_AGENT);
            unsigned spins = 0;
            while (__hip_atomic_load(c, __ATOMIC_RELAXED, __HIP_MEMORY_SCOPE_AGENT) < 4u && ++spins < (1u << 22)) __builtin_amdgcn_s_sleep(1);
            __builtin_amdgcn_fence(__ATOMIC_ACQUIRE, "agent");
            asm volatile("s_waitcnt vmcnt(0)" ::: "memory");
        }
        __syncthreads();
        if (tid < 256) {
            float t = 0.f;
#pragma unroll
            for (int q = 0; q < 4; ++q) t += __hip_atomic_load(part + (size_t)q * MTOK + u.pm * BM + tid, __ATOMIC_RELAXED, __HIP_MEMORY_SCOPE_AGENT);
            lrs[tid] = rsqrtf(t * (1.f / DM) + EPS);
        }
        __syncthreads();
        const float* mb = modn + (size_t)b * 3072;
#pragma unroll
        for (int bj = 0; bj < 2; ++bj) {
            const int c = col0 + bj * HALF;
            const f32x4 g0 = *(const f32x4*)(ng + c), g1 = *(const f32x4*)(ng + c + 4);
            f32x4 sh0 = {0.f, 0.f, 0.f, 0.f}, sh1 = sh0, sc0 = sh0, sc1 = sh0;
            if (!last) { sh0 = *(const f32x4*)(mb + c); sh1 = *(const f32x4*)(mb + c + 4); sc0 = *(const f32x4*)(mb + 1024 + c); sc1 = *(const f32x4*)(mb + 1024 + c + 4); }
            const f32x4 a0 = g0 * (sc0 + 1.f), a1 = g1 * (sc1 + 1.f);
#pragma unroll
            for (int ai = 0; ai < 2; ++ai)
#pragma unroll
                for (int m = 0; m < 4; ++m) {
                    const int rl = ai * HALF + wr * 64 + m * 16 + fr;
                    const float rstd = lrs[rl];
                    const size_t ro = (size_t)(u.pm * BM + rl) * DM + c;
                    const f32x4 h0 = (acc[ai][bj][m][0] * rstd) * a0 + sh0, h1 = (acc[ai][bj][m][1] * rstd) * a1 + sh1;
                    if (last) { *(f32x4*)(out32 + ro) = h0; *(f32x4*)(out32 + ro + 4) = h1; }
                    else { u32x4 w; w.x = cvt_pk_bf16(h0[0], h0[1]); w.y = cvt_pk_bf16(h0[2], h0[3]); w.z = cvt_pk_bf16(h1[0], h1[1]); w.w = cvt_pk_bf16(h1[2], h1[3]); *(u32x4*)(H + ro) = w; }
                }
        }
    }
};

template <class Epi>
__device__ __forceinline__ void gemm_phase(LAS unsigned char* lds, const Gemm g, const Epi& E) {
    const int tid = opaque_tid(), wid = __builtin_amdgcn_readfirstlane(tid >> 6), lane = tid & 63, wr = wid >> 2, wc = wid & 3, fr = lane & 15, fq = lane >> 4;
    const int nt = g.K / BK;
    unsigned voffA[2], voffB[2];
#pragma unroll
    for (int i = 0; i < 2; ++i) { int R, C; stage_rc(tid * 16 + i * 8192, R, C); const int Rb = Epi::PERM ? ((R & ~31) + perm32(R & 31)) : R;
        voffA[i] = (unsigned)(R * g.lda + C) * 2u; voffB[i] = (unsigned)(Rb * g.ldb + C) * 2u; }
    const size_t kstep = (size_t)(BK * 2);
    const size_t hstepA = (size_t)HALF * g.lda * 2, hstepB = (size_t)HALF * g.ldb * 2;
    const unsigned ldsw = (unsigned)wid * 1024u;
    const int aoff = lds_byte(wr * 64 + fr, fq * 8), boff = lds_byte(wc * 32 + fr, fq * 8);
#define PG8_SA(b, h) (((b) * 2 + (h)) * HTB)
#define PG8_SB(b, h) ((4 + (b) * 2 + (h)) * HTB)
#define PG8_STAGE(bufoff, gbase, voff) do { _Pragma("unroll") for (int _i = 0; _i < 2; ++_i) \
        __builtin_amdgcn_global_load_lds((const unsigned*)((const char*)(gbase) + (voff)[_i]), (LAS unsigned*)(lds + (bufoff) + ldsw + _i * 8192), 16, 0, 0); } while (0)
#define PG8_LDA(dst, b, h) do { _Pragma("unroll") for (int m = 0; m < 4; ++m) _Pragma("unroll") for (int k = 0; k < 2; ++k) dst[m][k] = *(const LAS bf16x8*)(lds + PG8_SA(b, h) + aoff + m * 2048 + k * 1024); } while (0)
#define PG8_LDB(dst, b, h) do { _Pragma("unroll") for (int n = 0; n < 2; ++n) _Pragma("unroll") for (int k = 0; k < 2; ++k) dst[n][k] = *(const LAS bf16x8*)(lds + PG8_SB(b, h) + boff + n * 2048 + k * 1024); } while (0)
#define PG8_MMA(ai, bj, At, Bt) do { __builtin_amdgcn_s_setprio(1); _Pragma("unroll") for (int m = 0; m < 4; ++m) _Pragma("unroll") for (int n = 0; n < 2; ++n) _Pragma("unroll") for (int k = 0; k < 2; ++k) \
        acc[ai][bj][m][n] = __builtin_amdgcn_mfma_f32_16x16x32_bf16(Bt[n][k], At[m][k], acc[ai][bj][m][n], 0, 0, 0); __builtin_amdgcn_s_setprio(0); } while (0)
#define PG8_WAIT_V(n) asm volatile("s_waitcnt vmcnt(" #n ")" ::: "memory")
#define PG8_WAIT_L(n) asm volatile("s_waitcnt lgkmcnt(" #n ")" ::: "memory")
#define PG8_BAR __builtin_amdgcn_s_barrier()
#define PG8_SCHED __builtin_amdgcn_sched_barrier(0)
    Unit cur, nxt; int ui = 0;
    const int bid = opaque_bid();
    if (!next_unit(g, bid, 0, cur)) return;
    f32x4 acc[2][2][4][2];
#pragma unroll
    for (int a = 0; a < 2; ++a)
#pragma unroll
        for (int b = 0; b < 2; ++b)
#pragma unroll
            for (int m = 0; m < 4; ++m)
#pragma unroll
                for (int n = 0; n < 2; ++n) acc[a][b][m][n] = (f32x4){0.f, 0.f, 0.f, 0.f};
    bf16x8 At[4][2], B0[2][2], B1[2][2];
    const char* cA = (const char*)g.A + (size_t)cur.pm * 2 * hstepA; const char* cB = (const char*)g.Bt + (size_t)cur.pn * 2 * hstepB + (size_t)(cur.pm >> 1) * g.bk * 2;
    PG8_STAGE(PG8_SB(0, 0), cB, voffB); PG8_STAGE(PG8_SA(0, 0), cA, voffA); PG8_STAGE(PG8_SB(0, 1), cB + hstepB, voffB); PG8_STAGE(PG8_SA(0, 1), cA + hstepA, voffA);
    if (wr == 1) PG8_BAR;
    PG8_WAIT_V(4); PG8_BAR;
    PG8_STAGE(PG8_SB(1, 0), cB + kstep, voffB); PG8_STAGE(PG8_SA(1, 0), cA + kstep, voffA); PG8_STAGE(PG8_SB(1, 1), cB + hstepB + kstep, voffB);
    PG8_WAIT_V(6); PG8_BAR;
    for (;;) {
        const bool has_next = next_unit(g, bid, ui + 1, nxt);
        const char* nA = has_next ? (const char*)g.A + (size_t)nxt.pm * 2 * hstepA : cA;
        const char* nB = has_next ? (const char*)g.Bt + (size_t)nxt.pn * 2 * hstepB + (size_t)(nxt.pm >> 1) * g.bk * 2 : cB;
        for (int t = 0; t < nt; t += 2) {
            const bool last = (t == nt - 2);
            const char* a1 = cA + (size_t)(t + 1) * kstep;
            const char* a2 = last ? nA : cA + (size_t)(t + 2) * kstep; const char* b2 = last ? nB : cB + (size_t)(t + 2) * kstep;
            const char* a3 = a2 + kstep; const char* b3 = b2 + kstep;
            PG8_LDB(B0, 0, 0); PG8_SCHED; PG8_LDA(At, 0, 0); PG8_STAGE(PG8_SA(1, 1), a1 + hstepA, voffA);
            PG8_WAIT_L(8); PG8_BAR; PG8_WAIT_L(0); PG8_MMA(0, 0, At, B0); PG8_BAR; PG8_SCHED;
            PG8_LDB(B1, 0, 1); PG8_STAGE(PG8_SB(0, 0), b2, voffB);
            PG8_BAR; PG8_WAIT_L(0); PG8_MMA(0, 1, At, B1); PG8_BAR;
            PG8_LDA(At, 0, 1); PG8_STAGE(PG8_SA(0, 0), a2, voffA);
            PG8_BAR; PG8_WAIT_L(0); PG8_MMA(1, 0, At, B0); PG8_BAR; PG8_SCHED;
            PG8_STAGE(PG8_SB(0, 1), b2 + hstepB, voffB);
            PG8_WAIT_V(6); PG8_BAR; PG8_MMA(1, 1, At, B1); PG8_BAR;
            PG8_LDB(B0, 1, 0); PG8_SCHED; PG8_LDA(At, 1, 0); PG8_STAGE(PG8_SA(0, 1), a2 + hstepA, voffA);
            PG8_WAIT_L(8); PG8_BAR; PG8_WAIT_L(0); PG8_MMA(0, 0, At, B0); PG8_BAR; PG8_SCHED;
            PG8_LDB(B1, 1, 1); PG8_STAGE(PG8_SB(1, 0), b3, voffB);
            PG8_BAR; PG8_WAIT_L(0); PG8_MMA(0, 1, At, B1); PG8_BAR;
            PG8_LDA(At, 1, 1); PG8_STAGE(PG8_SA(1, 0), a3, voffA);
            PG8_BAR; PG8_WAIT_L(0); PG8_MMA(1, 0, At, B0); PG8_BAR; PG8_SCHED;
            PG8_STAGE(PG8_SB(1, 1), b3 + hstepB, voffB);
            PG8_WAIT_V(6); PG8_BAR; PG8_MMA(1, 1, At, B1); PG8_BAR;
        }
        if constexpr (!Epi::AFTER_DRAIN) E(acc, cur, wr, wc, fr, fq);
        if (!has_next) break;
#pragma unroll
        for (int a = 0; a < 2; ++a)
#pragma unroll
            for (int b = 0; b < 2; ++b)
#pragma unroll
                for (int m = 0; m < 4; ++m)
#pragma unroll
                    for (int n = 0; n < 2; ++n) acc[a][b][m][n] = (f32x4){0.f, 0.f, 0.f, 0.f};
        cur = nxt; cA = nA; cB = nB; ++ui;
    }
    PG8_WAIT_V(0);
    if (wr == 0) PG8_BAR;
    PG8_BAR;
    if constexpr (Epi::AFTER_DRAIN) E.fused(acc, cur, wr, wc, fr, fq, lds, tid);
#undef PG8_SA
#undef PG8_SB
#undef PG8_STAGE
#undef PG8_LDA
#undef PG8_LDB
#undef PG8_MMA
#undef PG8_WAIT_V
#undef PG8_WAIT_L
#undef PG8_BAR
#undef PG8_SCHED
}

__device__ __forceinline__ void phase_mod(const Params& p, LAS unsigned char* lds) {
    const int tid = opaque_tid(), wid = tid >> 6, lane = tid & 63;
    LAS float* sc = (LAS float*)lds;
    LAS float* red = (LAS float*)(lds + 32768);
    float* mod = (float*)(p.ws + WS_MOD);
    for (int t = tid; t < NB * DM; t += 512) sc[t] = silu_f(p.c[t]);
    __syncthreads();
    for (int it = opaque_bid(); it < 192; it += gridDim.x) {
        const int col = it * 64 + lane, i = col / 3072, j = col - i * 3072;
        const float* w = p.ada_w + ((size_t)i * DM + wid * 128) * 3072 + j;
        float a[8];
#pragma unroll
        for (int b = 0; b < 8; ++b) a[b] = 0.f;
#pragma unroll 16
        for (int k = 0; k < 128; ++k) {
            const float wv = w[(size_t)k * 3072];
#pragma unroll
            for (int b = 0; b < 8; ++b) a[b] += sc[b * DM + wid * 128 + k] * wv;
        }
#pragma unroll
        for (int b = 0; b < 8; ++b) red[(wid * 8 + b) * 64 + lane] = a[b];
        __syncthreads();
        {
            const int b = tid >> 6; float s = 0.f;
#pragma unroll
            for (int w8 = 0; w8 < 8; ++w8) s += red[(w8 * 8 + b) * 64 + lane];
            mod[((size_t)i * NB + b) * 3072 + j] = s + p.ada_b[i * 3072 + j];
        }
        __syncthreads();
    }
}

__device__ __forceinline__ void conv_tile(const float* __restrict__ src, int srcN, int c0, bf16_t* __restrict__ dstrow, int K, int k0, LAS float* T) {
    const int tid = opaque_tid();
    f32x4 v[8];
#pragma unroll
    for (int ps = 0; ps < 8; ++ps) v[ps] = *(const f32x4*)(src + (size_t)(k0 + ps * 32 + (tid >> 4)) * srcN + c0 + (tid & 15) * 4);
#pragma unroll
    for (int ps = 0; ps < 8; ++ps) { LAS float* t = T + (ps * 32 + (tid >> 4)) * 65 + (tid & 15) * 4; t[0] = v[ps][0]; t[1] = v[ps][1]; t[2] = v[ps][2]; t[3] = v[ps][3]; }
    __syncthreads();
#pragma unroll
    for (int q = 0; q < 4; ++q) {
        const int item = tid + 512 * q, n = item >> 5, kg = item & 31; const LAS float* s = T + (kg * 8) * 65 + n;
        u32x4 o; o.x = cvt_pk_bf16(s[0], s[65]); o.y = cvt_pk_bf16(s[130], s[195]); o.z = cvt_pk_bf16(s[260], s[325]); o.w = cvt_pk_bf16(s[390], s[455]);
        *(u32x4*)(dstrow + (size_t)n * K + k0 + kg * 8) = o;
    }
    __syncthreads();
}

__device__ __forceinline__ void norm_rows(const Params& p, int layer, const float* xin, int item) {
    const int tid = opaque_tid(), wid = tid >> 6, lane = tid & 63;
    bf16_t* H = (bf16_t*)g_h;
    const float* mod = (const float*)(p.ws + WS_MOD) + (size_t)layer * NB * 3072;
    const float* gp = p.norm_g + (size_t)layer * DM;
#pragma unroll
    for (int h2 = 0; h2 < 2; ++h2) {
        const int row = item * 16 + h2 * 8 + wid, b = row >> 11;
        const f32x4* xr = (const f32x4*)(xin + (size_t)row * DM) + lane;
        f32x4 v[4]; float ss = 0.f;
#pragma unroll
        for (int q = 0; q < 4; ++q) { v[q] = xr[64 * q]; ss += (v[q][0] * v[q][0] + v[q][1] * v[q][1]) + (v[q][2] * v[q][2] + v[q][3] * v[q][3]); }
        const float rstd = rsqrtf(wave_sum(ss) * (1.f / DM) + EPS);
        const float* mb = mod + (size_t)b * 3072;
        u32x2* o8 = (u32x2*)(H + (size_t)row * DM) + lane;
#pragma unroll
        for (int q = 0; q < 4; ++q) {
            const int k = (lane + 64 * q) * 4;
            const f32x4 gv = *(const f32x4*)(gp + k), sh = *(const f32x4*)(mb + k), scl = *(const f32x4*)(mb + 1024 + k);
            const f32x4 hv = (v[q] * rstd * gv) * (scl + 1.f) + sh;
            u32x2 w; w.x = cvt_pk_bf16(hv[0], hv[1]); w.y = cvt_pk_bf16(hv[2], hv[3]);
            o8[64 * q] = w;
        }
    }
}
__device__ __forceinline__ void phase_norm_even(const Params& p, int j, const float* xin, LAS unsigned char* lds) {
    const int tid = opaque_tid();
    bf16_t* WIN_E = (bf16_t*)(p.ws + WS_WIN_E); bf16_t* WIN_O = (bf16_t*)(p.ws + WS_WIN_O); bf16_t* WOUT_E = (bf16_t*)(p.ws + WS_WOUT_E); bf16_t* WOUT_O = (bf16_t*)(p.ws + WS_WOUT_O);
    bf16_t* SGU = (bf16_t*)(p.ws + WS_SGU); bf16_t* POOLT = (bf16_t*)(p.ws + WS_POOLT); bf16_t* WINP = (bf16_t*)(p.ws + WS_WINP);
    constexpr int N0 = 448, N1 = N0 + 128, N2 = N1 + 128, N3 = N2 + 128, N4 = N3 + 64, N5 = N4 + 32, N6 = N5 + 512;
    const int TOTAL = N6 + (j == 0 ? MTOK / 16 : 0);
    for (int it = opaque_bid(); it < TOTAL; it += gridDim.x) {
        if (it < N0) {
            const int rt = it >> 2, kt = it & 3, r0 = rt * 64, T = r0 >> 8, q = r0 & 255; int c0;
            if (T < 8) c0 = (q < 128) ? (2048 + 128 * T + q) : (128 * T + q - 128);
            else if (T < 16) c0 = (q < 128) ? (1024 + 128 * (T - 8) + q) : (3072 + 128 * (T - 8) + q - 128);
            else if (T < 24) c0 = (q < 128) ? (4096 + 128 * (T - 16) + q) : (6144 + 128 * (T - 16) + q - 128);
            else c0 = 5120 + 256 * (T - 24) + q;
            conv_tile(p.ab_w_in + (size_t)j * DM * 7168, 7168, c0, WIN_E + (size_t)r0 * DM, DM, kt * 256, (LAS float*)lds);
        } else if (it < N1) {
            const int i2 = it - N0, rt = i2 >> 3, kt = i2 & 7, r0 = rt * 64;
            conv_tile(p.ab_w_out + (size_t)j * 2048 * DM, DM, r0, WOUT_E + (size_t)r0 * 2048, 2048, kt * 256, (LAS float*)lds);
        } else if (it < N2) {
            const int i2 = it - N1, rt = i2 >> 2, kt = i2 & 3, r0 = rt * 64;
            conv_tile(p.c_w_in + (size_t)j * DM * 4096, 4096, 2048 + r0, WIN_O + (size_t)(2048 + r0) * DM, DM, kt * 256, (LAS float*)lds);
        } else if (it < N3) {
            const int i2 = it - N2, rt = i2 >> 3, kt = i2 & 7, r0 = rt * 64;
            conv_tile(p.c_w_out + (size_t)j * 2048 * DM, DM, r0, WOUT_O + (size_t)r0 * 2048, 2048, kt * 256, (LAS float*)lds);
        } else if (it < N4) {
            const int i3 = it - N3, g = i3 >> 4, r = i3 & 15, rt = r >> 1, kt = r & 1, r0 = rt * 64;
            conv_tile(p.c_pool_w + ((size_t)j * 4 + g) * 512 * 512, 512, r0, POOLT + (size_t)g * 512 * 512 + (size_t)r0 * 512, 512, kt * 256, (LAS float*)lds);
        } else if (it < N5) {
            const int e0 = (it - N4) * 4096 + tid * 8, t = (e0 >> 7) & 127, s0 = e0 & 127;
            const float* src = p.ab_sgu_w + (size_t)j * 8 * 128 * 128 + e0;
            const f32x4 a = *(const f32x4*)src, b = *(const f32x4*)(src + 4);
            float v[8] = {a[0], a[1], a[2], a[3], b[0], b[1], b[2], b[3]};
#pragma unroll
            for (int e = 0; e < 8; ++e) v[e] = (s0 + e <= t) ? v[e] : 0.f;
            u32x4 o; o.x = cvt_pk_bf16(v[0], v[1]); o.y = cvt_pk_bf16(v[2], v[3]); o.z = cvt_pk_bf16(v[4], v[5]); o.w = cvt_pk_bf16(v[6], v[7]);
            *(u32x4*)(SGU + e0) = o;
        } else if (it < N6) {
            const int e0 = (it - N5) * 4096 + tid * 8, k = e0 >> 11, c = e0 & 2047;
            const float* src = p.c_w_in + ((size_t)j * DM + k) * 4096 + c;
            const f32x4 a = *(const f32x4*)src, b = *(const f32x4*)(src + 4);
            u32x4 o; o.x = cvt_pk_bf16(a[0], a[1]); o.y = cvt_pk_bf16(a[2], a[3]); o.z = cvt_pk_bf16(b[0], b[1]); o.w = cvt_pk_bf16(b[2], b[3]);
            *(u32x4*)(WINP + e0) = o;
        } else norm_rows(p, 2 * j, xin, it - N6);
    }
}
__device__ __forceinline__ void phase_final(const Params& p) {
    const int tid = opaque_tid(), wid = tid >> 6, lane = tid & 63;
    for (int it = opaque_bid(); it < MTOK / 8; it += gridDim.x) {
        const int row = it * 8 + wid;
        f32x4* xr = (f32x4*)(p.out + (size_t)row * DM) + lane;
        f32x4 v[4]; float ss = 0.f;
#pragma unroll
        for (int q = 0; q < 4; ++q) { v[q] = xr[64 * q]; ss += (v[q][0] * v[q][0] + v[q][1] * v[q][1]) + (v[q][2] * v[q][2] + v[q][3] * v[q][3]); }
        const float rstd = rsqrtf(wave_sum(ss) * (1.f / DM) + EPS);
#pragma unroll
        for (int q = 0; q < 4; ++q) { const f32x4 gv = *(const f32x4*)(p.final_g + (lane + 64 * q) * 4); xr[64 * q] = v[q] * rstd * gv; }
    }
}

__device__ __forceinline__ void unpack8(const u32x4 w, float (&f)[8]) {
    f[0] = bf_lo(w.x); f[1] = bf_hi(w.x); f[2] = bf_lo(w.y); f[3] = bf_hi(w.y); f[4] = bf_lo(w.z); f[5] = bf_hi(w.z); f[6] = bf_lo(w.w); f[7] = bf_hi(w.w);
}

__device__ __forceinline__ void phase_mix(const Params& p, int j, LAS unsigned char* lds) {
    const int tid = opaque_tid(), wid = tid >> 6, lane = tid & 63;
    const bf16_t* CH2 = (const bf16_t*)(p.ws + WS_RP); const bf16_t* BZ = CH2 + (size_t)MTOK * 1024; const bf16_t* UZ = BZ + (size_t)MTOK * 1024; const bf16_t* V = UZ + (size_t)MTOK * 1024;
    bf16_t* Y = (bf16_t*)(p.ws + WS_RA);
    if (blockIdx.x < 32) {
        Gemm g{(const bf16_t*)(p.ws + WS_POOLT), (const bf16_t*)(p.ws + WS_WINP), 512, 2048, 512, 8, 4, 512}; EpiBf E{(bf16_t*)(p.ws + WS_WIN_O), DM};
        gemm_phase(lds, g, E);
        __syncthreads();
    }
    {
        const bf16_t* Wm = (const bf16_t*)(p.ws + WS_SGU);
        LAS bf16_t* vnT = (LAS bf16_t*)lds;
        LAS float* red = (LAS float*)(lds + 36864);
        const int fr = lane & 15, fq = lane >> 4;
        const int s = lane + 64 * (wid & 1), q = wid >> 1;
        int it = opaque_bid();
        u32x4 vraw[4];
        if (it < 1024) { const bf16_t* vp = V + (size_t)((it >> 3) * 128 + s) * 1024 + (it & 7) * 128 + 32 * q;
#pragma unroll
            for (int i = 0; i < 4; ++i) vraw[i] = *(const u32x4*)(vp + 8 * i); }
        for (; it < 1024; it += gridDim.x) {
            const int hh = it & 7, cn = it >> 3;
            const int t = 16 * wid + fr; const size_t row = (size_t)cn * 128 + t;
            u32x2 uz[8];
#pragma unroll
            for (int n = 0; n < 8; ++n) uz[n] = *(const u32x2*)(UZ + row * 1024 + hh * 128 + 16 * n + 4 * fq);
            const float bias = p.ab_sgu_b[(size_t)j * 1024 + hh * 128 + t];
            const bf16_t* wrow = Wm + ((size_t)hh * 128 + 16 * wid + fr) * 128 + 8 * fq;
            bf16x8 af[4];
#pragma unroll
            for (int kk = 0; kk < 4; ++kk) af[kk] = *(const bf16x8*)(wrow + 32 * kk);
            float f[32];
#pragma unroll
            for (int i = 0; i < 4; ++i) { float t8[8]; unpack8(vraw[i], t8);
#pragma unroll
                for (int e = 0; e < 8; ++e) f[8 * i + e] = t8[e]; }
            float s1 = 0.f, s2 = 0.f;
#pragma unroll
            for (int i = 0; i < 32; ++i) { s1 += f[i]; s2 += f[i] * f[i]; }
            red[(s * 4 + q) * 2] = s1; red[(s * 4 + q) * 2 + 1] = s2;
            __syncthreads();
            {
                const int itn = it + gridDim.x;
                if (itn < 1024) { const bf16_t* vp = V + (size_t)((itn >> 3) * 128 + s) * 1024 + (itn & 7) * 128 + 32 * q;
#pragma unroll
                    for (int i = 0; i < 4; ++i) vraw[i] = *(const u32x4*)(vp + 8 * i); }
            }
            float S1 = 0.f, S2 = 0.f;
#pragma unroll
            for (int qq = 0; qq < 4; ++qq) { S1 += red[(s * 4 + qq) * 2]; S2 += red[(s * 4 + qq) * 2 + 1]; }
            const float mu = S1 * (1.f / 128.f), var = fmaxf(S2 * (1.f / 128.f) - mu * mu, 0.f), rstd = rsqrtf(var + EPS);
            const float* lg = p.ab_ln_g + (size_t)j * 1024 + hh * 128 + 32 * q; const float* lb = p.ab_ln_b + (size_t)j * 1024 + hh * 128 + 32 * q;
#pragma unroll
            for (int i = 0; i < 32; ++i) {
                const float vn = (f[i] - mu) * rstd * lg[i] + lb[i];
                vnT[(32 * q + i) * 136 + s] = (bf16_t)(cvt_pk_bf16(vn, 0.f) & 0xffffu);
            }
            __syncthreads();
            f32x4 acc[8];
#pragma unroll
            for (int n = 0; n < 8; ++n) acc[n] = (f32x4){0.f, 0.f, 0.f, 0.f};
#pragma unroll
            for (int kk = 0; kk < 4; ++kk) {
                if (32 * kk <= 16 * wid + 15) {
#pragma unroll
                    for (int n = 0; n < 8; ++n) {
                        const bf16x8 bfm = *(const LAS bf16x8*)(vnT + (16 * n + fr) * 136 + 32 * kk + 8 * fq);
                        acc[n] = __builtin_amdgcn_mfma_f32_16x16x32_bf16(bfm, af[kk], acc[n], 0, 0, 0);
                    }
                }
            }
#pragma unroll
            for (int n = 0; n < 8; ++n) {
                const int d = 16 * n + 4 * fq;
                u32x2 w; w.x = cvt_pk_bf16(bf_lo(uz[n].x) * (acc[n][0] + bias), bf_hi(uz[n].x) * (acc[n][1] + bias));
                w.y = cvt_pk_bf16(bf_lo(uz[n].y) * (acc[n][2] + bias), bf_hi(uz[n].y) * (acc[n][3] + bias));
                *(u32x2*)(Y + row * 2048 + 1024 + hh * 128 + d) = w;
            }
        }
    }
    {
        const float* cw = p.ab_conv_w + (size_t)j * 3 * 1024;
        for (int it = opaque_bid(); it < 256; it += gridDim.x) {
            const int rg = it * 4 + (tid >> 7), c0 = (tid & 127) * 8, t0 = rg * 16;
            float w0[8], w1[8], w2[8], p2[8], p1[8];
#pragma unroll
            for (int h4 = 0; h4 < 2; ++h4) {
                const f32x4 a = *(const f32x4*)(cw + c0 + 4 * h4), b = *(const f32x4*)(cw + 1024 + c0 + 4 * h4), c = *(const f32x4*)(cw + 2048 + c0 + 4 * h4);
#pragma unroll
                for (int e = 0; e < 4; ++e) { w0[4 * h4 + e] = a[e]; w1[4 * h4 + e] = b[e]; w2[4 * h4 + e] = c[e]; }
            }
            if ((t0 & (SEQ - 1)) != 0) {
                unpack8(*(const u32x4*)(CH2 + (size_t)(t0 - 2) * 1024 + c0), p2);
                unpack8(*(const u32x4*)(CH2 + (size_t)(t0 - 1) * 1024 + c0), p1);
            } else {
#pragma unroll
                for (int e = 0; e < 8; ++e) { p2[e] = 0.f; p1[e] = 0.f; }
            }
#pragma unroll 8
            for (int r = 0; r < 16; ++r) {
                float cur[8], bz[8], o[8];
                unpack8(*(const u32x4*)(CH2 + (size_t)(t0 + r) * 1024 + c0), cur);
                unpack8(*(const u32x4*)(BZ + (size_t)(t0 + r) * 1024 + c0), bz);
#pragma unroll
                for (int e = 0; e < 8; ++e) { o[e] = bz[e] * (w0[e] * p2[e] + w1[e] * p1[e] + w2[e] * cur[e]); p2[e] = p1[e]; p1[e] = cur[e]; }
                u32x4 w; w.x = cvt_pk_bf16(o[0], o[1]); w.y = cvt_pk_bf16(o[2], o[3]); w.z = cvt_pk_bf16(o[4], o[5]); w.w = cvt_pk_bf16(o[6], o[7]);
                *(u32x4*)(Y + (size_t)(t0 + r) * 2048 + c0) = w;
            }
        }
    }
}

__device__ __forceinline__ void phase_pool(const Params& p) {
    const int tid = opaque_tid();
    const bf16_t* Q = (const bf16_t*)(p.ws + WS_RP); const bf16_t* SZ = Q + (size_t)MTOK * 2048; bf16_t* Y = (bf16_t*)(p.ws + WS_RA);
    for (int it = opaque_bid(); it < 256; it += gridDim.x) {
        const int rg = it * 2 + (tid >> 8), ct = tid & 255, c0 = ct * 8, win = 2 << (ct >> 6), t0 = rg * 32, tl0 = t0 & (SEQ - 1);
        float S[8];
#pragma unroll
        for (int e = 0; e < 8; ++e) S[e] = 0.f;
        if (tl0 != 0) {
#pragma unroll
            for (int i = 1; i < 16; ++i) {
                if (i < win) { float v[8]; unpack8(*(const u32x4*)(Q + (size_t)(t0 - i) * 2048 + c0), v);
#pragma unroll
                    for (int e = 0; e < 8; ++e) S[e] += v[e]; }
            }
        }
#pragma unroll 8
        for (int r = 0; r < 32; ++r) {
            const int tl = tl0 + r;
            float cur[8], sz[8], o[8];
            unpack8(*(const u32x4*)(Q + (size_t)(t0 + r) * 2048 + c0), cur);
            unpack8(*(const u32x4*)(SZ + (size_t)(t0 + r) * 2048 + c0), sz);
            const float inv = 1.f / (float)min(tl + 1, win);
#pragma unroll
            for (int e = 0; e < 8; ++e) { S[e] += cur[e]; o[e] = (S[e] * inv - cur[e]) * sz[e]; }
            u32x4 w; w.x = cvt_pk_bf16(o[0], o[1]); w.y = cvt_pk_bf16(o[2], o[3]); w.z = cvt_pk_bf16(o[4], o[5]); w.w = cvt_pk_bf16(o[6], o[7]);
            *(u32x4*)(Y + (size_t)(t0 + r) * 2048 + c0) = w;
            if (tl - win + 1 >= 0) { float old[8]; unpack8(*(const u32x4*)(Q + (size_t)(t0 + r - win + 1) * 2048 + c0), old);
#pragma unroll
                for (int e = 0; e < 8; ++e) S[e] -= old[e]; }
        }
    }
}

#define XB_TMO      128
#define XB_XCNT(j)  (256  + 64 * (j))
#define XB_XSUB(j)  (1280 + 64 * (j))
#define XB_XGEN(j)  (2304 + 64 * (j))
#define XB_TOP      3328
#define XB_TOPGEN   3392
#define XCD_BAR_WORDS 3456
#define XB_SPIN_CAP (1u << 18)
__device__ __forceinline__ unsigned xb_ld(unsigned* p)              { return __hip_atomic_load(p, __ATOMIC_RELAXED, __HIP_MEMORY_SCOPE_AGENT); }
__device__ __forceinline__ unsigned xb_add(unsigned* p, unsigned v) { return __hip_atomic_fetch_add(p, v, __ATOMIC_RELAXED, __HIP_MEMORY_SCOPE_AGENT); }
__device__ __forceinline__ unsigned xb_xcc_id() { return (unsigned)__builtin_amdgcn_s_getreg((3 << 11) | 20) & 0xFu; }
#define XB_SPIN(cond, bar) do { unsigned _sp = 0; while (cond) { __builtin_amdgcn_s_sleep(1); \
    if ((++_sp & 255u) == 0u) { if (xb_ld(&(bar)[XB_TMO])) break; if (_sp > XB_SPIN_CAP) { atomicAdd(&(bar)[XB_TMO], 1u); break; } } } } while (0)
struct XcdBarrier { unsigned* bar; unsigned x; volatile LAS unsigned* st; };
__device__ __forceinline__ XcdBarrier xcd_barrier_post(unsigned* bar, volatile LAS unsigned* st) {
    XcdBarrier b; b.bar = bar; b.x = xb_xcc_id(); b.st = st;
    if (threadIdx.x == 0) (void)xb_add(&bar[XB_XCNT(b.x)], 1u);
    return b;
}
__device__ __forceinline__ void xcd_barrier_complete(unsigned* bar, unsigned x, unsigned& nloc, unsigned& nx) {
    const unsigned G = gridDim.x * gridDim.y * gridDim.z;
    unsigned sum, cnt, mine, sp = 0u;
    for (;;) {
        sum = 0u; cnt = 0u; mine = 0u;
#pragma unroll
        for (unsigned j = 0; j < 16; ++j) { const unsigned c = xb_ld(&bar[XB_XCNT(j)]); sum += c; cnt += (c > 0u) ? 1u : 0u; mine = (j == x) ? c : mine; }
        if (sum == G) break;
        __builtin_amdgcn_s_sleep(1);
        if ((++sp & 255u) == 0u) { if (xb_ld(&bar[XB_TMO])) break; if (sp > XB_SPIN_CAP) { atomicAdd(&bar[XB_TMO], 1u); break; } }
    }
    nloc = mine > 0u ? mine : 1u; nx = cnt > 0u ? cnt : 1u;
}
__device__ __forceinline__ void xcd_barrier(const XcdBarrier& b) {
    asm volatile("s_waitcnt vmcnt(0)" ::: "memory");
    __syncthreads();
    if (threadIdx.x == 0) {
        unsigned* bar = b.bar;
        __builtin_amdgcn_s_waitcnt(0);
        unsigned nloc = b.st[0], nx = b.st[1];
        if (nloc == 0u) { xcd_barrier_complete(bar, b.x, nloc, nx); b.st[0] = nloc; b.st[1] = nx; }
        const unsigned old = xb_add(&bar[XB_XSUB(b.x)], 1u);
        const unsigned gen = old / nloc;
        if (old + 1u == (gen + 1u) * nloc) {
            __builtin_amdgcn_fence(__ATOMIC_RELEASE, "agent");
            asm volatile("s_waitcnt vmcnt(0)" ::: "memory");
            const unsigned og = xb_add(&bar[XB_TOP], 1u);
            const unsigned tg = og / nx;
            if (og + 1u == (tg + 1u) * nx) xb_add(&bar[XB_TOPGEN], 1u);
            else XB_SPIN(xb_ld(&bar[XB_TOPGEN]) == tg, bar);
            __builtin_amdgcn_fence(__ATOMIC_ACQUIRE, "agent");
            xb_add(&bar[XB_XGEN(b.x)], 1u);
            asm volatile("s_waitcnt vmcnt(0)" ::: "memory");
        } else {
            XB_SPIN(xb_ld(&bar[XB_XGEN(b.x)]) == gen, bar);
            __builtin_amdgcn_fence(__ATOMIC_ACQUIRE, "agent");
            asm volatile("s_waitcnt vmcnt(0)" ::: "memory");
        }
    }
    __syncthreads();
}

__global__ void __launch_bounds__(512, 2) mega_fwd(Params p, int ph_lo, int ph_hi) {
    extern __shared__ __attribute__((aligned(16))) unsigned char smem[];
    LAS unsigned char* lds = (LAS unsigned char*)smem;
    cg::grid_group grid = cg::this_grid();
    if (ph_hi < 0) grid.sync();
    volatile LAS unsigned* st = (volatile LAS unsigned*)(lds + STAGE_BYTES);
    if (threadIdx.x < 4) st[threadIdx.x] = 0u;
    __syncthreads();
    const XcdBarrier xb = xcd_barrier_post((unsigned*)(p.ws + WS_BAR), st);
    int ph = 0;
#define PHASE(REP, ...) do { if (ph >= ph_lo && ph < ph_hi) { for (int _r = 0; _r < (REP); ++_r) { __VA_ARGS__; if (ph + 1 < ph_hi) xcd_barrier(xb); } } ++ph; } while (0)
    bf16_t* RA = (bf16_t*)(p.ws + WS_RA); bf16_t* RP = (bf16_t*)(p.ws + WS_RP);
    const bf16_t* WIN_E = (const bf16_t*)(p.ws + WS_WIN_E); const bf16_t* WIN_O = (const bf16_t*)(p.ws + WS_WIN_O);
    const bf16_t* WOUT_E = (const bf16_t*)(p.ws + WS_WOUT_E); const bf16_t* WOUT_O = (const bf16_t*)(p.ws + WS_WOUT_O);
    const float* mod = (const float*)(p.ws + WS_MOD);
    float* part = (float*)(p.ws + WS_PART); unsigned* cnt = (unsigned*)(p.ws + WS_BAR) + CNT_WORD0;
    PHASE(REP_THIN, phase_mod(p, lds));
#pragma unroll 1
    for (int lp = 0; lp < 2; ++lp) {
        {
            const int layer = 2 * lp; const float* xin = (lp == 0) ? p.x : p.out;
            PHASE(REP_THIN, phase_norm_even(p, lp, xin, lds));
            PHASE(REP_G1, { Gemm g{(const bf16_t*)g_h, WIN_E, DM, DM, DM, MTOK / BM, 7168 / BM, 0}; EpiEven E{RP}; gemm_phase(lds, g, E); });
            PHASE(REP_THIN, phase_mix(p, lp, lds));
            PHASE(1, { Gemm g{RA, WOUT_E, 2048, 2048, 2048, MTOK / BM, DM / BM, 0};
                       EpiResNorm E{lp == 0 ? p.x : nullptr, (const bf16_t*)g_x, (bf16_t*)g_x, p.out, mod + (size_t)layer * NB * 3072 + 2048, (bf16_t*)g_h, p.norm_g + (size_t)(layer + 1) * DM, mod + (size_t)(layer + 1) * NB * 3072,
                                    part + (size_t)layer * 4 * MTOK, cnt + layer * 64, 0};
                       gemm_phase(lds, g, E); });
        }
        {
            const int layer = 2 * lp + 1; const int last = (lp == 1) ? 1 : 0;
            PHASE(REP_G1, { Gemm g{(const bf16_t*)g_h, WIN_O, DM, DM, DM, MTOK / BM, 4096 / BM, 0}; EpiOdd E{RP, p.c_pool_scale + (size_t)lp * 2048}; gemm_phase(lds, g, E); });
            PHASE(REP_THIN, phase_pool(p));
            PHASE(1, { Gemm g{RA, WOUT_O, 2048, 2048, 2048, MTOK / BM, DM / BM, 0};
                       EpiResNorm E{nullptr, (const bf16_t*)g_x, (bf16_t*)g_x, p.out, mod + (size_t)layer * NB * 3072 + 2048, (bf16_t*)g_h, last ? p.final_g : p.norm_g + (size_t)(layer + 1) * DM, mod + (size_t)(last ? layer : layer + 1) * NB * 3072,
                                    part + (size_t)layer * 4 * MTOK, cnt + layer * 64, last};
                       gemm_phase(lds, g, E); });
        }
    }
#undef PHASE
}

extern "C" void kernel_launch(void* const* d_in, const int* in_sizes, int n_in, void* d_out, int out_size, void* d_ws, size_t ws_size, hipStream_t stream) {
    static int grid = 0;
    if (grid == 0) {
        if (n_in != 17 || out_size != MTOK * DM || ws_size < WS_END2) { fprintf(stderr, "kernel_launch: unexpected shapes (n_in %d out %d ws %zu need %zu)\n", n_in, out_size, ws_size, (size_t)WS_END2); grid = -1; return; }
        int dev = 0, cus = 0, per_cu = 0;
        hipGetDevice(&dev);
        hipDeviceGetAttribute(&cus, hipDeviceAttributeMultiprocessorCount, dev);
        if (hipFuncSetAttribute((const void*)mega_fwd, hipFuncAttributeMaxDynamicSharedMemorySize, LDS_BYTES) != hipSuccess) { fprintf(stderr, "kernel_launch: hipFuncSetAttribute failed\n"); grid = -1; return; }
        hipOccupancyMaxActiveBlocksPerMultiprocessor(&per_cu, (const void*)mega_fwd, 512, LDS_BYTES);
        if (per_cu < 1) { fprintf(stderr, "kernel_launch: occupancy query says %d blocks per CU\n", per_cu); per_cu = 1; }
        (void)hipGetLastError();
        grid = cus;
        if (grid != 256) { fprintf(stderr, "kernel_launch: built for 256 CUs (one out-projection tile per workgroup), got %d\n", grid); grid = -1; return; }
    }
    if (grid < 0) return;
    Params p{};
    p.x = (const float*)d_in[0]; p.c = (const float*)d_in[1]; p.norm_g = (const float*)d_in[2]; p.ada_w = (const float*)d_in[3]; p.ada_b = (const float*)d_in[4];
    p.ab_w_in = (const float*)d_in[5]; p.ab_conv_w = (const float*)d_in[6]; p.ab_ln_g = (const float*)d_in[7]; p.ab_ln_b = (const float*)d_in[8];
    p.ab_sgu_w = (const float*)d_in[9]; p.ab_sgu_b = (const float*)d_in[10]; p.ab_w_out = (const float*)d_in[11];
    p.c_w_in = (const float*)d_in[12]; p.c_pool_w = (const float*)d_in[13]; p.c_pool_scale = (const float*)d_in[14]; p.c_w_out = (const float*)d_in[15]; p.final_g = (const float*)d_in[16];
    p.out = (float*)d_out; p.ws = (unsigned char*)d_ws;
    if (hipMemsetAsync((unsigned char*)d_ws + WS_BAR, 0, CTL_WORDS * 4, stream) != hipSuccess) { fprintf(stderr, "kernel_launch: barrier memset failed\n"); return; }
    int lo = 0, hi = 15;
    void* args[] = {&p, &lo, &hi};
    hipError_t e = hipLaunchCooperativeKernel((const void*)mega_fwd, dim3(grid), dim3(512), args, LDS_BYTES, stream);
    if (e != hipSuccess) fprintf(stderr, "kernel_launch: cooperative launch failed: %s (grid %d)\n", hipGetErrorString(e), grid);
}
```

```cpp
#include <hip/hip_runtime.h>
#include <hip/hip_cooperative_groups.h>
#include <cstdio>
namespace cg = cooperative_groups;

#define LAS __attribute__((address_space(3)))
typedef unsigned short bf16_t;
typedef short bf16x8 __attribute__((ext_vector_type(8)));
typedef float f32x4 __attribute__((ext_vector_type(4)));
typedef unsigned u32x4 __attribute__((ext_vector_type(4)));
typedef unsigned u32x2 __attribute__((ext_vector_type(2)));

constexpr int DM = 1024, NB = 8, SEQ = 2048, MTOK = NB * SEQ;
constexpr int BM = 256, BK = 64, HALF = 128, HTB = HALF * BK * 2, STAGE_BYTES = 8 * HTB, NXCD = 8, WGM = 8;
constexpr int LDS_BYTES = STAGE_BYTES + 16;
constexpr float EPS = 1e-6f;
constexpr int REP_G1 = 1, REP_THIN = 1, REP_G2L0 = 1;

constexpr size_t WS_MOD = 0;
constexpr size_t WS_BAR = 393216;
constexpr size_t WS_WIN_E = 524288;
constexpr size_t WS_WIN_O = WS_WIN_E + (size_t)7168 * 1024 * 2;
constexpr size_t WS_WOUT_E = WS_WIN_O + (size_t)4096 * 1024 * 2;
constexpr size_t WS_WOUT_O = WS_WOUT_E + (size_t)1024 * 2048 * 2;
constexpr size_t WS_SGU = WS_WOUT_O + (size_t)1024 * 2048 * 2;
constexpr size_t WS_POOLT = WS_SGU + (size_t)8 * 128 * 128 * 2;
constexpr size_t WS_WINP = WS_POOLT + (size_t)4 * 512 * 512 * 2;
constexpr size_t WS_RA = WS_WINP + (size_t)1024 * 2048 * 2;
constexpr size_t WS_RP = WS_RA + (size_t)MTOK * 2048 * 2;
constexpr size_t WS_END = WS_RP + (size_t)MTOK * 4096 * 2;

constexpr size_t WS_PART = WS_END;
constexpr size_t WS_HALO = WS_PART + (size_t)4 * 4 * MTOK * 4;
constexpr size_t WS_END2 = WS_HALO + (size_t)128 * 6 * 1024 * 4;
constexpr int CNT_WORD0 = 3584;
constexpr int CTL_WORDS = CNT_WORD0 + 256;
__device__ unsigned short g_x[(size_t)MTOK * DM];
__device__ unsigned short g_h[(size_t)MTOK * DM];

struct Params {
    const float *x, *c, *norm_g, *ada_w, *ada_b, *ab_w_in, *ab_conv_w, *ab_ln_g, *ab_ln_b, *ab_sgu_w, *ab_sgu_b, *ab_w_out,
        *c_w_in, *c_pool_w, *c_pool_scale, *c_w_out, *final_g;
    float* out;
    unsigned char* ws;
};

__host__ __device__ __forceinline__ int lds_byte(int r, int c) { const int st = (r >> 4) * 2 + (c >> 5), rr = r & 15, cc = c & 31, ob = rr * 64 + cc * 2; return st * 1024 + (ob ^ (((ob >> 9) & 1) << 5)); }
__host__ __device__ __forceinline__ void stage_rc(int b, int& R, int& C) { const int st = b / 1024, sb = b % 1024, swz = sb ^ (((sb >> 9) & 1) << 5); R = (st >> 1) * 16 + swz / 64; C = (st & 1) * 32 + (swz % 64) / 2; }
__host__ __device__ __forceinline__ int perm32(int rho) { const int n = rho >> 4, i = rho & 15; return 8 * (i >> 2) + 4 * n + (i & 3); }
__device__ __forceinline__ unsigned cvt_pk_bf16(float lo, float hi) { unsigned r; asm volatile("v_cvt_pk_bf16_f32 %0, %1, %2" : "=v"(r) : "v"(lo), "v"(hi)); return r; }
__device__ __forceinline__ float bf_lo(unsigned w) { return __uint_as_float(w << 16); }
__device__ __forceinline__ float bf_hi(unsigned w) { return __uint_as_float(w & 0xffff0000u); }
__device__ __forceinline__ float silu_f(float v) { return v * __builtin_amdgcn_rcpf(1.f + __expf(-v)); }
__device__ __forceinline__ float wave_sum(float v) {
#pragma unroll
    for (int o = 1; o < 64; o <<= 1) v += __shfl_xor(v, o);
    return v;
}

__device__ __forceinline__ int opaque_tid() { int t = threadIdx.x; asm volatile("" : "+v"(t)); return t; }
__device__ __forceinline__ int opaque_bid() { int b = blockIdx.x; asm volatile("" : "+s"(b)); return b; }
struct Unit { int pm, pn; };
struct Gemm { const bf16_t* A; const bf16_t* Bt; int lda, ldb, K, nM, nN, bk; };

__device__ __forceinline__ bool next_unit(const Gemm& g, int bid, int i, Unit& u) {
    const int nwg = g.nM * g.nN;
    const long L = (long)i * gridDim.x + bid; if (L >= nwg) return false;
    int wgid = (int)L; { const int q = nwg / NXCD, r = nwg % NXCD, xcd = wgid % NXCD, off = wgid / NXCD; wgid = (xcd < r ? xcd * (q + 1) : r * (q + 1) + (xcd - r) * q) + off; }
    const int nig = WGM * g.nN, gid = wgid / nig, fm = gid * WGM, gsz = (g.nM - fm) < WGM ? (g.nM - fm) : WGM;
    u.pm = fm + ((wgid % nig) % gsz); u.pn = (wgid % nig) / gsz; return true;
}

struct EpiEven {
    static constexpr bool PERM = true, AFTER_DRAIN = false, PERMA = true;
    bf16_t* P; bf16_t* Y; float* halo; const float* cw;
    __device__ __forceinline__ void operator()(const f32x4 (&acc)[2][2][4][2], const Unit& u, int wr, int wc, int fr, int fq) const {
        const int tok0 = u.pm * BM + 8 * (wr * 16 + fr), T = u.pn;
        if (T < 16) {
            const int ch = T * 64 + 16 * wc + 4 * fq;
            const f32x4 w0 = *(const f32x4*)(cw + ch), w1 = *(const f32x4*)(cw + 1024 + ch), w2 = *(const f32x4*)(cw + 2048 + ch);
            f32x4 c[8], pm1, pm2;
#pragma unroll
            for (int i = 0; i < 8; ++i) c[i] = acc[i >> 2][0][i & 3][0] * acc[i >> 2][0][i & 3][1];
#pragma unroll
            for (int j = 0; j < 4; ++j) {
                pm1[j] = __int_as_float(__builtin_amdgcn_update_dpp(0, __float_as_int(c[7][j]), 0x111, 0xf, 0xf, true));
                pm2[j] = __int_as_float(__builtin_amdgcn_update_dpp(0, __float_as_int(c[6][j]), 0x111, 0xf, 0xf, true));
            }
            float* hb = halo + (size_t)(u.pm * 2 + wr) * 6 * 1024 + ch;
            if (fr == 15) { *(f32x4*)(hb) = c[6]; *(f32x4*)(hb + 1024) = c[7]; }
            bf16_t* yp = Y + (size_t)tok0 * 2048 + ch;
#pragma unroll
            for (int i = 0; i < 8; ++i) {
                f32x4 bz = acc[i >> 2][1][i & 3][0]; const f32x4 z = acc[i >> 2][1][i & 3][1];
#pragma unroll
                for (int j = 0; j < 4; ++j) bz[j] *= silu_f(z[j]);
                const f32x4 cm1 = (i >= 1) ? c[i >= 1 ? i - 1 : 0] : pm1, cm2 = (i >= 2) ? c[i >= 2 ? i - 2 : 0] : (i == 1 ? pm1 : pm2);
                const f32x4 y = bz * (w0 * ((i == 1) ? pm1 : cm2) + w1 * cm1 + w2 * c[i]);
                if (i < 2 && fr == 0) { *(f32x4*)(hb + (2 + i) * 1024) = c[i]; *(f32x4*)(hb + (4 + i) * 1024) = bz; }
                else { u32x2 w; w.x = cvt_pk_bf16(y[0], y[1]); w.y = cvt_pk_bf16(y[2], y[3]); *(u32x2*)(yp + (size_t)i * 2048) = w; }
            }
        } else if (T < 24) {
            bf16_t* base = P + (size_t)2 * MTOK * 1024 + (size_t)tok0 * 1024 + (T - 16) * 128 + wc * 32 + 8 * fq;
#pragma unroll
            for (int i = 0; i < 8; ++i) {
                f32x4 x0 = acc[i >> 2][0][i & 3][0], x1 = acc[i >> 2][0][i & 3][1]; const f32x4 y0 = acc[i >> 2][1][i & 3][0], y1 = acc[i >> 2][1][i & 3][1];
#pragma unroll
                for (int j = 0; j < 4; ++j) { x0[j] *= silu_f(y0[j]); x1[j] *= silu_f(y1[j]); }
                u32x4 w; w.x = cvt_pk_bf16(x0[0], x0[1]); w.y = cvt_pk_bf16(x0[2], x0[3]); w.z = cvt_pk_bf16(x1[0], x1[1]); w.w = cvt_pk_bf16(x1[2], x1[3]);
                *(u32x4*)(base + (size_t)i * 1024) = w;
            }
        } else {
            bf16_t* base = P + (size_t)3 * MTOK * 1024 + (size_t)tok0 * 1024 + (T - 24) * 256 + wc * 32 + 8 * fq;
#pragma unroll
            for (int i = 0; i < 8; ++i)
#pragma unroll
                for (int bj = 0; bj < 2; ++bj) {
                    const f32x4 v0 = acc[i >> 2][bj][i & 3][0], v1 = acc[i >> 2][bj][i & 3][1];
                    u32x4 w; w.x = cvt_pk_bf16(v0[0], v0[1]); w.y = cvt_pk_bf16(v0[2], v0[3]); w.z = cvt_pk_bf16(v1[0], v1[1]); w.w = cvt_pk_bf16(v1[2], v1[3]);
                    *(u32x4*)(base + (size_t)i * 1024 + bj * HALF) = w;
                }
        }
    }
};
struct EpiOdd {
    static constexpr bool PERM = true, AFTER_DRAIN = false, PERMA = false;
    bf16_t* P; const float* pscale;
    __device__ __forceinline__ void operator()(const f32x4 (&acc)[2][2][4][2], const Unit& u, int wr, int wc, int fr, int fq) const {
        const int row0 = u.pm * BM + wr * 64 + fr, T = u.pn;
        const bool isz = T >= 8; const int Tl = T & 7, col0 = Tl * 256 + wc * 32 + 8 * fq;
        bf16_t* base = P + (isz ? (size_t)MTOK * 2048 : (size_t)0) + col0;
        f32x4 sc[2][2];
#pragma unroll
        for (int bj = 0; bj < 2; ++bj)
#pragma unroll
            for (int n = 0; n < 2; ++n) sc[bj][n] = isz ? *(const f32x4*)(pscale + col0 + bj * HALF + 4 * n) : (f32x4){1.f, 1.f, 1.f, 1.f};
#pragma unroll
        for (int ai = 0; ai < 2; ++ai)
#pragma unroll
            for (int m = 0; m < 4; ++m) {
                bf16_t* rowp = base + (size_t)(row0 + ai * HALF + m * 16) * 2048;
#pragma unroll
                for (int bj = 0; bj < 2; ++bj) {
                    f32x4 v0 = acc[ai][bj][m][0], v1 = acc[ai][bj][m][1];
                    if (isz) {
#pragma unroll
                        for (int j = 0; j < 4; ++j) { v0[j] = silu_f(v0[j]); v1[j] = silu_f(v1[j]); }
                        v0 = v0 * sc[bj][0]; v1 = v1 * sc[bj][1];
                    }
                    u32x4 w; w.x = cvt_pk_bf16(v0[0], v0[1]); w.y = cvt_pk_bf16(v0[2], v0[3]); w.z = cvt_pk_bf16(v1[0], v1[1]); w.w = cvt_pk_bf16(v1[2], v1[3]);
                    *(u32x4*)(rowp + bj * HALF) = w;
                }
            }
    }
};
struct EpiBf {
    static constexpr bool PERM = true, AFTER_DRAIN = false, PERMA = false;
    bf16_t* O; int ld;
    __device__ __forceinline__ void operator()(const f32x4 (&acc)[2][2][4][2], const Unit& u, int wr, int wc, int fr, int fq) const {
        const int row0 = u.pm * BM + wr * 64 + fr, col0 = u.pn * BM + wc * 32 + 8 * fq;
#pragma unroll
        for (int ai = 0; ai < 2; ++ai)
#pragma unroll
            for (int m = 0; m < 4; ++m) {
                bf16_t* rowp = O + (size_t)(row0 + ai * HALF + m * 16) * ld + col0;
#pragma unroll
                for (int bj = 0; bj < 2; ++bj) {
                    const f32x4 v0 = acc[ai][bj][m][0], v1 = acc[ai][bj][m][1];
                    u32x4 w; w.x = cvt_pk_bf16(v0[0], v0[1]); w.y = cvt_pk_bf16(v0[2], v0[3]); w.z = cvt_pk_bf16(v1[0], v1[1]); w.w = cvt_pk_bf16(v1[2], v1[3]);
                    *(u32x4*)(rowp + bj * HALF) = w;
                }
            }
    }
};
struct EpiRes {
    static constexpr bool PERM = false, AFTER_DRAIN = false, PERMA = false;
    const float* xin; float* xout; const float* gate;
    __device__ __forceinline__ void operator()(const f32x4 (&acc)[2][2][4][2], const Unit& u, int wr, int wc, int fr, int fq) const {
        const int row0 = u.pm * BM + wr * 64 + fr, col0 = u.pn * BM + wc * 32 + 4 * fq;
        const float* gp = gate + (size_t)(u.pm >> 3) * 3072 + col0;
        f32x4 gv[2][2];
#pragma unroll
        for (int bj = 0; bj < 2; ++bj)
#pragma unroll
            for (int n = 0; n < 2; ++n) gv[bj][n] = *(const f32x4*)(gp + bj * HALF + n * 16);
#pragma unroll
        for (int ai = 0; ai < 2; ++ai)
#pragma unroll
            for (int m = 0; m < 4; ++m) {
                const size_t ro = (size_t)(row0 + ai * HALF + m * 16) * DM + col0;
#pragma unroll
                for (int bj = 0; bj < 2; ++bj)
#pragma unroll
                    for (int n = 0; n < 2; ++n) {
                        const f32x4 xv = *(const f32x4*)(xin + ro + bj * HALF + n * 16);
                        *(f32x4*)(xout + ro + bj * HALF + n * 16) = xv + gv[bj][n] * acc[ai][bj][m][n];
                    }
            }
    }
};

struct EpiResNorm {
    static constexpr bool PERM = true, AFTER_DRAIN = true, PERMA = false;
    const float* xin32; const bf16_t* xin16; bf16_t* xout16; float* out32; const float* gate; bf16_t* H; const float* ng; const float* modn; float* part; unsigned* cnt; int last;
    __device__ __forceinline__ void fused(f32x4 (&acc)[2][2][4][2], const Unit& u, int wr, int wc, int fr, int fq, LAS unsigned char* lds, int tid) const {
        const int row0 = u.pm * BM + wr * 64 + fr, col0 = u.pn * BM + wc * 32 + 8 * fq, b = u.pm >> 3;
        LAS float* lss = (LAS float*)lds;
        LAS float* lrs = (LAS float*)(lds + 4096);
        {
            const float* gp = gate + (size_t)b * 3072 + col0;
            f32x4 gv[2][2];
#pragma unroll
            for (int bj = 0; bj < 2; ++bj)
#pragma unroll
                for (int n = 0; n < 2; ++n) gv[bj][n] = *(const f32x4*)(gp + bj * HALF + 4 * n);
#pragma unroll
            for (int ai = 0; ai < 2; ++ai)
#pragma unroll
                for (int m = 0; m < 4; ++m) {
                    const size_t ro = (size_t)(row0 + ai * HALF + m * 16) * DM + col0;
                    float ss = 0.f;
#pragma unroll
                    for (int bj = 0; bj < 2; ++bj) {
                        f32x4 x0, x1;
                        if (xin32) { x0 = *(const f32x4*)(xin32 + ro + bj * HALF); x1 = *(const f32x4*)(xin32 + ro + bj * HALF + 4); }
                        else { const u32x4 w = *(const u32x4*)(xin16 + ro + bj * HALF); x0 = (f32x4){bf_lo(w.x), bf_hi(w.x), bf_lo(w.y), bf_hi(w.y)}; x1 = (f32x4){bf_lo(w.z), bf_hi(w.z), bf_lo(w.w), bf_hi(w.w)}; }
                        const f32x4 v0 = x0 + gv[bj][0] * acc[ai][bj][m][0], v1 = x1 + gv[bj][1] * acc[ai][bj][m][1];
                        acc[ai][bj][m][0] = v0; acc[ai][bj][m][1] = v1;
                        ss += ((v0[0] * v0[0] + v0[1] * v0[1]) + (v0[2] * v0[2] + v0[3] * v0[3])) + ((v1[0] * v1[0] + v1[1] * v1[1]) + (v1[2] * v1[2] + v1[3] * v1[3]));
                        if (!last) { u32x4 w; w.x = cvt_pk_bf16(v0[0], v0[1]); w.y = cvt_pk_bf16(v0[2], v0[3]); w.z = cvt_pk_bf16(v1[0], v1[1]); w.w = cvt_pk_bf16(v1[2], v1[3]); *(u32x4*)(xout16 + ro + bj * HALF) = w; }
                    }
                    ss += __shfl_xor(ss, 16); ss += __shfl_xor(ss, 32);
                    if (fq == 0) lss[(ai * HALF + wr * 64 + m * 16 + fr) * 4 + wc] = ss;
                }
        }
        __syncthreads();
        if (tid < 256) {
            const float t = (lss[tid * 4] + lss[tid * 4 + 1]) + (lss[tid * 4 + 2] + lss[tid * 4 + 3]);
            __hip_atomic_store(part + (size_t)u.pn * MTOK + u.pm * BM + tid, t, __ATOMIC_RELAXED, __HIP_MEMORY_SCOPE_AGENT);
        }
        asm volatile("s_waitcnt vmcnt(0)" ::: "memory");
        __syncthreads();
        if (tid == 0) {
            unsigned* c = cnt + u.pm;
            __hip_atomic_fetch_add(c, 1u, __ATOMIC_RELAXED, __HIP_MEMORY_SCOPE_AGENT);
            unsigned spins = 0;
            while (__hip_atomic_load(c, __ATOMIC_RELAXED, __HIP_MEMORY_SCOPE_AGENT) < 4u && ++spins < (1u << 22)) __builtin_amdgcn_s_sleep(1);
            __builtin_amdgcn_fence(__ATOMIC_ACQUIRE, "agent");
            asm volatile("s_waitcnt vmcnt(0)" ::: "memory");
        }
        __syncthreads();
        if (tid < 256) {
            float t = 0.f;
#pragma unroll
            for (int q = 0; q < 4; ++q) t += __hip_atomic_load(part + (size_t)q * MTOK + u.pm * BM + tid, __ATOMIC_RELAXED, __HIP_MEMORY_SCOPE_AGENT);
            lrs[tid] = rsqrtf(t * (1.f / DM) + EPS);
        }
        __syncthreads();
        const float* mb = modn + (size_t)b * 3072;
#pragma unroll
        for (int bj = 0; bj < 2; ++bj) {
            const int c = col0 + bj * HALF;
            const f32x4 g0 = *(const f32x4*)(ng + c), g1 = *(const f32x4*)(ng + c + 4);
            f32x4 sh0 = {0.f, 0.f, 0.f, 0.f}, sh1 = sh0, sc0 = sh0, sc1 = sh0;
            if (!last) { sh0 = *(const f32x4*)(mb + c); sh1 = *(const f32x4*)(mb + c + 4); sc0 = *(const f32x4*)(mb + 1024 + c); sc1 = *(const f32x4*)(mb + 1024 + c + 4); }
            const f32x4 a0 = g0 * (sc0 + 1.f), a1 = g1 * (sc1 + 1.f);
#pragma unroll
            for (int ai = 0; ai < 2; ++ai)
#pragma unroll
                for (int m = 0; m < 4; ++m) {
                    const int rl = ai * HALF + wr * 64 + m * 16 + fr;
                    const float rstd = lrs[rl];
                    const size_t ro = (size_t)(u.pm * BM + rl) * DM + c;
                    const f32x4 h0 = (acc[ai][bj][m][0] * rstd) * a0 + sh0, h1 = (acc[ai][bj][m][1] * rstd) * a1 + sh1;
                    if (last) { *(f32x4*)(out32 + ro) = h0; *(f32x4*)(out32 + ro + 4) = h1; }
                    else { u32x4 w; w.x = cvt_pk_bf16(h0[0], h0[1]); w.y = cvt_pk_bf16(h0[2], h0[3]); w.z = cvt_pk_bf16(h1[0], h1[1]); w.w = cvt_pk_bf16(h1[2], h1[3]); *(u32x4*)(H + ro) = w; }
                }
        }
    }
};

template <class Epi>
__device__ __forceinline__ void gemm_phase(LAS unsigned char* lds, const Gemm g, const Epi& E) {
    const int tid = opaque_tid(), wid = __builtin_amdgcn_readfirstlane(tid >> 6), lane = tid & 63, wr = wid >> 2, wc = wid & 3, fr = lane & 15, fq = lane >> 4;
    const int nt = g.K / BK;
    unsigned voffA[2], voffB[2];
#pragma unroll
    for (int i = 0; i < 2; ++i) { int R, C; stage_rc(tid * 16 + i * 8192, R, C); const int Rb = Epi::PERM ? ((R & ~31) + perm32(R & 31)) : R;
        const int Ra = Epi::PERMA ? (8 * ((R >> 6) * 16 + (R & 15)) + ((R >> 4) & 3)) : R;
        voffA[i] = (unsigned)(Ra * g.lda + C) * 2u; voffB[i] = (unsigned)(Rb * g.ldb + C) * 2u; }
    const size_t kstep = (size_t)(BK * 2);
    const size_t hstepA = (size_t)(Epi::PERMA ? 4 : HALF) * g.lda * 2, hstepB = (size_t)HALF * g.ldb * 2, tstepA = (size_t)BM * g.lda * 2;
    const unsigned ldsw = (unsigned)wid * 1024u;
    const int aoff = lds_byte(wr * 64 + fr, fq * 8), boff = lds_byte(wc * 32 + fr, fq * 8);
#define PG8_SA(b, h) (((b) * 2 + (h)) * HTB)
#define PG8_SB(b, h) ((4 + (b) * 2 + (h)) * HTB)
#define PG8_STAGE(bufoff, gbase, voff) do { _Pragma("unroll") for (int _i = 0; _i < 2; ++_i) \
        __builtin_amdgcn_global_load_lds((const unsigned*)((const char*)(gbase) + (voff)[_i]), (LAS unsigned*)(lds + (bufoff) + ldsw + _i * 8192), 16, 0, 0); } while (0)
#define PG8_LDA(dst, b, h) do { _Pragma("unroll") for (int m = 0; m < 4; ++m) _Pragma("unroll") for (int k = 0; k < 2; ++k) dst[m][k] = *(const LAS bf16x8*)(lds + PG8_SA(b, h) + aoff + m * 2048 + k * 1024); } while (0)
#define PG8_LDB(dst, b, h) do { _Pragma("unroll") for (int n = 0; n < 2; ++n) _Pragma("unroll") for (int k = 0; k < 2; ++k) dst[n][k] = *(const LAS bf16x8*)(lds + PG8_SB(b, h) + boff + n * 2048 + k * 1024); } while (0)
#define PG8_MMA(ai, bj, At, Bt) do { __builtin_amdgcn_s_setprio(1); _Pragma("unroll") for (int m = 0; m < 4; ++m) _Pragma("unroll") for (int n = 0; n < 2; ++n) _Pragma("unroll") for (int k = 0; k < 2; ++k) \
        acc[ai][bj][m][n] = __builtin_amdgcn_mfma_f32_16x16x32_bf16(Bt[n][k], At[m][k], acc[ai][bj][m][n], 0, 0, 0); __builtin_amdgcn_s_setprio(0); } while (0)
#define PG8_WAIT_V(n) asm volatile("s_waitcnt vmcnt(" #n ")" ::: "memory")
#define PG8_WAIT_L(n) asm volatile("s_waitcnt lgkmcnt(" #n ")" ::: "memory")
#define PG8_BAR __builtin_amdgcn_s_barrier()
#define PG8_SCHED __builtin_amdgcn_sched_barrier(0)
    Unit cur, nxt; int ui = 0;
    const int bid = opaque_bid();
    if (!next_unit(g, bid, 0, cur)) return;
    f32x4 acc[2][2][4][2];
#pragma unroll
    for (int a = 0; a < 2; ++a)
#pragma unroll
        for (int b = 0; b < 2; ++b)
#pragma unroll
            for (int m = 0; m < 4; ++m)
#pragma unroll
                for (int n = 0; n < 2; ++n) acc[a][b][m][n] = (f32x4){0.f, 0.f, 0.f, 0.f};
    bf16x8 At[4][2], B0[2][2], B1[2][2];
    const char* cA = (const char*)g.A + (size_t)cur.pm * tstepA; const char* cB = (const char*)g.Bt + (size_t)cur.pn * 2 * hstepB + (size_t)(cur.pm >> 1) * g.bk * 2;
    PG8_STAGE(PG8_SB(0, 0), cB, voffB); PG8_STAGE(PG8_SA(0, 0), cA, voffA); PG8_STAGE(PG8_SB(0, 1), cB + hstepB, voffB); PG8_STAGE(PG8_SA(0, 1), cA + hstepA, voffA);
    if (wr == 1) PG8_BAR;
    PG8_WAIT_V(4); PG8_BAR;
    PG8_STAGE(PG8_SB(1, 0), cB + kstep, voffB); PG8_STAGE(PG8_SA(1, 0), cA + kstep, voffA); PG8_STAGE(PG8_SB(1, 1), cB + hstepB + kstep, voffB);
    PG8_WAIT_V(6); PG8_BAR;
    for (;;) {
        const bool has_next = next_unit(g, bid, ui + 1, nxt);
        const char* nA = has_next ? (const char*)g.A + (size_t)nxt.pm * tstepA : cA;
        const char* nB = has_next ? (const char*)g.Bt + (size_t)nxt.pn * 2 * hstepB + (size_t)(nxt.pm >> 1) * g.bk * 2 : cB;
        for (int t = 0; t < nt; t += 2) {
            const bool last = (t == nt - 2);
            const char* a1 = cA + (size_t)(t + 1) * kstep;
            const char* a2 = last ? nA : cA + (size_t)(t + 2) * kstep; const char* b2 = last ? nB : cB + (size_t)(t + 2) * kstep;
            const char* a3 = a2 + kstep; const char* b3 = b2 + kstep;
            PG8_LDB(B0, 0, 0); PG8_SCHED; PG8_LDA(At, 0, 0); PG8_STAGE(PG8_SA(1, 1), a1 + hstepA, voffA);
            PG8_WAIT_L(8); PG8_BAR; PG8_WAIT_L(0); PG8_MMA(0, 0, At, B0); PG8_BAR; PG8_SCHED;
            PG8_LDB(B1, 0, 1); PG8_STAGE(PG8_SB(0, 0), b2, voffB);
            PG8_BAR; PG8_WAIT_L(0); PG8_MMA(0, 1, At, B1); PG8_BAR;
            PG8_LDA(At, 0, 1); PG8_STAGE(PG8_SA(0, 0), a2, voffA);
            PG8_BAR; PG8_WAIT_L(0); PG8_MMA(1, 0, At, B0); PG8_BAR; PG8_SCHED;
            PG8_STAGE(PG8_SB(0, 1), b2 + hstepB, voffB);
            PG8_WAIT_V(6); PG8_BAR; PG8_MMA(1, 1, At, B1); PG8_BAR;
            PG8_LDB(B0, 1, 0); PG8_SCHED; PG8_LDA(At, 1, 0); PG8_STAGE(PG8_SA(0, 1), a2 + hstepA, voffA);
            PG8_WAIT_L(8); PG8_BAR; PG8_WAIT_L(0); PG8_MMA(0, 0, At, B0); PG8_BAR; PG8_SCHED;
            PG8_LDB(B1, 1, 1); PG8_STAGE(PG8_SB(1, 0), b3, voffB);
            PG8_BAR; PG8_WAIT_L(0); PG8_MMA(0, 1, At, B1); PG8_BAR;
            PG8_LDA(At, 1, 1); PG8_STAGE(PG8_SA(1, 0), a3, voffA);
            PG8_BAR; PG8_WAIT_L(0); PG8_MMA(1, 0, At, B0); PG8_BAR; PG8_SCHED;
            PG8_STAGE(PG8_SB(1, 1), b3 + hstepB, voffB);
            PG8_WAIT_V(6); PG8_BAR; PG8_MMA(1, 1, At, B1); PG8_BAR;
        }
        if constexpr (!Epi::AFTER_DRAIN) E(acc, cur, wr, wc, fr, fq);
        if (!has_next) break;
#pragma unroll
        for (int a = 0; a < 2; ++a)
#pragma unroll
            for (int b = 0; b < 2; ++b)
#pragma unroll
                for (int m = 0; m < 4; ++m)
#pragma unroll
                    for (int n = 0; n < 2; ++n) acc[a][b][m][n] = (f32x4){0.f, 0.f, 0.f, 0.f};
        cur = nxt; cA = nA; cB = nB; ++ui;
    }
    PG8_WAIT_V(0);
    if (wr == 0) PG8_BAR;
    PG8_BAR;
    if constexpr (Epi::AFTER_DRAIN) E.fused(acc, cur, wr, wc, fr, fq, lds, tid);
#undef PG8_SA
#undef PG8_SB
#undef PG8_STAGE
#undef PG8_LDA
#undef PG8_LDB
#undef PG8_MMA
#undef PG8_WAIT_V
#undef PG8_WAIT_L
#undef PG8_BAR
#undef PG8_SCHED
}

__device__ __forceinline__ void phase_mod(const Params& p, LAS unsigned char* lds) {
    const int tid = opaque_tid(), wid = tid >> 6, lane = tid & 63;
    LAS float* sc = (LAS float*)lds;
    LAS float* red = (LAS float*)(lds + 32768);
    float* mod = (float*)(p.ws + WS_MOD);
    for (int t = tid; t < NB * DM; t += 512) sc[t] = silu_f(p.c[t]);
    __syncthreads();
    for (int it = opaque_bid(); it < 192; it += gridDim.x) {
        const int col = it * 64 + lane, i = col / 3072, j = col - i * 3072;
        const float* w = p.ada_w + ((size_t)i * DM + wid * 128) * 3072 + j;
        float a[8];
#pragma unroll
        for (int b = 0; b < 8; ++b) a[b] = 0.f;
#pragma unroll 16
        for (int k = 0; k < 128; ++k) {
            const float wv = w[(size_t)k * 3072];
#pragma unroll
            for (int b = 0; b < 8; ++b) a[b] += sc[b * DM + wid * 128 + k] * wv;
        }
#pragma unroll
        for (int b = 0; b < 8; ++b) red[(wid * 8 + b) * 64 + lane] = a[b];
        __syncthreads();
        {
            const int b = tid >> 6; float s = 0.f;
#pragma unroll
            for (int w8 = 0; w8 < 8; ++w8) s += red[(w8 * 8 + b) * 64 + lane];
            mod[((size_t)i * NB + b) * 3072 + j] = s + p.ada_b[i * 3072 + j];
        }
        __syncthreads();
    }
}

__device__ __forceinline__ void conv_tile(const float* __restrict__ src, int srcN, int c0, bf16_t* __restrict__ dstrow, int K, int k0, LAS float* T, int csrc = -1) {
    const int tid = opaque_tid();
    const int cs = csrc >= 0 ? csrc : c0 + (tid & 15) * 4;
    f32x4 v[8];
#pragma unroll
    for (int ps = 0; ps < 8; ++ps) v[ps] = *(const f32x4*)(src + (size_t)(k0 + ps * 32 + (tid >> 4)) * srcN + cs);
#pragma unroll
    for (int ps = 0; ps < 8; ++ps) { LAS float* t = T + (ps * 32 + (tid >> 4)) * 65 + (tid & 15) * 4; t[0] = v[ps][0]; t[1] = v[ps][1]; t[2] = v[ps][2]; t[3] = v[ps][3]; }
    __syncthreads();
#pragma unroll
    for (int q = 0; q < 4; ++q) {
        const int item = tid + 512 * q, n = item >> 5, kg = item & 31; const LAS float* s = T + (kg * 8) * 65 + n;
        u32x4 o; o.x = cvt_pk_bf16(s[0], s[65]); o.y = cvt_pk_bf16(s[130], s[195]); o.z = cvt_pk_bf16(s[260], s[325]); o.w = cvt_pk_bf16(s[390], s[455]);
        *(u32x4*)(dstrow + (size_t)n * K + k0 + kg * 8) = o;
    }
    __syncthreads();
}

__device__ __forceinline__ void norm_rows(const Params& p, int layer, const float* xin, int item) {
    const int tid = opaque_tid(), wid = tid >> 6, lane = tid & 63;
    bf16_t* H = (bf16_t*)g_h;
    const float* mod = (const float*)(p.ws + WS_MOD) + (size_t)layer * NB * 3072;
    const float* gp = p.norm_g + (size_t)layer * DM;
#pragma unroll
    for (int h2 = 0; h2 < 2; ++h2) {
        const int row = item * 16 + h2 * 8 + wid, b = row >> 11;
        const f32x4* xr = (const f32x4*)(xin + (size_t)row * DM) + lane;
        f32x4 v[4]; float ss = 0.f;
#pragma unroll
        for (int q = 0; q < 4; ++q) { v[q] = xr[64 * q]; ss += (v[q][0] * v[q][0] + v[q][1] * v[q][1]) + (v[q][2] * v[q][2] + v[q][3] * v[q][3]); }
        const float rstd = rsqrtf(wave_sum(ss) * (1.f / DM) + EPS);
        const float* mb = mod + (size_t)b * 3072;
        u32x2* o8 = (u32x2*)(H + (size_t)row * DM) + lane;
#pragma unroll
        for (int q = 0; q < 4; ++q) {
            const int k = (lane + 64 * q) * 4;
            const f32x4 gv = *(const f32x4*)(gp + k), sh = *(const f32x4*)(mb + k), scl = *(const f32x4*)(mb + 1024 + k);
            const f32x4 hv = (v[q] * rstd * gv) * (scl + 1.f) + sh;
            u32x2 w; w.x = cvt_pk_bf16(hv[0], hv[1]); w.y = cvt_pk_bf16(hv[2], hv[3]);
            o8[64 * q] = w;
        }
    }
}
__device__ __forceinline__ void phase_norm_even(const Params& p, int j, const float* xin, LAS unsigned char* lds) {
    const int tid = opaque_tid();
    bf16_t* WIN_E = (bf16_t*)(p.ws + WS_WIN_E); bf16_t* WIN_O = (bf16_t*)(p.ws + WS_WIN_O); bf16_t* WOUT_E = (bf16_t*)(p.ws + WS_WOUT_E); bf16_t* WOUT_O = (bf16_t*)(p.ws + WS_WOUT_O);
    bf16_t* SGU = (bf16_t*)(p.ws + WS_SGU); bf16_t* POOLT = (bf16_t*)(p.ws + WS_POOLT); bf16_t* WINP = (bf16_t*)(p.ws + WS_WINP);
    constexpr int N0 = 448, N1 = N0 + 128, N2 = N1 + 128, N3 = N2 + 128, N4 = N3 + 64, N5 = N4 + 32, N6 = N5 + 512;
    const int TOTAL = N6 + (j == 0 ? MTOK / 16 : 0);
    for (int it = opaque_bid(); it < TOTAL; it += gridDim.x) {
        if (it < N0) {
            const int rt = it >> 2, kt = it & 3, r0 = rt * 64, T = r0 >> 8, q = r0 & 255; int c0 = 0, csrc = -1;
            if (T < 16) {
                const int cg = tid & 15, bj = q >> 7, wcc = ((q >> 6) & 1) * 2 + (cg >> 3), fq4 = (cg >> 1) & 3, n = cg & 1;
                const int tbase = bj == 0 ? (n == 0 ? 2048 : 0) : (n == 0 ? 1024 : 3072);
                csrc = tbase + 64 * T + 16 * wcc + 4 * fq4;
            }
            else if (T < 24) c0 = (q < 128) ? (4096 + 128 * (T - 16) + q) : (6144 + 128 * (T - 16) + q - 128);
            else c0 = 5120 + 256 * (T - 24) + q;
            conv_tile(p.ab_w_in + (size_t)j * DM * 7168, 7168, c0, WIN_E + (size_t)r0 * DM, DM, kt * 256, (LAS float*)lds, csrc);
        } else if (it < N1) {
            const int i2 = it - N0, rt = i2 >> 3, kt = i2 & 7, r0 = rt * 64;
            conv_tile(p.ab_w_out + (size_t)j * 2048 * DM, DM, r0, WOUT_E + (size_t)r0 * 2048, 2048, kt * 256, (LAS float*)lds);
        } else if (it < N2) {
            const int i2 = it - N1, rt = i2 >> 2, kt = i2 & 3, r0 = rt * 64;
            conv_tile(p.c_w_in + (size_t)j * DM * 4096, 4096, 2048 + r0, WIN_O + (size_t)(2048 + r0) * DM, DM, kt * 256, (LAS float*)lds);
        } else if (it < N3) {
            const int i2 = it - N2, rt = i2 >> 3, kt = i2 & 7, r0 = rt * 64;
            conv_tile(p.c_w_out + (size_t)j * 2048 * DM, DM, r0, WOUT_O + (size_t)r0 * 2048, 2048, kt * 256, (LAS float*)lds);
        } else if (it < N4) {
            const int i3 = it - N3, g = i3 >> 4, r = i3 & 15, rt = r >> 1, kt = r & 1, r0 = rt * 64;
            conv_tile(p.c_pool_w + ((size_t)j * 4 + g) * 512 * 512, 512, r0, POOLT + (size_t)g * 512 * 512 + (size_t)r0 * 512, 512, kt * 256, (LAS float*)lds);
        } else if (it < N5) {
            const int e0 = (it - N4) * 4096 + tid * 8, t = (e0 >> 7) & 127, s0 = e0 & 127;
            const float* src = p.ab_sgu_w + (size_t)j * 8 * 128 * 128 + e0;
            const f32x4 a = *(const f32x4*)src, b = *(const f32x4*)(src + 4);
            float v[8] = {a[0], a[1], a[2], a[3], b[0], b[1], b[2], b[3]};
#pragma unroll
            for (int e = 0; e < 8; ++e) v[e] = (s0 + e <= t) ? v[e] : 0.f;
            u32x4 o; o.x = cvt_pk_bf16(v[0], v[1]); o.y = cvt_pk_bf16(v[2], v[3]); o.z = cvt_pk_bf16(v[4], v[5]); o.w = cvt_pk_bf16(v[6], v[7]);
            *(u32x4*)(SGU + e0) = o;
        } else if (it < N6) {
            const int e0 = (it - N5) * 4096 + tid * 8, k = e0 >> 11, c = e0 & 2047;
            const float* src = p.c_w_in + ((size_t)j * DM + k) * 4096 + c;
            const f32x4 a = *(const f32x4*)src, b = *(const f32x4*)(src + 4);
            u32x4 o; o.x = cvt_pk_bf16(a[0], a[1]); o.y = cvt_pk_bf16(a[2], a[3]); o.z = cvt_pk_bf16(b[0], b[1]); o.w = cvt_pk_bf16(b[2], b[3]);
            *(u32x4*)(WINP + e0) = o;
        } else norm_rows(p, 2 * j, xin, it - N6);
    }
}
__device__ __forceinline__ void phase_final(const Params& p) {
    const int tid = opaque_tid(), wid = tid >> 6, lane = tid & 63;
    for (int it = opaque_bid(); it < MTOK / 8; it += gridDim.x) {
        const int row = it * 8 + wid;
        f32x4* xr = (f32x4*)(p.out + (size_t)row * DM) + lane;
        f32x4 v[4]; float ss = 0.f;
#pragma unroll
        for (int q = 0; q < 4; ++q) { v[q] = xr[64 * q]; ss += (v[q][0] * v[q][0] + v[q][1] * v[q][1]) + (v[q][2] * v[q][2] + v[q][3] * v[q][3]); }
        const float rstd = rsqrtf(wave_sum(ss) * (1.f / DM) + EPS);
#pragma unroll
        for (int q = 0; q < 4; ++q) { const f32x4 gv = *(const f32x4*)(p.final_g + (lane + 64 * q) * 4); xr[64 * q] = v[q] * rstd * gv; }
    }
}

__device__ __forceinline__ void unpack8(const u32x4 w, float (&f)[8]) {
    f[0] = bf_lo(w.x); f[1] = bf_hi(w.x); f[2] = bf_lo(w.y); f[3] = bf_hi(w.y); f[4] = bf_lo(w.z); f[5] = bf_hi(w.z); f[6] = bf_lo(w.w); f[7] = bf_hi(w.w);
}

__device__ __forceinline__ void phase_mix(const Params& p, int j, LAS unsigned char* lds) {
    const int tid = opaque_tid(), wid = tid >> 6, lane = tid & 63;
    const bf16_t* CH2 = (const bf16_t*)(p.ws + WS_RP); const bf16_t* BZ = CH2 + (size_t)MTOK * 1024; const bf16_t* UZ = BZ + (size_t)MTOK * 1024; const bf16_t* V = UZ + (size_t)MTOK * 1024;
    bf16_t* Y = (bf16_t*)(p.ws + WS_RA);
    if (blockIdx.x < 32) {
        Gemm g{(const bf16_t*)(p.ws + WS_POOLT), (const bf16_t*)(p.ws + WS_WINP), 512, 2048, 512, 8, 4, 512}; EpiBf E{(bf16_t*)(p.ws + WS_WIN_O), DM};
        gemm_phase(lds, g, E);
        __syncthreads();
    }
    {
        const bf16_t* Wm = (const bf16_t*)(p.ws + WS_SGU);
        LAS bf16_t* vnT = (LAS bf16_t*)lds;
        LAS float* red = (LAS float*)(lds + 36864);
        const int fr = lane & 15, fq = lane >> 4;
        const int s = lane + 64 * (wid & 1), q = wid >> 1;
        int it = opaque_bid();
        u32x4 vraw[4];
        if (it < 1024) { const bf16_t* vp = V + (size_t)((it >> 3) * 128 + s) * 1024 + (it & 7) * 128 + 32 * q;
#pragma unroll
            for (int i = 0; i < 4; ++i) vraw[i] = *(const u32x4*)(vp + 8 * i); }
        for (; it < 1024; it += gridDim.x) {
            const int hh = it & 7, cn = it >> 3;
            const int t = 16 * wid + fr; const size_t row = (size_t)cn * 128 + t;
            u32x2 uz[8];
#pragma unroll
            for (int n = 0; n < 8; ++n) uz[n] = *(const u32x2*)(UZ + row * 1024 + hh * 128 + 16 * n + 4 * fq);
            const float bias = p.ab_sgu_b[(size_t)j * 1024 + hh * 128 + t];
            const bf16_t* wrow = Wm + ((size_t)hh * 128 + 16 * wid + fr) * 128 + 8 * fq;
            bf16x8 af[4];
#pragma unroll
            for (int kk = 0; kk < 4; ++kk) af[kk] = *(const bf16x8*)(wrow + 32 * kk);
            float f[32];
#pragma unroll
            for (int i = 0; i < 4; ++i) { float t8[8]; unpack8(vraw[i], t8);
#pragma unroll
                for (int e = 0; e < 8; ++e) f[8 * i + e] = t8[e]; }
            float s1 = 0.f, s2 = 0.f;
#pragma unroll
            for (int i = 0; i < 32; ++i) { s1 += f[i]; s2 += f[i] * f[i]; }
            red[(s * 4 + q) * 2] = s1; red[(s * 4 + q) * 2 + 1] = s2;
            __syncthreads();
            {
                const int itn = it + gridDim.x;
                if (itn < 1024) { const bf16_t* vp = V + (size_t)((itn >> 3) * 128 + s) * 1024 + (itn & 7) * 128 + 32 * q;
#pragma unroll
                    for (int i = 0; i < 4; ++i) vraw[i] = *(const u32x4*)(vp + 8 * i); }
            }
            float S1 = 0.f, S2 = 0.f;
#pragma unroll
            for (int qq = 0; qq < 4; ++qq) { S1 += red[(s * 4 + qq) * 2]; S2 += red[(s * 4 + qq) * 2 + 1]; }
            const float mu = S1 * (1.f / 128.f), var = fmaxf(S2 * (1.f / 128.f) - mu * mu, 0.f), rstd = rsqrtf(var + EPS);
            const float* lg = p.ab_ln_g + (size_t)j * 1024 + hh * 128 + 32 * q; const float* lb = p.ab_ln_b + (size_t)j * 1024 + hh * 128 + 32 * q;
#pragma unroll
            for (int i = 0; i < 32; ++i) {
                const float vn = (f[i] - mu) * rstd * lg[i] + lb[i];
                vnT[(32 * q + i) * 136 + s] = (bf16_t)(cvt_pk_bf16(vn, 0.f) & 0xffffu);
            }
            __syncthreads();
            f32x4 acc[8];
#pragma unroll
            for (int n = 0; n < 8; ++n) acc[n] = (f32x4){0.f, 0.f, 0.f, 0.f};
#pragma unroll
            for (int kk = 0; kk < 4; ++kk) {
                if (32 * kk <= 16 * wid + 15) {
#pragma unroll
                    for (int n = 0; n < 8; ++n) {
                        const bf16x8 bfm = *(const LAS bf16x8*)(vnT + (16 * n + fr) * 136 + 32 * kk + 8 * fq);
                        acc[n] = __builtin_amdgcn_mfma_f32_16x16x32_bf16(bfm, af[kk], acc[n], 0, 0, 0);
                    }
                }
            }
#pragma unroll
            for (int n = 0; n < 8; ++n) {
                const int d = 16 * n + 4 * fq;
                u32x2 w; w.x = cvt_pk_bf16(bf_lo(uz[n].x) * (acc[n][0] + bias), bf_hi(uz[n].x) * (acc[n][1] + bias));
                w.y = cvt_pk_bf16(bf_lo(uz[n].y) * (acc[n][2] + bias), bf_hi(uz[n].y) * (acc[n][3] + bias));
                *(u32x2*)(Y + row * 2048 + 1024 + hh * 128 + d) = w;
            }
        }
    }
    {
        const float* halo = (const float*)(p.ws + WS_HALO); const float* cw = p.ab_conv_w + (size_t)j * 3 * 1024;
        for (int gid = opaque_bid() * 512 + tid; gid < 128 * 1024; gid += gridDim.x * 512) {
            const int B = gid >> 10, c = gid & 1023; const bool hist = ((B * 128) & (SEQ - 1)) != 0;
            const float* hb = halo + (size_t)B * 6 * 1024 + c;
            const float c6 = hist ? hb[-6 * 1024] : 0.f, c7 = hist ? hb[-5 * 1024] : 0.f, c0 = hb[2 * 1024], c1 = hb[3 * 1024], b0 = hb[4 * 1024], b1 = hb[5 * 1024];
            const float w0 = cw[c], w1 = cw[1024 + c], w2 = cw[2048 + c];
            const float y0 = b0 * (w0 * c6 + w1 * c7 + w2 * c0), y1 = b1 * (w0 * c7 + w1 * c0 + w2 * c1);
            Y[(size_t)(B * 128) * 2048 + c] = (bf16_t)(cvt_pk_bf16(y0, 0.f) & 0xffffu);
            Y[(size_t)(B * 128 + 1) * 2048 + c] = (bf16_t)(cvt_pk_bf16(y1, 0.f) & 0xffffu);
        }
    }
}

__device__ __forceinline__ void phase_pool(const Params& p) {
    const int tid = opaque_tid();
    const bf16_t* Q = (const bf16_t*)(p.ws + WS_RP); const bf16_t* SZ = Q + (size_t)MTOK * 2048; bf16_t* Y = (bf16_t*)(p.ws + WS_RA);
    for (int it = opaque_bid(); it < 256; it += gridDim.x) {
        const int rg = it * 2 + (tid >> 8), ct = tid & 255, c0 = ct * 8, win = 2 << (ct >> 6), t0 = rg * 32, tl0 = t0 & (SEQ - 1);
        float S[8];
#pragma unroll
        for (int e = 0; e < 8; ++e) S[e] = 0.f;
        if (tl0 != 0) {
#pragma unroll
            for (int i = 1; i < 16; ++i) {
                if (i < win) { float v[8]; unpack8(*(const u32x4*)(Q + (size_t)(t0 - i) * 2048 + c0), v);
#pragma unroll
                    for (int e = 0; e < 8; ++e) S[e] += v[e]; }
            }
        }
#pragma unroll 8
        for (int r = 0; r < 32; ++r) {
            const int tl = tl0 + r;
            float cur[8], sz[8], o[8];
            unpack8(*(const u32x4*)(Q + (size_t)(t0 + r) * 2048 + c0), cur);
            unpack8(*(const u32x4*)(SZ + (size_t)(t0 + r) * 2048 + c0), sz);
            const float inv = 1.f / (float)min(tl + 1, win);
#pragma unroll
            for (int e = 0; e < 8; ++e) { S[e] += cur[e]; o[e] = (S[e] * inv - cur[e]) * sz[e]; }
            u32x4 w; w.x = cvt_pk_bf16(o[0], o[1]); w.y = cvt_pk_bf16(o[2], o[3]); w.z = cvt_pk_bf16(o[4], o[5]); w.w = cvt_pk_bf16(o[6], o[7]);
            *(u32x4*)(Y + (size_t)(t0 + r) * 2048 + c0) = w;
            if (tl - win + 1 >= 0) { float old[8]; unpack8(*(const u32x4*)(Q + (size_t)(t0 + r - win + 1) * 2048 + c0), old);
#pragma unroll
                for (int e = 0; e < 8; ++e) S[e] -= old[e]; }
        }
    }
}

#define XB_TMO      128
#define XB_XCNT(j)  (256  + 64 * (j))
#define XB_XSUB(j)  (1280 + 64 * (j))
#define XB_XGEN(j)  (2304 + 64 * (j))
#define XB_TOP      3328
#define XB_TOPGEN   3392
#define XCD_BAR_WORDS 3456
#define XB_SPIN_CAP (1u << 18)
__device__ __forceinline__ unsigned xb_ld(unsigned* p)              { return __hip_atomic_load(p, __ATOMIC_RELAXED, __HIP_MEMORY_SCOPE_AGENT); }
__device__ __forceinline__ unsigned xb_add(unsigned* p, unsigned v) { return __hip_atomic_fetch_add(p, v, __ATOMIC_RELAXED, __HIP_MEMORY_SCOPE_AGENT); }
__device__ __forceinline__ unsigned xb_xcc_id() { return (unsigned)__builtin_amdgcn_s_getreg((3 << 11) | 20) & 0xFu; }
#define XB_SPIN(cond, bar) do { unsigned _sp = 0; while (cond) { __builtin_amdgcn_s_sleep(1); \
    if ((++_sp & 255u) == 0u) { if (xb_ld(&(bar)[XB_TMO])) break; if (_sp > XB_SPIN_CAP) { atomicAdd(&(bar)[XB_TMO], 1u); break; } } } } while (0)
struct XcdBarrier { unsigned* bar; unsigned x; volatile LAS unsigned* st; };
__device__ __forceinline__ XcdBarrier xcd_barrier_post(unsigned* bar, volatile LAS unsigned* st) {
    XcdBarrier b; b.bar = bar; b.x = xb_xcc_id(); b.st = st;
    if (threadIdx.x == 0) (void)xb_add(&bar[XB_XCNT(b.x)], 1u);
    return b;
}
__device__ __forceinline__ void xcd_barrier_complete(unsigned* bar, unsigned x, unsigned& nloc, unsigned& nx) {
    const unsigned G = gridDim.x * gridDim.y * gridDim.z;
    unsigned sum, cnt, mine, sp = 0u;
    for (;;) {
        sum = 0u; cnt = 0u; mine = 0u;
#pragma unroll
        for (unsigned j = 0; j < 16; ++j) { const unsigned c = xb_ld(&bar[XB_XCNT(j)]); sum += c; cnt += (c > 0u) ? 1u : 0u; mine = (j == x) ? c : mine; }
        if (sum == G) break;
        __builtin_amdgcn_s_sleep(1);
        if ((++sp & 255u) == 0u) { if (xb_ld(&bar[XB_TMO])) break; if (sp > XB_SPIN_CAP) { atomicAdd(&bar[XB_TMO], 1u); break; } }
    }
    nloc = mine > 0u ? mine : 1u; nx = cnt > 0u ? cnt : 1u;
}
__device__ __forceinline__ void xcd_barrier(const XcdBarrier& b) {
    asm volatile("s_waitcnt vmcnt(0)" ::: "memory");
    __syncthreads();
    if (threadIdx.x == 0) {
        unsigned* bar = b.bar;
        __builtin_amdgcn_s_waitcnt(0);
        unsigned nloc = b.st[0], nx = b.st[1];
        if (nloc == 0u) { xcd_barrier_complete(bar, b.x, nloc, nx); b.st[0] = nloc; b.st[1] = nx; }
        const unsigned old = xb_add(&bar[XB_XSUB(b.x)], 1u);
        const unsigned gen = old / nloc;
        if (old + 1u == (gen + 1u) * nloc) {
            __builtin_amdgcn_fence(__ATOMIC_RELEASE, "agent");
            asm volatile("s_waitcnt vmcnt(0)" ::: "memory");
            const unsigned og = xb_add(&bar[XB_TOP], 1u);
            const unsigned tg = og / nx;
            if (og + 1u == (tg + 1u) * nx) xb_add(&bar[XB_TOPGEN], 1u);
            else XB_SPIN(xb_ld(&bar[XB_TOPGEN]) == tg, bar);
            __builtin_amdgcn_fence(__ATOMIC_ACQUIRE, "agent");
            xb_add(&bar[XB_XGEN(b.x)], 1u);
            asm volatile("s_waitcnt vmcnt(0)" ::: "memory");
        } else {
            XB_SPIN(xb_ld(&bar[XB_XGEN(b.x)]) == gen, bar);
            __builtin_amdgcn_fence(__ATOMIC_ACQUIRE, "agent");
            asm volatile("s_waitcnt vmcnt(0)" ::: "memory");
        }
    }
    __syncthreads();
}

__global__ void __launch_bounds__(512, 2) mega_fwd(Params p, int ph_lo, int ph_hi) {
    extern __shared__ __attribute__((aligned(16))) unsigned char smem[];
    LAS unsigned char* lds = (LAS unsigned char*)smem;
    cg::grid_group grid = cg::this_grid();
    if (ph_hi < 0) grid.sync();
    volatile LAS unsigned* st = (volatile LAS unsigned*)(lds + STAGE_BYTES);
    if (threadIdx.x < 4) st[threadIdx.x] = 0u;
    __syncthreads();
    const XcdBarrier xb = xcd_barrier_post((unsigned*)(p.ws + WS_BAR), st);
    int ph = 0;
#define PHASE(REP, ...) do { if (ph >= ph_lo && ph < ph_hi) { for (int _r = 0; _r < (REP); ++_r) { __VA_ARGS__; if (ph + 1 < ph_hi) xcd_barrier(xb); } } ++ph; } while (0)
    bf16_t* RA = (bf16_t*)(p.ws + WS_RA); bf16_t* RP = (bf16_t*)(p.ws + WS_RP);
    const bf16_t* WIN_E = (const bf16_t*)(p.ws + WS_WIN_E); const bf16_t* WIN_O = (const bf16_t*)(p.ws + WS_WIN_O);
    const bf16_t* WOUT_E = (const bf16_t*)(p.ws + WS_WOUT_E); const bf16_t* WOUT_O = (const bf16_t*)(p.ws + WS_WOUT_O);
    const float* mod = (const float*)(p.ws + WS_MOD);
    float* part = (float*)(p.ws + WS_PART); unsigned* cnt = (unsigned*)(p.ws + WS_BAR) + CNT_WORD0;
    PHASE(REP_THIN, phase_mod(p, lds));
#pragma unroll 1
    for (int lp = 0; lp < 2; ++lp) {
        {
            const int layer = 2 * lp; const float* xin = (lp == 0) ? p.x : p.out;
            PHASE(REP_THIN, phase_norm_even(p, lp, xin, lds));
            PHASE(REP_G1, { Gemm g{(const bf16_t*)g_h, WIN_E, DM, DM, DM, MTOK / BM, 7168 / BM, 0}; EpiEven E{RP, RA, (float*)(p.ws + WS_HALO), p.ab_conv_w + (size_t)lp * 3 * 1024}; gemm_phase(lds, g, E); });
            PHASE(REP_THIN, phase_mix(p, lp, lds));
            PHASE(1, { Gemm g{RA, WOUT_E, 2048, 2048, 2048, MTOK / BM, DM / BM, 0};
                       EpiResNorm E{lp == 0 ? p.x : nullptr, (const bf16_t*)g_x, (bf16_t*)g_x, p.out, mod + (size_t)layer * NB * 3072 + 2048, (bf16_t*)g_h, p.norm_g + (size_t)(layer + 1) * DM, mod + (size_t)(layer + 1) * NB * 3072,
                                    part + (size_t)layer * 4 * MTOK, cnt + layer * 64, 0};
                       gemm_phase(lds, g, E); });
        }
        {
            const int layer = 2 * lp + 1; const int last = (lp == 1) ? 1 : 0;
            PHASE(REP_G1, { Gemm g{(const bf16_t*)g_h, WIN_O, DM, DM, DM, MTOK / BM, 4096 / BM, 0}; EpiOdd E{RP, p.c_pool_scale + (size_t)lp * 2048}; gemm_phase(lds, g, E); });
            PHASE(REP_THIN, phase_pool(p));
            PHASE(1, { Gemm g{RA, WOUT_O, 2048, 2048, 2048, MTOK / BM, DM / BM, 0};
                       EpiResNorm E{nullptr, (const bf16_t*)g_x, (bf16_t*)g_x, p.out, mod + (size_t)layer * NB * 3072 + 2048, (bf16_t*)g_h, last ? p.final_g : p.norm_g + (size_t)(layer + 1) * DM, mod + (size_t)(last ? layer : layer + 1) * NB * 3072,
                                    part + (size_t)layer * 4 * MTOK, cnt + layer * 64, last};
                       gemm_phase(lds, g, E); });
        }
    }
#undef PHASE
}

extern "C" void kernel_launch(void* const* d_in, const int* in_sizes, int n_in, void* d_out, int out_size, void* d_ws, size_t ws_size, hipStream_t stream) {
    static int grid = 0;
    if (grid == 0) {
        if (n_in != 17 || out_size != MTOK * DM || ws_size < WS_END2) { fprintf(stderr, "kernel_launch: unexpected shapes (n_in %d out %d ws %zu need %zu)\n", n_in, out_size, ws_size, (size_t)WS_END2); grid = -1; return; }
        int dev = 0, cus = 0, per_cu = 0;
        hipGetDevice(&dev);
        hipDeviceGetAttribute(&cus, hipDeviceAttributeMultiprocessorCount, dev);
        if (hipFuncSetAttribute((const void*)mega_fwd, hipFuncAttributeMaxDynamicSharedMemorySize, LDS_BYTES) != hipSuccess) { fprintf(stderr, "kernel_launch: hipFuncSetAttribute failed\n"); grid = -1; return; }
        hipOccupancyMaxActiveBlocksPerMultiprocessor(&per_cu, (const void*)mega_fwd, 512, LDS_BYTES);
        if (per_cu < 1) { fprintf(stderr, "kernel_launch: occupancy query says %d blocks per CU\n", per_cu); per_cu = 1; }
        (void)hipGetLastError();
        grid = cus;
        if (grid != 256) { fprintf(stderr, "kernel_launch: built for 256 CUs (one out-projection tile per workgroup), got %d\n", grid); grid = -1; return; }
    }
    if (grid < 0) return;
    Params p{};
    p.x = (const float*)d_in[0]; p.c = (const float*)d_in[1]; p.norm_g = (const float*)d_in[2]; p.ada_w = (const float*)d_in[3]; p.ada_b = (const float*)d_in[4];
    p.ab_w_in = (const float*)d_in[5]; p.ab_conv_w = (const float*)d_in[6]; p.ab_ln_g = (const float*)d_in[7]; p.ab_ln_b = (const float*)d_in[8];
    p.ab_sgu_w = (const float*)d_in[9]; p.ab_sgu_b = (const float*)d_in[10]; p.ab_w_out = (const float*)d_in[11];
    p.c_w_in = (const float*)d_in[12]; p.c_pool_w = (const float*)d_in[13]; p.c_pool_scale = (const float*)d_in[14]; p.c_w_out = (const float*)d_in[15]; p.final_g = (const float*)d_in[16];
    p.out = (float*)d_out; p.ws = (unsigned char*)d_ws;
    if (hipMemsetAsync((unsigned char*)d_ws + WS_BAR, 0, CTL_WORDS * 4, stream) != hipSuccess) { fprintf(stderr, "kernel_launch: barrier memset failed\n"); return; }
    int lo = 0, hi = 15;
    void* args[] = {&p, &lo, &hi};
    hipError_t e = hipLaunchCooperativeKernel((const void*)mega_fwd, dim3(grid), dim3(512), args, LDS_BYTES, stream);
    if (e != hipSuccess) fprintf(stderr, "kernel_launch: cooperative launch failed: %s (grid %d)\n", hipGetErrorString(e), grid);
}
```

```cpp
#include <hip/hip_runtime.h>
#include <hip/hip_cooperative_groups.h>
#include <cstdio>
namespace cg = cooperative_groups;

#define LAS __attribute__((address_space(3)))
typedef unsigned short bf16_t;
typedef short bf16x8 __attribute__((ext_vector_type(8)));
typedef float f32x4 __attribute__((ext_vector_type(4)));
typedef unsigned u32x4 __attribute__((ext_vector_type(4)));
typedef unsigned u32x2 __attribute__((ext_vector_type(2)));

constexpr int DM = 1024, NB = 8, SEQ = 2048, MTOK = NB * SEQ;
constexpr int BM = 256, BK = 64, HALF = 128, HTB = HALF * BK * 2, STAGE_BYTES = 8 * HTB, NXCD = 8, WGM = 8;
constexpr int LDS_BYTES = STAGE_BYTES + 16;
constexpr float EPS = 1e-6f;
constexpr int REP_G1 = 1, REP_THIN = 1, REP_G2L0 = 1;

constexpr size_t WS_MOD = 0;
constexpr size_t WS_BAR = 393216;
constexpr size_t WS_WIN_E = 524288;
constexpr size_t WS_WIN_O = WS_WIN_E + (size_t)7168 * 1024 * 2;
constexpr size_t WS_WOUT_E = WS_WIN_O + (size_t)4096 * 1024 * 2;
constexpr size_t WS_WOUT_O = WS_WOUT_E + (size_t)1024 * 2048 * 2;
constexpr size_t WS_SGU = WS_WOUT_O + (size_t)1024 * 2048 * 2;
constexpr size_t WS_POOLT = WS_SGU + (size_t)8 * 128 * 128 * 2;
constexpr size_t WS_WINP = WS_POOLT + (size_t)4 * 512 * 512 * 2;
constexpr size_t WS_RA = WS_WINP + (size_t)1024 * 2048 * 2;
constexpr size_t WS_RP = WS_RA + (size_t)MTOK * 2048 * 2;
constexpr size_t WS_END = WS_RP + (size_t)MTOK * 4096 * 2;

constexpr size_t WS_PART = WS_END;
constexpr size_t WS_HALO = WS_PART + (size_t)4 * 4 * MTOK * 4;
constexpr size_t WS_END2 = WS_HALO + (size_t)128 * 6 * 1024 * 4;
constexpr size_t WS_HQ = WS_RP;
constexpr size_t WS_HS = WS_HQ + (size_t)128 * 32 * 2048 * 2;
constexpr int CNT_WORD0 = 3584;
constexpr int CTL_WORDS = CNT_WORD0 + 256;
__device__ unsigned short g_x[(size_t)MTOK * DM];
__device__ unsigned short g_h[(size_t)MTOK * DM];

struct Params {
    const float *x, *c, *norm_g, *ada_w, *ada_b, *ab_w_in, *ab_conv_w, *ab_ln_g, *ab_ln_b, *ab_sgu_w, *ab_sgu_b, *ab_w_out,
        *c_w_in, *c_pool_w, *c_pool_scale, *c_w_out, *final_g;
    float* out;
    unsigned char* ws;
};

__host__ __device__ __forceinline__ int lds_byte(int r, int c) { const int st = (r >> 4) * 2 + (c >> 5), rr = r & 15, cc = c & 31, ob = rr * 64 + cc * 2; return st * 1024 + (ob ^ (((ob >> 9) & 1) << 5)); }
__host__ __device__ __forceinline__ void stage_rc(int b, int& R, int& C) { const int st = b / 1024, sb = b % 1024, swz = sb ^ (((sb >> 9) & 1) << 5); R = (st >> 1) * 16 + swz / 64; C = (st & 1) * 32 + (swz % 64) / 2; }
__host__ __device__ __forceinline__ int perm32(int rho) { const int n = rho >> 4, i = rho & 15; return 8 * (i >> 2) + 4 * n + (i & 3); }
__device__ __forceinline__ unsigned cvt_pk_bf16(float lo, float hi) { unsigned r; asm volatile("v_cvt_pk_bf16_f32 %0, %1, %2" : "=v"(r) : "v"(lo), "v"(hi)); return r; }
__device__ __forceinline__ float bf_lo(unsigned w) { return __uint_as_float(w << 16); }
__device__ __forceinline__ float bf_hi(unsigned w) { return __uint_as_float(w & 0xffff0000u); }
__device__ __forceinline__ float silu_f(float v) { return v * __builtin_amdgcn_rcpf(1.f + __expf(-v)); }
__device__ __forceinline__ float wave_sum(float v) {
#pragma unroll
    for (int o = 1; o < 64; o <<= 1) v += __shfl_xor(v, o);
    return v;
}

__device__ __forceinline__ int opaque_tid() { int t = threadIdx.x; asm volatile("" : "+v"(t)); return t; }
__device__ __forceinline__ int opaque_bid() { int b = blockIdx.x; asm volatile("" : "+s"(b)); return b; }
struct Unit { int pm, pn; };
struct Gemm { const bf16_t* A; const bf16_t* Bt; int lda, ldb, K, nM, nN, bk; };

__device__ __forceinline__ bool next_unit(const Gemm& g, int bid, int i, Unit& u) {
    const int nwg = g.nM * g.nN;
    const long L = (long)i * gridDim.x + bid; if (L >= nwg) return false;
    int wgid = (int)L; { const int q = nwg / NXCD, r = nwg % NXCD, xcd = wgid % NXCD, off = wgid / NXCD; wgid = (xcd < r ? xcd * (q + 1) : r * (q + 1) + (xcd - r) * q) + off; }
    const int nig = WGM * g.nN, gid = wgid / nig, fm = gid * WGM, gsz = (g.nM - fm) < WGM ? (g.nM - fm) : WGM;
    u.pm = fm + ((wgid % nig) % gsz); u.pn = (wgid % nig) / gsz; return true;
}

struct EpiEven {
    static constexpr bool PERM = true, AFTER_DRAIN = false, PERMA = true;
    bf16_t* P; bf16_t* Y; float* halo; const float* cw;
    __device__ __forceinline__ void operator()(const f32x4 (&acc)[2][2][4][2], const Unit& u, int wr, int wc, int fr, int fq) const {
        const int tok0 = u.pm * BM + 8 * (wr * 16 + fr), T = u.pn;
        if (T < 16) {
            const int ch = T * 64 + 16 * wc + 4 * fq;
            const f32x4 w0 = *(const f32x4*)(cw + ch), w1 = *(const f32x4*)(cw + 1024 + ch), w2 = *(const f32x4*)(cw + 2048 + ch);
            f32x4 c[8], pm1, pm2;
#pragma unroll
            for (int i = 0; i < 8; ++i) c[i] = acc[i >> 2][0][i & 3][0] * acc[i >> 2][0][i & 3][1];
#pragma unroll
            for (int j = 0; j < 4; ++j) {
                pm1[j] = __int_as_float(__builtin_amdgcn_update_dpp(0, __float_as_int(c[7][j]), 0x111, 0xf, 0xf, true));
                pm2[j] = __int_as_float(__builtin_amdgcn_update_dpp(0, __float_as_int(c[6][j]), 0x111, 0xf, 0xf, true));
            }
            float* hb = halo + (size_t)(u.pm * 2 + wr) * 6 * 1024 + ch;
            if (fr == 15) { *(f32x4*)(hb) = c[6]; *(f32x4*)(hb + 1024) = c[7]; }
            bf16_t* yp = Y + (size_t)tok0 * 2048 + ch;
#pragma unroll
            for (int i = 0; i < 8; ++i) {
                f32x4 bz = acc[i >> 2][1][i & 3][0]; const f32x4 z = acc[i >> 2][1][i & 3][1];
#pragma unroll
                for (int j = 0; j < 4; ++j) bz[j] *= silu_f(z[j]);
                const f32x4 cm1 = (i >= 1) ? c[i >= 1 ? i - 1 : 0] : pm1, cm2 = (i >= 2) ? c[i >= 2 ? i - 2 : 0] : (i == 1 ? pm1 : pm2);
                const f32x4 y = bz * (w0 * ((i == 1) ? pm1 : cm2) + w1 * cm1 + w2 * c[i]);
                if (i < 2 && fr == 0) { *(f32x4*)(hb + (2 + i) * 1024) = c[i]; *(f32x4*)(hb + (4 + i) * 1024) = bz; }
                else { u32x2 w; w.x = cvt_pk_bf16(y[0], y[1]); w.y = cvt_pk_bf16(y[2], y[3]); *(u32x2*)(yp + (size_t)i * 2048) = w; }
            }
        } else if (T < 24) {
            bf16_t* base = P + (size_t)2 * MTOK * 1024 + (size_t)tok0 * 1024 + (T - 16) * 128 + wc * 32 + 8 * fq;
#pragma unroll
            for (int i = 0; i < 8; ++i) {
                f32x4 x0 = acc[i >> 2][0][i & 3][0], x1 = acc[i >> 2][0][i & 3][1]; const f32x4 y0 = acc[i >> 2][1][i & 3][0], y1 = acc[i >> 2][1][i & 3][1];
#pragma unroll
                for (int j = 0; j < 4; ++j) { x0[j] *= silu_f(y0[j]); x1[j] *= silu_f(y1[j]); }
                u32x4 w; w.x = cvt_pk_bf16(x0[0], x0[1]); w.y = cvt_pk_bf16(x0[2], x0[3]); w.z = cvt_pk_bf16(x1[0], x1[1]); w.w = cvt_pk_bf16(x1[2], x1[3]);
                *(u32x4*)(base + (size_t)i * 1024) = w;
            }
        } else {
            bf16_t* base = P + (size_t)3 * MTOK * 1024 + (size_t)tok0 * 1024 + (T - 24) * 256 + wc * 32 + 8 * fq;
#pragma unroll
            for (int i = 0; i < 8; ++i)
#pragma unroll
                for (int bj = 0; bj < 2; ++bj) {
                    const f32x4 v0 = acc[i >> 2][bj][i & 3][0], v1 = acc[i >> 2][bj][i & 3][1];
                    u32x4 w; w.x = cvt_pk_bf16(v0[0], v0[1]); w.y = cvt_pk_bf16(v0[2], v0[3]); w.z = cvt_pk_bf16(v1[0], v1[1]); w.w = cvt_pk_bf16(v1[2], v1[3]);
                    *(u32x4*)(base + (size_t)i * 1024 + bj * HALF) = w;
                }
        }
    }
};
template <int WIN> __device__ __forceinline__ void pool_quad(const f32x4 (&acc)[2][2][4][2], int n, const f32x4 ps, unsigned (&yq)[8][2], unsigned (&qq)[8][2], unsigned (&sq)[8][2]) {
    float y[8][4], szv[8][4];
#pragma unroll
    for (int j = 0; j < 4; ++j) {
        float h[23], PS[24];
#pragma unroll
        for (int k = 0; k < 8; ++k) h[15 + k] = acc[k >> 2][0][k & 3][n][j];
#pragma unroll
        for (int k = 0; k < 8; ++k) h[7 + k] = __int_as_float(__builtin_amdgcn_update_dpp(0, __float_as_int(h[15 + k]), 0x111, 0xf, 0xf, true));
#pragma unroll
        for (int k = 1; k < 8; ++k) h[k - 1] = __int_as_float(__builtin_amdgcn_update_dpp(0, __float_as_int(h[15 + k]), 0x112, 0xf, 0xf, true));
        PS[0] = 0.f;
#pragma unroll
        for (int x = 0; x < 23; ++x) PS[x + 1] = PS[x] + h[x];
#pragma unroll
        for (int i = 0; i < 8; ++i) {
            const float w = PS[16 + i] - PS[16 + i - WIN];
            const float z = acc[i >> 2][1][i & 3][n][j];
            szv[i][j] = silu_f(z) * ps[j];
            y[i][j] = (w * (1.f / WIN) - h[15 + i]) * szv[i][j];
        }
    }
#pragma unroll
    for (int i = 0; i < 8; ++i) {
        yq[i][0] = cvt_pk_bf16(y[i][0], y[i][1]); yq[i][1] = cvt_pk_bf16(y[i][2], y[i][3]);
        qq[i][0] = cvt_pk_bf16(acc[i >> 2][0][i & 3][n][0], acc[i >> 2][0][i & 3][n][1]); qq[i][1] = cvt_pk_bf16(acc[i >> 2][0][i & 3][n][2], acc[i >> 2][0][i & 3][n][3]);
        sq[i][0] = cvt_pk_bf16(szv[i][0], szv[i][1]); sq[i][1] = cvt_pk_bf16(szv[i][2], szv[i][3]);
    }
}
struct EpiOdd {
    static constexpr bool PERM = true, AFTER_DRAIN = false, PERMA = true;
    bf16_t* Y; bf16_t* HQ; bf16_t* HS; const float* pscale;
    __device__ __forceinline__ void operator()(const f32x4 (&acc)[2][2][4][2], const Unit& u, int wr, int wc, int fr, int fq) const {
        const int T = u.pn, g = T >> 2, B = u.pm * 2 + wr;
        const int tok0 = u.pm * BM + 8 * (wr * 16 + fr);
#pragma unroll
        for (int n = 0; n < 2; ++n) {
            const int ch = T * 128 + wc * 32 + 8 * fq + 4 * n;
            const f32x4 ps = *(const f32x4*)(pscale + ch);
            unsigned yq[8][2], qq[8][2], sq[8][2];
            if (g == 0) pool_quad<2>(acc, n, ps, yq, qq, sq);
            else if (g == 1) pool_quad<4>(acc, n, ps, yq, qq, sq);
            else if (g == 2) pool_quad<8>(acc, n, ps, yq, qq, sq);
            else pool_quad<16>(acc, n, ps, yq, qq, sq);
            bf16_t* yp = Y + (size_t)tok0 * 2048 + ch;
#pragma unroll
            for (int i = 0; i < 8; ++i) { u32x2 w; w.x = yq[i][0]; w.y = yq[i][1]; *(u32x2*)(yp + (size_t)i * 2048) = w; }
            if (fr >= 14) {
                bf16_t* hp = HQ + ((size_t)B * 32 + (fr - 14) * 8) * 2048 + ch;
#pragma unroll
                for (int i = 0; i < 8; ++i) { u32x2 w; w.x = qq[i][0]; w.y = qq[i][1]; *(u32x2*)(hp + (size_t)i * 2048) = w; }
            }
            if (fr <= 1) {
                bf16_t* hp = HQ + ((size_t)B * 32 + 16 + fr * 8) * 2048 + ch; bf16_t* sp = HS + ((size_t)B * 16 + fr * 8) * 2048 + ch;
#pragma unroll
                for (int i = 0; i < 8; ++i) { u32x2 w; w.x = qq[i][0]; w.y = qq[i][1]; *(u32x2*)(hp + (size_t)i * 2048) = w; u32x2 v; v.x = sq[i][0]; v.y = sq[i][1]; *(u32x2*)(sp + (size_t)i * 2048) = v; }
            }
        }
    }
};
struct EpiProd {
    static constexpr bool PERM = true, AFTER_DRAIN = false, PERMA = false;
    bf16_t* O;
    __device__ __forceinline__ void operator()(const f32x4 (&acc)[2][2][4][2], const Unit& u, int wr, int wc, int fr, int fq) const {
        const int col0 = u.pn * BM + wc * 32 + 8 * fq;
#pragma unroll
        for (int ai = 0; ai < 2; ++ai)
#pragma unroll
            for (int m = 0; m < 4; ++m) {
                bf16_t* rowp = O + (size_t)((u.pm * 2 + ai) * 256 + wr * 64 + m * 16 + fr) * DM + col0;
#pragma unroll
                for (int bj = 0; bj < 2; ++bj) {
                    const f32x4 v0 = acc[ai][bj][m][0], v1 = acc[ai][bj][m][1];
                    u32x4 w; w.x = cvt_pk_bf16(v0[0], v0[1]); w.y = cvt_pk_bf16(v0[2], v0[3]); w.z = cvt_pk_bf16(v1[0], v1[1]); w.w = cvt_pk_bf16(v1[2], v1[3]);
                    *(u32x4*)(rowp + bj * HALF) = w;
                }
            }
    }
};
struct EpiBf {
    static constexpr bool PERM = true, AFTER_DRAIN = false, PERMA = false;
    bf16_t* O; int ld;
    __device__ __forceinline__ void operator()(const f32x4 (&acc)[2][2][4][2], const Unit& u, int wr, int wc, int fr, int fq) const {
        const int row0 = u.pm * BM + wr * 64 + fr, col0 = u.pn * BM + wc * 32 + 8 * fq;
#pragma unroll
        for (int ai = 0; ai < 2; ++ai)
#pragma unroll
            for (int m = 0; m < 4; ++m) {
                bf16_t* rowp = O + (size_t)(row0 + ai * HALF + m * 16) * ld + col0;
#pragma unroll
                for (int bj = 0; bj < 2; ++bj) {
                    const f32x4 v0 = acc[ai][bj][m][0], v1 = acc[ai][bj][m][1];
                    u32x4 w; w.x = cvt_pk_bf16(v0[0], v0[1]); w.y = cvt_pk_bf16(v0[2], v0[3]); w.z = cvt_pk_bf16(v1[0], v1[1]); w.w = cvt_pk_bf16(v1[2], v1[3]);
                    *(u32x4*)(rowp + bj * HALF) = w;
                }
            }
    }
};
struct EpiRes {
    static constexpr bool PERM = false, AFTER_DRAIN = false, PERMA = false;
    const float* xin; float* xout; const float* gate;
    __device__ __forceinline__ void operator()(const f32x4 (&acc)[2][2][4][2], const Unit& u, int wr, int wc, int fr, int fq) const {
        const int row0 = u.pm * BM + wr * 64 + fr, col0 = u.pn * BM + wc * 32 + 4 * fq;
        const float* gp = gate + (size_t)(u.pm >> 3) * 3072 + col0;
        f32x4 gv[2][2];
#pragma unroll
        for (int bj = 0; bj < 2; ++bj)
#pragma unroll
            for (int n = 0; n < 2; ++n) gv[bj][n] = *(const f32x4*)(gp + bj * HALF + n * 16);
#pragma unroll
        for (int ai = 0; ai < 2; ++ai)
#pragma unroll
            for (int m = 0; m < 4; ++m) {
                const size_t ro = (size_t)(row0 + ai * HALF + m * 16) * DM + col0;
#pragma unroll
                for (int bj = 0; bj < 2; ++bj)
#pragma unroll
                    for (int n = 0; n < 2; ++n) {
                        const f32x4 xv = *(const f32x4*)(xin + ro + bj * HALF + n * 16);
                        *(f32x4*)(xout + ro + bj * HALF + n * 16) = xv + gv[bj][n] * acc[ai][bj][m][n];
                    }
            }
    }
};

struct EpiResNorm {
    static constexpr bool PERM = true, AFTER_DRAIN = true, PERMA = false;
    const float* xin32; const bf16_t* xin16; bf16_t* xout16; float* out32; const float* gate; bf16_t* H; const float* ng; const float* modn; float* part; unsigned* cnt; int last;
    __device__ __forceinline__ void fused(f32x4 (&acc)[2][2][4][2], const Unit& u, int wr, int wc, int fr, int fq, LAS unsigned char* lds, int tid) const {
        const int row0 = u.pm * BM + wr * 64 + fr, col0 = u.pn * BM + wc * 32 + 8 * fq, b = u.pm >> 3;
        LAS float* lss = (LAS float*)lds;
        LAS float* lrs = (LAS float*)(lds + 4096);
        {
            const float* gp = gate + (size_t)b * 3072 + col0;
            f32x4 gv[2][2];
#pragma unroll
            for (int bj = 0; bj < 2; ++bj)
#pragma unroll
                for (int n = 0; n < 2; ++n) gv[bj][n] = *(const f32x4*)(gp + bj * HALF + 4 * n);
#pragma unroll
            for (int ai = 0; ai < 2; ++ai)
#pragma unroll
                for (int m = 0; m < 4; ++m) {
                    const size_t ro = (size_t)(row0 + ai * HALF + m * 16) * DM + col0;
                    float ss = 0.f;
#pragma unroll
                    for (int bj = 0; bj < 2; ++bj) {
                        f32x4 x0, x1;
                        if (xin32) { x0 = *(const f32x4*)(xin32 + ro + bj * HALF); x1 = *(const f32x4*)(xin32 + ro + bj * HALF + 4); }
                        else { const u32x4 w = *(const u32x4*)(xin16 + ro + bj * HALF); x0 = (f32x4){bf_lo(w.x), bf_hi(w.x), bf_lo(w.y), bf_hi(w.y)}; x1 = (f32x4){bf_lo(w.z), bf_hi(w.z), bf_lo(w.w), bf_hi(w.w)}; }
                        const f32x4 v0 = x0 + gv[bj][0] * acc[ai][bj][m][0], v1 = x1 + gv[bj][1] * acc[ai][bj][m][1];
                        acc[ai][bj][m][0] = v0; acc[ai][bj][m][1] = v1;
                        ss += ((v0[0] * v0[0] + v0[1] * v0[1]) + (v0[2] * v0[2] + v0[3] * v0[3])) + ((v1[0] * v1[0] + v1[1] * v1[1]) + (v1[2] * v1[2] + v1[3] * v1[3]));
                        if (!last) { u32x4 w; w.x = cvt_pk_bf16(v0[0], v0[1]); w.y = cvt_pk_bf16(v0[2], v0[3]); w.z = cvt_pk_bf16(v1[0], v1[1]); w.w = cvt_pk_bf16(v1[2], v1[3]); *(u32x4*)(xout16 + ro + bj * HALF) = w; }
                    }
                    ss += __shfl_xor(ss, 16); ss += __shfl_xor(ss, 32);
                    if (fq == 0) lss[(ai * HALF + wr * 64 + m * 16 + fr) * 4 + wc] = ss;
                }
        }
        __syncthreads();
        if (tid < 256) {
            const float t = (lss[tid * 4] + lss[tid * 4 + 1]) + (lss[tid * 4 + 2] + lss[tid * 4 + 3]);
            __hip_atomic_store(part + (size_t)u.pn * MTOK + u.pm * BM + tid, t, __ATOMIC_RELAXED, __HIP_MEMORY_SCOPE_AGENT);
        }
        asm volatile("s_waitcnt vmcnt(0)" ::: "memory");
        __syncthreads();
        if (tid == 0) {
            unsigned* c = cnt + u.pm;
            __hip_atomic_fetch_add(c, 1u, __ATOMIC_RELAXED, __HIP_MEMORY_SCOPE_AGENT);
            unsigned spins = 0;
            while (__hip_atomic_load(c, __ATOMIC_RELAXED, __HIP_MEMORY_SCOPE_AGENT) < 4u && ++spins < (1u << 22)) __builtin_amdgcn_s_sleep(1);
            __builtin_amdgcn_fence(__ATOMIC_ACQUIRE, "agent");
            asm volatile("s_waitcnt vmcnt(0)" ::: "memory");
        }
        __syncthreads();
        if (tid < 256) {
            float t = 0.f;
#pragma unroll
            for (int q = 0; q < 4; ++q) t += __hip_atomic_load(part + (size_t)q * MTOK + u.pm * BM + tid, __ATOMIC_RELAXED, __HIP_MEMORY_SCOPE_AGENT);
            lrs[tid] = rsqrtf(t * (1.f / DM) + EPS);
        }
        __syncthreads();
        const float* mb = modn + (size_t)b * 3072;
#pragma unroll
        for (int bj = 0; bj < 2; ++bj) {
            const int c = col0 + bj * HALF;
            const f32x4 g0 = *(const f32x4*)(ng + c), g1 = *(const f32x4*)(ng + c + 4);
            f32x4 sh0 = {0.f, 0.f, 0.f, 0.f}, sh1 = sh0, sc0 = sh0, sc1 = sh0;
            if (!last) { sh0 = *(const f32x4*)(mb + c); sh1 = *(const f32x4*)(mb + c + 4); sc0 = *(const f32x4*)(mb + 1024 + c); sc1 = *(const f32x4*)(mb + 1024 + c + 4); }
            const f32x4 a0 = g0 * (sc0 + 1.f), a1 = g1 * (sc1 + 1.f);
#pragma unroll
            for (int ai = 0; ai < 2; ++ai)
#pragma unroll
                for (int m = 0; m < 4; ++m) {
                    const int rl = ai * HALF + wr * 64 + m * 16 + fr;
                    const float rstd = lrs[rl];
                    const size_t ro = (size_t)(u.pm * BM + rl) * DM + c;
                    const f32x4 h0 = (acc[ai][bj][m][0] * rstd) * a0 + sh0, h1 = (acc[ai][bj][m][1] * rstd) * a1 + sh1;
                    if (last) { *(f32x4*)(out32 + ro) = h0; *(f32x4*)(out32 + ro + 4) = h1; }
                    else { u32x4 w; w.x = cvt_pk_bf16(h0[0], h0[1]); w.y = cvt_pk_bf16(h0[2], h0[3]); w.z = cvt_pk_bf16(h1[0], h1[1]); w.w = cvt_pk_bf16(h1[2], h1[3]); *(u32x4*)(H + ro) = w; }
                }
        }
    }
};

template <class Epi>
__device__ __forceinline__ void gemm_phase(LAS unsigned char* lds, const Gemm g, const Epi& E) {
    const int tid = opaque_tid(), wid = __builtin_amdgcn_readfirstlane(tid >> 6), lane = tid & 63, wr = wid >> 2, wc = wid & 3, fr = lane & 15, fq = lane >> 4;
    const int nt = g.K / BK;
    unsigned voffA[2], voffB[2];
#pragma unroll
    for (int i = 0; i < 2; ++i) { int R, C; stage_rc(tid * 16 + i * 8192, R, C); const int Rb = Epi::PERM ? ((R & ~31) + perm32(R & 31)) : R;
        const int Ra = Epi::PERMA ? (8 * ((R >> 6) * 16 + (R & 15)) + ((R >> 4) & 3)) : R;
        voffA[i] = (unsigned)(Ra * g.lda + C) * 2u; voffB[i] = (unsigned)(Rb * g.ldb + C) * 2u; }
    const size_t kstep = (size_t)(BK * 2);
    const size_t hstepA = (size_t)(Epi::PERMA ? 4 : HALF) * g.lda * 2, hstepB = (size_t)HALF * g.ldb * 2, tstepA = (size_t)BM * g.lda * 2;
    const unsigned ldsw = (unsigned)wid * 1024u;
    const int aoff = lds_byte(wr * 64 + fr, fq * 8), boff = lds_byte(wc * 32 + fr, fq * 8);
#define PG8_SA(b, h) (((b) * 2 + (h)) * HTB)
#define PG8_SB(b, h) ((4 + (b) * 2 + (h)) * HTB)
#define PG8_STAGE(bufoff, gbase, voff) do { _Pragma("unroll") for (int _i = 0; _i < 2; ++_i) \
        __builtin_amdgcn_global_load_lds((const unsigned*)((const char*)(gbase) + (voff)[_i]), (LAS unsigned*)(lds + (bufoff) + ldsw + _i * 8192), 16, 0, 0); } while (0)
#define PG8_LDA(dst, b, h) do { _Pragma("unroll") for (int m = 0; m < 4; ++m) _Pragma("unroll") for (int k = 0; k < 2; ++k) dst[m][k] = *(const LAS bf16x8*)(lds + PG8_SA(b, h) + aoff + m * 2048 + k * 1024); } while (0)
#define PG8_LDB(dst, b, h) do { _Pragma("unroll") for (int n = 0; n < 2; ++n) _Pragma("unroll") for (int k = 0; k < 2; ++k) dst[n][k] = *(const LAS bf16x8*)(lds + PG8_SB(b, h) + boff + n * 2048 + k * 1024); } while (0)
#define PG8_MMA(ai, bj, At, Bt) do { __builtin_amdgcn_s_setprio(1); _Pragma("unroll") for (int m = 0; m < 4; ++m) _Pragma("unroll") for (int n = 0; n < 2; ++n) _Pragma("unroll") for (int k = 0; k < 2; ++k) \
        acc[ai][bj][m][n] = __builtin_amdgcn_mfma_f32_16x16x32_bf16(Bt[n][k], At[m][k], acc[ai][bj][m][n], 0, 0, 0); __builtin_amdgcn_s_setprio(0); } while (0)
#define PG8_WAIT_V(n) asm volatile("s_waitcnt vmcnt(" #n ")" ::: "memory")
#define PG8_WAIT_L(n) asm volatile("s_waitcnt lgkmcnt(" #n ")" ::: "memory")
#define PG8_BAR __builtin_amdgcn_s_barrier()
#define PG8_SCHED __builtin_amdgcn_sched_barrier(0)
    Unit cur, nxt; int ui = 0;
    const int bid = opaque_bid();
    if (!next_unit(g, bid, 0, cur)) return;
    f32x4 acc[2][2][4][2];
#pragma unroll
    for (int a = 0; a < 2; ++a)
#pragma unroll
        for (int b = 0; b < 2; ++b)
#pragma unroll
            for (int m = 0; m < 4; ++m)
#pragma unroll
                for (int n = 0; n < 2; ++n) acc[a][b][m][n] = (f32x4){0.f, 0.f, 0.f, 0.f};
    bf16x8 At[4][2], B0[2][2], B1[2][2];
    const char* cA = (const char*)g.A + (size_t)cur.pm * tstepA; const char* cB = (const char*)g.Bt + (size_t)cur.pn * 2 * hstepB + (size_t)(cur.pm >> 1) * g.bk * 2;
    PG8_STAGE(PG8_SB(0, 0), cB, voffB); PG8_STAGE(PG8_SA(0, 0), cA, voffA); PG8_STAGE(PG8_SB(0, 1), cB + hstepB, voffB); PG8_STAGE(PG8_SA(0, 1), cA + hstepA, voffA);
    if (wr == 1) PG8_BAR;
    PG8_WAIT_V(4); PG8_BAR;
    PG8_STAGE(PG8_SB(1, 0), cB + kstep, voffB); PG8_STAGE(PG8_SA(1, 0), cA + kstep, voffA); PG8_STAGE(PG8_SB(1, 1), cB + hstepB + kstep, voffB);
    PG8_WAIT_V(6); PG8_BAR;
    for (;;) {
        const bool has_next = next_unit(g, bid, ui + 1, nxt);
        const char* nA = has_next ? (const char*)g.A + (size_t)nxt.pm * tstepA : cA;
        const char* nB = has_next ? (const char*)g.Bt + (size_t)nxt.pn * 2 * hstepB + (size_t)(nxt.pm >> 1) * g.bk * 2 : cB;
        for (int t = 0; t < nt; t += 2) {
            const bool last = (t == nt - 2);
            const char* a1 = cA + (size_t)(t + 1) * kstep;
            const char* a2 = last ? nA : cA + (size_t)(t + 2) * kstep; const char* b2 = last ? nB : cB + (size_t)(t + 2) * kstep;
            const char* a3 = a2 + kstep; const char* b3 = b2 + kstep;
            PG8_LDB(B0, 0, 0); PG8_SCHED; PG8_LDA(At, 0, 0); PG8_STAGE(PG8_SA(1, 1), a1 + hstepA, voffA);
            PG8_WAIT_L(8); PG8_BAR; PG8_WAIT_L(0); PG8_MMA(0, 0, At, B0); PG8_BAR; PG8_SCHED;
            PG8_LDB(B1, 0, 1); PG8_STAGE(PG8_SB(0, 0), b2, voffB);
            PG8_BAR; PG8_WAIT_L(0); PG8_MMA(0, 1, At, B1); PG8_BAR;
            PG8_LDA(At, 0, 1); PG8_STAGE(PG8_SA(0, 0), a2, voffA);
            PG8_BAR; PG8_WAIT_L(0); PG8_MMA(1, 0, At, B0); PG8_BAR; PG8_SCHED;
            PG8_STAGE(PG8_SB(0, 1), b2 + hstepB, voffB);
            PG8_WAIT_V(6); PG8_BAR; PG8_MMA(1, 1, At, B1); PG8_BAR;
            PG8_LDB(B0, 1, 0); PG8_SCHED; PG8_LDA(At, 1, 0); PG8_STAGE(PG8_SA(0, 1), a2 + hstepA, voffA);
            PG8_WAIT_L(8); PG8_BAR; PG8_WAIT_L(0); PG8_MMA(0, 0, At, B0); PG8_BAR; PG8_SCHED;
            PG8_LDB(B1, 1, 1); PG8_STAGE(PG8_SB(1, 0), b3, voffB);
            PG8_BAR; PG8_WAIT_L(0); PG8_MMA(0, 1, At, B1); PG8_BAR;
            PG8_LDA(At, 1, 1); PG8_STAGE(PG8_SA(1, 0), a3, voffA);
            PG8_BAR; PG8_WAIT_L(0); PG8_MMA(1, 0, At, B0); PG8_BAR; PG8_SCHED;
            PG8_STAGE(PG8_SB(1, 1), b3 + hstepB, voffB);
            PG8_WAIT_V(6); PG8_BAR; PG8_MMA(1, 1, At, B1); PG8_BAR;
        }
        if constexpr (!Epi::AFTER_DRAIN) E(acc, cur, wr, wc, fr, fq);
        if (!has_next) break;
#pragma unroll
        for (int a = 0; a < 2; ++a)
#pragma unroll
            for (int b = 0; b < 2; ++b)
#pragma unroll
                for (int m = 0; m < 4; ++m)
#pragma unroll
                    for (int n = 0; n < 2; ++n) acc[a][b][m][n] = (f32x4){0.f, 0.f, 0.f, 0.f};
        cur = nxt; cA = nA; cB = nB; ++ui;
    }
    PG8_WAIT_V(0);
    if (wr == 0) PG8_BAR;
    PG8_BAR;
    if constexpr (Epi::AFTER_DRAIN) E.fused(acc, cur, wr, wc, fr, fq, lds, tid);
#undef PG8_SA
#undef PG8_SB
#undef PG8_STAGE
#undef PG8_LDA
#undef PG8_LDB
#undef PG8_MMA
#undef PG8_WAIT_V
#undef PG8_WAIT_L
#undef PG8_BAR
#undef PG8_SCHED
}

__device__ __forceinline__ void phase_mod(const Params& p, LAS unsigned char* lds) {
    const int tid = opaque_tid(), wid = tid >> 6, lane = tid & 63;
    LAS float* sc = (LAS float*)lds;
    LAS float* red = (LAS float*)(lds + 32768);
    float* mod = (float*)(p.ws + WS_MOD);
    for (int t = tid; t < NB * DM; t += 512) sc[t] = silu_f(p.c[t]);
    __syncthreads();
    for (int it = opaque_bid(); it < 192; it += gridDim.x) {
        const int col = it * 64 + lane, i = col / 3072, j = col - i * 3072;
        const float* w = p.ada_w + ((size_t)i * DM + wid * 128) * 3072 + j;
        float a[8];
#pragma unroll
        for (int b = 0; b < 8; ++b) a[b] = 0.f;
#pragma unroll 16
        for (int k = 0; k < 128; ++k) {
            const float wv = w[(size_t)k * 3072];
#pragma unroll
            for (int b = 0; b < 8; ++b) a[b] += sc[b * DM + wid * 128 + k] * wv;
        }
#pragma unroll
        for (int b = 0; b < 8; ++b) red[(wid * 8 + b) * 64 + lane] = a[b];
        __syncthreads();
        {
            const int b = tid >> 6; float s = 0.f;
#pragma unroll
            for (int w8 = 0; w8 < 8; ++w8) s += red[(w8 * 8 + b) * 64 + lane];
            mod[((size_t)i * NB + b) * 3072 + j] = s + p.ada_b[i * 3072 + j];
        }
        __syncthreads();
    }
}

__device__ __forceinline__ void conv_tile(const float* __restrict__ src, int srcN, int c0, bf16_t* __restrict__ dstrow, int K, int k0, LAS float* T, int csrc = -1) {
    const int tid = opaque_tid();
    const int cs = csrc >= 0 ? csrc : c0 + (tid & 15) * 4;
    f32x4 v[8];
#pragma unroll
    for (int ps = 0; ps < 8; ++ps) v[ps] = *(const f32x4*)(src + (size_t)(k0 + ps * 32 + (tid >> 4)) * srcN + cs);
#pragma unroll
    for (int ps = 0; ps < 8; ++ps) { LAS float* t = T + (ps * 32 + (tid >> 4)) * 65 + (tid & 15) * 4; t[0] = v[ps][0]; t[1] = v[ps][1]; t[2] = v[ps][2]; t[3] = v[ps][3]; }
    __syncthreads();
#pragma unroll
    for (int q = 0; q < 4; ++q) {
        const int item = tid + 512 * q, n = item >> 5, kg = item & 31; const LAS float* s = T + (kg * 8) * 65 + n;
        u32x4 o; o.x = cvt_pk_bf16(s[0], s[65]); o.y = cvt_pk_bf16(s[130], s[195]); o.z = cvt_pk_bf16(s[260], s[325]); o.w = cvt_pk_bf16(s[390], s[455]);
        *(u32x4*)(dstrow + (size_t)n * K + k0 + kg * 8) = o;
    }
    __syncthreads();
}

__device__ __forceinline__ void norm_rows(const Params& p, int layer, const float* xin, int item) {
    const int tid = opaque_tid(), wid = tid >> 6, lane = tid & 63;
    bf16_t* H = (bf16_t*)g_h;
    const float* mod = (const float*)(p.ws + WS_MOD) + (size_t)layer * NB * 3072;
    const float* gp = p.norm_g + (size_t)layer * DM;
#pragma unroll
    for (int h2 = 0; h2 < 2; ++h2) {
        const int row = item * 16 + h2 * 8 + wid, b = row >> 11;
        const f32x4* xr = (const f32x4*)(xin + (size_t)row * DM) + lane;
        f32x4 v[4]; float ss = 0.f;
#pragma unroll
        for (int q = 0; q < 4; ++q) { v[q] = xr[64 * q]; ss += (v[q][0] * v[q][0] + v[q][1] * v[q][1]) + (v[q][2] * v[q][2] + v[q][3] * v[q][3]); }
        const float rstd = rsqrtf(wave_sum(ss) * (1.f / DM) + EPS);
        const float* mb = mod + (size_t)b * 3072;
        u32x2* o8 = (u32x2*)(H + (size_t)row * DM) + lane;
#pragma unroll
        for (int q = 0; q < 4; ++q) {
            const int k = (lane + 64 * q) * 4;
            const f32x4 gv = *(const f32x4*)(gp + k), sh = *(const f32x4*)(mb + k), scl = *(const f32x4*)(mb + 1024 + k);
            const f32x4 hv = (v[q] * rstd * gv) * (scl + 1.f) + sh;
            u32x2 w; w.x = cvt_pk_bf16(hv[0], hv[1]); w.y = cvt_pk_bf16(hv[2], hv[3]);
            o8[64 * q] = w;
        }
    }
}
__device__ __forceinline__ void phase_norm_even(const Params& p, int j, const float* xin, LAS unsigned char* lds) {
    const int tid = opaque_tid();
    bf16_t* WIN_E = (bf16_t*)(p.ws + WS_WIN_E); bf16_t* WIN_O = (bf16_t*)(p.ws + WS_WIN_O); bf16_t* WOUT_E = (bf16_t*)(p.ws + WS_WOUT_E); bf16_t* WOUT_O = (bf16_t*)(p.ws + WS_WOUT_O);
    bf16_t* SGU = (bf16_t*)(p.ws + WS_SGU); bf16_t* POOLT = (bf16_t*)(p.ws + WS_POOLT); bf16_t* WINP = (bf16_t*)(p.ws + WS_WINP);
    constexpr int N0 = 448, N1 = N0 + 128, N2 = N1 + 128, N3 = N2 + 128, N4 = N3 + 64, N5 = N4 + 32, N6 = N5 + 512;
    const int TOTAL = N6 + (j == 0 ? MTOK / 16 : 0);
    for (int it = opaque_bid(); it < TOTAL; it += gridDim.x) {
        if (it < N0) {
            const int rt = it >> 2, kt = it & 3, r0 = rt * 64, T = r0 >> 8, q = r0 & 255; int c0 = 0, csrc = -1;
            if (T < 16) {
                const int cg = tid & 15, bj = q >> 7, wcc = ((q >> 6) & 1) * 2 + (cg >> 3), fq4 = (cg >> 1) & 3, n = cg & 1;
                const int tbase = bj == 0 ? (n == 0 ? 2048 : 0) : (n == 0 ? 1024 : 3072);
                csrc = tbase + 64 * T + 16 * wcc + 4 * fq4;
            }
            else if (T < 24) c0 = (q < 128) ? (4096 + 128 * (T - 16) + q) : (6144 + 128 * (T - 16) + q - 128);
            else c0 = 5120 + 256 * (T - 24) + q;
            conv_tile(p.ab_w_in + (size_t)j * DM * 7168, 7168, c0, WIN_E + (size_t)r0 * DM, DM, kt * 256, (LAS float*)lds, csrc);
        } else if (it < N1) {
            const int i2 = it - N0, rt = i2 >> 3, kt = i2 & 7, r0 = rt * 64;
            conv_tile(p.ab_w_out + (size_t)j * 2048 * DM, DM, r0, WOUT_E + (size_t)r0 * 2048, 2048, kt * 256, (LAS float*)lds);
        } else if (it < N2) {
            const int i2 = it - N1, rt = i2 >> 2, kt = i2 & 3, r0 = rt * 64;
            conv_tile(p.c_w_in + (size_t)j * DM * 4096, 4096, 2048 + r0, WIN_O + (size_t)((r0 >> 7) * 256 + 128 + (r0 & 127)) * DM, DM, kt * 256, (LAS float*)lds);
        } else if (it < N3) {
            const int i2 = it - N2, rt = i2 >> 3, kt = i2 & 7, r0 = rt * 64;
            conv_tile(p.c_w_out + (size_t)j * 2048 * DM, DM, r0, WOUT_O + (size_t)r0 * 2048, 2048, kt * 256, (LAS float*)lds);
        } else if (it < N4) {
            const int i3 = it - N3, g = i3 >> 4, r = i3 & 15, rt = r >> 1, kt = r & 1, r0 = rt * 64;
            conv_tile(p.c_pool_w + ((size_t)j * 4 + g) * 512 * 512, 512, r0, POOLT + (size_t)g * 512 * 512 + (size_t)r0 * 512, 512, kt * 256, (LAS float*)lds);
        } else if (it < N5) {
            const int e0 = (it - N4) * 4096 + tid * 8, t = (e0 >> 7) & 127, s0 = e0 & 127;
            const float* src = p.ab_sgu_w + (size_t)j * 8 * 128 * 128 + e0;
            const f32x4 a = *(const f32x4*)src, b = *(const f32x4*)(src + 4);
            float v[8] = {a[0], a[1], a[2], a[3], b[0], b[1], b[2], b[3]};
#pragma unroll
            for (int e = 0; e < 8; ++e) v[e] = (s0 + e <= t) ? v[e] : 0.f;
            u32x4 o; o.x = cvt_pk_bf16(v[0], v[1]); o.y = cvt_pk_bf16(v[2], v[3]); o.z = cvt_pk_bf16(v[4], v[5]); o.w = cvt_pk_bf16(v[6], v[7]);
            *(u32x4*)(SGU + e0) = o;
        } else if (it < N6) {
            const int e0 = (it - N5) * 4096 + tid * 8, k = e0 >> 11, c = e0 & 2047;
            const float* src = p.c_w_in + ((size_t)j * DM + k) * 4096 + c;
            const f32x4 a = *(const f32x4*)src, b = *(const f32x4*)(src + 4);
            u32x4 o; o.x = cvt_pk_bf16(a[0], a[1]); o.y = cvt_pk_bf16(a[2], a[3]); o.z = cvt_pk_bf16(b[0], b[1]); o.w = cvt_pk_bf16(b[2], b[3]);
            *(u32x4*)(WINP + e0) = o;
        } else norm_rows(p, 2 * j, xin, it - N6);
    }
}
__device__ __forceinline__ void phase_final(const Params& p) {
    const int tid = opaque_tid(), wid = tid >> 6, lane = tid & 63;
    for (int it = opaque_bid(); it < MTOK / 8; it += gridDim.x) {
        const int row = it * 8 + wid;
        f32x4* xr = (f32x4*)(p.out + (size_t)row * DM) + lane;
        f32x4 v[4]; float ss = 0.f;
#pragma unroll
        for (int q = 0; q < 4; ++q) { v[q] = xr[64 * q]; ss += (v[q][0] * v[q][0] + v[q][1] * v[q][1]) + (v[q][2] * v[q][2] + v[q][3] * v[q][3]); }
        const float rstd = rsqrtf(wave_sum(ss) * (1.f / DM) + EPS);
#pragma unroll
        for (int q = 0; q < 4; ++q) { const f32x4 gv = *(const f32x4*)(p.final_g + (lane + 64 * q) * 4); xr[64 * q] = v[q] * rstd * gv; }
    }
}

__device__ __forceinline__ void unpack8(const u32x4 w, float (&f)[8]) {
    f[0] = bf_lo(w.x); f[1] = bf_hi(w.x); f[2] = bf_lo(w.y); f[3] = bf_hi(w.y); f[4] = bf_lo(w.z); f[5] = bf_hi(w.z); f[6] = bf_lo(w.w); f[7] = bf_hi(w.w);
}

__device__ __forceinline__ void phase_mix(const Params& p, int j, LAS unsigned char* lds) {
    const int tid = opaque_tid(), wid = tid >> 6, lane = tid & 63;
    const bf16_t* CH2 = (const bf16_t*)(p.ws + WS_RP); const bf16_t* BZ = CH2 + (size_t)MTOK * 1024; const bf16_t* UZ = BZ + (size_t)MTOK * 1024; const bf16_t* V = UZ + (size_t)MTOK * 1024;
    bf16_t* Y = (bf16_t*)(p.ws + WS_RA);
    if (blockIdx.x < 32) {
        Gemm g{(const bf16_t*)(p.ws + WS_POOLT), (const bf16_t*)(p.ws + WS_WINP), 512, 2048, 512, 8, 4, 512}; EpiProd E{(bf16_t*)(p.ws + WS_WIN_O)};
        gemm_phase(lds, g, E);
        __syncthreads();
    }
    {
        const bf16_t* Wm = (const bf16_t*)(p.ws + WS_SGU);
        LAS bf16_t* vnT = (LAS bf16_t*)lds;
        LAS float* red = (LAS float*)(lds + 36864);
        const int fr = lane & 15, fq = lane >> 4;
        const int s = lane + 64 * (wid & 1), q = wid >> 1;
        int it = opaque_bid();
        u32x4 vraw[4];
        if (it < 1024) { const bf16_t* vp = V + (size_t)((it >> 3) * 128 + s) * 1024 + (it & 7) * 128 + 32 * q;
#pragma unroll
            for (int i = 0; i < 4; ++i) vraw[i] = *(const u32x4*)(vp + 8 * i); }
        for (; it < 1024; it += gridDim.x) {
            const int hh = it & 7, cn = it >> 3;
            const int t = 16 * wid + fr; const size_t row = (size_t)cn * 128 + t;
            u32x2 uz[8];
#pragma unroll
            for (int n = 0; n < 8; ++n) uz[n] = *(const u32x2*)(UZ + row * 1024 + hh * 128 + 16 * n + 4 * fq);
            const float bias = p.ab_sgu_b[(size_t)j * 1024 + hh * 128 + t];
            const bf16_t* wrow = Wm + ((size_t)hh * 128 + 16 * wid + fr) * 128 + 8 * fq;
            bf16x8 af[4];
#pragma unroll
            for (int kk = 0; kk < 4; ++kk) af[kk] = *(const bf16x8*)(wrow + 32 * kk);
            float f[32];
#pragma unroll
            for (int i = 0; i < 4; ++i) { float t8[8]; unpack8(vraw[i], t8);
#pragma unroll
                for (int e = 0; e < 8; ++e) f[8 * i + e] = t8[e]; }
            float s1 = 0.f, s2 = 0.f;
#pragma unroll
            for (int i = 0; i < 32; ++i) { s1 += f[i]; s2 += f[i] * f[i]; }
            red[(s * 4 + q) * 2] = s1; red[(s * 4 + q) * 2 + 1] = s2;
            __syncthreads();
            {
                const int itn = it + gridDim.x;
                if (itn < 1024) { const bf16_t* vp = V + (size_t)((itn >> 3) * 128 + s) * 1024 + (itn & 7) * 128 + 32 * q;
#pragma unroll
                    for (int i = 0; i < 4; ++i) vraw[i] = *(const u32x4*)(vp + 8 * i); }
            }
            float S1 = 0.f, S2 = 0.f;
#pragma unroll
            for (int qq = 0; qq < 4; ++qq) { S1 += red[(s * 4 + qq) * 2]; S2 += red[(s * 4 + qq) * 2 + 1]; }
            const float mu = S1 * (1.f / 128.f), var = fmaxf(S2 * (1.f / 128.f) - mu * mu, 0.f), rstd = rsqrtf(var + EPS);
            const float* lg = p.ab_ln_g + (size_t)j * 1024 + hh * 128 + 32 * q; const float* lb = p.ab_ln_b + (size_t)j * 1024 + hh * 128 + 32 * q;
#pragma unroll
            for (int i = 0; i < 32; ++i) {
                const float vn = (f[i] - mu) * rstd * lg[i] + lb[i];
                vnT[(32 * q + i) * 136 + s] = (bf16_t)(cvt_pk_bf16(vn, 0.f) & 0xffffu);
            }
            __syncthreads();
            f32x4 acc[8];
#pragma unroll
            for (int n = 0; n < 8; ++n) acc[n] = (f32x4){0.f, 0.f, 0.f, 0.f};
#pragma unroll
            for (int kk = 0; kk < 4; ++kk) {
                if (32 * kk <= 16 * wid + 15) {
#pragma unroll
                    for (int n = 0; n < 8; ++n) {
                        const bf16x8 bfm = *(const LAS bf16x8*)(vnT + (16 * n + fr) * 136 + 32 * kk + 8 * fq);
                        acc[n] = __builtin_amdgcn_mfma_f32_16x16x32_bf16(bfm, af[kk], acc[n], 0, 0, 0);
                    }
                }
            }
#pragma unroll
            for (int n = 0; n < 8; ++n) {
                const int d = 16 * n + 4 * fq;
                u32x2 w; w.x = cvt_pk_bf16(bf_lo(uz[n].x) * (acc[n][0] + bias), bf_hi(uz[n].x) * (acc[n][1] + bias));
                w.y = cvt_pk_bf16(bf_lo(uz[n].y) * (acc[n][2] + bias), bf_hi(uz[n].y) * (acc[n][3] + bias));
                *(u32x2*)(Y + row * 2048 + 1024 + hh * 128 + d) = w;
            }
        }
    }
    {
        const float* halo = (const float*)(p.ws + WS_HALO); const float* cw = p.ab_conv_w + (size_t)j * 3 * 1024;
        for (int gid = opaque_bid() * 512 + tid; gid < 128 * 1024; gid += gridDim.x * 512) {
            const int B = gid >> 10, c = gid & 1023; const bool hist = ((B * 128) & (SEQ - 1)) != 0;
            const float* hb = halo + (size_t)B * 6 * 1024 + c;
            const float c6 = hist ? hb[-6 * 1024] : 0.f, c7 = hist ? hb[-5 * 1024] : 0.f, c0 = hb[2 * 1024], c1 = hb[3 * 1024], b0 = hb[4 * 1024], b1 = hb[5 * 1024];
            const float w0 = cw[c], w1 = cw[1024 + c], w2 = cw[2048 + c];
            const float y0 = b0 * (w0 * c6 + w1 * c7 + w2 * c0), y1 = b1 * (w0 * c7 + w1 * c0 + w2 * c1);
            Y[(size_t)(B * 128) * 2048 + c] = (bf16_t)(cvt_pk_bf16(y0, 0.f) & 0xffffu);
            Y[(size_t)(B * 128 + 1) * 2048 + c] = (bf16_t)(cvt_pk_bf16(y1, 0.f) & 0xffffu);
        }
    }
}

__device__ __forceinline__ void phase_pool(const Params& p) {
    const int tid = opaque_tid();
    const bf16_t* HQ = (const bf16_t*)(p.ws + WS_HQ); const bf16_t* HS = (const bf16_t*)(p.ws + WS_HS); bf16_t* Y = (bf16_t*)(p.ws + WS_RA);
    for (int gid = opaque_bid() * 512 + tid; gid < 128 * 256; gid += gridDim.x * 512) {
        const int B = gid >> 8, ct = gid & 255, c0 = ct * 8, win = 2 << (ct >> 6); const bool hist = ((B * 128) & (SEQ - 1)) != 0;
        const bf16_t* tail = HQ + (size_t)(B - 1) * 32 * 2048 + c0;
        const bf16_t* head = HQ + ((size_t)B * 32 + 16) * 2048 + c0;
        const bf16_t* hs = HS + (size_t)B * 16 * 2048 + c0;
        float S[8];
#pragma unroll
        for (int e = 0; e < 8; ++e) S[e] = 0.f;
        if (hist) {
#pragma unroll
            for (int i = 1; i < 16; ++i) {
                if (i < win) { float v[8]; unpack8(*(const u32x4*)(tail + (size_t)(16 - i) * 2048), v);
#pragma unroll
                    for (int e = 0; e < 8; ++e) S[e] += v[e]; }
            }
        }
#pragma unroll 4
        for (int r = 0; r < 16; ++r) {
            float cur[8], sz[8], o[8];
            unpack8(*(const u32x4*)(head + (size_t)r * 2048), cur);
            unpack8(*(const u32x4*)(hs + (size_t)r * 2048), sz);
            const float inv = 1.f / (float)(hist ? win : min(r + 1, win));
#pragma unroll
            for (int e = 0; e < 8; ++e) { S[e] += cur[e]; o[e] = (S[e] * inv - cur[e]) * sz[e]; }
            u32x4 w; w.x = cvt_pk_bf16(o[0], o[1]); w.y = cvt_pk_bf16(o[2], o[3]); w.z = cvt_pk_bf16(o[4], o[5]); w.w = cvt_pk_bf16(o[6], o[7]);
            *(u32x4*)(Y + (size_t)(B * 128 + r) * 2048 + c0) = w;
            const int ro = r - win + 1;
            if (ro >= 0 || hist) { float old[8]; unpack8(*(const u32x4*)(ro >= 0 ? head + (size_t)ro * 2048 : tail + (size_t)(16 + ro) * 2048), old);
#pragma unroll
                for (int e = 0; e < 8; ++e) S[e] -= old[e]; }
        }
    }
}

#define XB_TMO      128
#define XB_XCNT(j)  (256  + 64 * (j))
#define XB_XSUB(j)  (1280 + 64 * (j))
#define XB_XGEN(j)  (2304 + 64 * (j))
#define XB_TOP      3328
#define XB_TOPGEN   3392
#define XCD_BAR_WORDS 3456
#define XB_SPIN_CAP (1u << 18)
__device__ __forceinline__ unsigned xb_ld(unsigned* p)              { return __hip_atomic_load(p, __ATOMIC_RELAXED, __HIP_MEMORY_SCOPE_AGENT); }
__device__ __forceinline__ unsigned xb_add(unsigned* p, unsigned v) { return __hip_atomic_fetch_add(p, v, __ATOMIC_RELAXED, __HIP_MEMORY_SCOPE_AGENT); }
__device__ __forceinline__ unsigned xb_xcc_id() { return (unsigned)__builtin_amdgcn_s_getreg((3 << 11) | 20) & 0xFu; }
#define XB_SPIN(cond, bar) do { unsigned _sp = 0; while (cond) { __builtin_amdgcn_s_sleep(1); \
    if ((++_sp & 255u) == 0u) { if (xb_ld(&(bar)[XB_TMO])) break; if (_sp > XB_SPIN_CAP) { atomicAdd(&(bar)[XB_TMO], 1u); break; } } } } while (0)
struct XcdBarrier { unsigned* bar; unsigned x; volatile LAS unsigned* st; };
__device__ __forceinline__ XcdBarrier xcd_barrier_post(unsigned* bar, volatile LAS unsigned* st) {
    XcdBarrier b; b.bar = bar; b.x = xb_xcc_id(); b.st = st;
    if (threadIdx.x == 0) (void)xb_add(&bar[XB_XCNT(b.x)], 1u);
    return b;
}
__device__ __forceinline__ void xcd_barrier_complete(unsigned* bar, unsigned x, unsigned& nloc, unsigned& nx) {
    const unsigned G = gridDim.x * gridDim.y * gridDim.z;
    unsigned sum, cnt, mine, sp = 0u;
    for (;;) {
        sum = 0u; cnt = 0u; mine = 0u;
#pragma unroll
        for (unsigned j = 0; j < 16; ++j) { const unsigned c = xb_ld(&bar[XB_XCNT(j)]); sum += c; cnt += (c > 0u) ? 1u : 0u; mine = (j == x) ? c : mine; }
        if (sum == G) break;
        __builtin_amdgcn_s_sleep(1);
        if ((++sp & 255u) == 0u) { if (xb_ld(&bar[XB_TMO])) break; if (sp > XB_SPIN_CAP) { atomicAdd(&bar[XB_TMO], 1u); break; } }
    }
    nloc = mine > 0u ? mine : 1u; nx = cnt > 0u ? cnt : 1u;
}
__device__ __forceinline__ void xcd_barrier(const XcdBarrier& b) {
    asm volatile("s_waitcnt vmcnt(0)" ::: "memory");
    __syncthreads();
    if (threadIdx.x == 0) {
        unsigned* bar = b.bar;
        __builtin_amdgcn_s_waitcnt(0);
        unsigned nloc = b.st[0], nx = b.st[1];
        if (nloc == 0u) { xcd_barrier_complete(bar, b.x, nloc, nx); b.st[0] = nloc; b.st[1] = nx; }
        const unsigned old = xb_add(&bar[XB_XSUB(b.x)], 1u);
        const unsigned gen = old / nloc;
        if (old + 1u == (gen + 1u) * nloc) {
            __builtin_amdgcn_fence(__ATOMIC_RELEASE, "agent");
            asm volatile("s_waitcnt vmcnt(0)" ::: "memory");
            const unsigned og = xb_add(&bar[XB_TOP], 1u);
            const unsigned tg = og / nx;
            if (og + 1u == (tg + 1u) * nx) xb_add(&bar[XB_TOPGEN], 1u);
            else XB_SPIN(xb_ld(&bar[XB_TOPGEN]) == tg, bar);
            __builtin_amdgcn_fence(__ATOMIC_ACQUIRE, "agent");
            xb_add(&bar[XB_XGEN(b.x)], 1u);
            asm volatile("s_waitcnt vmcnt(0)" ::: "memory");
        } else {
            XB_SPIN(xb_ld(&bar[XB_XGEN(b.x)]) == gen, bar);
            __builtin_amdgcn_fence(__ATOMIC_ACQUIRE, "agent");
            asm volatile("s_waitcnt vmcnt(0)" ::: "memory");
        }
    }
    __syncthreads();
}

__global__ void __launch_bounds__(512, 2) mega_fwd(Params p, int ph_lo, int ph_hi) {
    extern __shared__ __attribute__((aligned(16))) unsigned char smem[];
    LAS unsigned char* lds = (LAS unsigned char*)smem;
    cg::grid_group grid = cg::this_grid();
    if (ph_hi < 0) grid.sync();
    volatile LAS unsigned* st = (volatile LAS unsigned*)(lds + STAGE_BYTES);
    if (threadIdx.x < 4) st[threadIdx.x] = 0u;
    __syncthreads();
    const XcdBarrier xb = xcd_barrier_post((unsigned*)(p.ws + WS_BAR), st);
    int ph = 0;
#define PHASE(REP, ...) do { if (ph >= ph_lo && ph < ph_hi) { for (int _r = 0; _r < (REP); ++_r) { __VA_ARGS__; if (ph + 1 < ph_hi) xcd_barrier(xb); } } ++ph; } while (0)
    bf16_t* RA = (bf16_t*)(p.ws + WS_RA); bf16_t* RP = (bf16_t*)(p.ws + WS_RP);
    const bf16_t* WIN_E = (const bf16_t*)(p.ws + WS_WIN_E); const bf16_t* WIN_O = (const bf16_t*)(p.ws + WS_WIN_O);
    const bf16_t* WOUT_E = (const bf16_t*)(p.ws + WS_WOUT_E); const bf16_t* WOUT_O = (const bf16_t*)(p.ws + WS_WOUT_O);
    const float* mod = (const float*)(p.ws + WS_MOD);
    float* part = (float*)(p.ws + WS_PART); unsigned* cnt = (unsigned*)(p.ws + WS_BAR) + CNT_WORD0;
    PHASE(REP_THIN, phase_mod(p, lds));
#pragma unroll 1
    for (int lp = 0; lp < 2; ++lp) {
        {
            const int layer = 2 * lp; const float* xin = (lp == 0) ? p.x : p.out;
            PHASE(REP_THIN, phase_norm_even(p, lp, xin, lds));
            PHASE(REP_G1, { Gemm g{(const bf16_t*)g_h, WIN_E, DM, DM, DM, MTOK / BM, 7168 / BM, 0}; EpiEven E{RP, RA, (float*)(p.ws + WS_HALO), p.ab_conv_w + (size_t)lp * 3 * 1024}; gemm_phase(lds, g, E); });
            PHASE(REP_THIN, phase_mix(p, lp, lds));
            PHASE(1, { Gemm g{RA, WOUT_E, 2048, 2048, 2048, MTOK / BM, DM / BM, 0};
                       EpiResNorm E{lp == 0 ? p.x : nullptr, (const bf16_t*)g_x, (bf16_t*)g_x, p.out, mod + (size_t)layer * NB * 3072 + 2048, (bf16_t*)g_h, p.norm_g + (size_t)(layer + 1) * DM, mod + (size_t)(layer + 1) * NB * 3072,
                                    part + (size_t)layer * 4 * MTOK, cnt + layer * 64, 0};
                       gemm_phase(lds, g, E); });
        }
        {
            const int layer = 2 * lp + 1; const int last = (lp == 1) ? 1 : 0;
            PHASE(REP_G1, { Gemm g{(const bf16_t*)g_h, WIN_O, DM, DM, DM, MTOK / BM, 4096 / BM, 0}; EpiOdd E{RA, (bf16_t*)(p.ws + WS_HQ), (bf16_t*)(p.ws + WS_HS), p.c_pool_scale + (size_t)lp * 2048}; gemm_phase(lds, g, E); });
            PHASE(REP_THIN, phase_pool(p));
            PHASE(1, { Gemm g{RA, WOUT_O, 2048, 2048, 2048, MTOK / BM, DM / BM, 0};
                       EpiResNorm E{nullptr, (const bf16_t*)g_x, (bf16_t*)g_x, p.out, mod + (size_t)layer * NB * 3072 + 2048, (bf16_t*)g_h, last ? p.final_g : p.norm_g + (size_t)(layer + 1) * DM, mod + (size_t)(last ? layer : layer + 1) * NB * 3072,
                                    part + (size_t)layer * 4 * MTOK, cnt + layer * 64, last};
                       gemm_phase(lds, g, E); });
        }
    }
#undef PHASE
}

extern "C" void kernel_launch(void* const* d_in, const int* in_sizes, int n_in, void* d_out, int out_size, void* d_ws, size_t ws_size, hipStream_t stream) {
    static int grid = 0;
    if (grid == 0) {
        if (n_in != 17 || out_size != MTOK * DM || ws_size < WS_END2) { fprintf(stderr, "kernel_launch: unexpected shapes (n_in %d out %d ws %zu need %zu)\n", n_in, out_size, ws_size, (size_t)WS_END2); grid = -1; return; }
        int dev = 0, cus = 0, per_cu = 0;
        hipGetDevice(&dev);
        hipDeviceGetAttribute(&cus, hipDeviceAttributeMultiprocessorCount, dev);
        if (hipFuncSetAttribute((const void*)mega_fwd, hipFuncAttributeMaxDynamicSharedMemorySize, LDS_BYTES) != hipSuccess) { fprintf(stderr, "kernel_launch: hipFuncSetAttribute failed\n"); grid = -1; return; }
        hipOccupancyMaxActiveBlocksPerMultiprocessor(&per_cu, (const void*)mega_fwd, 512, LDS_BYTES);
        if (per_cu < 1) { fprintf(stderr, "kernel_launch: occupancy query says %d blocks per CU\n", per_cu); per_cu = 1; }
        (void)hipGetLastError();
        grid = cus;
        if (grid != 256) { fprintf(stderr, "kernel_launch: built for 256 CUs (one out-projection tile per workgroup), got %d\n", grid); grid = -1; return; }
    }
    if (grid < 0) return;
    Params p{};
    p.x = (const float*)d_in[0]; p.c = (const float*)d_in[1]; p.norm_g = (const float*)d_in[2]; p.ada_w = (const float*)d_in[3]; p.ada_b = (const float*)d_in[4];
    p.ab_w_in = (const float*)d_in[5]; p.ab_conv_w = (const float*)d_in[6]; p.ab_ln_g = (const float*)d_in[7]; p.ab_ln_b = (const float*)d_in[8];
    p.ab_sgu_w = (const float*)d_in[9]; p.ab_sgu_b = (const float*)d_in[10]; p.ab_w_out = (const float*)d_in[11];
    p.c_w_in = (const float*)d_in[12]; p.c_pool_w = (const float*)d_in[13]; p.c_pool_scale = (const float*)d_in[14]; p.c_w_out = (const float*)d_in[15]; p.final_g = (const float*)d_in[16];
    p.out = (float*)d_out; p.ws = (unsigned char*)d_ws;
    if (hipMemsetAsync((unsigned char*)d_ws + WS_BAR, 0, CTL_WORDS * 4, stream) != hipSuccess) { fprintf(stderr, "kernel_launch: barrier memset failed\n"); return; }
    int lo = 0, hi = 15;
    void* args[] = {&p, &lo, &hi};
    hipError_t e = hipLaunchCooperativeKernel((const void*)mega_fwd, dim3(grid), dim3(512), args, LDS_BYTES, stream);
    if (e != hipSuccess) fprintf(stderr, "kernel_launch: cooperative launch failed: %s (grid %d)\n", hipGetErrorString(e), grid);
}
```

```cpp
#include <hip/hip_runtime.h>
#include <hip/hip_cooperative_groups.h>
#include <cstdio>
namespace cg = cooperative_groups;

#define LAS __attribute__((address_space(3)))
typedef unsigned short bf16_t;
typedef short bf16x8 __attribute__((ext_vector_type(8)));
typedef float f32x4 __attribute__((ext_vector_type(4)));
typedef unsigned u32x4 __attribute__((ext_vector_type(4)));
typedef unsigned u32x2 __attribute__((ext_vector_type(2)));

constexpr int DM = 1024, NB = 8, SEQ = 2048, MTOK = NB * SEQ;
constexpr int BM = 256, BK = 64, HALF = 128, HTB = HALF * BK * 2, STAGE_BYTES = 8 * HTB, NXCD = 8, WGM = 8;
constexpr int LDS_BYTES = STAGE_BYTES + 16;
constexpr float EPS = 1e-6f;
constexpr int REP_G1 = 1, REP_THIN = 1, REP_G2L0 = 1;

constexpr size_t WS_MOD = 0;
constexpr size_t WS_BAR = 393216;
constexpr size_t WS_WIN_E = 524288;
constexpr size_t WS_WIN_O = WS_WIN_E + (size_t)7168 * 1024 * 2;
constexpr size_t WS_WOUT_E = WS_WIN_O + (size_t)4096 * 1024 * 2;
constexpr size_t WS_WOUT_O = WS_WOUT_E + (size_t)1024 * 2048 * 2;
constexpr size_t WS_SGU = WS_WOUT_O + (size_t)1024 * 2048 * 2;
constexpr size_t WS_POOLT = WS_SGU + (size_t)8 * 128 * 128 * 2;
constexpr size_t WS_WINP = WS_POOLT + (size_t)4 * 512 * 512 * 2;
constexpr size_t WS_RA = WS_WINP + (size_t)1024 * 2048 * 2;
constexpr size_t WS_RP = WS_RA + (size_t)MTOK * 2048 * 2;
constexpr size_t WS_END = WS_RP + (size_t)MTOK * 4096 * 2;

constexpr size_t WS_PART = WS_END;
constexpr size_t WS_HALO = WS_PART + (size_t)4 * 4 * MTOK * 4;
constexpr size_t WS_END2 = WS_HALO + (size_t)128 * 6 * 1024 * 4;
constexpr size_t WS_HQ = WS_RP;
constexpr size_t WS_HS = WS_HQ + (size_t)128 * 32 * 2048 * 2;
constexpr int CNT_WORD0 = 3584;
constexpr int CTL_WORDS = CNT_WORD0 + 256;
__device__ unsigned short g_x[(size_t)MTOK * DM];
__device__ unsigned short g_h[(size_t)MTOK * DM];

struct Params {
    const float *x, *c, *norm_g, *ada_w, *ada_b, *ab_w_in, *ab_conv_w, *ab_ln_g, *ab_ln_b, *ab_sgu_w, *ab_sgu_b, *ab_w_out,
        *c_w_in, *c_pool_w, *c_pool_scale, *c_w_out, *final_g;
    float* out;
    unsigned char* ws;
};

__host__ __device__ __forceinline__ int lds_byte(int r, int c) { const int st = (r >> 4) * 2 + (c >> 5), rr = r & 15, cc = c & 31, ob = rr * 64 + cc * 2; return st * 1024 + (ob ^ (((ob >> 9) & 1) << 5)); }
__host__ __device__ __forceinline__ void stage_rc(int b, int& R, int& C) { const int st = b / 1024, sb = b % 1024, swz = sb ^ (((sb >> 9) & 1) << 5); R = (st >> 1) * 16 + swz / 64; C = (st & 1) * 32 + (swz % 64) / 2; }
__host__ __device__ __forceinline__ int perm32(int rho) { const int n = rho >> 4, i = rho & 15; return 8 * (i >> 2) + 4 * n + (i & 3); }
__device__ __forceinline__ unsigned cvt_pk_bf16(float lo, float hi) { unsigned r; asm volatile("v_cvt_pk_bf16_f32 %0, %1, %2" : "=v"(r) : "v"(lo), "v"(hi)); return r; }
__device__ __forceinline__ float bf_lo(unsigned w) { return __uint_as_float(w << 16); }
__device__ __forceinline__ float bf_hi(unsigned w) { return __uint_as_float(w & 0xffff0000u); }
__device__ __forceinline__ float silu_f(float v) { return v * __builtin_amdgcn_rcpf(1.f + __expf(-v)); }
__device__ __forceinline__ float wave_sum(float v) {
#pragma unroll
    for (int o = 1; o < 64; o <<= 1) v += __shfl_xor(v, o);
    return v;
}

__device__ __forceinline__ int opaque_tid() { int t = threadIdx.x; asm volatile("" : "+v"(t)); return t; }
__device__ __forceinline__ int opaque_bid() { int b = blockIdx.x; asm volatile("" : "+s"(b)); return b; }
struct Unit { int pm, pn; };
struct Gemm { const bf16_t* A; const bf16_t* Bt; int lda, ldb, K, nM, nN, bk; };

__device__ __forceinline__ bool next_unit(const Gemm& g, int bid, int i, Unit& u) {
    const int nwg = g.nM * g.nN;
    const long L = (long)i * gridDim.x + bid; if (L >= nwg) return false;
    int wgid = (int)L; { const int q = nwg / NXCD, r = nwg % NXCD, xcd = wgid % NXCD, off = wgid / NXCD; wgid = (xcd < r ? xcd * (q + 1) : r * (q + 1) + (xcd - r) * q) + off; }
    const int nig = WGM * g.nN, gid = wgid / nig, fm = gid * WGM, gsz = (g.nM - fm) < WGM ? (g.nM - fm) : WGM;
    u.pm = fm + ((wgid % nig) % gsz); u.pn = (wgid % nig) / gsz; return true;
}

struct EpiEven {
    static constexpr bool PERM = true, AFTER_DRAIN = false, PERMA = true;
    bf16_t* P; bf16_t* Y; float* halo; const float* cw;
    __device__ __forceinline__ void operator()(const f32x4 (&acc)[2][2][4][2], const Unit& u, int wr, int wc, int fr, int fq) const {
        const int tok0 = u.pm * BM + 8 * (wr * 16 + fr), T = u.pn;
        if (T < 16) {
            const int ch = T * 64 + 16 * wc + 4 * fq;
            const f32x4 w0 = *(const f32x4*)(cw + ch), w1 = *(const f32x4*)(cw + 1024 + ch), w2 = *(const f32x4*)(cw + 2048 + ch);
            f32x4 c[8], pm1, pm2;
#pragma unroll
            for (int i = 0; i < 8; ++i) c[i] = acc[i >> 2][0][i & 3][0] * acc[i >> 2][0][i & 3][1];
#pragma unroll
            for (int j = 0; j < 4; ++j) {
                pm1[j] = __int_as_float(__builtin_amdgcn_update_dpp(0, __float_as_int(c[7][j]), 0x111, 0xf, 0xf, true));
                pm2[j] = __int_as_float(__builtin_amdgcn_update_dpp(0, __float_as_int(c[6][j]), 0x111, 0xf, 0xf, true));
            }
            float* hb = halo + (size_t)(u.pm * 2 + wr) * 6 * 1024 + ch;
            if (fr == 15) { *(f32x4*)(hb) = c[6]; *(f32x4*)(hb + 1024) = c[7]; }
            bf16_t* yp = Y + (size_t)tok0 * 2048 + ch;
#pragma unroll
            for (int i = 0; i < 8; ++i) {
                f32x4 bz = acc[i >> 2][1][i & 3][0]; const f32x4 z = acc[i >> 2][1][i & 3][1];
#pragma unroll
                for (int j = 0; j < 4; ++j) bz[j] *= silu_f(z[j]);
                const f32x4 cm1 = (i >= 1) ? c[i >= 1 ? i - 1 : 0] : pm1, cm2 = (i >= 2) ? c[i >= 2 ? i - 2 : 0] : (i == 1 ? pm1 : pm2);
                const f32x4 y = bz * (w0 * ((i == 1) ? pm1 : cm2) + w1 * cm1 + w2 * c[i]);
                if (i < 2 && fr == 0) { *(f32x4*)(hb + (2 + i) * 1024) = c[i]; *(f32x4*)(hb + (4 + i) * 1024) = bz; }
                else { u32x2 w; w.x = cvt_pk_bf16(y[0], y[1]); w.y = cvt_pk_bf16(y[2], y[3]); *(u32x2*)(yp + (size_t)i * 2048) = w; }
            }
        } else if (T < 24) {
            bf16_t* base = P + (size_t)2 * MTOK * 1024 + (size_t)tok0 * 1024 + (T - 16) * 128 + wc * 32 + 8 * fq;
#pragma unroll
            for (int i = 0; i < 8; ++i) {
                f32x4 x0 = acc[i >> 2][0][i & 3][0], x1 = acc[i >> 2][0][i & 3][1]; const f32x4 y0 = acc[i >> 2][1][i & 3][0], y1 = acc[i >> 2][1][i & 3][1];
#pragma unroll
                for (int j = 0; j < 4; ++j) { x0[j] *= silu_f(y0[j]); x1[j] *= silu_f(y1[j]); }
                u32x4 w; w.x = cvt_pk_bf16(x0[0], x0[1]); w.y = cvt_pk_bf16(x0[2], x0[3]); w.z = cvt_pk_bf16(x1[0], x1[1]); w.w = cvt_pk_bf16(x1[2], x1[3]);
                *(u32x4*)(base + (size_t)i * 1024) = w;
            }
        } else {
            bf16_t* base = P + (size_t)3 * MTOK * 1024 + (size_t)tok0 * 1024 + (T - 24) * 256 + wc * 32 + 8 * fq;
#pragma unroll
            for (int i = 0; i < 8; ++i)
#pragma unroll
                for (int bj = 0; bj < 2; ++bj) {
                    const f32x4 v0 = acc[i >> 2][bj][i & 3][0], v1 = acc[i >> 2][bj][i & 3][1];
                    u32x4 w; w.x = cvt_pk_bf16(v0[0], v0[1]); w.y = cvt_pk_bf16(v0[2], v0[3]); w.z = cvt_pk_bf16(v1[0], v1[1]); w.w = cvt_pk_bf16(v1[2], v1[3]);
                    *(u32x4*)(base + (size_t)i * 1024 + bj * HALF) = w;
                }
        }
    }
};
template <int WIN> __device__ __forceinline__ void pool_quad(const f32x4 (&acc)[2][2][4][2], int n, const f32x4 ps, unsigned (&yq)[8][2], unsigned (&qq)[8][2], unsigned (&sq)[8][2]) {
    float y[8][4], szv[8][4];
#pragma unroll
    for (int j = 0; j < 4; ++j) {
        float h[23], PS[24];
#pragma unroll
        for (int k = 0; k < 8; ++k) h[15 + k] = acc[k >> 2][0][k & 3][n][j];
#pragma unroll
        for (int k = 0; k < 8; ++k) h[7 + k] = __int_as_float(__builtin_amdgcn_update_dpp(0, __float_as_int(h[15 + k]), 0x111, 0xf, 0xf, true));
#pragma unroll
        for (int k = 1; k < 8; ++k) h[k - 1] = __int_as_float(__builtin_amdgcn_update_dpp(0, __float_as_int(h[15 + k]), 0x112, 0xf, 0xf, true));
        constexpr int LO = 16 - WIN;
#pragma unroll
        for (int x = 0; x <= LO; ++x) PS[x] = 0.f;
#pragma unroll
        for (int x = LO; x < 23; ++x) PS[x + 1] = PS[x] + h[x];
#pragma unroll
        for (int i = 0; i < 8; ++i) {
            const float w = PS[16 + i] - PS[16 + i - WIN];
            const float z = acc[i >> 2][1][i & 3][n][j];
            szv[i][j] = silu_f(z) * ps[j];
            y[i][j] = (w * (1.f / WIN) - h[15 + i]) * szv[i][j];
        }
    }
#pragma unroll
    for (int i = 0; i < 8; ++i) {
        yq[i][0] = cvt_pk_bf16(y[i][0], y[i][1]); yq[i][1] = cvt_pk_bf16(y[i][2], y[i][3]);
        qq[i][0] = cvt_pk_bf16(acc[i >> 2][0][i & 3][n][0], acc[i >> 2][0][i & 3][n][1]); qq[i][1] = cvt_pk_bf16(acc[i >> 2][0][i & 3][n][2], acc[i >> 2][0][i & 3][n][3]);
        sq[i][0] = cvt_pk_bf16(szv[i][0], szv[i][1]); sq[i][1] = cvt_pk_bf16(szv[i][2], szv[i][3]);
    }
}
struct EpiOdd {
    static constexpr bool PERM = true, AFTER_DRAIN = false, PERMA = true;
    bf16_t* Y; bf16_t* HQ; bf16_t* HS; const float* pscale;
    __device__ __forceinline__ void operator()(const f32x4 (&acc)[2][2][4][2], const Unit& u, int wr, int wc, int fr, int fq) const {
        const int T = u.pn, g = T >> 2, B = u.pm * 2 + wr;
        const int tok0 = u.pm * BM + 8 * (wr * 16 + fr);
        const int ch = T * 128 + wc * 32 + 8 * fq;
        unsigned yq[2][8][2];
#pragma unroll
        for (int n = 0; n < 2; ++n) {
            const f32x4 ps = *(const f32x4*)(pscale + ch + 4 * n);
            unsigned qq[8][2], sq[8][2];
            if (g == 0) pool_quad<2>(acc, n, ps, yq[n], qq, sq);
            else if (g == 1) pool_quad<4>(acc, n, ps, yq[n], qq, sq);
            else if (g == 2) pool_quad<8>(acc, n, ps, yq[n], qq, sq);
            else pool_quad<16>(acc, n, ps, yq[n], qq, sq);
            if (fr >= 14) {
                bf16_t* hp = HQ + ((size_t)B * 32 + (fr - 14) * 8) * 2048 + ch + 4 * n;
#pragma unroll
                for (int i = 0; i < 8; ++i) { u32x2 w; w.x = qq[i][0]; w.y = qq[i][1]; *(u32x2*)(hp + (size_t)i * 2048) = w; }
            }
            if (fr <= 1) {
                bf16_t* hp = HQ + ((size_t)B * 32 + 16 + fr * 8) * 2048 + ch + 4 * n; bf16_t* sp = HS + ((size_t)B * 16 + fr * 8) * 2048 + ch + 4 * n;
#pragma unroll
                for (int i = 0; i < 8; ++i) { u32x2 w; w.x = qq[i][0]; w.y = qq[i][1]; *(u32x2*)(hp + (size_t)i * 2048) = w; u32x2 v; v.x = sq[i][0]; v.y = sq[i][1]; *(u32x2*)(sp + (size_t)i * 2048) = v; }
            }
        }
        bf16_t* yp = Y + (size_t)tok0 * 2048 + ch;
#pragma unroll
        for (int i = 0; i < 8; ++i) { u32x4 w; w.x = yq[0][i][0]; w.y = yq[0][i][1]; w.z = yq[1][i][0]; w.w = yq[1][i][1]; *(u32x4*)(yp + (size_t)i * 2048) = w; }
    }
};
struct EpiProd {
    static constexpr bool PERM = true, AFTER_DRAIN = false, PERMA = false;
    bf16_t* O;
    __device__ __forceinline__ void operator()(const f32x4 (&acc)[2][2][4][2], const Unit& u, int wr, int wc, int fr, int fq) const {
        const int col0 = u.pn * BM + wc * 32 + 8 * fq;
#pragma unroll
        for (int ai = 0; ai < 2; ++ai)
#pragma unroll
            for (int m = 0; m < 4; ++m) {
                bf16_t* rowp = O + (size_t)((u.pm * 2 + ai) * 256 + wr * 64 + m * 16 + fr) * DM + col0;
#pragma unroll
                for (int bj = 0; bj < 2; ++bj) {
                    const f32x4 v0 = acc[ai][bj][m][0], v1 = acc[ai][bj][m][1];
                    u32x4 w; w.x = cvt_pk_bf16(v0[0], v0[1]); w.y = cvt_pk_bf16(v0[2], v0[3]); w.z = cvt_pk_bf16(v1[0], v1[1]); w.w = cvt_pk_bf16(v1[2], v1[3]);
                    *(u32x4*)(rowp + bj * HALF) = w;
                }
            }
    }
};
struct EpiBf {
    static constexpr bool PERM = true, AFTER_DRAIN = false, PERMA = false;
    bf16_t* O; int ld;
    __device__ __forceinline__ void operator()(const f32x4 (&acc)[2][2][4][2], const Unit& u, int wr, int wc, int fr, int fq) const {
        const int row0 = u.pm * BM + wr * 64 + fr, col0 = u.pn * BM + wc * 32 + 8 * fq;
#pragma unroll
        for (int ai = 0; ai < 2; ++ai)
#pragma unroll
            for (int m = 0; m < 4; ++m) {
                bf16_t* rowp = O + (size_t)(row0 + ai * HALF + m * 16) * ld + col0;
#pragma unroll
                for (int bj = 0; bj < 2; ++bj) {
                    const f32x4 v0 = acc[ai][bj][m][0], v1 = acc[ai][bj][m][1];
                    u32x4 w; w.x = cvt_pk_bf16(v0[0], v0[1]); w.y = cvt_pk_bf16(v0[2], v0[3]); w.z = cvt_pk_bf16(v1[0], v1[1]); w.w = cvt_pk_bf16(v1[2], v1[3]);
                    *(u32x4*)(rowp + bj * HALF) = w;
                }
            }
    }
};
struct EpiRes {
    static constexpr bool PERM = false, AFTER_DRAIN = false, PERMA = false;
    const float* xin; float* xout; const float* gate;
    __device__ __forceinline__ void operator()(const f32x4 (&acc)[2][2][4][2], const Unit& u, int wr, int wc, int fr, int fq) const {
        const int row0 = u.pm * BM + wr * 64 + fr, col0 = u.pn * BM + wc * 32 + 4 * fq;
        const float* gp = gate + (size_t)(u.pm >> 3) * 3072 + col0;
        f32x4 gv[2][2];
#pragma unroll
        for (int bj = 0; bj < 2; ++bj)
#pragma unroll
            for (int n = 0; n < 2; ++n) gv[bj][n] = *(const f32x4*)(gp + bj * HALF + n * 16);
#pragma unroll
        for (int ai = 0; ai < 2; ++ai)
#pragma unroll
            for (int m = 0; m < 4; ++m) {
                const size_t ro = (size_t)(row0 + ai * HALF + m * 16) * DM + col0;
#pragma unroll
                for (int bj = 0; bj < 2; ++bj)
#pragma unroll
                    for (int n = 0; n < 2; ++n) {
                        const f32x4 xv = *(const f32x4*)(xin + ro + bj * HALF + n * 16);
                        *(f32x4*)(xout + ro + bj * HALF + n * 16) = xv + gv[bj][n] * acc[ai][bj][m][n];
                    }
            }
    }
};

struct EpiResNorm {
    static constexpr bool PERM = true, AFTER_DRAIN = true, PERMA = false;
    const float* xin32; const bf16_t* xin16; bf16_t* xout16; float* out32; const float* gate; bf16_t* H; const float* ng; const float* modn; float* part; unsigned* cnt; int last;
    __device__ __forceinline__ void fused(f32x4 (&acc)[2][2][4][2], const Unit& u, int wr, int wc, int fr, int fq, LAS unsigned char* lds, int tid) const {
        const int row0 = u.pm * BM + wr * 64 + fr, col0 = u.pn * BM + wc * 32 + 8 * fq, b = u.pm >> 3;
        LAS float* lss = (LAS float*)lds;
        LAS float* lrs = (LAS float*)(lds + 4096);
        {
            const float* gp = gate + (size_t)b * 3072 + col0;
            f32x4 gv[2][2];
#pragma unroll
            for (int bj = 0; bj < 2; ++bj)
#pragma unroll
                for (int n = 0; n < 2; ++n) gv[bj][n] = *(const f32x4*)(gp + bj * HALF + 4 * n);
#pragma unroll
            for (int ai = 0; ai < 2; ++ai)
#pragma unroll
                for (int m = 0; m < 4; ++m) {
                    const size_t ro = (size_t)(row0 + ai * HALF + m * 16) * DM + col0;
                    float ss = 0.f;
#pragma unroll
                    for (int bj = 0; bj < 2; ++bj) {
                        f32x4 x0, x1;
                        if (xin32) { x0 = *(const f32x4*)(xin32 + ro + bj * HALF); x1 = *(const f32x4*)(xin32 + ro + bj * HALF + 4); }
                        else { const u32x4 w = *(const u32x4*)(xin16 + ro + bj * HALF); x0 = (f32x4){bf_lo(w.x), bf_hi(w.x), bf_lo(w.y), bf_hi(w.y)}; x1 = (f32x4){bf_lo(w.z), bf_hi(w.z), bf_lo(w.w), bf_hi(w.w)}; }
                        const f32x4 v0 = x0 + gv[bj][0] * acc[ai][bj][m][0], v1 = x1 + gv[bj][1] * acc[ai][bj][m][1];
                        acc[ai][bj][m][0] = v0; acc[ai][bj][m][1] = v1;
                        ss += ((v0[0] * v0[0] + v0[1] * v0[1]) + (v0[2] * v0[2] + v0[3] * v0[3])) + ((v1[0] * v1[0] + v1[1] * v1[1]) + (v1[2] * v1[2] + v1[3] * v1[3]));
                        if (!last) { u32x4 w; w.x = cvt_pk_bf16(v0[0], v0[1]); w.y = cvt_pk_bf16(v0[2], v0[3]); w.z = cvt_pk_bf16(v1[0], v1[1]); w.w = cvt_pk_bf16(v1[2], v1[3]); *(u32x4*)(xout16 + ro + bj * HALF) = w; }
                    }
                    ss += __shfl_xor(ss, 16); ss += __shfl_xor(ss, 32);
                    if (fq == 0) lss[(ai * HALF + wr * 64 + m * 16 + fr) * 4 + wc] = ss;
                }
        }
        __syncthreads();
        if (tid < 256) {
            const float t = (lss[tid * 4] + lss[tid * 4 + 1]) + (lss[tid * 4 + 2] + lss[tid * 4 + 3]);
            __hip_atomic_store(part + (size_t)u.pn * MTOK + u.pm * BM + tid, t, __ATOMIC_RELAXED, __HIP_MEMORY_SCOPE_AGENT);
        }
        asm volatile("s_waitcnt vmcnt(0)" ::: "memory");
        __syncthreads();
        if (tid == 0) {
            unsigned* c = cnt + u.pm;
            __hip_atomic_fetch_add(c, 1u, __ATOMIC_RELAXED, __HIP_MEMORY_SCOPE_AGENT);
            unsigned spins = 0;
            while (__hip_atomic_load(c, __ATOMIC_RELAXED, __HIP_MEMORY_SCOPE_AGENT) < 4u && ++spins < (1u << 22)) __builtin_amdgcn_s_sleep(1);
            __builtin_amdgcn_fence(__ATOMIC_ACQUIRE, "agent");
            asm volatile("s_waitcnt vmcnt(0)" ::: "memory");
        }
        __syncthreads();
        if (tid < 256) {
            float t = 0.f;
#pragma unroll
            for (int q = 0; q < 4; ++q) t += __hip_atomic_load(part + (size_t)q * MTOK + u.pm * BM + tid, __ATOMIC_RELAXED, __HIP_MEMORY_SCOPE_AGENT);
            lrs[tid] = rsqrtf(t * (1.f / DM) + EPS);
        }
        __syncthreads();
        const float* mb = modn + (size_t)b * 3072;
#pragma unroll
        for (int bj = 0; bj < 2; ++bj) {
            const int c = col0 + bj * HALF;
            const f32x4 g0 = *(const f32x4*)(ng + c), g1 = *(const f32x4*)(ng + c + 4);
            f32x4 sh0 = {0.f, 0.f, 0.f, 0.f}, sh1 = sh0, sc0 = sh0, sc1 = sh0;
            if (!last) { sh0 = *(const f32x4*)(mb + c); sh1 = *(const f32x4*)(mb + c + 4); sc0 = *(const f32x4*)(mb + 1024 + c); sc1 = *(const f32x4*)(mb + 1024 + c + 4); }
            const f32x4 a0 = g0 * (sc0 + 1.f), a1 = g1 * (sc1 + 1.f);
#pragma unroll
            for (int ai = 0; ai < 2; ++ai)
#pragma unroll
                for (int m = 0; m < 4; ++m) {
                    const int rl = ai * HALF + wr * 64 + m * 16 + fr;
                    const float rstd = lrs[rl];
                    const size_t ro = (size_t)(u.pm * BM + rl) * DM + c;
                    const f32x4 h0 = (acc[ai][bj][m][0] * rstd) * a0 + sh0, h1 = (acc[ai][bj][m][1] * rstd) * a1 + sh1;
                    if (last) { *(f32x4*)(out32 + ro) = h0; *(f32x4*)(out32 + ro + 4) = h1; }
                    else { u32x4 w; w.x = cvt_pk_bf16(h0[0], h0[1]); w.y = cvt_pk_bf16(h0[2], h0[3]); w.z = cvt_pk_bf16(h1[0], h1[1]); w.w = cvt_pk_bf16(h1[2], h1[3]); *(u32x4*)(H + ro) = w; }
                }
        }
    }
};

template <class Epi>
__device__ __forceinline__ void gemm_phase(LAS unsigned char* lds, const Gemm g, const Epi& E) {
    const int tid = opaque_tid(), wid = __builtin_amdgcn_readfirstlane(tid >> 6), lane = tid & 63, wr = wid >> 2, wc = wid & 3, fr = lane & 15, fq = lane >> 4;
    const int nt = g.K / BK;
    unsigned voffA[2], voffB[2];
#pragma unroll
    for (int i = 0; i < 2; ++i) { int R, C; stage_rc(tid * 16 + i * 8192, R, C); const int Rb = Epi::PERM ? ((R & ~31) + perm32(R & 31)) : R;
        const int Ra = Epi::PERMA ? (8 * ((R >> 6) * 16 + (R & 15)) + ((R >> 4) & 3)) : R;
        voffA[i] = (unsigned)(Ra * g.lda + C) * 2u; voffB[i] = (unsigned)(Rb * g.ldb + C) * 2u; }
    const size_t kstep = (size_t)(BK * 2);
    const size_t hstepA = (size_t)(Epi::PERMA ? 4 : HALF) * g.lda * 2, hstepB = (size_t)HALF * g.ldb * 2, tstepA = (size_t)BM * g.lda * 2;
    const unsigned ldsw = (unsigned)wid * 1024u;
    const int aoff = lds_byte(wr * 64 + fr, fq * 8), boff = lds_byte(wc * 32 + fr, fq * 8);
#define PG8_SA(b, h) (((b) * 2 + (h)) * HTB)
#define PG8_SB(b, h) ((4 + (b) * 2 + (h)) * HTB)
#define PG8_STAGE(bufoff, gbase, voff) do { _Pragma("unroll") for (int _i = 0; _i < 2; ++_i) \
        __builtin_amdgcn_global_load_lds((const unsigned*)((const char*)(gbase) + (voff)[_i]), (LAS unsigned*)(lds + (bufoff) + ldsw + _i * 8192), 16, 0, 0); } while (0)
#define PG8_LDA(dst, b, h) do { _Pragma("unroll") for (int m = 0; m < 4; ++m) _Pragma("unroll") for (int k = 0; k < 2; ++k) dst[m][k] = *(const LAS bf16x8*)(lds + PG8_SA(b, h) + aoff + m * 2048 + k * 1024); } while (0)
#define PG8_LDB(dst, b, h) do { _Pragma("unroll") for (int n = 0; n < 2; ++n) _Pragma("unroll") for (int k = 0; k < 2; ++k) dst[n][k] = *(const LAS bf16x8*)(lds + PG8_SB(b, h) + boff + n * 2048 + k * 1024); } while (0)
#define PG8_MMA(ai, bj, At, Bt) do { __builtin_amdgcn_s_setprio(1); _Pragma("unroll") for (int m = 0; m < 4; ++m) _Pragma("unroll") for (int n = 0; n < 2; ++n) _Pragma("unroll") for (int k = 0; k < 2; ++k) \
        acc[ai][bj][m][n] = __builtin_amdgcn_mfma_f32_16x16x32_bf16(Bt[n][k], At[m][k], acc[ai][bj][m][n], 0, 0, 0); __builtin_amdgcn_s_setprio(0); } while (0)
#define PG8_WAIT_V(n) asm volatile("s_waitcnt vmcnt(" #n ")" ::: "memory")
#define PG8_WAIT_L(n) asm volatile("s_waitcnt lgkmcnt(" #n ")" ::: "memory")
#define PG8_BAR __builtin_amdgcn_s_barrier()
#define PG8_SCHED __builtin_amdgcn_sched_barrier(0)
    Unit cur, nxt; int ui = 0;
    const int bid = opaque_bid();
    if (!next_unit(g, bid, 0, cur)) return;
    f32x4 acc[2][2][4][2];
#pragma unroll
    for (int a = 0; a < 2; ++a)
#pragma unroll
        for (int b = 0; b < 2; ++b)
#pragma unroll
            for (int m = 0; m < 4; ++m)
#pragma unroll
                for (int n = 0; n < 2; ++n) acc[a][b][m][n] = (f32x4){0.f, 0.f, 0.f, 0.f};
    bf16x8 At[4][2], B0[2][2], B1[2][2];
    const char* cA = (const char*)g.A + (size_t)cur.pm * tstepA; const char* cB = (const char*)g.Bt + (size_t)cur.pn * 2 * hstepB + (size_t)(cur.pm >> 1) * g.bk * 2;
    PG8_STAGE(PG8_SB(0, 0), cB, voffB); PG8_STAGE(PG8_SA(0, 0), cA, voffA); PG8_STAGE(PG8_SB(0, 1), cB + hstepB, voffB); PG8_STAGE(PG8_SA(0, 1), cA + hstepA, voffA);
    if (wr == 1) PG8_BAR;
    PG8_WAIT_V(4); PG8_BAR;
    PG8_STAGE(PG8_SB(1, 0), cB + kstep, voffB); PG8_STAGE(PG8_SA(1, 0), cA + kstep, voffA); PG8_STAGE(PG8_SB(1, 1), cB + hstepB + kstep, voffB);
    PG8_WAIT_V(6); PG8_BAR;
    for (;;) {
        const bool has_next = next_unit(g, bid, ui + 1, nxt);
        const char* nA = has_next ? (const char*)g.A + (size_t)nxt.pm * tstepA : cA;
        const char* nB = has_next ? (const char*)g.Bt + (size_t)nxt.pn * 2 * hstepB + (size_t)(nxt.pm >> 1) * g.bk * 2 : cB;
        for (int t = 0; t < nt; t += 2) {
            const bool last = (t == nt - 2);
            const char* a1 = cA + (size_t)(t + 1) * kstep;
            const char* a2 = last ? nA : cA + (size_t)(t + 2) * kstep; const char* b2 = last ? nB : cB + (size_t)(t + 2) * kstep;
            const char* a3 = a2 + kstep; const char* b3 = b2 + kstep;
            PG8_LDB(B0, 0, 0); PG8_SCHED; PG8_LDA(At, 0, 0); PG8_STAGE(PG8_SA(1, 1), a1 + hstepA, voffA);
            PG8_WAIT_L(8); PG8_BAR; PG8_WAIT_L(0); PG8_MMA(0, 0, At, B0); PG8_BAR; PG8_SCHED;
            PG8_LDB(B1, 0, 1); PG8_STAGE(PG8_SB(0, 0), b2, voffB);
            PG8_BAR; PG8_WAIT_L(0); PG8_MMA(0, 1, At, B1); PG8_BAR;
            PG8_LDA(At, 0, 1); PG8_STAGE(PG8_SA(0, 0), a2, voffA);
            PG8_BAR; PG8_WAIT_L(0); PG8_MMA(1, 0, At, B0); PG8_BAR; PG8_SCHED;
            PG8_STAGE(PG8_SB(0, 1), b2 + hstepB, voffB);
            PG8_WAIT_V(6); PG8_BAR; PG8_MMA(1, 1, At, B1); PG8_BAR;
            PG8_LDB(B0, 1, 0); PG8_SCHED; PG8_LDA(At, 1, 0); PG8_STAGE(PG8_SA(0, 1), a2 + hstepA, voffA);
            PG8_WAIT_L(8); PG8_BAR; PG8_WAIT_L(0); PG8_MMA(0, 0, At, B0); PG8_BAR; PG8_SCHED;
            PG8_LDB(B1, 1, 1); PG8_STAGE(PG8_SB(1, 0), b3, voffB);
            PG8_BAR; PG8_WAIT_L(0); PG8_MMA(0, 1, At, B1); PG8_BAR;
            PG8_LDA(At, 1, 1); PG8_STAGE(PG8_SA(1, 0), a3, voffA);
            PG8_BAR; PG8_WAIT_L(0); PG8_MMA(1, 0, At, B0); PG8_BAR; PG8_SCHED;
            PG8_STAGE(PG8_SB(1, 1), b3 + hstepB, voffB);
            PG8_WAIT_V(6); PG8_BAR; PG8_MMA(1, 1, At, B1); PG8_BAR;
        }
        if constexpr (!Epi::AFTER_DRAIN) E(acc, cur, wr, wc, fr, fq);
        if (!has_next) break;
#pragma unroll
        for (int a = 0; a < 2; ++a)
#pragma unroll
            for (int b = 0; b < 2; ++b)
#pragma unroll
                for (int m = 0; m < 4; ++m)
#pragma unroll
                    for (int n = 0; n < 2; ++n) acc[a][b][m][n] = (f32x4){0.f, 0.f, 0.f, 0.f};
        cur = nxt; cA = nA; cB = nB; ++ui;
    }
    PG8_WAIT_V(0);
    if (wr == 0) PG8_BAR;
    PG8_BAR;
    if constexpr (Epi::AFTER_DRAIN) E.fused(acc, cur, wr, wc, fr, fq, lds, tid);
#undef PG8_SA
#undef PG8_SB
#undef PG8_STAGE
#undef PG8_LDA
#undef PG8_LDB
#undef PG8_MMA
#undef PG8_WAIT_V
#undef PG8_WAIT_L
#undef PG8_BAR
#undef PG8_SCHED
}

__device__ __forceinline__ void phase_mod(const Params& p, LAS unsigned char* lds) {
    const int tid = opaque_tid(), wid = tid >> 6, lane = tid & 63;
    LAS float* sc = (LAS float*)lds;
    LAS float* red = (LAS float*)(lds + 32768);
    float* mod = (float*)(p.ws + WS_MOD);
    for (int t = tid; t < NB * DM; t += 512) sc[t] = silu_f(p.c[t]);
    __syncthreads();
    for (int it = opaque_bid(); it < 192; it += gridDim.x) {
        const int col = it * 64 + lane, i = col / 3072, j = col - i * 3072;
        const float* w = p.ada_w + ((size_t)i * DM + wid * 128) * 3072 + j;
        float a[8];
#pragma unroll
        for (int b = 0; b < 8; ++b) a[b] = 0.f;
#pragma unroll 16
        for (int k = 0; k < 128; ++k) {
            const float wv = w[(size_t)k * 3072];
#pragma unroll
            for (int b = 0; b < 8; ++b) a[b] += sc[b * DM + wid * 128 + k] * wv;
        }
#pragma unroll
        for (int b = 0; b < 8; ++b) red[(wid * 8 + b) * 64 + lane] = a[b];
        __syncthreads();
        {
            const int b = tid >> 6; float s = 0.f;
#pragma unroll
            for (int w8 = 0; w8 < 8; ++w8) s += red[(w8 * 8 + b) * 64 + lane];
            mod[((size_t)i * NB + b) * 3072 + j] = s + p.ada_b[i * 3072 + j];
        }
        __syncthreads();
    }
}

__device__ __forceinline__ void conv_tile(const float* __restrict__ src, int srcN, int c0, bf16_t* __restrict__ dstrow, int K, int k0, LAS float* T, int csrc = -1) {
    const int tid = opaque_tid();
    const int cs = csrc >= 0 ? csrc : c0 + (tid & 15) * 4;
    f32x4 v[8];
#pragma unroll
    for (int ps = 0; ps < 8; ++ps) v[ps] = *(const f32x4*)(src + (size_t)(k0 + ps * 32 + (tid >> 4)) * srcN + cs);
#pragma unroll
    for (int ps = 0; ps < 8; ++ps) { LAS float* t = T + (ps * 32 + (tid >> 4)) * 65 + (tid & 15) * 4; t[0] = v[ps][0]; t[1] = v[ps][1]; t[2] = v[ps][2]; t[3] = v[ps][3]; }
    __syncthreads();
#pragma unroll
    for (int q = 0; q < 4; ++q) {
        const int item = tid + 512 * q, n = item >> 5, kg = item & 31; const LAS float* s = T + (kg * 8) * 65 + n;
        u32x4 o; o.x = cvt_pk_bf16(s[0], s[65]); o.y = cvt_pk_bf16(s[130], s[195]); o.z = cvt_pk_bf16(s[260], s[325]); o.w = cvt_pk_bf16(s[390], s[455]);
        *(u32x4*)(dstrow + (size_t)n * K + k0 + kg * 8) = o;
    }
    __syncthreads();
}

__device__ __forceinline__ void norm_rows(const Params& p, int layer, const float* xin, int item) {
    const int tid = opaque_tid(), wid = tid >> 6, lane = tid & 63;
    bf16_t* H = (bf16_t*)g_h;
    const float* mod = (const float*)(p.ws + WS_MOD) + (size_t)layer * NB * 3072;
    const float* gp = p.norm_g + (size_t)layer * DM;
#pragma unroll
    for (int h2 = 0; h2 < 2; ++h2) {
        const int row = item * 16 + h2 * 8 + wid, b = row >> 11;
        const f32x4* xr = (const f32x4*)(xin + (size_t)row * DM) + lane;
        f32x4 v[4]; float ss = 0.f;
#pragma unroll
        for (int q = 0; q < 4; ++q) { v[q] = xr[64 * q]; ss += (v[q][0] * v[q][0] + v[q][1] * v[q][1]) + (v[q][2] * v[q][2] + v[q][3] * v[q][3]); }
        const float rstd = rsqrtf(wave_sum(ss) * (1.f / DM) + EPS);
        const float* mb = mod + (size_t)b * 3072;
        u32x2* o8 = (u32x2*)(H + (size_t)row * DM) + lane;
#pragma unroll
        for (int q = 0; q < 4; ++q) {
            const int k = (lane + 64 * q) * 4;
            const f32x4 gv = *(const f32x4*)(gp + k), sh = *(const f32x4*)(mb + k), scl = *(const f32x4*)(mb + 1024 + k);
            const f32x4 hv = (v[q] * rstd * gv) * (scl + 1.f) + sh;
            u32x2 w; w.x = cvt_pk_bf16(hv[0], hv[1]); w.y = cvt_pk_bf16(hv[2], hv[3]);
            o8[64 * q] = w;
        }
    }
}
__device__ __forceinline__ void phase_norm_even(const Params& p, int j, const float* xin, LAS unsigned char* lds) {
    const int tid = opaque_tid();
    bf16_t* WIN_E = (bf16_t*)(p.ws + WS_WIN_E); bf16_t* WIN_O = (bf16_t*)(p.ws + WS_WIN_O); bf16_t* WOUT_E = (bf16_t*)(p.ws + WS_WOUT_E); bf16_t* WOUT_O = (bf16_t*)(p.ws + WS_WOUT_O);
    bf16_t* SGU = (bf16_t*)(p.ws + WS_SGU); bf16_t* POOLT = (bf16_t*)(p.ws + WS_POOLT); bf16_t* WINP = (bf16_t*)(p.ws + WS_WINP);
    constexpr int N0 = 448, N1 = N0 + 128, N2 = N1 + 128, N3 = N2 + 128, N4 = N3 + 64, N5 = N4 + 32, N6 = N5 + 512;
    const int TOTAL = N6 + (j == 0 ? MTOK / 16 : 0);
    for (int it = opaque_bid(); it < TOTAL; it += gridDim.x) {
        if (it < N0) {
            const int rt = it >> 2, kt = it & 3, r0 = rt * 64, T = r0 >> 8, q = r0 & 255; int c0 = 0, csrc = -1;
            if (T < 16) {
                const int cg = tid & 15, bj = q >> 7, wcc = ((q >> 6) & 1) * 2 + (cg >> 3), fq4 = (cg >> 1) & 3, n = cg & 1;
                const int tbase = bj == 0 ? (n == 0 ? 2048 : 0) : (n == 0 ? 1024 : 3072);
                csrc = tbase + 64 * T + 16 * wcc + 4 * fq4;
            }
            else if (T < 24) c0 = (q < 128) ? (4096 + 128 * (T - 16) + q) : (6144 + 128 * (T - 16) + q - 128);
            else c0 = 5120 + 256 * (T - 24) + q;
            conv_tile(p.ab_w_in + (size_t)j * DM * 7168, 7168, c0, WIN_E + (size_t)r0 * DM, DM, kt * 256, (LAS float*)lds, csrc);
        } else if (it < N1) {
            const int i2 = it - N0, rt = i2 >> 3, kt = i2 & 7, r0 = rt * 64;
            conv_tile(p.ab_w_out + (size_t)j * 2048 * DM, DM, r0, WOUT_E + (size_t)r0 * 2048, 2048, kt * 256, (LAS float*)lds);
        } else if (it < N2) {
            const int i2 = it - N1, rt = i2 >> 2, kt = i2 & 3, r0 = rt * 64;
            conv_tile(p.c_w_in + (size_t)j * DM * 4096, 4096, 2048 + r0, WIN_O + (size_t)((r0 >> 7) * 256 + 128 + (r0 & 127)) * DM, DM, kt * 256, (LAS float*)lds);
        } else if (it < N3) {
            const int i2 = it - N2, rt = i2 >> 3, kt = i2 & 7, r0 = rt * 64;
            conv_tile(p.c_w_out + (size_t)j * 2048 * DM, DM, r0, WOUT_O + (size_t)r0 * 2048, 2048, kt * 256, (LAS float*)lds);
        } else if (it < N4) {
            const int i3 = it - N3, g = i3 >> 4, r = i3 & 15, rt = r >> 1, kt = r & 1, r0 = rt * 64;
            conv_tile(p.c_pool_w + ((size_t)j * 4 + g) * 512 * 512, 512, r0, POOLT + (size_t)g * 512 * 512 + (size_t)r0 * 512, 512, kt * 256, (LAS float*)lds);
        } else if (it < N5) {
            const int e0 = (it - N4) * 4096 + tid * 8, t = (e0 >> 7) & 127, s0 = e0 & 127;
            const float* src = p.ab_sgu_w + (size_t)j * 8 * 128 * 128 + e0;
            const f32x4 a = *(const f32x4*)src, b = *(const f32x4*)(src + 4);
            float v[8] = {a[0], a[1], a[2], a[3], b[0], b[1], b[2], b[3]};
#pragma unroll
            for (int e = 0; e < 8; ++e) v[e] = (s0 + e <= t) ? v[e] : 0.f;
            u32x4 o; o.x = cvt_pk_bf16(v[0], v[1]); o.y = cvt_pk_bf16(v[2], v[3]); o.z = cvt_pk_bf16(v[4], v[5]); o.w = cvt_pk_bf16(v[6], v[7]);
            *(u32x4*)(SGU + e0) = o;
        } else if (it < N6) {
            const int e0 = (it - N5) * 4096 + tid * 8, k = e0 >> 11, c = e0 & 2047;
            const float* src = p.c_w_in + ((size_t)j * DM + k) * 4096 + c;
            const f32x4 a = *(const f32x4*)src, b = *(const f32x4*)(src + 4);
            u32x4 o; o.x = cvt_pk_bf16(a[0], a[1]); o.y = cvt_pk_bf16(a[2], a[3]); o.z = cvt_pk_bf16(b[0], b[1]); o.w = cvt_pk_bf16(b[2], b[3]);
            *(u32x4*)(WINP + e0) = o;
        } else norm_rows(p, 2 * j, xin, it - N6);
    }
}
__device__ __forceinline__ void phase_final(const Params& p) {
    const int tid = opaque_tid(), wid = tid >> 6, lane = tid & 63;
    for (int it = opaque_bid(); it < MTOK / 8; it += gridDim.x) {
        const int row = it * 8 + wid;
        f32x4* xr = (f32x4*)(p.out + (size_t)row * DM) + lane;
        f32x4 v[4]; float ss = 0.f;
#pragma unroll
        for (int q = 0; q < 4; ++q) { v[q] = xr[64 * q]; ss += (v[q][0] * v[q][0] + v[q][1] * v[q][1]) + (v[q][2] * v[q][2] + v[q][3] * v[q][3]); }
        const float rstd = rsqrtf(wave_sum(ss) * (1.f / DM) + EPS);
#pragma unroll
        for (int q = 0; q < 4; ++q) { const f32x4 gv = *(const f32x4*)(p.final_g + (lane + 64 * q) * 4); xr[64 * q] = v[q] * rstd * gv; }
    }
}

__device__ __forceinline__ void unpack8(const u32x4 w, float (&f)[8]) {
    f[0] = bf_lo(w.x); f[1] = bf_hi(w.x); f[2] = bf_lo(w.y); f[3] = bf_hi(w.y); f[4] = bf_lo(w.z); f[5] = bf_hi(w.z); f[6] = bf_lo(w.w); f[7] = bf_hi(w.w);
}

__device__ __forceinline__ void phase_mix(const Params& p, int j, LAS unsigned char* lds) {
    const int tid = opaque_tid(), wid = tid >> 6, lane = tid & 63;
    const bf16_t* CH2 = (const bf16_t*)(p.ws + WS_RP); const bf16_t* BZ = CH2 + (size_t)MTOK * 1024; const bf16_t* UZ = BZ + (size_t)MTOK * 1024; const bf16_t* V = UZ + (size_t)MTOK * 1024;
    bf16_t* Y = (bf16_t*)(p.ws + WS_RA);
    if (blockIdx.x < 32) {
        Gemm g{(const bf16_t*)(p.ws + WS_POOLT), (const bf16_t*)(p.ws + WS_WINP), 512, 2048, 512, 8, 4, 512}; EpiProd E{(bf16_t*)(p.ws + WS_WIN_O)};
        gemm_phase(lds, g, E);
        __syncthreads();
    }
    {
        const bf16_t* Wm = (const bf16_t*)(p.ws + WS_SGU);
        LAS bf16_t* vnT = (LAS bf16_t*)lds;
        LAS float* red = (LAS float*)(lds + 36864);
        const int fr = lane & 15, fq = lane >> 4;
        const int s = lane + 64 * (wid & 1), q = wid >> 1;
        int it = opaque_bid();
        u32x4 vraw[4];
        if (it < 1024) { const bf16_t* vp = V + (size_t)((it >> 3) * 128 + s) * 1024 + (it & 7) * 128 + 32 * q;
#pragma unroll
            for (int i = 0; i < 4; ++i) vraw[i] = *(const u32x4*)(vp + 8 * i); }
        for (; it < 1024; it += gridDim.x) {
            const int hh = it & 7, cn = it >> 3;
            const int t = 16 * wid + fr; const size_t row = (size_t)cn * 128 + t;
            u32x2 uz[8];
#pragma unroll
            for (int n = 0; n < 8; ++n) uz[n] = *(const u32x2*)(UZ + row * 1024 + hh * 128 + 16 * n + 4 * fq);
            const float bias = p.ab_sgu_b[(size_t)j * 1024 + hh * 128 + t];
            const bf16_t* wrow = Wm + ((size_t)hh * 128 + 16 * wid + fr) * 128 + 8 * fq;
            bf16x8 af[4];
#pragma unroll
            for (int kk = 0; kk < 4; ++kk) af[kk] = *(const bf16x8*)(wrow + 32 * kk);
            float f[32];
#pragma unroll
            for (int i = 0; i < 4; ++i) { float t8[8]; unpack8(vraw[i], t8);
#pragma unroll
                for (int e = 0; e < 8; ++e) f[8 * i + e] = t8[e]; }
            float s1 = 0.f, s2 = 0.f;
#pragma unroll
            for (int i = 0; i < 32; ++i) { s1 += f[i]; s2 += f[i] * f[i]; }
            red[(s * 4 + q) * 2] = s1; red[(s * 4 + q) * 2 + 1] = s2;
            __syncthreads();
            {
                const int itn = it + gridDim.x;
                if (itn < 1024) { const bf16_t* vp = V + (size_t)((itn >> 3) * 128 + s) * 1024 + (itn & 7) * 128 + 32 * q;
#pragma unroll
                    for (int i = 0; i < 4; ++i) vraw[i] = *(const u32x4*)(vp + 8 * i); }
            }
            float S1 = 0.f, S2 = 0.f;
#pragma unroll
            for (int qq = 0; qq < 4; ++qq) { S1 += red[(s * 4 + qq) * 2]; S2 += red[(s * 4 + qq) * 2 + 1]; }
            const float mu = S1 * (1.f / 128.f), var = fmaxf(S2 * (1.f / 128.f) - mu * mu, 0.f), rstd = rsqrtf(var + EPS);
            const float* lg = p.ab_ln_g + (size_t)j * 1024 + hh * 128 + 32 * q; const float* lb = p.ab_ln_b + (size_t)j * 1024 + hh * 128 + 32 * q;
#pragma unroll
            for (int i = 0; i < 32; ++i) {
                const float vn = (f[i] - mu) * rstd * lg[i] + lb[i];
                vnT[(32 * q + i) * 136 + s] = (bf16_t)(cvt_pk_bf16(vn, 0.f) & 0xffffu);
            }
            __syncthreads();
            f32x4 acc[8];
#pragma unroll
            for (int n = 0; n < 8; ++n) acc[n] = (f32x4){0.f, 0.f, 0.f, 0.f};
#pragma unroll
            for (int kk = 0; kk < 4; ++kk) {
                if (32 * kk <= 16 * wid + 15) {
#pragma unroll
                    for (int n = 0; n < 8; ++n) {
                        const bf16x8 bfm = *(const LAS bf16x8*)(vnT + (16 * n + fr) * 136 + 32 * kk + 8 * fq);
                        acc[n] = __builtin_amdgcn_mfma_f32_16x16x32_bf16(bfm, af[kk], acc[n], 0, 0, 0);
                    }
                }
            }
#pragma unroll
            for (int n = 0; n < 8; ++n) {
                const int d = 16 * n + 4 * fq;
                u32x2 w; w.x = cvt_pk_bf16(bf_lo(uz[n].x) * (acc[n][0] + bias), bf_hi(uz[n].x) * (acc[n][1] + bias));
                w.y = cvt_pk_bf16(bf_lo(uz[n].y) * (acc[n][2] + bias), bf_hi(uz[n].y) * (acc[n][3] + bias));
                *(u32x2*)(Y + row * 2048 + 1024 + hh * 128 + d) = w;
            }
        }
    }
    {
        const float* halo = (const float*)(p.ws + WS_HALO); const float* cw = p.ab_conv_w + (size_t)j * 3 * 1024;
        for (int gid = opaque_bid() * 512 + tid; gid < 128 * 1024; gid += gridDim.x * 512) {
            const int B = gid >> 10, c = gid & 1023; const bool hist = ((B * 128) & (SEQ - 1)) != 0;
            const float* hb = halo + (size_t)B * 6 * 1024 + c;
            const float c6 = hist ? hb[-6 * 1024] : 0.f, c7 = hist ? hb[-5 * 1024] : 0.f, c0 = hb[2 * 1024], c1 = hb[3 * 1024], b0 = hb[4 * 1024], b1 = hb[5 * 1024];
            const float w0 = cw[c], w1 = cw[1024 + c], w2 = cw[2048 + c];
            const float y0 = b0 * (w0 * c6 + w1 * c7 + w2 * c0), y1 = b1 * (w0 * c7 + w1 * c0 + w2 * c1);
            Y[(size_t)(B * 128) * 2048 + c] = (bf16_t)(cvt_pk_bf16(y0, 0.f) & 0xffffu);
            Y[(size_t)(B * 128 + 1) * 2048 + c] = (bf16_t)(cvt_pk_bf16(y1, 0.f) & 0xffffu);
        }
    }
}

__device__ __forceinline__ void phase_pool(const Params& p) {
    const int tid = opaque_tid();
    const bf16_t* HQ = (const bf16_t*)(p.ws + WS_HQ); const bf16_t* HS = (const bf16_t*)(p.ws + WS_HS); bf16_t* Y = (bf16_t*)(p.ws + WS_RA);
    for (int gid = opaque_bid() * 512 + tid; gid < 128 * 256; gid += gridDim.x * 512) {
        const int B = gid >> 8, ct = gid & 255, c0 = ct * 8, win = 2 << (ct >> 6); const bool hist = ((B * 128) & (SEQ - 1)) != 0;
        const bf16_t* tail = HQ + (size_t)(B - 1) * 32 * 2048 + c0;
        const bf16_t* head = HQ + ((size_t)B * 32 + 16) * 2048 + c0;
        const bf16_t* hs = HS + (size_t)B * 16 * 2048 + c0;
        float S[8];
#pragma unroll
        for (int e = 0; e < 8; ++e) S[e] = 0.f;
        if (hist) {
#pragma unroll
            for (int i = 1; i < 16; ++i) {
                if (i < win) { float v[8]; unpack8(*(const u32x4*)(tail + (size_t)(16 - i) * 2048), v);
#pragma unroll
                    for (int e = 0; e < 8; ++e) S[e] += v[e]; }
            }
        }
#pragma unroll 4
        for (int r = 0; r < 16; ++r) {
            float cur[8], sz[8], o[8];
            unpack8(*(const u32x4*)(head + (size_t)r * 2048), cur);
            unpack8(*(const u32x4*)(hs + (size_t)r * 2048), sz);
            const float inv = 1.f / (float)(hist ? win : min(r + 1, win));
#pragma unroll
            for (int e = 0; e < 8; ++e) { S[e] += cur[e]; o[e] = (S[e] * inv - cur[e]) * sz[e]; }
            u32x4 w; w.x = cvt_pk_bf16(o[0], o[1]); w.y = cvt_pk_bf16(o[2], o[3]); w.z = cvt_pk_bf16(o[4], o[5]); w.w = cvt_pk_bf16(o[6], o[7]);
            *(u32x4*)(Y + (size_t)(B * 128 + r) * 2048 + c0) = w;
            const int ro = r - win + 1;
            if (ro >= 0 || hist) { float old[8]; unpack8(*(const u32x4*)(ro >= 0 ? head + (size_t)ro * 2048 : tail + (size_t)(16 + ro) * 2048), old);
#pragma unroll
                for (int e = 0; e < 8; ++e) S[e] -= old[e]; }
        }
    }
}

#define XB_TMO      128
#define XB_XCNT(j)  (256  + 64 * (j))
#define XB_XSUB(j)  (1280 + 64 * (j))
#define XB_XGEN(j)  (2304 + 64 * (j))
#define XB_TOP      3328
#define XB_TOPGEN   3392
#define XCD_BAR_WORDS 3456
#define XB_SPIN_CAP (1u << 18)
__device__ __forceinline__ unsigned xb_ld(unsigned* p)              { return __hip_atomic_load(p, __ATOMIC_RELAXED, __HIP_MEMORY_SCOPE_AGENT); }
__device__ __forceinline__ unsigned xb_add(unsigned* p, unsigned v) { return __hip_atomic_fetch_add(p, v, __ATOMIC_RELAXED, __HIP_MEMORY_SCOPE_AGENT); }
__device__ __forceinline__ unsigned xb_xcc_id() { return (unsigned)__builtin_amdgcn_s_getreg((3 << 11) | 20) & 0xFu; }
#define XB_SPIN(cond, bar) do { unsigned _sp = 0; while (cond) { __builtin_amdgcn_s_sleep(1); \
    if ((++_sp & 255u) == 0u) { if (xb_ld(&(bar)[XB_TMO])) break; if (_sp > XB_SPIN_CAP) { atomicAdd(&(bar)[XB_TMO], 1u); break; } } } } while (0)
struct XcdBarrier { unsigned* bar; unsigned x; volatile LAS unsigned* st; };
__device__ __forceinline__ XcdBarrier xcd_barrier_post(unsigned* bar, volatile LAS unsigned* st) {
    XcdBarrier b; b.bar = bar; b.x = xb_xcc_id(); b.st = st;
    if (threadIdx.x == 0) (void)xb_add(&bar[XB_XCNT(b.x)], 1u);
    return b;
}
__device__ __forceinline__ void xcd_barrier_complete(unsigned* bar, unsigned x, unsigned& nloc, unsigned& nx) {
    const unsigned G = gridDim.x * gridDim.y * gridDim.z;
    unsigned sum, cnt, mine, sp = 0u;
    for (;;) {
        sum = 0u; cnt = 0u; mine = 0u;
#pragma unroll
        for (unsigned j = 0; j < 16; ++j) { const unsigned c = xb_ld(&bar[XB_XCNT(j)]); sum += c; cnt += (c > 0u) ? 1u : 0u; mine = (j == x) ? c : mine; }
        if (sum == G) break;
        __builtin_amdgcn_s_sleep(1);
        if ((++sp & 255u) == 0u) { if (xb_ld(&bar[XB_TMO])) break; if (sp > XB_SPIN_CAP) { atomicAdd(&bar[XB_TMO], 1u); break; } }
    }
    nloc = mine > 0u ? mine : 1u; nx = cnt > 0u ? cnt : 1u;
}
__device__ __forceinline__ void xcd_barrier(const XcdBarrier& b) {
    asm volatile("s_waitcnt vmcnt(0)" ::: "memory");
    __syncthreads();
    if (threadIdx.x == 0) {
        unsigned* bar = b.bar;
        __builtin_amdgcn_s_waitcnt(0);
        unsigned nloc = b.st[0], nx = b.st[1];
        if (nloc == 0u) { xcd_barrier_complete(bar, b.x, nloc, nx); b.st[0] = nloc; b.st[1] = nx; }
        const unsigned old = xb_add(&bar[XB_XSUB(b.x)], 1u);
        const unsigned gen = old / nloc;
        if (old + 1u == (gen + 1u) * nloc) {
            __builtin_amdgcn_fence(__ATOMIC_RELEASE, "agent");
            asm volatile("s_waitcnt vmcnt(0)" ::: "memory");
            const unsigned og = xb_add(&bar[XB_TOP], 1u);
            const unsigned tg = og / nx;
            if (og + 1u == (tg + 1u) * nx) xb_add(&bar[XB_TOPGEN], 1u);
            else XB_SPIN(xb_ld(&bar[XB_TOPGEN]) == tg, bar);
            __builtin_amdgcn_fence(__ATOMIC_ACQUIRE, "agent");
            xb_add(&bar[XB_XGEN(b.x)], 1u);
            asm volatile("s_waitcnt vmcnt(0)" ::: "memory");
        } else {
            XB_SPIN(xb_ld(&bar[XB_XGEN(b.x)]) == gen, bar);
            __builtin_amdgcn_fence(__ATOMIC_ACQUIRE, "agent");
            asm volatile("s_waitcnt vmcnt(0)" ::: "memory");
        }
    }
    __syncthreads();
}

__global__ void __launch_bounds__(512, 2) mega_fwd(Params p, int ph_lo, int ph_hi) {
    extern __shared__ __attribute__((aligned(16))) unsigned char smem[];
    LAS unsigned char* lds = (LAS unsigned char*)smem;
    cg::grid_group grid = cg::this_grid();
    if (ph_hi < 0) grid.sync();
    volatile LAS unsigned* st = (volatile LAS unsigned*)(lds + STAGE_BYTES);
    if (threadIdx.x < 4) st[threadIdx.x] = 0u;
    __syncthreads();
    const XcdBarrier xb = xcd_barrier_post((unsigned*)(p.ws + WS_BAR), st);
    int ph = 0;
#define PHASE(REP, ...) do { if (ph >= ph_lo && ph < ph_hi) { for (int _r = 0; _r < (REP); ++_r) { __VA_ARGS__; if (ph + 1 < ph_hi) xcd_barrier(xb); } } ++ph; } while (0)
    bf16_t* RA = (bf16_t*)(p.ws + WS_RA); bf16_t* RP = (bf16_t*)(p.ws + WS_RP);
    const bf16_t* WIN_E = (const bf16_t*)(p.ws + WS_WIN_E); const bf16_t* WIN_O = (const bf16_t*)(p.ws + WS_WIN_O);
    const bf16_t* WOUT_E = (const bf16_t*)(p.ws + WS_WOUT_E); const bf16_t* WOUT_O = (const bf16_t*)(p.ws + WS_WOUT_O);
    const float* mod = (const float*)(p.ws + WS_MOD);
    float* part = (float*)(p.ws + WS_PART); unsigned* cnt = (unsigned*)(p.ws + WS_BAR) + CNT_WORD0;
    PHASE(REP_THIN, phase_mod(p, lds));
#pragma unroll 1
    for (int lp = 0; lp < 2; ++lp) {
        {
            const int layer = 2 * lp; const float* xin = (lp == 0) ? p.x : p.out;
            PHASE(REP_THIN, phase_norm_even(p, lp, xin, lds));
            PHASE(REP_G1, { Gemm g{(const bf16_t*)g_h, WIN_E, DM, DM, DM, MTOK / BM, 7168 / BM, 0}; EpiEven E{RP, RA, (float*)(p.ws + WS_HALO), p.ab_conv_w + (size_t)lp * 3 * 1024}; gemm_phase(lds, g, E); });
            PHASE(REP_THIN, phase_mix(p, lp, lds));
            PHASE(1, { Gemm g{RA, WOUT_E, 2048, 2048, 2048, MTOK / BM, DM / BM, 0};
                       EpiResNorm E{lp == 0 ? p.x : nullptr, (const bf16_t*)g_x, (bf16_t*)g_x, p.out, mod + (size_t)layer * NB * 3072 + 2048, (bf16_t*)g_h, p.norm_g + (size_t)(layer + 1) * DM, mod + (size_t)(layer + 1) * NB * 3072,
                                    part + (size_t)layer * 4 * MTOK, cnt + layer * 64, 0};
                       gemm_phase(lds, g, E); });
        }
        {
            const int layer = 2 * lp + 1; const int last = (lp == 1) ? 1 : 0;
            PHASE(REP_G1, { Gemm g{(const bf16_t*)g_h, WIN_O, DM, DM, DM, MTOK / BM, 4096 / BM, 0}; EpiOdd E{RA, (bf16_t*)(p.ws + WS_HQ), (bf16_t*)(p.ws + WS_HS), p.c_pool_scale + (size_t)lp * 2048}; gemm_phase(lds, g, E); });
            PHASE(REP_THIN, phase_pool(p));
            PHASE(1, { Gemm g{RA, WOUT_O, 2048, 2048, 2048, MTOK / BM, DM / BM, 0};
                       EpiResNorm E{nullptr, (const bf16_t*)g_x, (bf16_t*)g_x, p.out, mod + (size_t)layer * NB * 3072 + 2048, (bf16_t*)g_h, last ? p.final_g : p.norm_g + (size_t)(layer + 1) * DM, mod + (size_t)(last ? layer : layer + 1) * NB * 3072,
                                    part + (size_t)layer * 4 * MTOK, cnt + layer * 64, last};
                       gemm_phase(lds, g, E); });
        }
    }
#undef PHASE
}

extern "C" void kernel_launch(void* const* d_in, const int* in_sizes, int n_in, void* d_out, int out_size, void* d_ws, size_t ws_size, hipStream_t stream) {
    static int grid = 0;
    if (grid == 0) {
        if (n_in != 17 || out_size != MTOK * DM || ws_size < WS_END2) { fprintf(stderr, "kernel_launch: unexpected shapes (n_in %d out %d ws %zu need %zu)\n", n_in, out_size, ws_size, (size_t)WS_END2); grid = -1; return; }
        int dev = 0, cus = 0, per_cu = 0;
        hipGetDevice(&dev);
        hipDeviceGetAttribute(&cus, hipDeviceAttributeMultiprocessorCount, dev);
        if (hipFuncSetAttribute((const void*)mega_fwd, hipFuncAttributeMaxDynamicSharedMemorySize, LDS_BYTES) != hipSuccess) { fprintf(stderr, "kernel_launch: hipFuncSetAttribute failed\n"); grid = -1; return; }
        hipOccupancyMaxActiveBlocksPerMultiprocessor(&per_cu, (const void*)mega_fwd, 512, LDS_BYTES);
        if (per_cu < 1) { fprintf(stderr, "kernel_launch: occupancy query says %d blocks per CU\n", per_cu); per_cu = 1; }
        (void)hipGetLastError();
        grid = cus;
        if (grid != 256) { fprintf(stderr, "kernel_launch: built for 256 CUs (one out-projection tile per workgroup), got %d\n", grid); grid = -1; return; }
    }
    if (grid < 0) return;
    Params p{};
    p.x = (const float*)d_in[0]; p.c = (const float*)d_in[1]; p.norm_g = (const float*)d_in[2]; p.ada_w = (const float*)d_in[3]; p.ada_b = (const float*)d_in[4];
    p.ab_w_in = (const float*)d_in[5]; p.ab_conv_w = (const float*)d_in[6]; p.ab_ln_g = (const float*)d_in[7]; p.ab_ln_b = (const float*)d_in[8];
    p.ab_sgu_w = (const float*)d_in[9]; p.ab_sgu_b = (const float*)d_in[10]; p.ab_w_out = (const float*)d_in[11];
    p.c_w_in = (const float*)d_in[12]; p.c_pool_w = (const float*)d_in[13]; p.c_pool_scale = (const float*)d_in[14]; p.c_w_out = (const float*)d_in[15]; p.final_g = (const float*)d_in[16];
    p.out = (float*)d_out; p.ws = (unsigned char*)d_ws;
    if (hipMemsetAsync((unsigned char*)d_ws + WS_BAR, 0, CTL_WORDS * 4, stream) != hipSuccess) { fprintf(stderr, "kernel_launch: barrier memset failed\n"); return; }
    int lo = 0, hi = 15;
    void* args[] = {&p, &lo, &hi};
    hipError_t e = hipLaunchCooperativeKernel((const void*)mega_fwd, dim3(grid), dim3(512), args, LDS_BYTES, stream);
    if (e != hipSuccess) fprintf(stderr, "kernel_launch: cooperative launch failed: %s (grid %d)\n", hipGetErrorString(e), grid);
}
```

```cpp
#include <hip/hip_runtime.h>
#include <hip/hip_cooperative_groups.h>
#include <cstdio>
namespace cg = cooperative_groups;

#define LAS __attribute__((address_space(3)))
typedef unsigned short bf16_t;
typedef short bf16x8 __attribute__((ext_vector_type(8)));
typedef float f32x4 __attribute__((ext_vector_type(4)));
typedef unsigned u32x4 __attribute__((ext_vector_type(4)));
typedef unsigned u32x2 __attribute__((ext_vector_type(2)));

constexpr int DM = 1024, NB = 8, SEQ = 2048, MTOK = NB * SEQ;
constexpr int BM = 256, BK = 64, HALF = 128, HTB = HALF * BK * 2, STAGE_BYTES = 8 * HTB, NXCD = 8, WGM = 8;
constexpr int LDS_BYTES = STAGE_BYTES + 16;
constexpr float EPS = 1e-6f;
constexpr int REP_G1 = 1, REP_THIN = 1, REP_G2L0 = 1;

constexpr size_t WS_MOD = 0;
constexpr size_t WS_BAR = 393216;
constexpr size_t WS_WIN_E = 524288;
constexpr size_t WS_WIN_O = WS_WIN_E + (size_t)7168 * 1024 * 2;
constexpr size_t WS_WOUT_E = WS_WIN_O + (size_t)4096 * 1024 * 2;
constexpr size_t WS_WOUT_O = WS_WOUT_E + (size_t)1024 * 2048 * 2;
constexpr size_t WS_SGU = WS_WOUT_O + (size_t)1024 * 2048 * 2;
constexpr size_t WS_POOLT = WS_SGU + (size_t)8 * 128 * 128 * 2;
constexpr size_t WS_WINP = WS_POOLT + (size_t)4 * 512 * 512 * 2;
constexpr size_t WS_RA = WS_WINP + (size_t)1024 * 2048 * 2;
constexpr size_t WS_RP = WS_RA + (size_t)MTOK * 2048 * 2;
constexpr size_t WS_END = WS_RP + (size_t)MTOK * 4096 * 2;

constexpr size_t WS_PART = WS_END;
constexpr size_t WS_HALO = WS_PART + (size_t)4 * 4 * MTOK * 4;
constexpr size_t WS_END2 = WS_HALO + (size_t)128 * 6 * 1024 * 4;
constexpr size_t WS_HQ = WS_RP;
constexpr size_t WS_HS = WS_HQ + (size_t)128 * 32 * 2048 * 2;
constexpr int CNT_WORD0 = 3584;
constexpr int CTL_WORDS = CNT_WORD0 + 256;
__device__ unsigned short g_x[(size_t)MTOK * DM];
__device__ unsigned short g_h[(size_t)MTOK * DM];

struct Params {
    const float *x, *c, *norm_g, *ada_w, *ada_b, *ab_w_in, *ab_conv_w, *ab_ln_g, *ab_ln_b, *ab_sgu_w, *ab_sgu_b, *ab_w_out,
        *c_w_in, *c_pool_w, *c_pool_scale, *c_w_out, *final_g;
    float* out;
    unsigned char* ws;
};

__host__ __device__ __forceinline__ int lds_byte(int r, int c) { const int st = (r >> 4) * 2 + (c >> 5), rr = r & 15, cc = c & 31, ob = rr * 64 + cc * 2; return st * 1024 + (ob ^ (((ob >> 9) & 1) << 5)); }
__host__ __device__ __forceinline__ void stage_rc(int b, int& R, int& C) { const int st = b / 1024, sb = b % 1024, swz = sb ^ (((sb >> 9) & 1) << 5); R = (st >> 1) * 16 + swz / 64; C = (st & 1) * 32 + (swz % 64) / 2; }
__host__ __device__ __forceinline__ int perm32(int rho) { const int n = rho >> 4, i = rho & 15; return 8 * (i >> 2) + 4 * n + (i & 3); }
__device__ __forceinline__ unsigned cvt_pk_bf16(float lo, float hi) { unsigned r; asm volatile("v_cvt_pk_bf16_f32 %0, %1, %2" : "=v"(r) : "v"(lo), "v"(hi)); return r; }
__device__ __forceinline__ float bf_lo(unsigned w) { return __uint_as_float(w << 16); }
__device__ __forceinline__ float bf_hi(unsigned w) { return __uint_as_float(w & 0xffff0000u); }
__device__ __forceinline__ float silu_f(float v) { return v * __builtin_amdgcn_rcpf(1.f + __expf(-v)); }
__device__ __forceinline__ float wave_sum(float v) {
#pragma unroll
    for (int o = 1; o < 64; o <<= 1) v += __shfl_xor(v, o);
    return v;
}

__device__ __forceinline__ int opaque_tid() { int t = threadIdx.x; asm volatile("" : "+v"(t)); return t; }
__device__ __forceinline__ int opaque_bid() { int b = blockIdx.x; asm volatile("" : "+s"(b)); return b; }
struct Unit { int pm, pn; };
struct Gemm { const bf16_t* A; const bf16_t* Bt; int lda, ldb, K, nM, nN, bk; };

__device__ __forceinline__ bool next_unit(const Gemm& g, int bid, int i, Unit& u) {
    const int nwg = g.nM * g.nN;
    const long L = (long)i * gridDim.x + bid; if (L >= nwg) return false;
    int wgid = (int)L; { const int q = nwg / NXCD, r = nwg % NXCD, xcd = wgid % NXCD, off = wgid / NXCD; wgid = (xcd < r ? xcd * (q + 1) : r * (q + 1) + (xcd - r) * q) + off; }
    const int nig = WGM * g.nN, gid = wgid / nig, fm = gid * WGM, gsz = (g.nM - fm) < WGM ? (g.nM - fm) : WGM;
    u.pm = fm + ((wgid % nig) % gsz); u.pn = (wgid % nig) / gsz; return true;
}

struct EpiEven {
    static constexpr bool PERM = true, AFTER_DRAIN = false, PERMA = true;
    bf16_t* P; bf16_t* Y; float* halo; const float* cw;
    __device__ __forceinline__ void operator()(const f32x4 (&acc)[2][2][4][2], const Unit& u, int wr, int wc, int fr, int fq) const {
        const int tok0 = u.pm * BM + 8 * (wr * 16 + fr), T = u.pn;
        if (T < 16) {
            const int ch = T * 64 + 16 * wc + 4 * fq;
            const f32x4 w0 = *(const f32x4*)(cw + ch), w1 = *(const f32x4*)(cw + 1024 + ch), w2 = *(const f32x4*)(cw + 2048 + ch);
            f32x4 c[8], pm1, pm2;
#pragma unroll
            for (int i = 0; i < 8; ++i) c[i] = acc[i >> 2][0][i & 3][0] * acc[i >> 2][0][i & 3][1];
#pragma unroll
            for (int j = 0; j < 4; ++j) {
                pm1[j] = __int_as_float(__builtin_amdgcn_update_dpp(0, __float_as_int(c[7][j]), 0x111, 0xf, 0xf, true));
                pm2[j] = __int_as_float(__builtin_amdgcn_update_dpp(0, __float_as_int(c[6][j]), 0x111, 0xf, 0xf, true));
            }
            float* hb = halo + (size_t)(u.pm * 2 + wr) * 6 * 1024 + ch;
            if (fr == 15) { *(f32x4*)(hb) = c[6]; *(f32x4*)(hb + 1024) = c[7]; }
            bf16_t* yp = Y + (size_t)tok0 * 2048 + ch;
#pragma unroll
            for (int i = 0; i < 8; ++i) {
                f32x4 bz = acc[i >> 2][1][i & 3][0]; const f32x4 z = acc[i >> 2][1][i & 3][1];
#pragma unroll
                for (int j = 0; j < 4; ++j) bz[j] *= silu_f(z[j]);
                const f32x4 cm1 = (i >= 1) ? c[i >= 1 ? i - 1 : 0] : pm1, cm2 = (i >= 2) ? c[i >= 2 ? i - 2 : 0] : (i == 1 ? pm1 : pm2);
                const f32x4 y = bz * (w0 * ((i == 1) ? pm1 : cm2) + w1 * cm1 + w2 * c[i]);
                if (i < 2 && fr == 0) { *(f32x4*)(hb + (2 + i) * 1024) = c[i]; *(f32x4*)(hb + (4 + i) * 1024) = bz; }
                else { u32x2 w; w.x = cvt_pk_bf16(y[0], y[1]); w.y = cvt_pk_bf16(y[2], y[3]); *(u32x2*)(yp + (size_t)i * 2048) = w; }
            }
        } else if (T < 24) {
            bf16_t* base = P + (size_t)2 * MTOK * 1024 + (size_t)tok0 * 1024 + (T - 16) * 128 + wc * 32 + 8 * fq;
#pragma unroll
            for (int i = 0; i < 8; ++i) {
                f32x4 x0 = acc[i >> 2][0][i & 3][0], x1 = acc[i >> 2][0][i & 3][1]; const f32x4 y0 = acc[i >> 2][1][i & 3][0], y1 = acc[i >> 2][1][i & 3][1];
#pragma unroll
                for (int j = 0; j < 4; ++j) { x0[j] *= silu_f(y0[j]); x1[j] *= silu_f(y1[j]); }
                u32x4 w; w.x = cvt_pk_bf16(x0[0], x0[1]); w.y = cvt_pk_bf16(x0[2], x0[3]); w.z = cvt_pk_bf16(x1[0], x1[1]); w.w = cvt_pk_bf16(x1[2], x1[3]);
                *(u32x4*)(base + (size_t)i * 1024) = w;
            }
        } else {
            bf16_t* base = P + (size_t)3 * MTOK * 1024 + (size_t)tok0 * 1024 + (T - 24) * 256 + wc * 32 + 8 * fq;
#pragma unroll
            for (int i = 0; i < 8; ++i)
#pragma unroll
                for (int bj = 0; bj < 2; ++bj) {
                    const f32x4 v0 = acc[i >> 2][bj][i & 3][0], v1 = acc[i >> 2][bj][i & 3][1];
                    u32x4 w; w.x = cvt_pk_bf16(v0[0], v0[1]); w.y = cvt_pk_bf16(v0[2], v0[3]); w.z = cvt_pk_bf16(v1[0], v1[1]); w.w = cvt_pk_bf16(v1[2], v1[3]);
                    *(u32x4*)(base + (size_t)i * 1024 + bj * HALF) = w;
                }
        }
    }
};
template <int WIN> __device__ __forceinline__ void pool_quad(const f32x4 (&acc)[2][2][4][2], int n, const f32x4 ps, unsigned (&yq)[8][2], unsigned (&qq)[8][2], unsigned (&sq)[8][2]) {
    float y[8][4], szv[8][4];
#pragma unroll
    for (int j = 0; j < 4; ++j) {
        float h[23], PS[24];
#pragma unroll
        for (int k = 0; k < 8; ++k) h[15 + k] = acc[k >> 2][0][k & 3][n][j];
#pragma unroll
        for (int k = 0; k < 8; ++k) h[7 + k] = __int_as_float(__builtin_amdgcn_update_dpp(0, __float_as_int(h[15 + k]), 0x111, 0xf, 0xf, true));
#pragma unroll
        for (int k = 1; k < 8; ++k) h[k - 1] = __int_as_float(__builtin_amdgcn_update_dpp(0, __float_as_int(h[15 + k]), 0x112, 0xf, 0xf, true));
        constexpr int LO = 16 - WIN;
#pragma unroll
        for (int x = 0; x <= LO; ++x) PS[x] = 0.f;
#pragma unroll
        for (int x = LO; x < 23; ++x) PS[x + 1] = PS[x] + h[x];
#pragma unroll
        for (int i = 0; i < 8; ++i) {
            const float w = PS[16 + i] - PS[16 + i - WIN];
            const float z = acc[i >> 2][1][i & 3][n][j];
            szv[i][j] = silu_f(z) * ps[j];
            y[i][j] = (w * (1.f / WIN) - h[15 + i]) * szv[i][j];
        }
    }
#pragma unroll
    for (int i = 0; i < 8; ++i) {
        yq[i][0] = cvt_pk_bf16(y[i][0], y[i][1]); yq[i][1] = cvt_pk_bf16(y[i][2], y[i][3]);
        qq[i][0] = cvt_pk_bf16(acc[i >> 2][0][i & 3][n][0], acc[i >> 2][0][i & 3][n][1]); qq[i][1] = cvt_pk_bf16(acc[i >> 2][0][i & 3][n][2], acc[i >> 2][0][i & 3][n][3]);
        sq[i][0] = cvt_pk_bf16(szv[i][0], szv[i][1]); sq[i][1] = cvt_pk_bf16(szv[i][2], szv[i][3]);
    }
}
struct EpiOdd {
    static constexpr bool PERM = true, AFTER_DRAIN = false, PERMA = true;
    bf16_t* Y; bf16_t* HQ; bf16_t* HS; const float* pscale;
    __device__ __forceinline__ void operator()(const f32x4 (&acc)[2][2][4][2], const Unit& u, int wr, int wc, int fr, int fq) const {
        const int T = u.pn, g = T >> 2, B = u.pm * 2 + wr;
        const int tok0 = u.pm * BM + 8 * (wr * 16 + fr);
        const int ch = T * 128 + wc * 32 + 8 * fq;
        unsigned yq[2][8][2];
#pragma unroll
        for (int n = 0; n < 2; ++n) {
            const f32x4 ps = *(const f32x4*)(pscale + ch + 4 * n);
            unsigned qq[8][2], sq[8][2];
            if (g == 0) pool_quad<2>(acc, n, ps, yq[n], qq, sq);
            else if (g == 1) pool_quad<4>(acc, n, ps, yq[n], qq, sq);
            else if (g == 2) pool_quad<8>(acc, n, ps, yq[n], qq, sq);
            else pool_quad<16>(acc, n, ps, yq[n], qq, sq);
            if (fr >= 14) {
                bf16_t* hp = HQ + ((size_t)B * 32 + (fr - 14) * 8) * 2048 + ch + 4 * n;
#pragma unroll
                for (int i = 0; i < 8; ++i) { u32x2 w; w.x = qq[i][0]; w.y = qq[i][1]; *(u32x2*)(hp + (size_t)i * 2048) = w; }
            }
            if (fr <= 1) {
                bf16_t* hp = HQ + ((size_t)B * 32 + 16 + fr * 8) * 2048 + ch + 4 * n; bf16_t* sp = HS + ((size_t)B * 16 + fr * 8) * 2048 + ch + 4 * n;
#pragma unroll
                for (int i = 0; i < 8; ++i) { u32x2 w; w.x = qq[i][0]; w.y = qq[i][1]; *(u32x2*)(hp + (size_t)i * 2048) = w; u32x2 v; v.x = sq[i][0]; v.y = sq[i][1]; *(u32x2*)(sp + (size_t)i * 2048) = v; }
            }
        }
        bf16_t* yp = Y + (size_t)tok0 * 2048 + ch;
#pragma unroll
        for (int i = 0; i < 8; ++i) { u32x4 w; w.x = yq[0][i][0]; w.y = yq[0][i][1]; w.z = yq[1][i][0]; w.w = yq[1][i][1]; *(u32x4*)(yp + (size_t)i * 2048) = w; }
    }
};
struct EpiProd {
    static constexpr bool PERM = true, AFTER_DRAIN = false, PERMA = false;
    bf16_t* O;
    __device__ __forceinline__ void operator()(const f32x4 (&acc)[2][2][4][2], const Unit& u, int wr, int wc, int fr, int fq) const {
        const int col0 = u.pn * BM + wc * 32 + 8 * fq;
#pragma unroll
        for (int ai = 0; ai < 2; ++ai)
#pragma unroll
            for (int m = 0; m < 4; ++m) {
                bf16_t* rowp = O + (size_t)((u.pm * 2 + ai) * 256 + wr * 64 + m * 16 + fr) * DM + col0;
#pragma unroll
                for (int bj = 0; bj < 2; ++bj) {
                    const f32x4 v0 = acc[ai][bj][m][0], v1 = acc[ai][bj][m][1];
                    u32x4 w; w.x = cvt_pk_bf16(v0[0], v0[1]); w.y = cvt_pk_bf16(v0[2], v0[3]); w.z = cvt_pk_bf16(v1[0], v1[1]); w.w = cvt_pk_bf16(v1[2], v1[3]);
                    *(u32x4*)(rowp + bj * HALF) = w;
                }
            }
    }
};
struct EpiBf {
    static constexpr bool PERM = true, AFTER_DRAIN = false, PERMA = false;
    bf16_t* O; int ld;
    __device__ __forceinline__ void operator()(const f32x4 (&acc)[2][2][4][2], const Unit& u, int wr, int wc, int fr, int fq) const {
        const int row0 = u.pm * BM + wr * 64 + fr, col0 = u.pn * BM + wc * 32 + 8 * fq;
#pragma unroll
        for (int ai = 0; ai < 2; ++ai)
#pragma unroll
            for (int m = 0; m < 4; ++m) {
                bf16_t* rowp = O + (size_t)(row0 + ai * HALF + m * 16) * ld + col0;
#pragma unroll
                for (int bj = 0; bj < 2; ++bj) {
                    const f32x4 v0 = acc[ai][bj][m][0], v1 = acc[ai][bj][m][1];
                    u32x4 w; w.x = cvt_pk_bf16(v0[0], v0[1]); w.y = cvt_pk_bf16(v0[2], v0[3]); w.z = cvt_pk_bf16(v1[0], v1[1]); w.w = cvt_pk_bf16(v1[2], v1[3]);
                    *(u32x4*)(rowp + bj * HALF) = w;
                }
            }
    }
};
struct EpiRes {
    static constexpr bool PERM = false, AFTER_DRAIN = false, PERMA = false;
    const float* xin; float* xout; const float* gate;
    __device__ __forceinline__ void operator()(const f32x4 (&acc)[2][2][4][2], const Unit& u, int wr, int wc, int fr, int fq) const {
        const int row0 = u.pm * BM + wr * 64 + fr, col0 = u.pn * BM + wc * 32 + 4 * fq;
        const float* gp = gate + (size_t)(u.pm >> 3) * 3072 + col0;
        f32x4 gv[2][2];
#pragma unroll
        for (int bj = 0; bj < 2; ++bj)
#pragma unroll
            for (int n = 0; n < 2; ++n) gv[bj][n] = *(const f32x4*)(gp + bj * HALF + n * 16);
#pragma unroll
        for (int ai = 0; ai < 2; ++ai)
#pragma unroll
            for (int m = 0; m < 4; ++m) {
                const size_t ro = (size_t)(row0 + ai * HALF + m * 16) * DM + col0;
#pragma unroll
                for (int bj = 0; bj < 2; ++bj)
#pragma unroll
                    for (int n = 0; n < 2; ++n) {
                        const f32x4 xv = *(const f32x4*)(xin + ro + bj * HALF + n * 16);
                        *(f32x4*)(xout + ro + bj * HALF + n * 16) = xv + gv[bj][n] * acc[ai][bj][m][n];
                    }
            }
    }
};

struct EpiResNorm {
    static constexpr bool PERM = true, AFTER_DRAIN = true, PERMA = false;
    const float* xin32; const bf16_t* xin16; bf16_t* xout16; float* out32; const float* gate; bf16_t* H; const float* ng; const float* modn; float* part; unsigned* cnt; int last;
    __device__ __forceinline__ void fused(f32x4 (&acc)[2][2][4][2], const Unit& u, int wr, int wc, int fr, int fq, LAS unsigned char* lds, int tid) const {
        const int row0 = u.pm * BM + wr * 64 + fr, col0 = u.pn * BM + wc * 32 + 8 * fq, b = u.pm >> 3;
        LAS float* lss = (LAS float*)lds;
        LAS float* lrs = (LAS float*)(lds + 4096);
        {
            const float* gp = gate + (size_t)b * 3072 + col0;
            f32x4 gv[2][2];
#pragma unroll
            for (int bj = 0; bj < 2; ++bj)
#pragma unroll
                for (int n = 0; n < 2; ++n) gv[bj][n] = *(const f32x4*)(gp + bj * HALF + 4 * n);
#pragma unroll
            for (int ai = 0; ai < 2; ++ai)
#pragma unroll
                for (int m = 0; m < 4; ++m) {
                    const size_t ro = (size_t)(row0 + ai * HALF + m * 16) * DM + col0;
                    float ss = 0.f;
#pragma unroll
                    for (int bj = 0; bj < 2; ++bj) {
                        f32x4 x0, x1;
                        if (xin32) { x0 = *(const f32x4*)(xin32 + ro + bj * HALF); x1 = *(const f32x4*)(xin32 + ro + bj * HALF + 4); }
                        else { const u32x4 w = *(const u32x4*)(xin16 + ro + bj * HALF); x0 = (f32x4){bf_lo(w.x), bf_hi(w.x), bf_lo(w.y), bf_hi(w.y)}; x1 = (f32x4){bf_lo(w.z), bf_hi(w.z), bf_lo(w.w), bf_hi(w.w)}; }
                        const f32x4 v0 = x0 + gv[bj][0] * acc[ai][bj][m][0], v1 = x1 + gv[bj][1] * acc[ai][bj][m][1];
                        acc[ai][bj][m][0] = v0; acc[ai][bj][m][1] = v1;
                        ss += ((v0[0] * v0[0] + v0[1] * v0[1]) + (v0[2] * v0[2] + v0[3] * v0[3])) + ((v1[0] * v1[0] + v1[1] * v1[1]) + (v1[2] * v1[2] + v1[3] * v1[3]));
                        if (!last) { u32x4 w; w.x = cvt_pk_bf16(v0[0], v0[1]); w.y = cvt_pk_bf16(v0[2], v0[3]); w.z = cvt_pk_bf16(v1[0], v1[1]); w.w = cvt_pk_bf16(v1[2], v1[3]); *(u32x4*)(xout16 + ro + bj * HALF) = w; }
                    }
                    ss += __shfl_xor(ss, 16); ss += __shfl_xor(ss, 32);
                    if (fq == 0) lss[(ai * HALF + wr * 64 + m * 16 + fr) * 4 + wc] = ss;
                }
        }
        __syncthreads();
        if (tid < 256) {
            const float t = (lss[tid * 4] + lss[tid * 4 + 1]) + (lss[tid * 4 + 2] + lss[tid * 4 + 3]);
            __hip_atomic_store(part + (size_t)u.pn * MTOK + u.pm * BM + tid, t, __ATOMIC_RELAXED, __HIP_MEMORY_SCOPE_AGENT);
        }
        asm volatile("s_waitcnt vmcnt(0)" ::: "memory");
        __syncthreads();
        if (tid == 0) {
            unsigned* c = cnt + u.pm;
            __hip_atomic_fetch_add(c, 1u, __ATOMIC_RELAXED, __HIP_MEMORY_SCOPE_AGENT);
            unsigned spins = 0;
            while (__hip_atomic_load(c, __ATOMIC_RELAXED, __HIP_MEMORY_SCOPE_AGENT) < 4u && ++spins < (1u << 22)) __builtin_amdgcn_s_sleep(1);
            __builtin_amdgcn_fence(__ATOMIC_ACQUIRE, "agent");
            asm volatile("s_waitcnt vmcnt(0)" ::: "memory");
        }
        __syncthreads();
        if (tid < 256) {
            float t = 0.f;
#pragma unroll
            for (int q = 0; q < 4; ++q) t += __hip_atomic_load(part + (size_t)q * MTOK + u.pm * BM + tid, __ATOMIC_RELAXED, __HIP_MEMORY_SCOPE_AGENT);
            lrs[tid] = rsqrtf(t * (1.f / DM) + EPS);
        }
        __syncthreads();
        const float* mb = modn + (size_t)b * 3072;
#pragma unroll
        for (int bj = 0; bj < 2; ++bj) {
            const int c = col0 + bj * HALF;
            const f32x4 g0 = *(const f32x4*)(ng + c), g1 = *(const f32x4*)(ng + c + 4);
            f32x4 sh0 = {0.f, 0.f, 0.f, 0.f}, sh1 = sh0, sc0 = sh0, sc1 = sh0;
            if (!last) { sh0 = *(const f32x4*)(mb + c); sh1 = *(const f32x4*)(mb + c + 4); sc0 = *(const f32x4*)(mb + 1024 + c); sc1 = *(const f32x4*)(mb + 1024 + c + 4); }
            const f32x4 a0 = g0 * (sc0 + 1.f), a1 = g1 * (sc1 + 1.f);
#pragma unroll
            for (int ai = 0; ai < 2; ++ai)
#pragma unroll
                for (int m = 0; m < 4; ++m) {
                    const int rl = ai * HALF + wr * 64 + m * 16 + fr;
                    const float rstd = lrs[rl];
                    const size_t ro = (size_t)(u.pm * BM + rl) * DM + c;
                    const f32x4 h0 = (acc[ai][bj][m][0] * rstd) * a0 + sh0, h1 = (acc[ai][bj][m][1] * rstd) * a1 + sh1;
                    if (last) { *(f32x4*)(out32 + ro) = h0; *(f32x4*)(out32 + ro + 4) = h1; }
                    else { u32x4 w; w.x = cvt_pk_bf16(h0[0], h0[1]); w.y = cvt_pk_bf16(h0[2], h0[3]); w.z = cvt_pk_bf16(h1[0], h1[1]); w.w = cvt_pk_bf16(h1[2], h1[3]); *(u32x4*)(H + ro) = w; }
                }
        }
    }
};

template <class Epi>
__device__ __forceinline__ void gemm_phase(LAS unsigned char* lds, const Gemm g, const Epi& E) {
    const int tid = opaque_tid(), wid = __builtin_amdgcn_readfirstlane(tid >> 6), lane = tid & 63, wr = wid >> 2, wc = wid & 3, fr = lane & 15, fq = lane >> 4;
    const int nt = g.K / BK;
    unsigned voffA[2], voffB[2];
#pragma unroll
    for (int i = 0; i < 2; ++i) { int R, C; stage_rc(tid * 16 + i * 8192, R, C); const int Rb = Epi::PERM ? ((R & ~31) + perm32(R & 31)) : R;
        const int Ra = Epi::PERMA ? (8 * ((R >> 6) * 16 + (R & 15)) + ((R >> 4) & 3)) : R;
        voffA[i] = (unsigned)(Ra * g.lda + C) * 2u; voffB[i] = (unsigned)(Rb * g.ldb + C) * 2u; }
    const size_t kstep = (size_t)(BK * 2);
    const size_t hstepA = (size_t)(Epi::PERMA ? 4 : HALF) * g.lda * 2, hstepB = (size_t)HALF * g.ldb * 2, tstepA = (size_t)BM * g.lda * 2;
    const unsigned ldsw = (unsigned)wid * 1024u;
    const int aoff = lds_byte(wr * 64 + fr, fq * 8), boff = lds_byte(wc * 32 + fr, fq * 8);
#define PG8_SA(b, h) (((b) * 2 + (h)) * HTB)
#define PG8_SB(b, h) ((4 + (b) * 2 + (h)) * HTB)
#define PG8_STAGE(bufoff, gbase, voff) do { _Pragma("unroll") for (int _i = 0; _i < 2; ++_i) \
        __builtin_amdgcn_global_load_lds((const unsigned*)((const char*)(gbase) + (voff)[_i]), (LAS unsigned*)(lds + (bufoff) + ldsw + _i * 8192), 16, 0, 0); } while (0)
#define PG8_LDA(dst, b, h) do { _Pragma("unroll") for (int m = 0; m < 4; ++m) _Pragma("unroll") for (int k = 0; k < 2; ++k) dst[m][k] = *(const LAS bf16x8*)(lds + PG8_SA(b, h) + aoff + m * 2048 + k * 1024); } while (0)
#define PG8_LDB(dst, b, h) do { _Pragma("unroll") for (int n = 0; n < 2; ++n) _Pragma("unroll") for (int k = 0; k < 2; ++k) dst[n][k] = *(const LAS bf16x8*)(lds + PG8_SB(b, h) + boff + n * 2048 + k * 1024); } while (0)
#define PG8_MMA(ai, bj, At, Bt) do { __builtin_amdgcn_s_setprio(1); _Pragma("unroll") for (int m = 0; m < 4; ++m) _Pragma("unroll") for (int n = 0; n < 2; ++n) _Pragma("unroll") for (int k = 0; k < 2; ++k) \
        acc[ai][bj][m][n] = __builtin_amdgcn_mfma_f32_16x16x32_bf16(Bt[n][k], At[m][k], acc[ai][bj][m][n], 0, 0, 0); __builtin_amdgcn_s_setprio(0); } while (0)
#define PG8_WAIT_V(n) asm volatile("s_waitcnt vmcnt(" #n ")" ::: "memory")
#define PG8_WAIT_L(n) asm volatile("s_waitcnt lgkmcnt(" #n ")" ::: "memory")
#define PG8_BAR __builtin_amdgcn_s_barrier()
#define PG8_SCHED __builtin_amdgcn_sched_barrier(0)
    Unit cur, nxt; int ui = 0;
    const int bid = opaque_bid();
    if (!next_unit(g, bid, 0, cur)) return;
    f32x4 acc[2][2][4][2];
#pragma unroll
    for (int a = 0; a < 2; ++a)
#pragma unroll
        for (int b = 0; b < 2; ++b)
#pragma unroll
            for (int m = 0; m < 4; ++m)
#pragma unroll
                for (int n = 0; n < 2; ++n) acc[a][b][m][n] = (f32x4){0.f, 0.f, 0.f, 0.f};
    bf16x8 At[4][2], B0[2][2], B1[2][2];
    const char* cA = (const char*)g.A + (size_t)cur.pm * tstepA; const char* cB = (const char*)g.Bt + (size_t)cur.pn * 2 * hstepB + (size_t)(cur.pm >> 1) * g.bk * 2;
    PG8_STAGE(PG8_SB(0, 0), cB, voffB); PG8_STAGE(PG8_SA(0, 0), cA, voffA); PG8_STAGE(PG8_SB(0, 1), cB + hstepB, voffB); PG8_STAGE(PG8_SA(0, 1), cA + hstepA, voffA);
    if (wr == 1) PG8_BAR;
    PG8_WAIT_V(4); PG8_BAR;
    PG8_STAGE(PG8_SB(1, 0), cB + kstep, voffB); PG8_STAGE(PG8_SA(1, 0), cA + kstep, voffA); PG8_STAGE(PG8_SB(1, 1), cB + hstepB + kstep, voffB);
    PG8_WAIT_V(6); PG8_BAR;
    for (;;) {
        const bool has_next = next_unit(g, bid, ui + 1, nxt);
        const char* nA = has_next ? (const char*)g.A + (size_t)nxt.pm * tstepA : cA;
        const char* nB = has_next ? (const char*)g.Bt + (size_t)nxt.pn * 2 * hstepB + (size_t)(nxt.pm >> 1) * g.bk * 2 : cB;
        for (int t = 0; t < nt; t += 2) {
            const bool last = (t == nt - 2);
            const char* a1 = cA + (size_t)(t + 1) * kstep;
            const char* a2 = last ? nA : cA + (size_t)(t + 2) * kstep; const char* b2 = last ? nB : cB + (size_t)(t + 2) * kstep;
            const char* a3 = a2 + kstep; const char* b3 = b2 + kstep;
            PG8_LDB(B0, 0, 0); PG8_SCHED; PG8_LDA(At, 0, 0); PG8_STAGE(PG8_SA(1, 1), a1 + hstepA, voffA);
            PG8_WAIT_L(8); PG8_BAR; PG8_WAIT_L(0); PG8_MMA(0, 0, At, B0); PG8_BAR; PG8_SCHED;
            PG8_LDB(B1, 0, 1); PG8_STAGE(PG8_SB(0, 0), b2, voffB);
            PG8_BAR; PG8_WAIT_L(0); PG8_MMA(0, 1, At, B1); PG8_BAR;
            PG8_LDA(At, 0, 1); PG8_STAGE(PG8_SA(0, 0), a2, voffA);
            PG8_BAR; PG8_WAIT_L(0); PG8_MMA(1, 0, At, B0); PG8_BAR; PG8_SCHED;
            PG8_STAGE(PG8_SB(0, 1), b2 + hstepB, voffB);
            PG8_WAIT_V(6); PG8_BAR; PG8_MMA(1, 1, At, B1); PG8_BAR;
            PG8_LDB(B0, 1, 0); PG8_SCHED; PG8_LDA(At, 1, 0); PG8_STAGE(PG8_SA(0, 1), a2 + hstepA, voffA);
            PG8_WAIT_L(8); PG8_BAR; PG8_WAIT_L(0); PG8_MMA(0, 0, At, B0); PG8_BAR; PG8_SCHED;
            PG8_LDB(B1, 1, 1); PG8_STAGE(PG8_SB(1, 0), b3, voffB);
            PG8_BAR; PG8_WAIT_L(0); PG8_MMA(0, 1, At, B1); PG8_BAR;
            PG8_LDA(At, 1, 1); PG8_STAGE(PG8_SA(1, 0), a3, voffA);
            PG8_BAR; PG8_WAIT_L(0); PG8_MMA(1, 0, At, B0); PG8_BAR; PG8_SCHED;
            PG8_STAGE(PG8_SB(1, 1), b3 + hstepB, voffB);
            PG8_WAIT_V(6); PG8_BAR; PG8_MMA(1, 1, At, B1); PG8_BAR;
        }
        if constexpr (!Epi::AFTER_DRAIN) E(acc, cur, wr, wc, fr, fq);
        if (!has_next) break;
#pragma unroll
        for (int a = 0; a < 2; ++a)
#pragma unroll
            for (int b = 0; b < 2; ++b)
#pragma unroll
                for (int m = 0; m < 4; ++m)
#pragma unroll
                    for (int n = 0; n < 2; ++n) acc[a][b][m][n] = (f32x4){0.f, 0.f, 0.f, 0.f};
        cur = nxt; cA = nA; cB = nB; ++ui;
    }
    PG8_WAIT_V(0);
    if (wr == 0) PG8_BAR;
    PG8_BAR;
    if constexpr (Epi::AFTER_DRAIN) E.fused(acc, cur, wr, wc, fr, fq, lds, tid);
#undef PG8_SA
#undef PG8_SB
#undef PG8_STAGE
#undef PG8_LDA
#undef PG8_LDB
#undef PG8_MMA
#undef PG8_WAIT_V
#undef PG8_WAIT_L
#undef PG8_BAR
#undef PG8_SCHED
}

__device__ __forceinline__ void phase_mod(const Params& p, LAS unsigned char* lds) {
    const int tid = opaque_tid(), wid = tid >> 6, lane = tid & 63;
    LAS float* sc = (LAS float*)lds;
    LAS float* red = (LAS float*)(lds + 32768);
    float* mod = (float*)(p.ws + WS_MOD);
    for (int t = tid; t < NB * DM; t += 512) sc[t] = silu_f(p.c[t]);
    __syncthreads();
    for (int it = opaque_bid(); it < 192; it += gridDim.x) {
        const int col = it * 64 + lane, i = col / 3072, j = col - i * 3072;
        const float* w = p.ada_w + ((size_t)i * DM + wid * 128) * 3072 + j;
        float a[8];
#pragma unroll
        for (int b = 0; b < 8; ++b) a[b] = 0.f;
#pragma unroll 16
        for (int k = 0; k < 128; ++k) {
            const float wv = w[(size_t)k * 3072];
#pragma unroll
            for (int b = 0; b < 8; ++b) a[b] += sc[b * DM + wid * 128 + k] * wv;
        }
#pragma unroll
        for (int b = 0; b < 8; ++b) red[(wid * 8 + b) * 64 + lane] = a[b];
        __syncthreads();
        {
            const int b = tid >> 6; float s = 0.f;
#pragma unroll
            for (int w8 = 0; w8 < 8; ++w8) s += red[(w8 * 8 + b) * 64 + lane];
            mod[((size_t)i * NB + b) * 3072 + j] = s + p.ada_b[i * 3072 + j];
        }
        __syncthreads();
    }
}

__device__ __forceinline__ void conv_tile(const float* __restrict__ src, int srcN, int c0, bf16_t* __restrict__ dstrow, int K, int k0, LAS float* T, int csrc = -1) {
    const int tid = opaque_tid();
    const int cs = csrc >= 0 ? csrc : c0 + (tid & 15) * 4;
    f32x4 v[8];
#pragma unroll
    for (int ps = 0; ps < 8; ++ps) v[ps] = *(const f32x4*)(src + (size_t)(k0 + ps * 32 + (tid >> 4)) * srcN + cs);
#pragma unroll
    for (int ps = 0; ps < 8; ++ps) { LAS float* t = T + (ps * 32 + (tid >> 4)) * 65 + (tid & 15) * 4; t[0] = v[ps][0]; t[1] = v[ps][1]; t[2] = v[ps][2]; t[3] = v[ps][3]; }
    __syncthreads();
#pragma unroll
    for (int q = 0; q < 4; ++q) {
        const int item = tid + 512 * q, n = item >> 5, kg = item & 31; const LAS float* s = T + (kg * 8) * 65 + n;
        u32x4 o; o.x = cvt_pk_bf16(s[0], s[65]); o.y = cvt_pk_bf16(s[130], s[195]); o.z = cvt_pk_bf16(s[260], s[325]); o.w = cvt_pk_bf16(s[390], s[455]);
        *(u32x4*)(dstrow + (size_t)n * K + k0 + kg * 8) = o;
    }
    __syncthreads();
}

__device__ __forceinline__ void norm_rows(const Params& p, int layer, const float* xin, int item) {
    const int tid = opaque_tid(), wid = tid >> 6, lane = tid & 63;
    bf16_t* H = (bf16_t*)g_h;
    const float* mod = (const float*)(p.ws + WS_MOD) + (size_t)layer * NB * 3072;
    const float* gp = p.norm_g + (size_t)layer * DM;
#pragma unroll
    for (int h2 = 0; h2 < 2; ++h2) {
        const int row = item * 16 + h2 * 8 + wid, b = row >> 11;
        const f32x4* xr = (const f32x4*)(xin + (size_t)row * DM) + lane;
        f32x4 v[4]; float ss = 0.f;
#pragma unroll
        for (int q = 0; q < 4; ++q) { v[q] = xr[64 * q]; ss += (v[q][0] * v[q][0] + v[q][1] * v[q][1]) + (v[q][2] * v[q][2] + v[q][3] * v[q][3]); }
        const float rstd = rsqrtf(wave_sum(ss) * (1.f / DM) + EPS);
        const float* mb = mod + (size_t)b * 3072;
        u32x2* o8 = (u32x2*)(H + (size_t)row * DM) + lane;
#pragma unroll
        for (int q = 0; q < 4; ++q) {
            const int k = (lane + 64 * q) * 4;
            const f32x4 gv = *(const f32x4*)(gp + k), sh = *(const f32x4*)(mb + k), scl = *(const f32x4*)(mb + 1024 + k);
            const f32x4 hv = (v[q] * rstd * gv) * (scl + 1.f) + sh;
            u32x2 w; w.x = cvt_pk_bf16(hv[0], hv[1]); w.y = cvt_pk_bf16(hv[2], hv[3]);
            o8[64 * q] = w;
        }
    }
}
__device__ __forceinline__ void phase_norm_even(const Params& p, int j, const float* xin, LAS unsigned char* ldsb, int sel, int wg0, int ldsoff, int rot) {
    const int tid = opaque_tid();
    LAS unsigned char* lds = ldsb + ldsoff;
    bf16_t* WIN_E = (bf16_t*)(p.ws + WS_WIN_E); bf16_t* WIN_O = (bf16_t*)(p.ws + WS_WIN_O); bf16_t* WOUT_E = (bf16_t*)(p.ws + WS_WOUT_E); bf16_t* WOUT_O = (bf16_t*)(p.ws + WS_WOUT_O);
    bf16_t* SGU = (bf16_t*)(p.ws + WS_SGU); bf16_t* POOLT = (bf16_t*)(p.ws + WS_POOLT); bf16_t* WINP = (bf16_t*)(p.ws + WS_WINP);
    constexpr int N0 = 448, N1 = N0 + 128, N2 = N1 + 128, N3 = N2 + 128, N4 = N3 + 64, N5 = N4 + 32, N6 = N5 + 512;
    const int NROWS = (j == 0 ? MTOK / 16 : 0);
    const int TOTAL = sel == 1 ? 576 : sel == 2 ? 864 + NROWS : N6 + NROWS;
    const int bid = opaque_bid();
    if (bid < wg0) return;
    for (int v = (bid - wg0 + rot) % (gridDim.x - wg0); v < TOTAL; v += gridDim.x - wg0) {
        const int it = sel == 1 ? (v < 64 ? N3 + v : N5 + (v - 64)) : sel == 2 ? (v < N3 ? v : v < 864 ? N4 + (v - N3) : N6 + (v - 864)) : v;
        if (it < N0) {
            const int rt = it >> 2, kt = it & 3, r0 = rt * 64, T = r0 >> 8, q = r0 & 255; int c0 = 0, csrc = -1;
            if (T < 16) {
                const int cg = tid & 15, bj = q >> 7, wcc = ((q >> 6) & 1) * 2 + (cg >> 3), fq4 = (cg >> 1) & 3, n = cg & 1;
                const int tbase = bj == 0 ? (n == 0 ? 2048 : 0) : (n == 0 ? 1024 : 3072);
                csrc = tbase + 64 * T + 16 * wcc + 4 * fq4;
            }
            else if (T < 24) c0 = (q < 128) ? (4096 + 128 * (T - 16) + q) : (6144 + 128 * (T - 16) + q - 128);
            else c0 = 5120 + 256 * (T - 24) + q;
            conv_tile(p.ab_w_in + (size_t)j * DM * 7168, 7168, c0, WIN_E + (size_t)r0 * DM, DM, kt * 256, (LAS float*)lds, csrc);
        } else if (it < N1) {
            const int i2 = it - N0, rt = i2 >> 3, kt = i2 & 7, r0 = rt * 64;
            conv_tile(p.ab_w_out + (size_t)j * 2048 * DM, DM, r0, WOUT_E + (size_t)r0 * 2048, 2048, kt * 256, (LAS float*)lds);
        } else if (it < N2) {
            const int i2 = it - N1, rt = i2 >> 2, kt = i2 & 3, r0 = rt * 64;
            conv_tile(p.c_w_in + (size_t)j * DM * 4096, 4096, 2048 + r0, WIN_O + (size_t)((r0 >> 7) * 256 + 128 + (r0 & 127)) * DM, DM, kt * 256, (LAS float*)lds);
        } else if (it < N3) {
            const int i2 = it - N2, rt = i2 >> 3, kt = i2 & 7, r0 = rt * 64;
            conv_tile(p.c_w_out + (size_t)j * 2048 * DM, DM, r0, WOUT_O + (size_t)r0 * 2048, 2048, kt * 256, (LAS float*)lds);
        } else if (it < N4) {
            const int i3 = it - N3, g = i3 >> 4, r = i3 & 15, rt = r >> 1, kt = r & 1, r0 = rt * 64;
            conv_tile(p.c_pool_w + ((size_t)j * 4 + g) * 512 * 512, 512, r0, POOLT + (size_t)g * 512 * 512 + (size_t)r0 * 512, 512, kt * 256, (LAS float*)lds);
        } else if (it < N5) {
            const int e0 = (it - N4) * 4096 + tid * 8, t = (e0 >> 7) & 127, s0 = e0 & 127;
            const float* src = p.ab_sgu_w + (size_t)j * 8 * 128 * 128 + e0;
            const f32x4 a = *(const f32x4*)src, b = *(const f32x4*)(src + 4);
            float v[8] = {a[0], a[1], a[2], a[3], b[0], b[1], b[2], b[3]};
#pragma unroll
            for (int e = 0; e < 8; ++e) v[e] = (s0 + e <= t) ? v[e] : 0.f;
            u32x4 o; o.x = cvt_pk_bf16(v[0], v[1]); o.y = cvt_pk_bf16(v[2], v[3]); o.z = cvt_pk_bf16(v[4], v[5]); o.w = cvt_pk_bf16(v[6], v[7]);
            *(u32x4*)(SGU + e0) = o;
        } else if (it < N6) {
            const int e0 = (it - N5) * 4096 + tid * 8, k = e0 >> 11, c = e0 & 2047;
            const float* src = p.c_w_in + ((size_t)j * DM + k) * 4096 + c;
            const f32x4 a = *(const f32x4*)src, b = *(const f32x4*)(src + 4);
            u32x4 o; o.x = cvt_pk_bf16(a[0], a[1]); o.y = cvt_pk_bf16(a[2], a[3]); o.z = cvt_pk_bf16(b[0], b[1]); o.w = cvt_pk_bf16(b[2], b[3]);
            *(u32x4*)(WINP + e0) = o;
        } else norm_rows(p, 2 * j, xin, it - N6);
    }
}
__device__ __forceinline__ void phase_final(const Params& p) {
    const int tid = opaque_tid(), wid = tid >> 6, lane = tid & 63;
    for (int it = opaque_bid(); it < MTOK / 8; it += gridDim.x) {
        const int row = it * 8 + wid;
        f32x4* xr = (f32x4*)(p.out + (size_t)row * DM) + lane;
        f32x4 v[4]; float ss = 0.f;
#pragma unroll
        for (int q = 0; q < 4; ++q) { v[q] = xr[64 * q]; ss += (v[q][0] * v[q][0] + v[q][1] * v[q][1]) + (v[q][2] * v[q][2] + v[q][3] * v[q][3]); }
        const float rstd = rsqrtf(wave_sum(ss) * (1.f / DM) + EPS);
#pragma unroll
        for (int q = 0; q < 4; ++q) { const f32x4 gv = *(const f32x4*)(p.final_g + (lane + 64 * q) * 4); xr[64 * q] = v[q] * rstd * gv; }
    }
}

__device__ __forceinline__ void unpack8(const u32x4 w, float (&f)[8]) {
    f[0] = bf_lo(w.x); f[1] = bf_hi(w.x); f[2] = bf_lo(w.y); f[3] = bf_hi(w.y); f[4] = bf_lo(w.z); f[5] = bf_hi(w.z); f[6] = bf_lo(w.w); f[7] = bf_hi(w.w);
}

__device__ __forceinline__ void product_units(const Params& p, LAS unsigned char* lds) {
    Gemm g{(const bf16_t*)(p.ws + WS_POOLT), (const bf16_t*)(p.ws + WS_WINP), 512, 2048, 512, 8, 4, 512}; EpiProd E{(bf16_t*)(p.ws + WS_WIN_O)};
    gemm_phase(lds, g, E);
}
__device__ __forceinline__ void phase_mix(const Params& p, int j, LAS unsigned char* lds) {
    const int tid = opaque_tid(), wid = tid >> 6, lane = tid & 63;
    const bf16_t* CH2 = (const bf16_t*)(p.ws + WS_RP); const bf16_t* BZ = CH2 + (size_t)MTOK * 1024; const bf16_t* UZ = BZ + (size_t)MTOK * 1024; const bf16_t* V = UZ + (size_t)MTOK * 1024;
    bf16_t* Y = (bf16_t*)(p.ws + WS_RA);
    {
        const bf16_t* Wm = (const bf16_t*)(p.ws + WS_SGU);
        LAS bf16_t* vnT = (LAS bf16_t*)lds;
        LAS float* red = (LAS float*)(lds + 36864);
        const int fr = lane & 15, fq = lane >> 4;
        const int s = lane + 64 * (wid & 1), q = wid >> 1;
        int it = opaque_bid();
        u32x4 vraw[4];
        if (it < 1024) { const bf16_t* vp = V + (size_t)((it >> 3) * 128 + s) * 1024 + (it & 7) * 128 + 32 * q;
#pragma unroll
            for (int i = 0; i < 4; ++i) vraw[i] = *(const u32x4*)(vp + 8 * i); }
        for (; it < 1024; it += gridDim.x) {
            const int hh = it & 7, cn = it >> 3;
            const int t = 16 * wid + fr; const size_t row = (size_t)cn * 128 + t;
            u32x2 uz[8];
#pragma unroll
            for (int n = 0; n < 8; ++n) uz[n] = *(const u32x2*)(UZ + row * 1024 + hh * 128 + 16 * n + 4 * fq);
            const float bias = p.ab_sgu_b[(size_t)j * 1024 + hh * 128 + t];
            const bf16_t* wrow = Wm + ((size_t)hh * 128 + 16 * wid + fr) * 128 + 8 * fq;
            bf16x8 af[4];
#pragma unroll
            for (int kk = 0; kk < 4; ++kk) af[kk] = *(const bf16x8*)(wrow + 32 * kk);
            float f[32];
#pragma unroll
            for (int i = 0; i < 4; ++i) { float t8[8]; unpack8(vraw[i], t8);
#pragma unroll
                for (int e = 0; e < 8; ++e) f[8 * i + e] = t8[e]; }
            float s1 = 0.f, s2 = 0.f;
#pragma unroll
            for (int i = 0; i < 32; ++i) { s1 += f[i]; s2 += f[i] * f[i]; }
            red[(s * 4 + q) * 2] = s1; red[(s * 4 + q) * 2 + 1] = s2;
            __syncthreads();
            {
                const int itn = it + gridDim.x;
                if (itn < 1024) { const bf16_t* vp = V + (size_t)((itn >> 3) * 128 + s) * 1024 + (itn & 7) * 128 + 32 * q;
#pragma unroll
                    for (int i = 0; i < 4; ++i) vraw[i] = *(const u32x4*)(vp + 8 * i); }
            }
            float S1 = 0.f, S2 = 0.f;
#pragma unroll
            for (int qq = 0; qq < 4; ++qq) { S1 += red[(s * 4 + qq) * 2]; S2 += red[(s * 4 + qq) * 2 + 1]; }
            const float mu = S1 * (1.f / 128.f), var = fmaxf(S2 * (1.f / 128.f) - mu * mu, 0.f), rstd = rsqrtf(var + EPS);
            const float* lg = p.ab_ln_g + (size_t)j * 1024 + hh * 128 + 32 * q; const float* lb = p.ab_ln_b + (size_t)j * 1024 + hh * 128 + 32 * q;
#pragma unroll
            for (int i = 0; i < 32; ++i) {
                const float vn = (f[i] - mu) * rstd * lg[i] + lb[i];
                vnT[(32 * q + i) * 136 + s] = (bf16_t)(cvt_pk_bf16(vn, 0.f) & 0xffffu);
            }
            __syncthreads();
            f32x4 acc[8];
#pragma unroll
            for (int n = 0; n < 8; ++n) acc[n] = (f32x4){0.f, 0.f, 0.f, 0.f};
#pragma unroll
            for (int kk = 0; kk < 4; ++kk) {
                if (32 * kk <= 16 * wid + 15) {
#pragma unroll
                    for (int n = 0; n < 8; ++n) {
                        const bf16x8 bfm = *(const LAS bf16x8*)(vnT + (16 * n + fr) * 136 + 32 * kk + 8 * fq);
                        acc[n] = __builtin_amdgcn_mfma_f32_16x16x32_bf16(bfm, af[kk], acc[n], 0, 0, 0);
                    }
                }
            }
#pragma unroll
            for (int n = 0; n < 8; ++n) {
                const int d = 16 * n + 4 * fq;
                u32x2 w; w.x = cvt_pk_bf16(bf_lo(uz[n].x) * (acc[n][0] + bias), bf_hi(uz[n].x) * (acc[n][1] + bias));
                w.y = cvt_pk_bf16(bf_lo(uz[n].y) * (acc[n][2] + bias), bf_hi(uz[n].y) * (acc[n][3] + bias));
                *(u32x2*)(Y + row * 2048 + 1024 + hh * 128 + d) = w;
            }
        }
    }
    {
        const float* halo = (const float*)(p.ws + WS_HALO); const float* cw = p.ab_conv_w + (size_t)j * 3 * 1024;
        for (int gid = opaque_bid() * 512 + tid; gid < 128 * 1024; gid += gridDim.x * 512) {
            const int B = gid >> 10, c = gid & 1023; const bool hist = ((B * 128) & (SEQ - 1)) != 0;
            const float* hb = halo + (size_t)B * 6 * 1024 + c;
            const float c6 = hist ? hb[-6 * 1024] : 0.f, c7 = hist ? hb[-5 * 1024] : 0.f, c0 = hb[2 * 1024], c1 = hb[3 * 1024], b0 = hb[4 * 1024], b1 = hb[5 * 1024];
            const float w0 = cw[c], w1 = cw[1024 + c], w2 = cw[2048 + c];
            const float y0 = b0 * (w0 * c6 + w1 * c7 + w2 * c0), y1 = b1 * (w0 * c7 + w1 * c0 + w2 * c1);
            Y[(size_t)(B * 128) * 2048 + c] = (bf16_t)(cvt_pk_bf16(y0, 0.f) & 0xffffu);
            Y[(size_t)(B * 128 + 1) * 2048 + c] = (bf16_t)(cvt_pk_bf16(y1, 0.f) & 0xffffu);
        }
    }
}

__device__ __forceinline__ void phase_pool(const Params& p) {
    const int tid = opaque_tid();
    const bf16_t* HQ = (const bf16_t*)(p.ws + WS_HQ); const bf16_t* HS = (const bf16_t*)(p.ws + WS_HS); bf16_t* Y = (bf16_t*)(p.ws + WS_RA);
    for (int gid = opaque_bid() * 512 + tid; gid < 128 * 256; gid += gridDim.x * 512) {
        const int B = gid >> 8, ct = gid & 255, c0 = ct * 8, win = 2 << (ct >> 6); const bool hist = ((B * 128) & (SEQ - 1)) != 0;
        const bf16_t* tail = HQ + (size_t)(B - 1) * 32 * 2048 + c0;
        const bf16_t* head = HQ + ((size_t)B * 32 + 16) * 2048 + c0;
        const bf16_t* hs = HS + (size_t)B * 16 * 2048 + c0;
        float S[8];
#pragma unroll
        for (int e = 0; e < 8; ++e) S[e] = 0.f;
        if (hist) {
#pragma unroll
            for (int i = 1; i < 16; ++i) {
                if (i < win) { float v[8]; unpack8(*(const u32x4*)(tail + (size_t)(16 - i) * 2048), v);
#pragma unroll
                    for (int e = 0; e < 8; ++e) S[e] += v[e]; }
            }
        }
#pragma unroll 4
        for (int r = 0; r < 16; ++r) {
            float cur[8], sz[8], o[8];
            unpack8(*(const u32x4*)(head + (size_t)r * 2048), cur);
            unpack8(*(const u32x4*)(hs + (size_t)r * 2048), sz);
            const float inv = 1.f / (float)(hist ? win : min(r + 1, win));
#pragma unroll
            for (int e = 0; e < 8; ++e) { S[e] += cur[e]; o[e] = (S[e] * inv - cur[e]) * sz[e]; }
            u32x4 w; w.x = cvt_pk_bf16(o[0], o[1]); w.y = cvt_pk_bf16(o[2], o[3]); w.z = cvt_pk_bf16(o[4], o[5]); w.w = cvt_pk_bf16(o[6], o[7]);
            *(u32x4*)(Y + (size_t)(B * 128 + r) * 2048 + c0) = w;
            const int ro = r - win + 1;
            if (ro >= 0 || hist) { float old[8]; unpack8(*(const u32x4*)(ro >= 0 ? head + (size_t)ro * 2048 : tail + (size_t)(16 + ro) * 2048), old);
#pragma unroll
                for (int e = 0; e < 8; ++e) S[e] -= old[e]; }
        }
    }
}

#define XB_TMO      128
#define XB_XCNT(j)  (256  + 64 * (j))
#define XB_XSUB(j)  (1280 + 64 * (j))
#define XB_XGEN(j)  (2304 + 64 * (j))
#define XB_TOP      3328
#define XB_TOPGEN   3392
#define XCD_BAR_WORDS 3456
#define XB_SPIN_CAP (1u << 18)
__device__ __forceinline__ unsigned xb_ld(unsigned* p)              { return __hip_atomic_load(p, __ATOMIC_RELAXED, __HIP_MEMORY_SCOPE_AGENT); }
__device__ __forceinline__ unsigned xb_add(unsigned* p, unsigned v) { return __hip_atomic_fetch_add(p, v, __ATOMIC_RELAXED, __HIP_MEMORY_SCOPE_AGENT); }
__device__ __forceinline__ unsigned xb_xcc_id() { return (unsigned)__builtin_amdgcn_s_getreg((3 << 11) | 20) & 0xFu; }
#define XB_SPIN(cond, bar) do { unsigned _sp = 0; while (cond) { __builtin_amdgcn_s_sleep(1); \
    if ((++_sp & 255u) == 0u) { if (xb_ld(&(bar)[XB_TMO])) break; if (_sp > XB_SPIN_CAP) { atomicAdd(&(bar)[XB_TMO], 1u); break; } } } } while (0)
struct XcdBarrier { unsigned* bar; unsigned x; volatile LAS unsigned* st; };
__device__ __forceinline__ XcdBarrier xcd_barrier_post(unsigned* bar, volatile LAS unsigned* st) {
    XcdBarrier b; b.bar = bar; b.x = xb_xcc_id(); b.st = st;
    if (threadIdx.x == 0) (void)xb_add(&bar[XB_XCNT(b.x)], 1u);
    return b;
}
__device__ __forceinline__ void xcd_barrier_complete(unsigned* bar, unsigned x, unsigned& nloc, unsigned& nx) {
    const unsigned G = gridDim.x * gridDim.y * gridDim.z;
    unsigned sum, cnt, mine, sp = 0u;
    for (;;) {
        sum = 0u; cnt = 0u; mine = 0u;
#pragma unroll
        for (unsigned j = 0; j < 16; ++j) { const unsigned c = xb_ld(&bar[XB_XCNT(j)]); sum += c; cnt += (c > 0u) ? 1u : 0u; mine = (j == x) ? c : mine; }
        if (sum == G) break;
        __builtin_amdgcn_s_sleep(1);
        if ((++sp & 255u) == 0u) { if (xb_ld(&bar[XB_TMO])) break; if (sp > XB_SPIN_CAP) { atomicAdd(&bar[XB_TMO], 1u); break; } }
    }
    nloc = mine > 0u ? mine : 1u; nx = cnt > 0u ? cnt : 1u;
}
__device__ __forceinline__ void xcd_barrier(const XcdBarrier& b) {
    asm volatile("s_waitcnt vmcnt(0)" ::: "memory");
    __syncthreads();
    if (threadIdx.x == 0) {
        unsigned* bar = b.bar;
        __builtin_amdgcn_s_waitcnt(0);
        unsigned nloc = b.st[0], nx = b.st[1];
        if (nloc == 0u) { xcd_barrier_complete(bar, b.x, nloc, nx); b.st[0] = nloc; b.st[1] = nx; }
        const unsigned old = xb_add(&bar[XB_XSUB(b.x)], 1u);
        const unsigned gen = old / nloc;
        if (old + 1u == (gen + 1u) * nloc) {
            __builtin_amdgcn_fence(__ATOMIC_RELEASE, "agent");
            asm volatile("s_waitcnt vmcnt(0)" ::: "memory");
            const unsigned og = xb_add(&bar[XB_TOP], 1u);
            const unsigned tg = og / nx;
            if (og + 1u == (tg + 1u) * nx) xb_add(&bar[XB_TOPGEN], 1u);
            else XB_SPIN(xb_ld(&bar[XB_TOPGEN]) == tg, bar);
            __builtin_amdgcn_fence(__ATOMIC_ACQUIRE, "agent");
            xb_add(&bar[XB_XGEN(b.x)], 1u);
            asm volatile("s_waitcnt vmcnt(0)" ::: "memory");
        } else {
            XB_SPIN(xb_ld(&bar[XB_XGEN(b.x)]) == gen, bar);
            __builtin_amdgcn_fence(__ATOMIC_ACQUIRE, "agent");
            asm volatile("s_waitcnt vmcnt(0)" ::: "memory");
        }
    }
    __syncthreads();
}

__global__ void __launch_bounds__(512, 2) mega_fwd(Params p, int ph_lo, int ph_hi) {
    extern __shared__ __attribute__((aligned(16))) unsigned char smem[];
    LAS unsigned char* lds = (LAS unsigned char*)smem;
    cg::grid_group grid = cg::this_grid();
    if (ph_hi < 0) grid.sync();
    volatile LAS unsigned* st = (volatile LAS unsigned*)(lds + STAGE_BYTES);
    if (threadIdx.x < 4) st[threadIdx.x] = 0u;
    __syncthreads();
    const XcdBarrier xb = xcd_barrier_post((unsigned*)(p.ws + WS_BAR), st);
    int ph = 0;
#define PHASE(REP, ...) do { if (ph >= ph_lo && ph < ph_hi) { for (int _r = 0; _r < (REP); ++_r) { __VA_ARGS__; if (ph + 1 < ph_hi) xcd_barrier(xb); } } ++ph; } while (0)
    bf16_t* RA = (bf16_t*)(p.ws + WS_RA); bf16_t* RP = (bf16_t*)(p.ws + WS_RP);
    const bf16_t* WIN_E = (const bf16_t*)(p.ws + WS_WIN_E); const bf16_t* WIN_O = (const bf16_t*)(p.ws + WS_WIN_O);
    const bf16_t* WOUT_E = (const bf16_t*)(p.ws + WS_WOUT_E); const bf16_t* WOUT_O = (const bf16_t*)(p.ws + WS_WOUT_O);
    const float* mod = (const float*)(p.ws + WS_MOD);
    float* part = (float*)(p.ws + WS_PART); unsigned* cnt = (unsigned*)(p.ws + WS_BAR) + CNT_WORD0;
    PHASE(1, { phase_mod(p, lds); phase_norm_even(p, 0, nullptr, lds, 1, 0, 49152, 64); });
#pragma unroll 1
    for (int lp = 0; lp < 2; ++lp) {
        {
            const int layer = 2 * lp; const float* xin = (lp == 0) ? p.x : p.out;
            PHASE(1, { if (blockIdx.x < 32) product_units(p, lds); else phase_norm_even(p, lp, xin, lds, 2, 32, 0, 0); });
            PHASE(REP_G1, { Gemm g{(const bf16_t*)g_h, WIN_E, DM, DM, DM, MTOK / BM, 7168 / BM, 0}; EpiEven E{RP, RA, (float*)(p.ws + WS_HALO), p.ab_conv_w + (size_t)lp * 3 * 1024}; gemm_phase(lds, g, E); });
            PHASE(REP_THIN, phase_mix(p, lp, lds));
            PHASE(1, { Gemm g{RA, WOUT_E, 2048, 2048, 2048, MTOK / BM, DM / BM, 0};
                       EpiResNorm E{lp == 0 ? p.x : nullptr, (const bf16_t*)g_x, (bf16_t*)g_x, p.out, mod + (size_t)layer * NB * 3072 + 2048, (bf16_t*)g_h, p.norm_g + (size_t)(layer + 1) * DM, mod + (size_t)(layer + 1) * NB * 3072,
                                    part + (size_t)layer * 4 * MTOK, cnt + layer * 64, 0};
                       gemm_phase(lds, g, E); });
        }
        {
            const int layer = 2 * lp + 1; const int last = (lp == 1) ? 1 : 0;
            PHASE(REP_G1, { Gemm g{(const bf16_t*)g_h, WIN_O, DM, DM, DM, MTOK / BM, 4096 / BM, 0}; EpiOdd E{RA, (bf16_t*)(p.ws + WS_HQ), (bf16_t*)(p.ws + WS_HS), p.c_pool_scale + (size_t)lp * 2048}; gemm_phase(lds, g, E); });
            PHASE(1, { phase_pool(p); if (lp == 0) phase_norm_even(p, 1, nullptr, lds, 1, 0, 0, 0); });
            PHASE(1, { Gemm g{RA, WOUT_O, 2048, 2048, 2048, MTOK / BM, DM / BM, 0};
                       EpiResNorm E{nullptr, (const bf16_t*)g_x, (bf16_t*)g_x, p.out, mod + (size_t)layer * NB * 3072 + 2048, (bf16_t*)g_h, last ? p.final_g : p.norm_g + (size_t)(layer + 1) * DM, mod + (size_t)(last ? layer : layer + 1) * NB * 3072,
                                    part + (size_t)layer * 4 * MTOK, cnt + layer * 64, last};
                       gemm_phase(lds, g, E); });
        }
    }
#undef PHASE
}

extern "C" void kernel_launch(void* const* d_in, const int* in_sizes, int n_in, void* d_out, int out_size, void* d_ws, size_t ws_size, hipStream_t stream) {
    static int grid = 0;
    if (grid == 0) {
        if (n_in != 17 || out_size != MTOK * DM || ws_size < WS_END2) { fprintf(stderr, "kernel_launch: unexpected shapes (n_in %d out %d ws %zu need %zu)\n", n_in, out_size, ws_size, (size_t)WS_END2); grid = -1; return; }
        int dev = 0, cus = 0, per_cu = 0;
        hipGetDevice(&dev);
        hipDeviceGetAttribute(&cus, hipDeviceAttributeMultiprocessorCount, dev);
        if (hipFuncSetAttribute((const void*)mega_fwd, hipFuncAttributeMaxDynamicSharedMemorySize, LDS_BYTES) != hipSuccess) { fprintf(stderr, "kernel_launch: hipFuncSetAttribute failed\n"); grid = -1; return; }
        hipOccupancyMaxActiveBlocksPerMultiprocessor(&per_cu, (const void*)mega_fwd, 512, LDS_BYTES);
        if (per_cu < 1) { fprintf(stderr, "kernel_launch: occupancy query says %d blocks per CU\n", per_cu); per_cu = 1; }
        (void)hipGetLastError();
        grid = cus;
        if (grid != 256) { fprintf(stderr, "kernel_launch: built for 256 CUs (one out-projection tile per workgroup), got %d\n", grid); grid = -1; return; }
    }
    if (grid < 0) return;
    Params p{};
    p.x = (const float*)d_in[0]; p.c = (const float*)d_in[1]; p.norm_g = (const float*)d_in[2]; p.ada_w = (const float*)d_in[3]; p.ada_b = (const float*)d_in[4];
    p.ab_w_in = (const float*)d_in[5]; p.ab_conv_w = (const float*)d_in[6]; p.ab_ln_g = (const float*)d_in[7]; p.ab_ln_b = (const float*)d_in[8];
    p.ab_sgu_w = (const float*)d_in[9]; p.ab_sgu_b = (const float*)d_in[10]; p.ab_w_out = (const float*)d_in[11];
    p.c_w_in = (const float*)d_in[12]; p.c_pool_w = (const float*)d_in[13]; p.c_pool_scale = (const float*)d_in[14]; p.c_w_out = (const float*)d_in[15]; p.final_g = (const float*)d_in[16];
    p.out = (float*)d_out; p.ws = (unsigned char*)d_ws;
    if (hipMemsetAsync((unsigned char*)d_ws + WS_BAR, 0, CTL_WORDS * 4, stream) != hipSuccess) { fprintf(stderr, "kernel_launch: barrier memset failed\n"); return; }
    int lo = 0, hi = 15;
    void* args[] = {&p, &lo, &hi};
    hipError_t e = hipLaunchCooperativeKernel((const void*)mega_fwd, dim3(grid), dim3(512), args, LDS_BYTES, stream);
    if (e != hipSuccess) fprintf(stderr, "kernel_launch: cooperative launch failed: %s (grid %d)\n", hipGetErrorString(e), grid);
}
```

```cpp
#include <hip/hip_runtime.h>
#include <hip/hip_cooperative_groups.h>
#include <cstdio>
namespace cg = cooperative_groups;

#define LAS __attribute__((address_space(3)))
typedef unsigned short bf16_t;
typedef short bf16x8 __attribute__((ext_vector_type(8)));
typedef float f32x4 __attribute__((ext_vector_type(4)));
typedef unsigned u32x4 __attribute__((ext_vector_type(4)));
typedef unsigned u32x2 __attribute__((ext_vector_type(2)));

constexpr int DM = 1024, NB = 8, SEQ = 2048, MTOK = NB * SEQ;
constexpr int BM = 256, BK = 64, HALF = 128, HTB = HALF * BK * 2, STAGE_BYTES = 8 * HTB, NXCD = 8, WGM = 8;
constexpr int LDS_BYTES = STAGE_BYTES + 16;
constexpr float EPS = 1e-6f;
constexpr int REP_G1 = 1, REP_THIN = 1, REP_G2L0 = 1;

constexpr size_t WS_MOD = 0;
constexpr size_t WS_BAR = 393216;
constexpr size_t WS_WIN_E = 524288;
constexpr size_t WS_WIN_O = WS_WIN_E + (size_t)7168 * 1024 * 2;
constexpr size_t WS_WOUT_E = WS_WIN_O + (size_t)4096 * 1024 * 2;
constexpr size_t WS_WOUT_O = WS_WOUT_E + (size_t)1024 * 2048 * 2;
constexpr size_t WS_SGU = WS_WOUT_O + (size_t)1024 * 2048 * 2;
constexpr size_t WS_POOLT = WS_SGU + (size_t)8 * 128 * 128 * 2;
constexpr size_t WS_WINP = WS_POOLT + (size_t)4 * 512 * 512 * 2;
constexpr size_t WS_RA = WS_WINP + (size_t)1024 * 2048 * 2;
constexpr size_t WS_RP = WS_RA + (size_t)MTOK * 2048 * 2;
constexpr size_t WS_END = WS_RP + (size_t)MTOK * 4096 * 2;

constexpr size_t WS_PART = WS_END;
constexpr size_t WS_HALO = WS_PART + (size_t)4 * 4 * MTOK * 4;
constexpr size_t WS_END2 = WS_HALO + (size_t)128 * 6 * 1024 * 4;
constexpr size_t WS_HQ = WS_RP;
constexpr size_t WS_HS = WS_HQ + (size_t)128 * 32 * 2048 * 2;
constexpr int CNT_WORD0 = 3584;
constexpr int CTL_WORDS = CNT_WORD0 + 256;
__device__ unsigned short g_x[(size_t)MTOK * DM];
__device__ unsigned short g_h[(size_t)MTOK * DM];

struct Params {
    const float *x, *c, *norm_g, *ada_w, *ada_b, *ab_w_in, *ab_conv_w, *ab_ln_g, *ab_ln_b, *ab_sgu_w, *ab_sgu_b, *ab_w_out,
        *c_w_in, *c_pool_w, *c_pool_scale, *c_w_out, *final_g;
    float* out;
    unsigned char* ws;
};

__host__ __device__ __forceinline__ int lds_byte(int r, int c) { const int st = (r >> 4) * 2 + (c >> 5), rr = r & 15, cc = c & 31, ob = rr * 64 + cc * 2; return st * 1024 + (ob ^ (((ob >> 9) & 1) << 5)); }
__host__ __device__ __forceinline__ void stage_rc(int b, int& R, int& C) { const int st = b / 1024, sb = b % 1024, swz = sb ^ (((sb >> 9) & 1) << 5); R = (st >> 1) * 16 + swz / 64; C = (st & 1) * 32 + (swz % 64) / 2; }
__host__ __device__ __forceinline__ int perm32(int rho) { const int n = rho >> 4, i = rho & 15; return 8 * (i >> 2) + 4 * n + (i & 3); }
__device__ __forceinline__ unsigned cvt_pk_bf16(float lo, float hi) { unsigned r; asm volatile("v_cvt_pk_bf16_f32 %0, %1, %2" : "=v"(r) : "v"(lo), "v"(hi)); return r; }
__device__ __forceinline__ float bf_lo(unsigned w) { return __uint_as_float(w << 16); }
__device__ __forceinline__ float bf_hi(unsigned w) { return __uint_as_float(w & 0xffff0000u); }
__device__ __forceinline__ float silu_f(float v) { return v * __builtin_amdgcn_rcpf(1.f + __expf(-v)); }
__device__ __forceinline__ float wave_sum(float v) {
#pragma unroll
    for (int o = 1; o < 64; o <<= 1) v += __shfl_xor(v, o);
    return v;
}

__device__ __forceinline__ int opaque_tid() { int t = threadIdx.x; asm volatile("" : "+v"(t)); return t; }
__device__ __forceinline__ int opaque_bid() { int b = blockIdx.x; asm volatile("" : "+s"(b)); return b; }
struct Unit { int pm, pn; };
struct Gemm { const bf16_t* A; const bf16_t* Bt; int lda, ldb, K, nM, nN, bk; };

__device__ __forceinline__ bool next_unit(const Gemm& g, int bid, int i, Unit& u) {
    const int nwg = g.nM * g.nN;
    const long L = (long)i * gridDim.x + bid; if (L >= nwg) return false;
    int wgid = (int)L; { const int q = nwg / NXCD, r = nwg % NXCD, xcd = wgid % NXCD, off = wgid / NXCD; wgid = (xcd < r ? xcd * (q + 1) : r * (q + 1) + (xcd - r) * q) + off; }
    const int nig = WGM * g.nN, gid = wgid / nig, fm = gid * WGM, gsz = (g.nM - fm) < WGM ? (g.nM - fm) : WGM;
    u.pm = fm + ((wgid % nig) % gsz); u.pn = (wgid % nig) / gsz; return true;
}

struct EpiEven {
    static constexpr bool PERM = true, AFTER_DRAIN = false, PERMA = true;
    bf16_t* P; bf16_t* Y; float* halo; const float* cw;
    __device__ __forceinline__ void operator()(const f32x4 (&acc)[2][2][4][2], const Unit& u, int wr, int wc, int fr, int fq) const {
        const int tok0 = u.pm * BM + 8 * (wr * 16 + fr), T = u.pn;
        if (T < 16) {
            const int ch = T * 64 + 16 * wc + 4 * fq;
            const f32x4 w0 = *(const f32x4*)(cw + ch), w1 = *(const f32x4*)(cw + 1024 + ch), w2 = *(const f32x4*)(cw + 2048 + ch);
            f32x4 c[8], pm1, pm2;
#pragma unroll
            for (int i = 0; i < 8; ++i) c[i] = acc[i >> 2][0][i & 3][0] * acc[i >> 2][0][i & 3][1];
#pragma unroll
            for (int j = 0; j < 4; ++j) {
                pm1[j] = __int_as_float(__builtin_amdgcn_update_dpp(0, __float_as_int(c[7][j]), 0x111, 0xf, 0xf, true));
                pm2[j] = __int_as_float(__builtin_amdgcn_update_dpp(0, __float_as_int(c[6][j]), 0x111, 0xf, 0xf, true));
            }
            float* hb = halo + (size_t)(u.pm * 2 + wr) * 6 * 1024 + ch;
            if (fr == 15) { *(f32x4*)(hb) = c[6]; *(f32x4*)(hb + 1024) = c[7]; }
            bf16_t* yp = Y + (size_t)tok0 * 2048 + ch;
#pragma unroll
            for (int i = 0; i < 8; ++i) {
                f32x4 bz = acc[i >> 2][1][i & 3][0]; const f32x4 z = acc[i >> 2][1][i & 3][1];
#pragma unroll
                for (int j = 0; j < 4; ++j) bz[j] *= silu_f(z[j]);
                const f32x4 cm1 = (i >= 1) ? c[i >= 1 ? i - 1 : 0] : pm1, cm2 = (i >= 2) ? c[i >= 2 ? i - 2 : 0] : (i == 1 ? pm1 : pm2);
                const f32x4 y = bz * (w0 * ((i == 1) ? pm1 : cm2) + w1 * cm1 + w2 * c[i]);
                if (i < 2 && fr == 0) { *(f32x4*)(hb + (2 + i) * 1024) = c[i]; *(f32x4*)(hb + (4 + i) * 1024) = bz; }
                else { u32x2 w; w.x = cvt_pk_bf16(y[0], y[1]); w.y = cvt_pk_bf16(y[2], y[3]); *(u32x2*)(yp + (size_t)i * 2048) = w; }
            }
        } else if (T < 24) {
            bf16_t* base = P + (size_t)2 * MTOK * 1024 + (size_t)tok0 * 1024 + (T - 16) * 128 + wc * 32 + 8 * fq;
#pragma unroll
            for (int i = 0; i < 8; ++i) {
                f32x4 x0 = acc[i >> 2][0][i & 3][0], x1 = acc[i >> 2][0][i & 3][1]; const f32x4 y0 = acc[i >> 2][1][i & 3][0], y1 = acc[i >> 2][1][i & 3][1];
#pragma unroll
                for (int j = 0; j < 4; ++j) { x0[j] *= silu_f(y0[j]); x1[j] *= silu_f(y1[j]); }
                u32x4 w; w.x = cvt_pk_bf16(x0[0], x0[1]); w.y = cvt_pk_bf16(x0[2], x0[3]); w.z = cvt_pk_bf16(x1[0], x1[1]); w.w = cvt_pk_bf16(x1[2], x1[3]);
                *(u32x4*)(base + (size_t)i * 1024) = w;
            }
        } else {
            bf16_t* base = P + (size_t)3 * MTOK * 1024 + (size_t)tok0 * 1024 + (T - 24) * 256 + wc * 32 + 8 * fq;
#pragma unroll
            for (int i = 0; i < 8; ++i)
#pragma unroll
                for (int bj = 0; bj < 2; ++bj) {
                    const f32x4 v0 = acc[i >> 2][bj][i & 3][0], v1 = acc[i >> 2][bj][i & 3][1];
                    u32x4 w; w.x = cvt_pk_bf16(v0[0], v0[1]); w.y = cvt_pk_bf16(v0[2], v0[3]); w.z = cvt_pk_bf16(v1[0], v1[1]); w.w = cvt_pk_bf16(v1[2], v1[3]);
                    *(u32x4*)(base + (size_t)i * 1024 + bj * HALF) = w;
                }
        }
    }
};
template <int WIN> __device__ __forceinline__ void pool_quad(const f32x4 (&acc)[2][2][4][2], int n, const f32x4 ps, unsigned (&yq)[8][2], unsigned (&qq)[8][2], unsigned (&sq)[8][2]) {
    float y[8][4], szv[8][4];
#pragma unroll
    for (int j = 0; j < 4; ++j) {
        float h[23], PS[24];
#pragma unroll
        for (int k = 0; k < 8; ++k) h[15 + k] = acc[k >> 2][0][k & 3][n][j];
#pragma unroll
        for (int k = 0; k < 8; ++k) h[7 + k] = __int_as_float(__builtin_amdgcn_update_dpp(0, __float_as_int(h[15 + k]), 0x111, 0xf, 0xf, true));
#pragma unroll
        for (int k = 1; k < 8; ++k) h[k - 1] = __int_as_float(__builtin_amdgcn_update_dpp(0, __float_as_int(h[15 + k]), 0x112, 0xf, 0xf, true));
        constexpr int LO = 16 - WIN;
#pragma unroll
        for (int x = 0; x <= LO; ++x) PS[x] = 0.f;
#pragma unroll
        for (int x = LO; x < 23; ++x) PS[x + 1] = PS[x] + h[x];
#pragma unroll
        for (int i = 0; i < 8; ++i) {
            const float w = PS[16 + i] - PS[16 + i - WIN];
            const float z = acc[i >> 2][1][i & 3][n][j];
            szv[i][j] = silu_f(z) * ps[j];
            y[i][j] = (w * (1.f / WIN) - h[15 + i]) * szv[i][j];
        }
    }
#pragma unroll
    for (int i = 0; i < 8; ++i) {
        yq[i][0] = cvt_pk_bf16(y[i][0], y[i][1]); yq[i][1] = cvt_pk_bf16(y[i][2], y[i][3]);
        qq[i][0] = cvt_pk_bf16(acc[i >> 2][0][i & 3][n][0], acc[i >> 2][0][i & 3][n][1]); qq[i][1] = cvt_pk_bf16(acc[i >> 2][0][i & 3][n][2], acc[i >> 2][0][i & 3][n][3]);
        sq[i][0] = cvt_pk_bf16(szv[i][0], szv[i][1]); sq[i][1] = cvt_pk_bf16(szv[i][2], szv[i][3]);
    }
}
struct EpiOdd {
    static constexpr bool PERM = true, AFTER_DRAIN = false, PERMA = true;
    bf16_t* Y; bf16_t* HQ; bf16_t* HS; const float* pscale;
    __device__ __forceinline__ void operator()(const f32x4 (&acc)[2][2][4][2], const Unit& u, int wr, int wc, int fr, int fq) const {
        const int T = u.pn, g = T >> 2, B = u.pm * 2 + wr;
        const int tok0 = u.pm * BM + 8 * (wr * 16 + fr);
        const int ch = T * 128 + wc * 32 + 8 * fq;
        unsigned yq[2][8][2];
#pragma unroll
        for (int n = 0; n < 2; ++n) {
            const f32x4 ps = *(const f32x4*)(pscale + ch + 4 * n);
            unsigned qq[8][2], sq[8][2];
            if (g == 0) pool_quad<2>(acc, n, ps, yq[n], qq, sq);
            else if (g == 1) pool_quad<4>(acc, n, ps, yq[n], qq, sq);
            else if (g == 2) pool_quad<8>(acc, n, ps, yq[n], qq, sq);
            else pool_quad<16>(acc, n, ps, yq[n], qq, sq);
            if (fr >= 14) {
                bf16_t* hp = HQ + ((size_t)B * 32 + (fr - 14) * 8) * 2048 + ch + 4 * n;
#pragma unroll
                for (int i = 0; i < 8; ++i) { u32x2 w; w.x = qq[i][0]; w.y = qq[i][1]; *(u32x2*)(hp + (size_t)i * 2048) = w; }
            }
            if (fr <= 1) {
                bf16_t* hp = HQ + ((size_t)B * 32 + 16 + fr * 8) * 2048 + ch + 4 * n; bf16_t* sp = HS + ((size_t)B * 16 + fr * 8) * 2048 + ch + 4 * n;
#pragma unroll
                for (int i = 0; i < 8; ++i) { u32x2 w; w.x = qq[i][0]; w.y = qq[i][1]; *(u32x2*)(hp + (size_t)i * 2048) = w; u32x2 v; v.x = sq[i][0]; v.y = sq[i][1]; *(u32x2*)(sp + (size_t)i * 2048) = v; }
            }
        }
        bf16_t* yp = Y + (size_t)tok0 * 2048 + ch;
#pragma unroll
        for (int i = 0; i < 8; ++i) { u32x4 w; w.x = yq[0][i][0]; w.y = yq[0][i][1]; w.z = yq[1][i][0]; w.w = yq[1][i][1]; *(u32x4*)(yp + (size_t)i * 2048) = w; }
    }
};
struct EpiProd {
    static constexpr bool PERM = true, AFTER_DRAIN = false, PERMA = false;
    bf16_t* O;
    __device__ __forceinline__ void operator()(const f32x4 (&acc)[2][2][4][2], const Unit& u, int wr, int wc, int fr, int fq) const {
        const int col0 = u.pn * BM + wc * 32 + 8 * fq;
#pragma unroll
        for (int ai = 0; ai < 2; ++ai)
#pragma unroll
            for (int m = 0; m < 4; ++m) {
                bf16_t* rowp = O + (size_t)((u.pm * 2 + ai) * 256 + wr * 64 + m * 16 + fr) * DM + col0;
#pragma unroll
                for (int bj = 0; bj < 2; ++bj) {
                    const f32x4 v0 = acc[ai][bj][m][0], v1 = acc[ai][bj][m][1];
                    u32x4 w; w.x = cvt_pk_bf16(v0[0], v0[1]); w.y = cvt_pk_bf16(v0[2], v0[3]); w.z = cvt_pk_bf16(v1[0], v1[1]); w.w = cvt_pk_bf16(v1[2], v1[3]);
                    *(u32x4*)(rowp + bj * HALF) = w;
                }
            }
    }
};
struct EpiBf {
    static constexpr bool PERM = true, AFTER_DRAIN = false, PERMA = false;
    bf16_t* O; int ld;
    __device__ __forceinline__ void operator()(const f32x4 (&acc)[2][2][4][2], const Unit& u, int wr, int wc, int fr, int fq) const {
        const int row0 = u.pm * BM + wr * 64 + fr, col0 = u.pn * BM + wc * 32 + 8 * fq;
#pragma unroll
        for (int ai = 0; ai < 2; ++ai)
#pragma unroll
            for (int m = 0; m < 4; ++m) {
                bf16_t* rowp = O + (size_t)(row0 + ai * HALF + m * 16) * ld + col0;
#pragma unroll
                for (int bj = 0; bj < 2; ++bj) {
                    const f32x4 v0 = acc[ai][bj][m][0], v1 = acc[ai][bj][m][1];
                    u32x4 w; w.x = cvt_pk_bf16(v0[0], v0[1]); w.y = cvt_pk_bf16(v0[2], v0[3]); w.z = cvt_pk_bf16(v1[0], v1[1]); w.w = cvt_pk_bf16(v1[2], v1[3]);
                    *(u32x4*)(rowp + bj * HALF) = w;
                }
            }
    }
};
struct EpiRes {
    static constexpr bool PERM = false, AFTER_DRAIN = false, PERMA = false;
    const float* xin; float* xout; const float* gate;
    __device__ __forceinline__ void operator()(const f32x4 (&acc)[2][2][4][2], const Unit& u, int wr, int wc, int fr, int fq) const {
        const int row0 = u.pm * BM + wr * 64 + fr, col0 = u.pn * BM + wc * 32 + 4 * fq;
        const float* gp = gate + (size_t)(u.pm >> 3) * 3072 + col0;
        f32x4 gv[2][2];
#pragma unroll
        for (int bj = 0; bj < 2; ++bj)
#pragma unroll
            for (int n = 0; n < 2; ++n) gv[bj][n] = *(const f32x4*)(gp + bj * HALF + n * 16);
#pragma unroll
        for (int ai = 0; ai < 2; ++ai)
#pragma unroll
            for (int m = 0; m < 4; ++m) {
                const size_t ro = (size_t)(row0 + ai * HALF + m * 16) * DM + col0;
#pragma unroll
                for (int bj = 0; bj < 2; ++bj)
#pragma unroll
                    for (int n = 0; n < 2; ++n) {
                        const f32x4 xv = *(const f32x4*)(xin + ro + bj * HALF + n * 16);
                        *(f32x4*)(xout + ro + bj * HALF + n * 16) = xv + gv[bj][n] * acc[ai][bj][m][n];
                    }
            }
    }
};

struct EpiResNorm {
    static constexpr bool PERM = true, AFTER_DRAIN = true, PERMA = false;
    const float* xin32; const bf16_t* xin16; bf16_t* xout16; float* out32; const float* gate; bf16_t* H; const float* ng; const float* modn; float* part; unsigned* cnt; int last;
    __device__ __forceinline__ void fused(f32x4 (&acc)[2][2][4][2], const Unit& u, int wr, int wc, int fr, int fq, LAS unsigned char* lds, int tid) const {
        const int row0 = u.pm * BM + wr * 64 + fr, col0 = u.pn * BM + wc * 32 + 8 * fq, b = u.pm >> 3;
        LAS float* lss = (LAS float*)lds;
        LAS float* lrs = (LAS float*)(lds + 4096);
        {
            const float* gp = gate + (size_t)b * 3072 + col0;
            f32x4 gv[2][2];
#pragma unroll
            for (int bj = 0; bj < 2; ++bj)
#pragma unroll
                for (int n = 0; n < 2; ++n) gv[bj][n] = *(const f32x4*)(gp + bj * HALF + 4 * n);
#pragma unroll
            for (int ai = 0; ai < 2; ++ai)
#pragma unroll
                for (int m = 0; m < 4; ++m) {
                    const size_t ro = (size_t)(row0 + ai * HALF + m * 16) * DM + col0;
                    float ss = 0.f;
#pragma unroll
                    for (int bj = 0; bj < 2; ++bj) {
                        f32x4 x0, x1;
                        if (xin32) { x0 = *(const f32x4*)(xin32 + ro + bj * HALF); x1 = *(const f32x4*)(xin32 + ro + bj * HALF + 4); }
                        else { const u32x4 w = *(const u32x4*)(xin16 + ro + bj * HALF); x0 = (f32x4){bf_lo(w.x), bf_hi(w.x), bf_lo(w.y), bf_hi(w.y)}; x1 = (f32x4){bf_lo(w.z), bf_hi(w.z), bf_lo(w.w), bf_hi(w.w)}; }
                        const f32x4 v0 = x0 + gv[bj][0] * acc[ai][bj][m][0], v1 = x1 + gv[bj][1] * acc[ai][bj][m][1];
                        acc[ai][bj][m][0] = v0; acc[ai][bj][m][1] = v1;
                        ss += ((v0[0] * v0[0] + v0[1] * v0[1]) + (v0[2] * v0[2] + v0[3] * v0[3])) + ((v1[0] * v1[0] + v1[1] * v1[1]) + (v1[2] * v1[2] + v1[3] * v1[3]));
                        if (!last) { u32x4 w; w.x = cvt_pk_bf16(v0[0], v0[1]); w.y = cvt_pk_bf16(v0[2], v0[3]); w.z = cvt_pk_bf16(v1[0], v1[1]); w.w = cvt_pk_bf16(v1[2], v1[3]); *(u32x4*)(xout16 + ro + bj * HALF) = w; }
                    }
                    ss += __shfl_xor(ss, 16); ss += __shfl_xor(ss, 32);
                    if (fq == 0) lss[(ai * HALF + wr * 64 + m * 16 + fr) * 4 + wc] = ss;
                }
        }
        __syncthreads();
        if (tid < 256) {
            const float t = (lss[tid * 4] + lss[tid * 4 + 1]) + (lss[tid * 4 + 2] + lss[tid * 4 + 3]);
            __hip_atomic_store(part + (size_t)u.pn * MTOK + u.pm * BM + tid, t, __ATOMIC_RELAXED, __HIP_MEMORY_SCOPE_AGENT);
        }
        asm volatile("s_waitcnt vmcnt(0)" ::: "memory");
        __syncthreads();
        if (tid == 0) {
            unsigned* c = cnt + u.pm;
            __hip_atomic_fetch_add(c, 1u, __ATOMIC_RELAXED, __HIP_MEMORY_SCOPE_AGENT);
            unsigned spins = 0;
            while (__hip_atomic_load(c, __ATOMIC_RELAXED, __HIP_MEMORY_SCOPE_AGENT) < 4u && ++spins < (1u << 22)) __builtin_amdgcn_s_sleep(1);
            __builtin_amdgcn_fence(__ATOMIC_ACQUIRE, "agent");
            asm volatile("s_waitcnt vmcnt(0)" ::: "memory");
        }
        __syncthreads();
        if (tid < 256) {
            float t = 0.f;
#pragma unroll
            for (int q = 0; q < 4; ++q) t += __hip_atomic_load(part + (size_t)q * MTOK + u.pm * BM + tid, __ATOMIC_RELAXED, __HIP_MEMORY_SCOPE_AGENT);
            lrs[tid] = rsqrtf(t * (1.f / DM) + EPS);
        }
        __syncthreads();
        const float* mb = modn + (size_t)b * 3072;
#pragma unroll
        for (int bj = 0; bj < 2; ++bj) {
            const int c = col0 + bj * HALF;
            const f32x4 g0 = *(const f32x4*)(ng + c), g1 = *(const f32x4*)(ng + c + 4);
            f32x4 sh0 = {0.f, 0.f, 0.f, 0.f}, sh1 = sh0, sc0 = sh0, sc1 = sh0;
            if (!last) { sh0 = *(const f32x4*)(mb + c); sh1 = *(const f32x4*)(mb + c + 4); sc0 = *(const f32x4*)(mb + 1024 + c); sc1 = *(const f32x4*)(mb + 1024 + c + 4); }
            const f32x4 a0 = g0 * (sc0 + 1.f), a1 = g1 * (sc1 + 1.f);
#pragma unroll
            for (int ai = 0; ai < 2; ++ai)
#pragma unroll
                for (int m = 0; m < 4; ++m) {
                    const int rl = ai * HALF + wr * 64 + m * 16 + fr;
                    const float rstd = lrs[rl];
                    const size_t ro = (size_t)(u.pm * BM + rl) * DM + c;
                    const f32x4 h0 = (acc[ai][bj][m][0] * rstd) * a0 + sh0, h1 = (acc[ai][bj][m][1] * rstd) * a1 + sh1;
                    if (last) { *(f32x4*)(out32 + ro) = h0; *(f32x4*)(out32 + ro + 4) = h1; }
                    else { u32x4 w; w.x = cvt_pk_bf16(h0[0], h0[1]); w.y = cvt_pk_bf16(h0[2], h0[3]); w.z = cvt_pk_bf16(h1[0], h1[1]); w.w = cvt_pk_bf16(h1[2], h1[3]); *(u32x4*)(H + ro) = w; }
                }
        }
    }
};

template <class Epi>
__device__ __forceinline__ void gemm_phase(LAS unsigned char* lds, const Gemm g, const Epi& E) {
    const int tid = opaque_tid(), wid = __builtin_amdgcn_readfirstlane(tid >> 6), lane = tid & 63, wr = wid >> 2, wc = wid & 3, fr = lane & 15, fq = lane >> 4;
    const int nt = g.K / BK;
    unsigned voffA[2], voffB[2];
#pragma unroll
    for (int i = 0; i < 2; ++i) { int R, C; stage_rc(tid * 16 + i * 8192, R, C); const int Rb = Epi::PERM ? ((R & ~31) + perm32(R & 31)) : R;
        const int Ra = Epi::PERMA ? (8 * ((R >> 6) * 16 + (R & 15)) + ((R >> 4) & 3)) : R;
        voffA[i] = (unsigned)(Ra * g.lda + C) * 2u; voffB[i] = (unsigned)(Rb * g.ldb + C) * 2u; }
    const size_t kstep = (size_t)(BK * 2);
    const size_t hstepA = (size_t)(Epi::PERMA ? 4 : HALF) * g.lda * 2, hstepB = (size_t)HALF * g.ldb * 2, tstepA = (size_t)BM * g.lda * 2;
    const unsigned ldsw = (unsigned)wid * 1024u;
    const int aoff = lds_byte(wr * 64 + fr, fq * 8), boff = lds_byte(wc * 32 + fr, fq * 8);
#define PG8_SA(b, h) (((b) * 2 + (h)) * HTB)
#define PG8_SB(b, h) ((4 + (b) * 2 + (h)) * HTB)
#define PG8_STAGE(bufoff, gbase, voff) do { _Pragma("unroll") for (int _i = 0; _i < 2; ++_i) \
        __builtin_amdgcn_global_load_lds((const unsigned*)((const char*)(gbase) + (voff)[_i]), (LAS unsigned*)(lds + (bufoff) + ldsw + _i * 8192), 16, 0, 0); } while (0)
#define PG8_LDA(dst, b, h) do { _Pragma("unroll") for (int m = 0; m < 4; ++m) _Pragma("unroll") for (int k = 0; k < 2; ++k) dst[m][k] = *(const LAS bf16x8*)(lds + PG8_SA(b, h) + aoff + m * 2048 + k * 1024); } while (0)
#define PG8_LDB(dst, b, h) do { _Pragma("unroll") for (int n = 0; n < 2; ++n) _Pragma("unroll") for (int k = 0; k < 2; ++k) dst[n][k] = *(const LAS bf16x8*)(lds + PG8_SB(b, h) + boff + n * 2048 + k * 1024); } while (0)
#define PG8_MMA(ai, bj, At, Bt) do { __builtin_amdgcn_s_setprio(1); _Pragma("unroll") for (int m = 0; m < 4; ++m) _Pragma("unroll") for (int n = 0; n < 2; ++n) _Pragma("unroll") for (int k = 0; k < 2; ++k) \
        acc[ai][bj][m][n] = __builtin_amdgcn_mfma_f32_16x16x32_bf16(Bt[n][k], At[m][k], acc[ai][bj][m][n], 0, 0, 0); __builtin_amdgcn_s_setprio(0); } while (0)
#define PG8_WAIT_V(n) asm volatile("s_waitcnt vmcnt(" #n ")" ::: "memory")
#define PG8_WAIT_L(n) asm volatile("s_waitcnt lgkmcnt(" #n ")" ::: "memory")
#define PG8_BAR __builtin_amdgcn_s_barrier()
#define PG8_SCHED __builtin_amdgcn_sched_barrier(0)
    Unit cur, nxt; int ui = 0;
    const int bid = opaque_bid();
    if (!next_unit(g, bid, 0, cur)) return;
    f32x4 acc[2][2][4][2];
#pragma unroll
    for (int a = 0; a < 2; ++a)
#pragma unroll
        for (int b = 0; b < 2; ++b)
#pragma unroll
            for (int m = 0; m < 4; ++m)
#pragma unroll
                for (int n = 0; n < 2; ++n) acc[a][b][m][n] = (f32x4){0.f, 0.f, 0.f, 0.f};
    bf16x8 At[4][2], B0[2][2], B1[2][2];
    const char* cA = (const char*)g.A + (size_t)cur.pm * tstepA; const char* cB = (const char*)g.Bt + (size_t)cur.pn * 2 * hstepB + (size_t)(cur.pm >> 1) * g.bk * 2;
    PG8_STAGE(PG8_SB(0, 0), cB, voffB); PG8_STAGE(PG8_SA(0, 0), cA, voffA); PG8_STAGE(PG8_SB(0, 1), cB + hstepB, voffB); PG8_STAGE(PG8_SA(0, 1), cA + hstepA, voffA);
    if (wr == 1) PG8_BAR;
    PG8_WAIT_V(4); PG8_BAR;
    PG8_STAGE(PG8_SB(1, 0), cB + kstep, voffB); PG8_STAGE(PG8_SA(1, 0), cA + kstep, voffA); PG8_STAGE(PG8_SB(1, 1), cB + hstepB + kstep, voffB);
    PG8_WAIT_V(6); PG8_BAR;
    for (;;) {
        const bool has_next = next_unit(g, bid, ui + 1, nxt);
        const char* nA = has_next ? (const char*)g.A + (size_t)nxt.pm * tstepA : cA;
        const char* nB = has_next ? (const char*)g.Bt + (size_t)nxt.pn * 2 * hstepB + (size_t)(nxt.pm >> 1) * g.bk * 2 : cB;
        for (int t = 0; t < nt; t += 2) {
            const bool last = (t == nt - 2);
            const char* a1 = cA + (size_t)(t + 1) * kstep;
            const char* a2 = last ? nA : cA + (size_t)(t + 2) * kstep; const char* b2 = last ? nB : cB + (size_t)(t + 2) * kstep;
            const char* a3 = a2 + kstep; const char* b3 = b2 + kstep;
            PG8_LDB(B0, 0, 0); PG8_SCHED; PG8_LDA(At, 0, 0); PG8_STAGE(PG8_SA(1, 1), a1 + hstepA, voffA);
            PG8_WAIT_L(8); PG8_BAR; PG8_WAIT_L(0); PG8_MMA(0, 0, At, B0); PG8_BAR; PG8_SCHED;
            PG8_LDB(B1, 0, 1); PG8_STAGE(PG8_SB(0, 0), b2, voffB);
            PG8_BAR; PG8_WAIT_L(0); PG8_MMA(0, 1, At, B1); PG8_BAR;
            PG8_LDA(At, 0, 1); PG8_STAGE(PG8_SA(0, 0), a2, voffA);
            PG8_BAR; PG8_WAIT_L(0); PG8_MMA(1, 0, At, B0); PG8_BAR; PG8_SCHED;
            PG8_STAGE(PG8_SB(0, 1), b2 + hstepB, voffB);
            PG8_WAIT_V(6); PG8_BAR; PG8_MMA(1, 1, At, B1); PG8_BAR;
            PG8_LDB(B0, 1, 0); PG8_SCHED; PG8_LDA(At, 1, 0); PG8_STAGE(PG8_SA(0, 1), a2 + hstepA, voffA);
            PG8_WAIT_L(8); PG8_BAR; PG8_WAIT_L(0); PG8_MMA(0, 0, At, B0); PG8_BAR; PG8_SCHED;
            PG8_LDB(B1, 1, 1); PG8_STAGE(PG8_SB(1, 0), b3, voffB);
            PG8_BAR; PG8_WAIT_L(0); PG8_MMA(0, 1, At, B1); PG8_BAR;
            PG8_LDA(At, 1, 1); PG8_STAGE(PG8_SA(1, 0), a3, voffA);
            PG8_BAR; PG8_WAIT_L(0); PG8_MMA(1, 0, At, B0); PG8_BAR; PG8_SCHED;
            PG8_STAGE(PG8_SB(1, 1), b3 + hstepB, voffB);
            PG8_WAIT_V(6); PG8_BAR; PG8_MMA(1, 1, At, B1); PG8_BAR;
        }
        if constexpr (!Epi::AFTER_DRAIN) E(acc, cur, wr, wc, fr, fq);
        if (!has_next) break;
#pragma unroll
        for (int a = 0; a < 2; ++a)
#pragma unroll
            for (int b = 0; b < 2; ++b)
#pragma unroll
                for (int m = 0; m < 4; ++m)
#pragma unroll
                    for (int n = 0; n < 2; ++n) acc[a][b][m][n] = (f32x4){0.f, 0.f, 0.f, 0.f};
        cur = nxt; cA = nA; cB = nB; ++ui;
    }
    PG8_WAIT_V(0);
    if (wr == 0) PG8_BAR;
    PG8_BAR;
    if constexpr (Epi::AFTER_DRAIN) E.fused(acc, cur, wr, wc, fr, fq, lds, tid);
#undef PG8_SA
#undef PG8_SB
#undef PG8_STAGE
#undef PG8_LDA
#undef PG8_LDB
#undef PG8_MMA
#undef PG8_WAIT_V
#undef PG8_WAIT_L
#undef PG8_BAR
#undef PG8_SCHED
}

__device__ __forceinline__ void phase_mod(const Params& p, LAS unsigned char* lds) {
    const int tid = opaque_tid(), wid = tid >> 6, lane = tid & 63;
    LAS float* sc = (LAS float*)lds;
    LAS float* red = (LAS float*)(lds + 32768);
    float* mod = (float*)(p.ws + WS_MOD);
    for (int t = tid; t < NB * DM; t += 512) sc[t] = silu_f(p.c[t]);
    __syncthreads();
    for (int it = opaque_bid(); it < 192; it += gridDim.x) {
        const int col = it * 64 + lane, i = col / 3072, j = col - i * 3072;
        const float* w = p.ada_w + ((size_t)i * DM + wid * 128) * 3072 + j;
        float a[8];
#pragma unroll
        for (int b = 0; b < 8; ++b) a[b] = 0.f;
#pragma unroll 32
        for (int k = 0; k < 128; ++k) {
            const float wv = w[(size_t)k * 3072];
#pragma unroll
            for (int b = 0; b < 8; ++b) a[b] += sc[b * DM + wid * 128 + k] * wv;
        }
#pragma unroll
        for (int b = 0; b < 8; ++b) red[(wid * 8 + b) * 64 + lane] = a[b];
        __syncthreads();
        {
            const int b = tid >> 6; float s = 0.f;
#pragma unroll
            for (int w8 = 0; w8 < 8; ++w8) s += red[(w8 * 8 + b) * 64 + lane];
            mod[((size_t)i * NB + b) * 3072 + j] = s + p.ada_b[i * 3072 + j];
        }
        __syncthreads();
    }
}

__device__ __forceinline__ void conv_tile(const float* __restrict__ src, int srcN, int c0, bf16_t* __restrict__ dstrow, int K, int k0, LAS float* T, int csrc = -1) {
    const int tid = opaque_tid();
    const int cs = csrc >= 0 ? csrc : c0 + (tid & 15) * 4;
    f32x4 v[8];
#pragma unroll
    for (int ps = 0; ps < 8; ++ps) v[ps] = *(const f32x4*)(src + (size_t)(k0 + ps * 32 + (tid >> 4)) * srcN + cs);
#pragma unroll
    for (int ps = 0; ps < 8; ++ps) { LAS float* t = T + (ps * 32 + (tid >> 4)) * 65 + (tid & 15) * 4; t[0] = v[ps][0]; t[1] = v[ps][1]; t[2] = v[ps][2]; t[3] = v[ps][3]; }
    __syncthreads();
#pragma unroll
    for (int q = 0; q < 4; ++q) {
        const int item = tid + 512 * q, n = item >> 5, kg = item & 31; const LAS float* s = T + (kg * 8) * 65 + n;
        u32x4 o; o.x = cvt_pk_bf16(s[0], s[65]); o.y = cvt_pk_bf16(s[130], s[195]); o.z = cvt_pk_bf16(s[260], s[325]); o.w = cvt_pk_bf16(s[390], s[455]);
        *(u32x4*)(dstrow + (size_t)n * K + k0 + kg * 8) = o;
    }
    __syncthreads();
}

__device__ __forceinline__ void norm_rows(const Params& p, int layer, const float* xin, int item) {
    const int tid = opaque_tid(), wid = tid >> 6, lane = tid & 63;
    bf16_t* H = (bf16_t*)g_h;
    const float* mod = (const float*)(p.ws + WS_MOD) + (size_t)layer * NB * 3072;
    const float* gp = p.norm_g + (size_t)layer * DM;
#pragma unroll
    for (int h2 = 0; h2 < 2; ++h2) {
        const int row = item * 16 + h2 * 8 + wid, b = row >> 11;
        const f32x4* xr = (const f32x4*)(xin + (size_t)row * DM) + lane;
        f32x4 v[4]; float ss = 0.f;
#pragma unroll
        for (int q = 0; q < 4; ++q) { v[q] = xr[64 * q]; ss += (v[q][0] * v[q][0] + v[q][1] * v[q][1]) + (v[q][2] * v[q][2] + v[q][3] * v[q][3]); }
        const float rstd = rsqrtf(wave_sum(ss) * (1.f / DM) + EPS);
        const float* mb = mod + (size_t)b * 3072;
        u32x2* o8 = (u32x2*)(H + (size_t)row * DM) + lane;
#pragma unroll
        for (int q = 0; q < 4; ++q) {
            const int k = (lane + 64 * q) * 4;
            const f32x4 gv = *(const f32x4*)(gp + k), sh = *(const f32x4*)(mb + k), scl = *(const f32x4*)(mb + 1024 + k);
            const f32x4 hv = (v[q] * rstd * gv) * (scl + 1.f) + sh;
            u32x2 w; w.x = cvt_pk_bf16(hv[0], hv[1]); w.y = cvt_pk_bf16(hv[2], hv[3]);
            o8[64 * q] = w;
        }
    }
}
struct ConvD { const float* sp; bf16_t* dst; int srcN, K, k0; };
__device__ __forceinline__ bool conv_desc(const Params& p, int j, int it, int tid, ConvD& d) {
    constexpr int N0 = 448, N1 = N0 + 128, N2 = N1 + 128, N3 = N2 + 128, N4 = N3 + 64;
    if (it >= N4) return false;
    const float* src; int srcN, cs = (tid & 15) * 4, K, k0; bf16_t* dst;
    if (it < N0) {
        const int rt = it >> 2, kt = it & 3, r0 = rt * 64, T = r0 >> 8, q = r0 & 255;
        if (T < 16) {
            const int cg = tid & 15, bj = q >> 7, wcc = ((q >> 6) & 1) * 2 + (cg >> 3), fq4 = (cg >> 1) & 3, n = cg & 1;
            const int tbase = bj == 0 ? (n == 0 ? 2048 : 0) : (n == 0 ? 1024 : 3072);
            cs = tbase + 64 * T + 16 * wcc + 4 * fq4;
        }
        else if (T < 24) cs += (q < 128) ? (4096 + 128 * (T - 16) + q) : (6144 + 128 * (T - 16) + q - 128);
        else cs += 5120 + 256 * (T - 24) + q;
        src = p.ab_w_in + (size_t)j * DM * 7168; srcN = 7168; dst = (bf16_t*)(p.ws + WS_WIN_E) + (size_t)r0 * DM; K = DM; k0 = kt * 256;
    } else if (it < N1) {
        const int i2 = it - N0, rt = i2 >> 3, kt = i2 & 7, r0 = rt * 64;
        src = p.ab_w_out + (size_t)j * 2048 * DM; srcN = DM; cs += r0; dst = (bf16_t*)(p.ws + WS_WOUT_E) + (size_t)r0 * 2048; K = 2048; k0 = kt * 256;
    } else if (it < N2) {
        const int i2 = it - N1, rt = i2 >> 2, kt = i2 & 3, r0 = rt * 64;
        src = p.c_w_in + (size_t)j * DM * 4096; srcN = 4096; cs += 2048 + r0; dst = (bf16_t*)(p.ws + WS_WIN_O) + (size_t)((r0 >> 7) * 256 + 128 + (r0 & 127)) * DM; K = DM; k0 = kt * 256;
    } else if (it < N3) {
        const int i2 = it - N2, rt = i2 >> 3, kt = i2 & 7, r0 = rt * 64;
        src = p.c_w_out + (size_t)j * 2048 * DM; srcN = DM; cs += r0; dst = (bf16_t*)(p.ws + WS_WOUT_O) + (size_t)r0 * 2048; K = 2048; k0 = kt * 256;
    } else {
        const int i3 = it - N3, g = i3 >> 4, r = i3 & 15, rt = r >> 1, kt = r & 1, r0 = rt * 64;
        src = p.c_pool_w + ((size_t)j * 4 + g) * 512 * 512; srcN = 512; cs += r0; dst = (bf16_t*)(p.ws + WS_POOLT) + (size_t)g * 512 * 512 + (size_t)r0 * 512; K = 512; k0 = kt * 256;
    }
    d.sp = src + (size_t)(k0 + (tid >> 4)) * srcN + cs; d.dst = dst; d.srcN = srcN; d.K = K; d.k0 = k0;
    return true;
}
__device__ __forceinline__ void phase_norm_even(const Params& p, int j, const float* xin, LAS unsigned char* ldsb, int sel, int wg0, int ldsoff, int rot) {
    const int tid = opaque_tid();
    LAS float* T = (LAS float*)(ldsb + ldsoff);
    bf16_t* SGU = (bf16_t*)(p.ws + WS_SGU); bf16_t* WINP = (bf16_t*)(p.ws + WS_WINP);
    constexpr int N3 = 448 + 128 + 128 + 128, N4 = N3 + 64, N5 = N4 + 32, N6 = N5 + 512;
    const int NROWS = (j == 0 ? MTOK / 16 : 0);
    const int TOTAL = sel == 1 ? 576 : sel == 2 ? 864 + NROWS : N6 + NROWS;
    const int bid = opaque_bid();
    if (bid < wg0) return;
    const int stride = gridDim.x - wg0;
#define SETUP_MAP(v) (sel == 1 ? ((v) < 64 ? N3 + (v) : N5 + ((v) - 64)) : sel == 2 ? ((v) < N3 ? (v) : (v) < 864 ? N4 + ((v) - N3) : N6 + ((v) - 864)) : (v))
    int v = (bid - wg0 + rot) % stride;
    ConvD d; bool isc = (v < TOTAL) && conv_desc(p, j, SETUP_MAP(v), tid, d);
    f32x4 r[8];
    if (isc) {
#pragma unroll
        for (int ps = 0; ps < 8; ++ps) r[ps] = *(const f32x4*)(d.sp + (size_t)ps * 32 * d.srcN);
    }
    while (v < TOTAL) {
        const int vn = v + stride; ConvD dn; const bool iscn = (vn < TOTAL) && conv_desc(p, j, SETUP_MAP(vn), tid, dn);
        if (isc) {
#pragma unroll
            for (int ps = 0; ps < 8; ++ps) { LAS float* t = T + (ps * 32 + (tid >> 4)) * 65 + (tid & 15) * 4; t[0] = r[ps][0]; t[1] = r[ps][1]; t[2] = r[ps][2]; t[3] = r[ps][3]; }
            __syncthreads();
            if (iscn) {
#pragma unroll
                for (int ps = 0; ps < 8; ++ps) r[ps] = *(const f32x4*)(dn.sp + (size_t)ps * 32 * dn.srcN);
            }
#pragma unroll
            for (int q = 0; q < 4; ++q) {
                const int item = tid + 512 * q, n = item >> 5, kg = item & 31; const LAS float* s = T + (kg * 8) * 65 + n;
                u32x4 o; o.x = cvt_pk_bf16(s[0], s[65]); o.y = cvt_pk_bf16(s[130], s[195]); o.z = cvt_pk_bf16(s[260], s[325]); o.w = cvt_pk_bf16(s[390], s[455]);
                *(u32x4*)(d.dst + (size_t)n * d.K + d.k0 + kg * 8) = o;
            }
            __syncthreads();
        } else {
            if (iscn) {
#pragma unroll
                for (int ps = 0; ps < 8; ++ps) r[ps] = *(const f32x4*)(dn.sp + (size_t)ps * 32 * dn.srcN);
            }
            const int it = SETUP_MAP(v);
            if (it < N5) {
                const int e0 = (it - N4) * 4096 + tid * 8, t = (e0 >> 7) & 127, s0 = e0 & 127;
                const float* src = p.ab_sgu_w + (size_t)j * 8 * 128 * 128 + e0;
                const f32x4 a = *(const f32x4*)src, b = *(const f32x4*)(src + 4);
                float w[8] = {a[0], a[1], a[2], a[3], b[0], b[1], b[2], b[3]};
#pragma unroll
                for (int e = 0; e < 8; ++e) w[e] = (s0 + e <= t) ? w[e] : 0.f;
                u32x4 o; o.x = cvt_pk_bf16(w[0], w[1]); o.y = cvt_pk_bf16(w[2], w[3]); o.z = cvt_pk_bf16(w[4], w[5]); o.w = cvt_pk_bf16(w[6], w[7]);
                *(u32x4*)(SGU + e0) = o;
            } else if (it < N6) {
                const int e0 = (it - N5) * 4096 + tid * 8, k = e0 >> 11, c = e0 & 2047;
                const float* src = p.c_w_in + ((size_t)j * DM + k) * 4096 + c;
                const f32x4 a = *(const f32x4*)src, b = *(const f32x4*)(src + 4);
                u32x4 o; o.x = cvt_pk_bf16(a[0], a[1]); o.y = cvt_pk_bf16(a[2], a[3]); o.z = cvt_pk_bf16(b[0], b[1]); o.w = cvt_pk_bf16(b[2], b[3]);
                *(u32x4*)(WINP + e0) = o;
            } else norm_rows(p, 2 * j, xin, it - N6);
        }
        v = vn; d = dn; isc = iscn;
    }
#undef SETUP_MAP
}
__device__ __forceinline__ void phase_final(const Params& p) {
    const int tid = opaque_tid(), wid = tid >> 6, lane = tid & 63;
    for (int it = opaque_bid(); it < MTOK / 8; it += gridDim.x) {
        const int row = it * 8 + wid;
        f32x4* xr = (f32x4*)(p.out + (size_t)row * DM) + lane;
        f32x4 v[4]; float ss = 0.f;
#pragma unroll
        for (int q = 0; q < 4; ++q) { v[q] = xr[64 * q]; ss += (v[q][0] * v[q][0] + v[q][1] * v[q][1]) + (v[q][2] * v[q][2] + v[q][3] * v[q][3]); }
        const float rstd = rsqrtf(wave_sum(ss) * (1.f / DM) + EPS);
#pragma unroll
        for (int q = 0; q < 4; ++q) { const f32x4 gv = *(const f32x4*)(p.final_g + (lane + 64 * q) * 4); xr[64 * q] = v[q] * rstd * gv; }
    }
}

__device__ __forceinline__ void unpack8(const u32x4 w, float (&f)[8]) {
    f[0] = bf_lo(w.x); f[1] = bf_hi(w.x); f[2] = bf_lo(w.y); f[3] = bf_hi(w.y); f[4] = bf_lo(w.z); f[5] = bf_hi(w.z); f[6] = bf_lo(w.w); f[7] = bf_hi(w.w);
}

__device__ __forceinline__ void product_units(const Params& p, LAS unsigned char* lds) {
    Gemm g{(const bf16_t*)(p.ws + WS_POOLT), (const bf16_t*)(p.ws + WS_WINP), 512, 2048, 512, 8, 4, 512}; EpiProd E{(bf16_t*)(p.ws + WS_WIN_O)};
    gemm_phase(lds, g, E);
}
__device__ __forceinline__ void phase_mix(const Params& p, int j, LAS unsigned char* lds) {
    const int tid = opaque_tid(), wid = tid >> 6, lane = tid & 63;
    const bf16_t* CH2 = (const bf16_t*)(p.ws + WS_RP); const bf16_t* BZ = CH2 + (size_t)MTOK * 1024; const bf16_t* UZ = BZ + (size_t)MTOK * 1024; const bf16_t* V = UZ + (size_t)MTOK * 1024;
    bf16_t* Y = (bf16_t*)(p.ws + WS_RA);
    {
        const bf16_t* Wm = (const bf16_t*)(p.ws + WS_SGU);
        const int fr = lane & 15, fq = lane >> 4;
        const int rs = tid >> 4, c = tid & 15;
        int it = opaque_bid(), par = 0;
        u32x4 vraw[4];
        if (it < 1024) { const bf16_t* vp = V + (size_t)((it >> 3) * 128 + rs) * 1024 + (it & 7) * 128 + 8 * c;
#pragma unroll
            for (int ps = 0; ps < 4; ++ps) vraw[ps] = *(const u32x4*)(vp + (size_t)ps * 32 * 1024); }
        for (; it < 1024; it += gridDim.x, par ^= 1) {
            const int hh = it & 7, cn = it >> 3;
            LAS bf16_t* vnT = (LAS bf16_t*)(lds + par * 36864);
            const int t = 16 * wid + fr; const size_t row = (size_t)cn * 128 + t;
            u32x2 uz[8];
#pragma unroll
            for (int n = 0; n < 8; ++n) uz[n] = *(const u32x2*)(UZ + row * 1024 + hh * 128 + 16 * n + 4 * fq);
            const float bias = p.ab_sgu_b[(size_t)j * 1024 + hh * 128 + t];
            const bf16_t* wrow = Wm + ((size_t)hh * 128 + 16 * wid + fr) * 128 + 8 * fq;
            bf16x8 af[4];
#pragma unroll
            for (int kk = 0; kk < 4; ++kk) af[kk] = *(const bf16x8*)(wrow + 32 * kk);
            const float* lg = p.ab_ln_g + (size_t)j * 1024 + hh * 128 + 8 * c; const float* lb = p.ab_ln_b + (size_t)j * 1024 + hh * 128 + 8 * c;
            const f32x4 g0 = *(const f32x4*)lg, g1 = *(const f32x4*)(lg + 4), b0 = *(const f32x4*)lb, b1 = *(const f32x4*)(lb + 4);
            const float gg[8] = {g0[0], g0[1], g0[2], g0[3], g1[0], g1[1], g1[2], g1[3]}, bb[8] = {b0[0], b0[1], b0[2], b0[3], b1[0], b1[1], b1[2], b1[3]};
#pragma unroll
            for (int ps = 0; ps < 4; ++ps) {
                float f[8]; unpack8(vraw[ps], f);
                float s1 = 0.f, s2 = 0.f;
#pragma unroll
                for (int e = 0; e < 8; ++e) { s1 += f[e]; s2 += f[e] * f[e]; }
#pragma unroll
                for (int o = 1; o < 16; o <<= 1) { s1 += __shfl_xor(s1, o); s2 += __shfl_xor(s2, o); }
                const float mu = s1 * (1.f / 128.f), var = fmaxf(s2 * (1.f / 128.f) - mu * mu, 0.f), rstd = rsqrtf(var + EPS);
                const int sr = ps * 32 + rs;
                LAS bf16_t* wp = vnT + (8 * c) * 136 + ((((sr >> 3) ^ c) & 15) << 3) + (sr & 7);
#pragma unroll
                for (int e = 0; e < 8; ++e) wp[e * 136] = (bf16_t)(cvt_pk_bf16((f[e] - mu) * rstd * gg[e] + bb[e], 0.f) & 0xffffu);
            }
            __syncthreads();
            {
                const int itn = it + gridDim.x;
                if (itn < 1024) { const bf16_t* vp = V + (size_t)((itn >> 3) * 128 + rs) * 1024 + (itn & 7) * 128 + 8 * c;
#pragma unroll
                    for (int ps = 0; ps < 4; ++ps) vraw[ps] = *(const u32x4*)(vp + (size_t)ps * 32 * 1024); }
            }
            f32x4 acc[8];
#pragma unroll
            for (int n = 0; n < 8; ++n) acc[n] = (f32x4){0.f, 0.f, 0.f, 0.f};
#pragma unroll
            for (int kk = 0; kk < 4; ++kk) {
                if (32 * kk <= 16 * wid + 15) {
#pragma unroll
                    for (int n = 0; n < 8; ++n) {
                        const int cd = (2 * n + (fr >> 3)) & 15;
                        const bf16x8 bfm = *(const LAS bf16x8*)(vnT + (16 * n + fr) * 136 + ((((4 * kk + fq) ^ cd) & 15) << 3));
                        acc[n] = __builtin_amdgcn_mfma_f32_16x16x32_bf16(bfm, af[kk], acc[n], 0, 0, 0);
                    }
                }
            }
#pragma unroll
            for (int n = 0; n < 8; ++n) {
                const int d = 16 * n + 4 * fq;
                u32x2 w; w.x = cvt_pk_bf16(bf_lo(uz[n].x) * (acc[n][0] + bias), bf_hi(uz[n].x) * (acc[n][1] + bias));
                w.y = cvt_pk_bf16(bf_lo(uz[n].y) * (acc[n][2] + bias), bf_hi(uz[n].y) * (acc[n][3] + bias));
                *(u32x2*)(Y + row * 2048 + 1024 + hh * 128 + d) = w;
            }
        }
        __syncthreads();
    }
    {
        const float* halo = (const float*)(p.ws + WS_HALO); const float* cw = p.ab_conv_w + (size_t)j * 3 * 1024;
        for (int gid = opaque_bid() * 512 + tid; gid < 128 * 1024; gid += gridDim.x * 512) {
            const int B = gid >> 10, c = gid & 1023; const bool hist = ((B * 128) & (SEQ - 1)) != 0;
            const float* hb = halo + (size_t)B * 6 * 1024 + c;
            const float c6 = hist ? hb[-6 * 1024] : 0.f, c7 = hist ? hb[-5 * 1024] : 0.f, c0 = hb[2 * 1024], c1 = hb[3 * 1024], b0 = hb[4 * 1024], b1 = hb[5 * 1024];
            const float w0 = cw[c], w1 = cw[1024 + c], w2 = cw[2048 + c];
            const float y0 = b0 * (w0 * c6 + w1 * c7 + w2 * c0), y1 = b1 * (w0 * c7 + w1 * c0 + w2 * c1);
            Y[(size_t)(B * 128) * 2048 + c] = (bf16_t)(cvt_pk_bf16(y0, 0.f) & 0xffffu);
            Y[(size_t)(B * 128 + 1) * 2048 + c] = (bf16_t)(cvt_pk_bf16(y1, 0.f) & 0xffffu);
        }
    }
}

__device__ __forceinline__ void phase_pool(const Params& p) {
    const int tid = opaque_tid();
    const bf16_t* HQ = (const bf16_t*)(p.ws + WS_HQ); const bf16_t* HS = (const bf16_t*)(p.ws + WS_HS); bf16_t* Y = (bf16_t*)(p.ws + WS_RA);
    for (int gid = opaque_bid() * 512 + tid; gid < 128 * 256; gid += gridDim.x * 512) {
        const int B = gid >> 8, ct = gid & 255, c0 = ct * 8, win = 2 << (ct >> 6); const bool hist = ((B * 128) & (SEQ - 1)) != 0;
        const bf16_t* tail = HQ + (size_t)(B - 1) * 32 * 2048 + c0;
        const bf16_t* head = HQ + ((size_t)B * 32 + 16) * 2048 + c0;
        const bf16_t* hs = HS + (size_t)B * 16 * 2048 + c0;
        float S[8];
#pragma unroll
        for (int e = 0; e < 8; ++e) S[e] = 0.f;
        if (hist) {
#pragma unroll
            for (int i = 1; i < 16; ++i) {
                if (i < win) { float v[8]; unpack8(*(const u32x4*)(tail + (size_t)(16 - i) * 2048), v);
#pragma unroll
                    for (int e = 0; e < 8; ++e) S[e] += v[e]; }
            }
        }
#pragma unroll 4
        for (int r = 0; r < 16; ++r) {
            float cur[8], sz[8], o[8];
            unpack8(*(const u32x4*)(head + (size_t)r * 2048), cur);
            unpack8(*(const u32x4*)(hs + (size_t)r * 2048), sz);
            const float inv = 1.f / (float)(hist ? win : min(r + 1, win));
#pragma unroll
            for (int e = 0; e < 8; ++e) { S[e] += cur[e]; o[e] = (S[e] * inv - cur[e]) * sz[e]; }
            u32x4 w; w.x = cvt_pk_bf16(o[0], o[1]); w.y = cvt_pk_bf16(o[2], o[3]); w.z = cvt_pk_bf16(o[4], o[5]); w.w = cvt_pk_bf16(o[6], o[7]);
            *(u32x4*)(Y + (size_t)(B * 128 + r) * 2048 + c0) = w;
            const int ro = r - win + 1;
            if (ro >= 0 || hist) { float old[8]; unpack8(*(const u32x4*)(ro >= 0 ? head + (size_t)ro * 2048 : tail + (size_t)(16 + ro) * 2048), old);
#pragma unroll
                for (int e = 0; e < 8; ++e) S[e] -= old[e]; }
        }
    }
}

#define XB_TMO      128
#define XB_XCNT(j)  (256  + 64 * (j))
#define XB_XSUB(j)  (1280 + 64 * (j))
#define XB_XGEN(j)  (2304 + 64 * (j))
#define XB_TOP      3328
#define XB_TOPGEN   3392
#define XCD_BAR_WORDS 3456
#define XB_SPIN_CAP (1u << 18)
__device__ __forceinline__ unsigned xb_ld(unsigned* p)              { return __hip_atomic_load(p, __ATOMIC_RELAXED, __HIP_MEMORY_SCOPE_AGENT); }
__device__ __forceinline__ unsigned xb_add(unsigned* p, unsigned v) { return __hip_atomic_fetch_add(p, v, __ATOMIC_RELAXED, __HIP_MEMORY_SCOPE_AGENT); }
__device__ __forceinline__ unsigned xb_xcc_id() { return (unsigned)__builtin_amdgcn_s_getreg((3 << 11) | 20) & 0xFu; }
#define XB_SPIN(cond, bar) do { unsigned _sp = 0; while (cond) { __builtin_amdgcn_s_sleep(1); \
    if ((++_sp & 255u) == 0u) { if (xb_ld(&(bar)[XB_TMO])) break; if (_sp > XB_SPIN_CAP) { atomicAdd(&(bar)[XB_TMO], 1u); break; } } } } while (0)
struct XcdBarrier { unsigned* bar; unsigned x; volatile LAS unsigned* st; };
__device__ __forceinline__ XcdBarrier xcd_barrier_post(unsigned* bar, volatile LAS unsigned* st) {
    XcdBarrier b; b.bar = bar; b.x = xb_xcc_id(); b.st = st;
    if (threadIdx.x == 0) (void)xb_add(&bar[XB_XCNT(b.x)], 1u);
    return b;
}
__device__ __forceinline__ void xcd_barrier_complete(unsigned* bar, unsigned x, unsigned& nloc, unsigned& nx) {
    const unsigned G = gridDim.x * gridDim.y * gridDim.z;
    unsigned sum, cnt, mine, sp = 0u;
    for (;;) {
        sum = 0u; cnt = 0u; mine = 0u;
#pragma unroll
        for (unsigned j = 0; j < 16; ++j) { const unsigned c = xb_ld(&bar[XB_XCNT(j)]); sum += c; cnt += (c > 0u) ? 1u : 0u; mine = (j == x) ? c : mine; }
        if (sum == G) break;
        __builtin_amdgcn_s_sleep(1);
        if ((++sp & 255u) == 0u) { if (xb_ld(&bar[XB_TMO])) break; if (sp > XB_SPIN_CAP) { atomicAdd(&bar[XB_TMO], 1u); break; } }
    }
    nloc = mine > 0u ? mine : 1u; nx = cnt > 0u ? cnt : 1u;
}
__device__ __forceinline__ void xcd_barrier(const XcdBarrier& b) {
    asm volatile("s_waitcnt vmcnt(0)" ::: "memory");
    __syncthreads();
    if (threadIdx.x == 0) {
        unsigned* bar = b.bar;
        __builtin_amdgcn_s_waitcnt(0);
        unsigned nloc = b.st[0], nx = b.st[1];
        if (nloc == 0u) { xcd_barrier_complete(bar, b.x, nloc, nx); b.st[0] = nloc; b.st[1] = nx; }
        const unsigned old = xb_add(&bar[XB_XSUB(b.x)], 1u);
        const unsigned gen = old / nloc;
        if (old + 1u == (gen + 1u) * nloc) {
            __builtin_amdgcn_fence(__ATOMIC_RELEASE, "agent");
            asm volatile("s_waitcnt vmcnt(0)" ::: "memory");
            const unsigned og = xb_add(&bar[XB_TOP], 1u);
            const unsigned tg = og / nx;
            if (og + 1u == (tg + 1u) * nx) xb_add(&bar[XB_TOPGEN], 1u);
            else XB_SPIN(xb_ld(&bar[XB_TOPGEN]) == tg, bar);
            __builtin_amdgcn_fence(__ATOMIC_ACQUIRE, "agent");
            xb_add(&bar[XB_XGEN(b.x)], 1u);
            asm volatile("s_waitcnt vmcnt(0)" ::: "memory");
        } else {
            XB_SPIN(xb_ld(&bar[XB_XGEN(b.x)]) == gen, bar);
            __builtin_amdgcn_fence(__ATOMIC_ACQUIRE, "agent");
            asm volatile("s_waitcnt vmcnt(0)" ::: "memory");
        }
    }
    __syncthreads();
}

__global__ void __launch_bounds__(512, 2) mega_fwd(Params p, int ph_lo, int ph_hi) {
    extern __shared__ __attribute__((aligned(16))) unsigned char smem[];
    LAS unsigned char* lds = (LAS unsigned char*)smem;
    cg::grid_group grid = cg::this_grid();
    if (ph_hi < 0) grid.sync();
    volatile LAS unsigned* st = (volatile LAS unsigned*)(lds + STAGE_BYTES);
    if (threadIdx.x < 4) st[threadIdx.x] = 0u;
    __syncthreads();
    const XcdBarrier xb = xcd_barrier_post((unsigned*)(p.ws + WS_BAR), st);
    int ph = 0;
#define PHASE(REP, ...) do { if (ph >= ph_lo && ph < ph_hi) { for (int _r = 0; _r < (REP); ++_r) { __VA_ARGS__; if (ph + 1 < ph_hi) xcd_barrier(xb); } } ++ph; } while (0)
    bf16_t* RA = (bf16_t*)(p.ws + WS_RA); bf16_t* RP = (bf16_t*)(p.ws + WS_RP);
    const bf16_t* WIN_E = (const bf16_t*)(p.ws + WS_WIN_E); const bf16_t* WIN_O = (const bf16_t*)(p.ws + WS_WIN_O);
    const bf16_t* WOUT_E = (const bf16_t*)(p.ws + WS_WOUT_E); const bf16_t* WOUT_O = (const bf16_t*)(p.ws + WS_WOUT_O);
    const float* mod = (const float*)(p.ws + WS_MOD);
    float* part = (float*)(p.ws + WS_PART); unsigned* cnt = (unsigned*)(p.ws + WS_BAR) + CNT_WORD0;
    PHASE(1, { phase_mod(p, lds); phase_norm_even(p, 0, nullptr, lds, 1, 0, 49152, 64); });
#pragma unroll 1
    for (int lp = 0; lp < 2; ++lp) {
        {
            const int layer = 2 * lp; const float* xin = (lp == 0) ? p.x : p.out;
            PHASE(1, { if (blockIdx.x < 32) product_units(p, lds); else phase_norm_even(p, lp, xin, lds, 2, 32, 0, 0); });
            PHASE(REP_G1, { Gemm g{(const bf16_t*)g_h, WIN_E, DM, DM, DM, MTOK / BM, 7168 / BM, 0}; EpiEven E{RP, RA, (float*)(p.ws + WS_HALO), p.ab_conv_w + (size_t)lp * 3 * 1024}; gemm_phase(lds, g, E); });
            PHASE(REP_THIN, phase_mix(p, lp, lds));
            PHASE(1, { Gemm g{RA, WOUT_E, 2048, 2048, 2048, MTOK / BM, DM / BM, 0};
                       EpiResNorm E{lp == 0 ? p.x : nullptr, (const bf16_t*)g_x, (bf16_t*)g_x, p.out, mod + (size_t)layer * NB * 3072 + 2048, (bf16_t*)g_h, p.norm_g + (size_t)(layer + 1) * DM, mod + (size_t)(layer + 1) * NB * 3072,
                                    part + (size_t)layer * 4 * MTOK, cnt + layer * 64, 0};
                       gemm_phase(lds, g, E); });
        }
        {
            const int layer = 2 * lp + 1; const int last = (lp == 1) ? 1 : 0;
            PHASE(REP_G1, { Gemm g{(const bf16_t*)g_h, WIN_O, DM, DM, DM, MTOK / BM, 4096 / BM, 0}; EpiOdd E{RA, (bf16_t*)(p.ws + WS_HQ), (bf16_t*)(p.ws + WS_HS), p.c_pool_scale + (size_t)lp * 2048}; gemm_phase(lds, g, E); });
            PHASE(1, { phase_pool(p); if (lp == 0) phase_norm_even(p, 1, nullptr, lds, 1, 0, 0, 0); });
            PHASE(1, { Gemm g{RA, WOUT_O, 2048, 2048, 2048, MTOK / BM, DM / BM, 0};
                       EpiResNorm E{nullptr, (const bf16_t*)g_x, (bf16_t*)g_x, p.out, mod + (size_t)layer * NB * 3072 + 2048, (bf16_t*)g_h, last ? p.final_g : p.norm_g + (size_t)(layer + 1) * DM, mod + (size_t)(last ? layer : layer + 1) * NB * 3072,
                                    part + (size_t)layer * 4 * MTOK, cnt + layer * 64, last};
                       gemm_phase(lds, g, E); });
        }
    }
#undef PHASE
}

extern "C" void kernel_launch(void* const* d_in, const int* in_sizes, int n_in, void* d_out, int out_size, void* d_ws, size_t ws_size, hipStream_t stream) {
    static int grid = 0;
    if (grid == 0) {
        if (n_in != 17 || out_size != MTOK * DM || ws_size < WS_END2) { fprintf(stderr, "kernel_launch: unexpected shapes (n_in %d out %d ws %zu need %zu)\n", n_in, out_size, ws_size, (size_t)WS_END2); grid = -1; return; }
        int dev = 0, cus = 0, per_cu = 0;
        hipGetDevice(&dev);
        hipDeviceGetAttribute(&cus, hipDeviceAttributeMultiprocessorCount, dev);
        if (hipFuncSetAttribute((const void*)mega_fwd, hipFuncAttributeMaxDynamicSharedMemorySize, LDS_BYTES) != hipSuccess) { fprintf(stderr, "kernel_launch: hipFuncSetAttribute failed\n"); grid = -1; return; }
        hipOccupancyMaxActiveBlocksPerMultiprocessor(&per_cu, (const void*)mega_fwd, 512, LDS_BYTES);
        if (per_cu < 1) { fprintf(stderr, "kernel_launch: occupancy query says %d blocks per CU\n", per_cu); per_cu = 1; }
        (void)hipGetLastError();
        grid = cus;
        if (grid != 256) { fprintf(stderr, "kernel_launch: built for 256 CUs (one out-projection tile per workgroup), got %d\n", grid); grid = -1; return; }
    }
    if (grid < 0) return;
    Params p{};
    p.x = (const float*)d_in[0]; p.c = (const float*)d_in[1]; p.norm_g = (const float*)d_in[2]; p.ada_w = (const float*)d_in[3]; p.ada_b = (const float*)d_in[4];
    p.ab_w_in = (const float*)d_in[5]; p.ab_conv_w = (const float*)d_in[6]; p.ab_ln_g = (const float*)d_in[7]; p.ab_ln_b = (const float*)d_in[8];
    p.ab_sgu_w = (const float*)d_in[9]; p.ab_sgu_b = (const float*)d_in[10]; p.ab_w_out = (const float*)d_in[11];
    p.c_w_in = (const float*)d_in[12]; p.c_pool_w = (const float*)d_in[13]; p.c_pool_scale = (const float*)d_in[14]; p.c_w_out = (const float*)d_in[15]; p.final_g = (const float*)d_in[16];
    p.out = (float*)d_out; p.ws = (unsigned char*)d_ws;
    if (hipMemsetAsync((unsigned char*)d_ws + WS_BAR, 0, CTL_WORDS * 4, stream) != hipSuccess) { fprintf(stderr, "kernel_launch: barrier memset failed\n"); return; }
    int lo = 0, hi = 15;
    void* args[] = {&p, &lo, &hi};
    hipError_t e = hipLaunchCooperativeKernel((const void*)mega_fwd, dim3(grid), dim3(512), args, LDS_BYTES, stream);
    if (e != hipSuccess) fprintf(stderr, "kernel_launch: cooperative launch failed: %s (grid %d)\n", hipGetErrorString(e), grid);
}
```

```cpp
#include <hip/hip_runtime.h>
#include <hip/hip_cooperative_groups.h>
#include <cstdio>
namespace cg = cooperative_groups;

#define LAS __attribute__((address_space(3)))
typedef unsigned short bf16_t;
typedef short bf16x8 __attribute__((ext_vector_type(8)));
typedef float f32x4 __attribute__((ext_vector_type(4)));
typedef unsigned u32x4 __attribute__((ext_vector_type(4)));
typedef unsigned u32x2 __attribute__((ext_vector_type(2)));

constexpr int DM = 1024, NB = 8, SEQ = 2048, MTOK = NB * SEQ;
constexpr int BM = 256, BK = 64, HALF = 128, HTB = HALF * BK * 2, STAGE_BYTES = 8 * HTB, NXCD = 8, WGM = 8;
constexpr int LDS_BYTES = STAGE_BYTES + 8192;
constexpr float EPS = 1e-6f;
constexpr int REP_G1 = 1, REP_THIN = 1, REP_G2L0 = 1;

constexpr size_t WS_MOD = 0;
constexpr size_t WS_BAR = 393216;
constexpr size_t WS_WIN_E = 524288;
constexpr size_t WS_WIN_O = WS_WIN_E + (size_t)7168 * 1024 * 2;
constexpr size_t WS_WOUT_E = WS_WIN_O + (size_t)4096 * 1024 * 2;
constexpr size_t WS_WOUT_O = WS_WOUT_E + (size_t)1024 * 2048 * 2;
constexpr size_t WS_SGU = WS_WOUT_O + (size_t)1024 * 2048 * 2;
constexpr size_t WS_POOLT = WS_SGU + (size_t)8 * 128 * 128 * 2;
constexpr size_t WS_WINP = WS_POOLT + (size_t)4 * 512 * 512 * 2;
constexpr size_t WS_RA = WS_WINP + (size_t)1024 * 2048 * 2;
constexpr size_t WS_RP = WS_RA + (size_t)MTOK * 2048 * 2;
constexpr size_t WS_END = WS_RP + (size_t)MTOK * 4096 * 2;

constexpr size_t WS_PART = WS_END;
constexpr size_t WS_HALO = WS_PART + (size_t)4 * 4 * MTOK * 4;
constexpr size_t WS_END2 = WS_HALO + (size_t)128 * 6 * 1024 * 4;
constexpr size_t WS_HQ = WS_RP;
constexpr size_t WS_HS = WS_HQ + (size_t)128 * 32 * 2048 * 2;
constexpr int CNT_WORD0 = 3584;
constexpr int LOC_WORD0 = CNT_WORD0 + 256;
constexpr int TAB_WORD0 = LOC_WORD0 + 512;
constexpr int CTL_WORDS = TAB_WORD0 + 256;
constexpr int XLD = 2048;
__device__ unsigned short g_x[(size_t)MTOK * XLD];
__device__ unsigned short g_h[(size_t)MTOK * DM];

struct Params {
    const float *x, *c, *norm_g, *ada_w, *ada_b, *ab_w_in, *ab_conv_w, *ab_ln_g, *ab_ln_b, *ab_sgu_w, *ab_sgu_b, *ab_w_out,
        *c_w_in, *c_pool_w, *c_pool_scale, *c_w_out, *final_g;
    float* out;
    unsigned char* ws;
};

__host__ __device__ __forceinline__ int lds_byte(int r, int c) { const int st = (r >> 4) * 2 + (c >> 5), rr = r & 15, cc = c & 31, ob = rr * 64 + cc * 2; return st * 1024 + (ob ^ (((ob >> 9) & 1) << 5)); }
__host__ __device__ __forceinline__ void stage_rc(int b, int& R, int& C) { const int st = b / 1024, sb = b % 1024, swz = sb ^ (((sb >> 9) & 1) << 5); R = (st >> 1) * 16 + swz / 64; C = (st & 1) * 32 + (swz % 64) / 2; }
__host__ __device__ __forceinline__ int perm32(int rho) { const int n = rho >> 4, i = rho & 15; return 8 * (i >> 2) + 4 * n + (i & 3); }
__device__ __forceinline__ unsigned cvt_pk_bf16(float lo, float hi) { unsigned r; asm volatile("v_cvt_pk_bf16_f32 %0, %1, %2" : "=v"(r) : "v"(lo), "v"(hi)); return r; }
__device__ __forceinline__ float bf_lo(unsigned w) { return __uint_as_float(w << 16); }
__device__ __forceinline__ float bf_hi(unsigned w) { return __uint_as_float(w & 0xffff0000u); }
__device__ __forceinline__ float silu_f(float v) { return v * __builtin_amdgcn_rcpf(1.f + __expf(-v)); }
__device__ __forceinline__ float wave_sum(float v) {
#pragma unroll
    for (int o = 1; o < 64; o <<= 1) v += __shfl_xor(v, o);
    return v;
}

__device__ __forceinline__ int opaque_tid() { int t = threadIdx.x; asm volatile("" : "+v"(t)); return t; }
__device__ __forceinline__ int opaque_bid() { int b = blockIdx.x; asm volatile("" : "+s"(b)); return b; }
struct Unit { int pm, pn; };
struct Gemm { const bf16_t* A; const bf16_t* Bt; int lda, ldb, K, nM, nN, bk; };

__device__ __forceinline__ bool next_unit(const Gemm& g, int bid, int i, Unit& u) {
    const int nwg = g.nM * g.nN;
    if ((long)i * gridDim.x + bid >= nwg) return false;
    const int nr = nwg / (int)gridDim.x;
    const int ir = (nr > 1 && nr * (int)gridDim.x == nwg) ? (i + (bid & 7)) % nr : i;
    const long L = (long)ir * gridDim.x + bid;
    int wgid = (int)L; { const int q = nwg / NXCD, r = nwg % NXCD, xcd = wgid % NXCD, off = wgid / NXCD; wgid = (xcd < r ? xcd * (q + 1) : r * (q + 1) + (xcd - r) * q) + off; }
    const int nig = WGM * g.nN, gid = wgid / nig, fm = gid * WGM, gsz = (g.nM - fm) < WGM ? (g.nM - fm) : WGM;
    u.pm = fm + ((wgid % nig) % gsz); u.pn = (wgid % nig) / gsz; return true;
}

struct EpiEven {
    static constexpr bool PERM = true, AFTER_DRAIN = false, PERMA = true;
    bf16_t* P; bf16_t* Y; float* halo; const float* cw;
    __device__ __forceinline__ void operator()(const f32x4 (&acc)[2][2][4][2], const Unit& u, int wr, int wc, int fr, int fq) const {
        const int tok0 = u.pm * BM + 8 * (wr * 16 + fr), T = u.pn;
        if (T < 16) {
            const int ch = T * 64 + 16 * wc + 4 * fq;
            const f32x4 w0 = *(const f32x4*)(cw + ch), w1 = *(const f32x4*)(cw + 1024 + ch), w2 = *(const f32x4*)(cw + 2048 + ch);
            f32x4 c[8], pm1, pm2;
#pragma unroll
            for (int i = 0; i < 8; ++i) c[i] = acc[i >> 2][0][i & 3][0] * acc[i >> 2][0][i & 3][1];
#pragma unroll
            for (int j = 0; j < 4; ++j) {
                pm1[j] = __int_as_float(__builtin_amdgcn_update_dpp(0, __float_as_int(c[7][j]), 0x111, 0xf, 0xf, true));
                pm2[j] = __int_as_float(__builtin_amdgcn_update_dpp(0, __float_as_int(c[6][j]), 0x111, 0xf, 0xf, true));
            }
            float* hb = halo + (size_t)(u.pm * 2 + wr) * 6 * 1024 + ch;
            if (fr == 15) { *(f32x4*)(hb) = c[6]; *(f32x4*)(hb + 1024) = c[7]; }
            bf16_t* yp = Y + (size_t)tok0 * 2048 + ch;
#pragma unroll
            for (int i = 0; i < 8; ++i) {
                f32x4 bz = acc[i >> 2][1][i & 3][0]; const f32x4 z = acc[i >> 2][1][i & 3][1];
#pragma unroll
                for (int j = 0; j < 4; ++j) bz[j] *= silu_f(z[j]);
                const f32x4 cm1 = (i >= 1) ? c[i >= 1 ? i - 1 : 0] : pm1, cm2 = (i >= 2) ? c[i >= 2 ? i - 2 : 0] : (i == 1 ? pm1 : pm2);
                const f32x4 y = bz * (w0 * ((i == 1) ? pm1 : cm2) + w1 * cm1 + w2 * c[i]);
                if (i < 2 && fr == 0) { *(f32x4*)(hb + (2 + i) * 1024) = c[i]; *(f32x4*)(hb + (4 + i) * 1024) = bz; }
                else { u32x2 w; w.x = cvt_pk_bf16(y[0], y[1]); w.y = cvt_pk_bf16(y[2], y[3]); *(u32x2*)(yp + (size_t)i * 2048) = w; }
            }
        } else if (T < 24) {
            bf16_t* base = P + (size_t)2 * MTOK * 1024 + (size_t)tok0 * 1024 + (T - 16) * 128 + wc * 32 + 8 * fq;
#pragma unroll
            for (int i = 0; i < 8; ++i) {
                f32x4 x0 = acc[i >> 2][0][i & 3][0], x1 = acc[i >> 2][0][i & 3][1]; const f32x4 y0 = acc[i >> 2][1][i & 3][0], y1 = acc[i >> 2][1][i & 3][1];
#pragma unroll
                for (int j = 0; j < 4; ++j) { x0[j] *= silu_f(y0[j]); x1[j] *= silu_f(y1[j]); }
                u32x4 w; w.x = cvt_pk_bf16(x0[0], x0[1]); w.y = cvt_pk_bf16(x0[2], x0[3]); w.z = cvt_pk_bf16(x1[0], x1[1]); w.w = cvt_pk_bf16(x1[2], x1[3]);
                *(u32x4*)(base + (size_t)i * 1024) = w;
            }
        } else {
            bf16_t* base = P + (size_t)3 * MTOK * 1024 + (size_t)tok0 * 1024 + (T - 24) * 256 + wc * 32 + 8 * fq;
#pragma unroll
            for (int i = 0; i < 8; ++i)
#pragma unroll
                for (int bj = 0; bj < 2; ++bj) {
                    const f32x4 v0 = acc[i >> 2][bj][i & 3][0], v1 = acc[i >> 2][bj][i & 3][1];
                    u32x4 w; w.x = cvt_pk_bf16(v0[0], v0[1]); w.y = cvt_pk_bf16(v0[2], v0[3]); w.z = cvt_pk_bf16(v1[0], v1[1]); w.w = cvt_pk_bf16(v1[2], v1[3]);
                    *(u32x4*)(base + (size_t)i * 1024 + bj * HALF) = w;
                }
        }
    }
};
template <int WIN> __device__ __forceinline__ void pool_quad(const f32x4 (&acc)[2][2][4][2], int n, const f32x4 ps, unsigned (&yq)[8][2], unsigned (&qq)[8][2], unsigned (&sq)[8][2]) {
    float y[8][4], szv[8][4];
#pragma unroll
    for (int j = 0; j < 4; ++j) {
        float h[23], PS[24];
#pragma unroll
        for (int k = 0; k < 8; ++k) h[15 + k] = acc[k >> 2][0][k & 3][n][j];
#pragma unroll
        for (int k = 0; k < 8; ++k) h[7 + k] = __int_as_float(__builtin_amdgcn_update_dpp(0, __float_as_int(h[15 + k]), 0x111, 0xf, 0xf, true));
#pragma unroll
        for (int k = 1; k < 8; ++k) h[k - 1] = __int_as_float(__builtin_amdgcn_update_dpp(0, __float_as_int(h[15 + k]), 0x112, 0xf, 0xf, true));
        constexpr int LO = 16 - WIN;
#pragma unroll
        for (int x = 0; x <= LO; ++x) PS[x] = 0.f;
#pragma unroll
        for (int x = LO; x < 23; ++x) PS[x + 1] = PS[x] + h[x];
#pragma unroll
        for (int i = 0; i < 8; ++i) {
            const float w = PS[16 + i] - PS[16 + i - WIN];
            const float z = acc[i >> 2][1][i & 3][n][j];
            szv[i][j] = silu_f(z) * ps[j];
            y[i][j] = (w * (1.f / WIN) - h[15 + i]) * szv[i][j];
        }
    }
#pragma unroll
    for (int i = 0; i < 8; ++i) {
        yq[i][0] = cvt_pk_bf16(y[i][0], y[i][1]); yq[i][1] = cvt_pk_bf16(y[i][2], y[i][3]);
        qq[i][0] = cvt_pk_bf16(acc[i >> 2][0][i & 3][n][0], acc[i >> 2][0][i & 3][n][1]); qq[i][1] = cvt_pk_bf16(acc[i >> 2][0][i & 3][n][2], acc[i >> 2][0][i & 3][n][3]);
        sq[i][0] = cvt_pk_bf16(szv[i][0], szv[i][1]); sq[i][1] = cvt_pk_bf16(szv[i][2], szv[i][3]);
    }
}
struct EpiOdd {
    static constexpr bool PERM = true, AFTER_DRAIN = false, PERMA = true;
    bf16_t* Y; bf16_t* HQ; bf16_t* HS; const float* pscale;
    __device__ __forceinline__ void operator()(const f32x4 (&acc)[2][2][4][2], const Unit& u, int wr, int wc, int fr, int fq) const {
        const int T = u.pn, g = T >> 2, B = u.pm * 2 + wr;
        const int tok0 = u.pm * BM + 8 * (wr * 16 + fr);
        const int ch = T * 128 + wc * 32 + 8 * fq;
        unsigned yq[2][8][2];
#pragma unroll
        for (int n = 0; n < 2; ++n) {
            const f32x4 ps = *(const f32x4*)(pscale + ch + 4 * n);
            unsigned qq[8][2], sq[8][2];
            if (g == 0) pool_quad<2>(acc, n, ps, yq[n], qq, sq);
            else if (g == 1) pool_quad<4>(acc, n, ps, yq[n], qq, sq);
            else if (g == 2) pool_quad<8>(acc, n, ps, yq[n], qq, sq);
            else pool_quad<16>(acc, n, ps, yq[n], qq, sq);
            if (fr >= 14) {
                bf16_t* hp = HQ + ((size_t)B * 32 + (fr - 14) * 8) * 2048 + ch + 4 * n;
#pragma unroll
                for (int i = 0; i < 8; ++i) { u32x2 w; w.x = qq[i][0]; w.y = qq[i][1]; *(u32x2*)(hp + (size_t)i * 2048) = w; }
            }
            if (fr <= 1) {
                bf16_t* hp = HQ + ((size_t)B * 32 + 16 + fr * 8) * 2048 + ch + 4 * n; bf16_t* sp = HS + ((size_t)B * 16 + fr * 8) * 2048 + ch + 4 * n;
#pragma unroll
                for (int i = 0; i < 8; ++i) { u32x2 w; w.x = qq[i][0]; w.y = qq[i][1]; *(u32x2*)(hp + (size_t)i * 2048) = w; u32x2 v; v.x = sq[i][0]; v.y = sq[i][1]; *(u32x2*)(sp + (size_t)i * 2048) = v; }
            }
        }
        bf16_t* yp = Y + (size_t)tok0 * 2048 + ch;
#pragma unroll
        for (int i = 0; i < 8; ++i) { u32x4 w; w.x = yq[0][i][0]; w.y = yq[0][i][1]; w.z = yq[1][i][0]; w.w = yq[1][i][1]; *(u32x4*)(yp + (size_t)i * 2048) = w; }
    }
};
struct EpiProd {
    static constexpr bool PERM = true, AFTER_DRAIN = false, PERMA = false;
    bf16_t* O;
    __device__ __forceinline__ void operator()(const f32x4 (&acc)[2][2][4][2], const Unit& u, int wr, int wc, int fr, int fq) const {
        const int col0 = u.pn * BM + wc * 32 + 8 * fq;
#pragma unroll
        for (int ai = 0; ai < 2; ++ai)
#pragma unroll
            for (int m = 0; m < 4; ++m) {
                bf16_t* rowp = O + (size_t)((u.pm * 2 + ai) * 256 + wr * 64 + m * 16 + fr) * DM + col0;
#pragma unroll
                for (int bj = 0; bj < 2; ++bj) {
                    const f32x4 v0 = acc[ai][bj][m][0], v1 = acc[ai][bj][m][1];
                    u32x4 w; w.x = cvt_pk_bf16(v0[0], v0[1]); w.y = cvt_pk_bf16(v0[2], v0[3]); w.z = cvt_pk_bf16(v1[0], v1[1]); w.w = cvt_pk_bf16(v1[2], v1[3]);
                    *(u32x4*)(rowp + bj * HALF) = w;
                }
            }
    }
};
struct EpiBf {
    static constexpr bool PERM = true, AFTER_DRAIN = false, PERMA = false;
    bf16_t* O; int ld;
    __device__ __forceinline__ void operator()(const f32x4 (&acc)[2][2][4][2], const Unit& u, int wr, int wc, int fr, int fq) const {
        const int row0 = u.pm * BM + wr * 64 + fr, col0 = u.pn * BM + wc * 32 + 8 * fq;
#pragma unroll
        for (int ai = 0; ai < 2; ++ai)
#pragma unroll
            for (int m = 0; m < 4; ++m) {
                bf16_t* rowp = O + (size_t)(row0 + ai * HALF + m * 16) * ld + col0;
#pragma unroll
                for (int bj = 0; bj < 2; ++bj) {
                    const f32x4 v0 = acc[ai][bj][m][0], v1 = acc[ai][bj][m][1];
                    u32x4 w; w.x = cvt_pk_bf16(v0[0], v0[1]); w.y = cvt_pk_bf16(v0[2], v0[3]); w.z = cvt_pk_bf16(v1[0], v1[1]); w.w = cvt_pk_bf16(v1[2], v1[3]);
                    *(u32x4*)(rowp + bj * HALF) = w;
                }
            }
    }
};
struct EpiRes {
    static constexpr bool PERM = false, AFTER_DRAIN = false, PERMA = false;
    const float* xin; float* xout; const float* gate;
    __device__ __forceinline__ void operator()(const f32x4 (&acc)[2][2][4][2], const Unit& u, int wr, int wc, int fr, int fq) const {
        const int row0 = u.pm * BM + wr * 64 + fr, col0 = u.pn * BM + wc * 32 + 4 * fq;
        const float* gp = gate + (size_t)(u.pm >> 3) * 3072 + col0;
        f32x4 gv[2][2];
#pragma unroll
        for (int bj = 0; bj < 2; ++bj)
#pragma unroll
            for (int n = 0; n < 2; ++n) gv[bj][n] = *(const f32x4*)(gp + bj * HALF + n * 16);
#pragma unroll
        for (int ai = 0; ai < 2; ++ai)
#pragma unroll
            for (int m = 0; m < 4; ++m) {
                const size_t ro = (size_t)(row0 + ai * HALF + m * 16) * DM + col0;
#pragma unroll
                for (int bj = 0; bj < 2; ++bj)
#pragma unroll
                    for (int n = 0; n < 2; ++n) {
                        const f32x4 xv = *(const f32x4*)(xin + ro + bj * HALF + n * 16);
                        *(f32x4*)(xout + ro + bj * HALF + n * 16) = xv + gv[bj][n] * acc[ai][bj][m][n];
                    }
            }
    }
};

struct EpiResNorm {
    static constexpr bool PERM = true, AFTER_DRAIN = true, PERMA = false;
    __device__ __forceinline__ bool xpre() const { return xin32 == nullptr; }
    const float* xin32; const bf16_t* xin16; bf16_t* xout16; float* out32; const float* gate; bf16_t* H; const float* ng; const float* modn; float* part; unsigned* cnt; int last;
    __device__ __forceinline__ void fused(f32x4 (&acc)[2][2][4][2], const Unit& u, int wr, int wc, int fr, int fq, LAS unsigned char* lds, int tid) const {
        const int row0 = u.pm * BM + wr * 64 + fr, col0 = u.pn * BM + wc * 32 + 8 * fq, b = u.pm >> 3;
        LAS float* lss = (LAS float*)(lds + STAGE_BYTES + 1024);
        LAS float* lrs = (LAS float*)(lds + STAGE_BYTES + 1024 + 4096);
        {
            const float* gp = gate + (size_t)b * 3072 + col0;
            f32x4 gv[2][2];
#pragma unroll
            for (int bj = 0; bj < 2; ++bj)
#pragma unroll
                for (int n = 0; n < 2; ++n) gv[bj][n] = *(const f32x4*)(gp + bj * HALF + 4 * n);
#pragma unroll
            for (int ai = 0; ai < 2; ++ai)
#pragma unroll
                for (int m = 0; m < 4; ++m) {
                    const size_t ro = (size_t)(row0 + ai * HALF + m * 16) * DM + col0, rox = (size_t)(row0 + ai * HALF + m * 16) * XLD + col0;
                    float ss = 0.f;
#pragma unroll
                    for (int bj = 0; bj < 2; ++bj) {
                        f32x4 x0, x1;
                        if (xin32) { x0 = *(const f32x4*)(xin32 + ro + bj * HALF); x1 = *(const f32x4*)(xin32 + ro + bj * HALF + 4); }
                        else { u32x4 w;
                            if (ai == 1 && bj == 1 && wc >= 2) w = *(const u32x4*)(xin16 + rox + bj * HALF);
                            else {
                                const int cb = 2 * bj + (wc >> 1), slot = (cb & 1) ? (ai * 2 + (cb >> 1)) : (4 + ai * 2 + (cb >> 1));
                                w = *(const LAS u32x4*)(lds + slot * HTB + lds_byte(wr * 64 + m * 16 + fr, (wc & 1) * 32 + 8 * fq));
                            } x0 = (f32x4){bf_lo(w.x), bf_hi(w.x), bf_lo(w.y), bf_hi(w.y)}; x1 = (f32x4){bf_lo(w.z), bf_hi(w.z), bf_lo(w.w), bf_hi(w.w)}; }
                        const f32x4 v0 = x0 + gv[bj][0] * acc[ai][bj][m][0], v1 = x1 + gv[bj][1] * acc[ai][bj][m][1];
                        acc[ai][bj][m][0] = v0; acc[ai][bj][m][1] = v1;
                        ss += ((v0[0] * v0[0] + v0[1] * v0[1]) + (v0[2] * v0[2] + v0[3] * v0[3])) + ((v1[0] * v1[0] + v1[1] * v1[1]) + (v1[2] * v1[2] + v1[3] * v1[3]));
                        if (!last) { u32x4 w; w.x = cvt_pk_bf16(v0[0], v0[1]); w.y = cvt_pk_bf16(v0[2], v0[3]); w.z = cvt_pk_bf16(v1[0], v1[1]); w.w = cvt_pk_bf16(v1[2], v1[3]); *(u32x4*)(xout16 + rox + bj * HALF) = w; }
                    }
                    ss += __shfl_xor(ss, 16); ss += __shfl_xor(ss, 32);
                    if (fq == 0) lss[(ai * HALF + wr * 64 + m * 16 + fr) * 4 + wc] = ss;
                }
        }
        __syncthreads();
        if (tid < 256) {
            const float t = (lss[tid * 4] + lss[tid * 4 + 1]) + (lss[tid * 4 + 2] + lss[tid * 4 + 3]);
            __hip_atomic_store(part + (size_t)u.pn * MTOK + u.pm * BM + tid, t, __ATOMIC_RELAXED, __HIP_MEMORY_SCOPE_AGENT);
        }
        asm volatile("s_waitcnt vmcnt(0)" ::: "memory");
        __syncthreads();
        if (tid == 0) {
            unsigned* c = cnt + u.pm;
            __hip_atomic_fetch_add(c, 1u, __ATOMIC_RELAXED, __HIP_MEMORY_SCOPE_AGENT);
            unsigned spins = 0;
            while (__hip_atomic_load(c, __ATOMIC_RELAXED, __HIP_MEMORY_SCOPE_AGENT) < 4u && ++spins < (1u << 22)) __builtin_amdgcn_s_sleep(1);
            __builtin_amdgcn_fence(__ATOMIC_ACQUIRE, "agent");
            asm volatile("s_waitcnt vmcnt(0)" ::: "memory");
        }
        __syncthreads();
        if (tid < 256) {
            float t = 0.f;
#pragma unroll
            for (int q = 0; q < 4; ++q) t += __hip_atomic_load(part + (size_t)q * MTOK + u.pm * BM + tid, __ATOMIC_RELAXED, __HIP_MEMORY_SCOPE_AGENT);
            lrs[tid] = rsqrtf(t * (1.f / DM) + EPS);
        }
        __syncthreads();
        const float* mb = modn + (size_t)b * 3072;
#pragma unroll
        for (int bj = 0; bj < 2; ++bj) {
            const int c = col0 + bj * HALF;
            const f32x4 g0 = *(const f32x4*)(ng + c), g1 = *(const f32x4*)(ng + c + 4);
            f32x4 sh0 = {0.f, 0.f, 0.f, 0.f}, sh1 = sh0, sc0 = sh0, sc1 = sh0;
            if (!last) { sh0 = *(const f32x4*)(mb + c); sh1 = *(const f32x4*)(mb + c + 4); sc0 = *(const f32x4*)(mb + 1024 + c); sc1 = *(const f32x4*)(mb + 1024 + c + 4); }
            const f32x4 a0 = g0 * (sc0 + 1.f), a1 = g1 * (sc1 + 1.f);
#pragma unroll
            for (int ai = 0; ai < 2; ++ai)
#pragma unroll
                for (int m = 0; m < 4; ++m) {
                    const int rl = ai * HALF + wr * 64 + m * 16 + fr;
                    const float rstd = lrs[rl];
                    const size_t ro = (size_t)(u.pm * BM + rl) * DM + c;
                    const f32x4 h0 = (acc[ai][bj][m][0] * rstd) * a0 + sh0, h1 = (acc[ai][bj][m][1] * rstd) * a1 + sh1;
                    if (last) { *(f32x4*)(out32 + ro) = h0; *(f32x4*)(out32 + ro + 4) = h1; }
                    else { u32x4 w; w.x = cvt_pk_bf16(h0[0], h0[1]); w.y = cvt_pk_bf16(h0[2], h0[3]); w.z = cvt_pk_bf16(h1[0], h1[1]); w.w = cvt_pk_bf16(h1[2], h1[3]); *(u32x4*)(H + ro) = w; }
                }
        }
    }
};

template <class Epi>
__device__ __forceinline__ void gemm_phase(LAS unsigned char* lds, const Gemm g, const Epi& E) {
    const int tid = opaque_tid(), wid = __builtin_amdgcn_readfirstlane(tid >> 6), lane = tid & 63, wr = wid >> 2, wc = wid & 3, fr = lane & 15, fq = lane >> 4;
    const int nt = g.K / BK;
    unsigned voffA[2], voffB[2];
#pragma unroll
    for (int i = 0; i < 2; ++i) { int R, C; stage_rc(tid * 16 + i * 8192, R, C); const int Rb = Epi::PERM ? ((R & ~31) + perm32(R & 31)) : R;
        const int Ra = Epi::PERMA ? (8 * ((R >> 6) * 16 + (R & 15)) + ((R >> 4) & 3)) : R;
        voffA[i] = (unsigned)(Ra * g.lda + C) * 2u; voffB[i] = (unsigned)(Rb * g.ldb + C) * 2u; }
    const size_t kstep = (size_t)(BK * 2);
    const size_t hstepA = (size_t)(Epi::PERMA ? 4 : HALF) * g.lda * 2, hstepB = (size_t)HALF * g.ldb * 2, tstepA = (size_t)BM * g.lda * 2;
    const unsigned ldsw = (unsigned)wid * 1024u;
    const int aoff = lds_byte(wr * 64 + fr, fq * 8), boff = lds_byte(wc * 32 + fr, fq * 8);
#define PG8_SA(b, h) (((b) * 2 + (h)) * HTB)
#define PG8_SB(b, h) ((4 + (b) * 2 + (h)) * HTB)
#define PG8_STAGE(bufoff, gbase, voff) do { _Pragma("unroll") for (int _i = 0; _i < 2; ++_i) \
        __builtin_amdgcn_global_load_lds((const unsigned*)((const char*)(gbase) + (voff)[_i]), (LAS unsigned*)(lds + (bufoff) + ldsw + _i * 8192), 16, 0, 0); } while (0)
#define PG8_LDA(dst, b, h) do { _Pragma("unroll") for (int m = 0; m < 4; ++m) _Pragma("unroll") for (int k = 0; k < 2; ++k) dst[m][k] = *(const LAS bf16x8*)(lds + PG8_SA(b, h) + aoff + m * 2048 + k * 1024); } while (0)
#define PG8_LDB(dst, b, h) do { _Pragma("unroll") for (int n = 0; n < 2; ++n) _Pragma("unroll") for (int k = 0; k < 2; ++k) dst[n][k] = *(const LAS bf16x8*)(lds + PG8_SB(b, h) + boff + n * 2048 + k * 1024); } while (0)
#define PG8_MMA(ai, bj, At, Bt) do { __builtin_amdgcn_s_setprio(1); _Pragma("unroll") for (int m = 0; m < 4; ++m) _Pragma("unroll") for (int n = 0; n < 2; ++n) _Pragma("unroll") for (int k = 0; k < 2; ++k) \
        acc[ai][bj][m][n] = __builtin_amdgcn_mfma_f32_16x16x32_bf16(Bt[n][k], At[m][k], acc[ai][bj][m][n], 0, 0, 0); __builtin_amdgcn_s_setprio(0); } while (0)
#define PG8_WAIT_V(n) asm volatile("s_waitcnt vmcnt(" #n ")" ::: "memory")
#define PG8_WAIT_L(n) asm volatile("s_waitcnt lgkmcnt(" #n ")" ::: "memory")
#define PG8_BAR __builtin_amdgcn_s_barrier()
#define PG8_SCHED __builtin_amdgcn_sched_barrier(0)
    Unit cur, nxt; int ui = 0;
    const int bid = opaque_bid();
    if (!next_unit(g, bid, 0, cur)) return;
    f32x4 acc[2][2][4][2];
#pragma unroll
    for (int a = 0; a < 2; ++a)
#pragma unroll
        for (int b = 0; b < 2; ++b)
#pragma unroll
            for (int m = 0; m < 4; ++m)
#pragma unroll
                for (int n = 0; n < 2; ++n) acc[a][b][m][n] = (f32x4){0.f, 0.f, 0.f, 0.f};
    bf16x8 At[4][2], B0[2][2], B1[2][2];
    const char* cA = (const char*)g.A + (size_t)cur.pm * tstepA; const char* cB = (const char*)g.Bt + (size_t)cur.pn * 2 * hstepB + (size_t)(cur.pm >> 1) * g.bk * 2;
    PG8_STAGE(PG8_SB(0, 0), cB, voffB); PG8_STAGE(PG8_SA(0, 0), cA, voffA); PG8_STAGE(PG8_SB(0, 1), cB + hstepB, voffB); PG8_STAGE(PG8_SA(0, 1), cA + hstepA, voffA);
    if (wr == 1) PG8_BAR;
    PG8_WAIT_V(4); PG8_BAR;
    PG8_STAGE(PG8_SB(1, 0), cB + kstep, voffB); PG8_STAGE(PG8_SA(1, 0), cA + kstep, voffA); PG8_STAGE(PG8_SB(1, 1), cB + hstepB + kstep, voffB);
    PG8_WAIT_V(6); PG8_BAR;
    for (;;) {
        const bool has_next = next_unit(g, bid, ui + 1, nxt);
        const char* nA = has_next ? (const char*)g.A + (size_t)nxt.pm * tstepA : cA;
        const char* nB = has_next ? (const char*)g.Bt + (size_t)nxt.pn * 2 * hstepB + (size_t)(nxt.pm >> 1) * g.bk * 2 : cB;
#define PG8_ITER(S2, S3, S4, S5, S6, S7, S8) do { \
              PG8_LDB(B0, 0, 0); PG8_SCHED; PG8_LDA(At, 0, 0); PG8_STAGE(PG8_SA(1, 1), a1 + hstepA, voffA); \
            PG8_WAIT_L(8); PG8_BAR; PG8_WAIT_L(0); PG8_MMA(0, 0, At, B0); PG8_BAR; PG8_SCHED; \
              PG8_LDB(B1, 0, 1); S2; \
            PG8_BAR; PG8_WAIT_L(0); PG8_MMA(0, 1, At, B1); PG8_BAR; \
              PG8_LDA(At, 0, 1); S3; \
            PG8_BAR; PG8_WAIT_L(0); PG8_MMA(1, 0, At, B0); PG8_BAR; PG8_SCHED; \
              S4; \
            PG8_WAIT_V(6); PG8_BAR; PG8_MMA(1, 1, At, B1); PG8_BAR; \
              PG8_LDB(B0, 1, 0); PG8_SCHED; PG8_LDA(At, 1, 0); S5; \
            PG8_WAIT_L(8); PG8_BAR; PG8_WAIT_L(0); PG8_MMA(0, 0, At, B0); PG8_BAR; PG8_SCHED; \
              PG8_LDB(B1, 1, 1); S6; \
            PG8_BAR; PG8_WAIT_L(0); PG8_MMA(0, 1, At, B1); PG8_BAR; \
              PG8_LDA(At, 1, 1); S7; \
            PG8_BAR; PG8_WAIT_L(0); PG8_MMA(1, 0, At, B0); PG8_BAR; PG8_SCHED; \
              S8; \
            PG8_WAIT_V(6); PG8_BAR; PG8_MMA(1, 1, At, B1); PG8_BAR; } while (0)
        bool xpre = false;
        if constexpr (Epi::AFTER_DRAIN) xpre = !has_next && E.xpre();
        const int nt_main = xpre ? nt - 2 : nt;
        for (int t = 0; t < nt_main; t += 2) {
            const bool last = (t == nt - 2);
            const char* a1 = cA + (size_t)(t + 1) * kstep;
            const char* a2 = last ? nA : cA + (size_t)(t + 2) * kstep; const char* b2 = last ? nB : cB + (size_t)(t + 2) * kstep;
            const char* a3 = a2 + kstep; const char* b3 = b2 + kstep;
            PG8_ITER(PG8_STAGE(PG8_SB(0, 0), b2, voffB), PG8_STAGE(PG8_SA(0, 0), a2, voffA), PG8_STAGE(PG8_SB(0, 1), b2 + hstepB, voffB), PG8_STAGE(PG8_SA(0, 1), a2 + hstepA, voffA),
                     PG8_STAGE(PG8_SB(1, 0), b3, voffB), PG8_STAGE(PG8_SA(1, 0), a3, voffA), PG8_STAGE(PG8_SB(1, 1), b3 + hstepB, voffB));
        }
        if constexpr (Epi::AFTER_DRAIN) {
            if (xpre) {
                const char* a1 = cA + (size_t)(nt - 1) * kstep;
                const char* xq = (const char*)E.xin16 + ((size_t)cur.pm * BM * XLD + (size_t)cur.pn * BM) * 2;
                const size_t xh = (size_t)HALF * XLD * 2;
                PG8_ITER(PG8_STAGE(PG8_SB(0, 0), xq, voffA), PG8_STAGE(PG8_SA(0, 0), xq + 128, voffA), PG8_STAGE(PG8_SB(0, 1), xq + 256, voffA), PG8_STAGE(PG8_SA(0, 1), xq + 384, voffA),
                         PG8_STAGE(PG8_SB(1, 0), xq + xh, voffA), PG8_STAGE(PG8_SA(1, 0), xq + xh + 128, voffA), PG8_STAGE(PG8_SB(1, 1), xq + xh + 256, voffA));
            }
        }
#undef PG8_ITER
        if constexpr (!Epi::AFTER_DRAIN) E(acc, cur, wr, wc, fr, fq);
        if (!has_next) break;
#pragma unroll
        for (int a = 0; a < 2; ++a)
#pragma unroll
            for (int b = 0; b < 2; ++b)
#pragma unroll
                for (int m = 0; m < 4; ++m)
#pragma unroll
                    for (int n = 0; n < 2; ++n) acc[a][b][m][n] = (f32x4){0.f, 0.f, 0.f, 0.f};
        cur = nxt; cA = nA; cB = nB; ++ui;
    }
    PG8_WAIT_V(0);
    if (wr == 0) PG8_BAR;
    PG8_BAR;
    if constexpr (Epi::AFTER_DRAIN) E.fused(acc, cur, wr, wc, fr, fq, lds, tid);
#undef PG8_SA
#undef PG8_SB
#undef PG8_STAGE
#undef PG8_LDA
#undef PG8_LDB
#undef PG8_MMA
#undef PG8_WAIT_V
#undef PG8_WAIT_L
#undef PG8_BAR
#undef PG8_SCHED
}

__device__ __forceinline__ void phase_mod(const Params& p, LAS unsigned char* lds) {
    const int tid = opaque_tid(), wid = tid >> 6, lane = tid & 63;
    LAS float* sc = (LAS float*)lds;
    LAS float* red = (LAS float*)(lds + 32768);
    float* mod = (float*)(p.ws + WS_MOD);
    for (int t = tid; t < NB * DM; t += 512) sc[t] = silu_f(p.c[t]);
    __syncthreads();
    for (int it = opaque_bid(); it < 192; it += gridDim.x) {
        const int col = it * 64 + lane, i = col / 3072, j = col - i * 3072;
        const float* w = p.ada_w + ((size_t)i * DM + wid * 128) * 3072 + j;
        float a[8];
#pragma unroll
        for (int b = 0; b < 8; ++b) a[b] = 0.f;
#pragma unroll 32
        for (int k = 0; k < 128; ++k) {
            const float wv = w[(size_t)k * 3072];
#pragma unroll
            for (int b = 0; b < 8; ++b) a[b] += sc[b * DM + wid * 128 + k] * wv;
        }
#pragma unroll
        for (int b = 0; b < 8; ++b) red[(wid * 8 + b) * 64 + lane] = a[b];
        __syncthreads();
        {
            const int b = tid >> 6; float s = 0.f;
#pragma unroll
            for (int w8 = 0; w8 < 8; ++w8) s += red[(w8 * 8 + b) * 64 + lane];
            mod[((size_t)i * NB + b) * 3072 + j] = s + p.ada_b[i * 3072 + j];
        }
        __syncthreads();
    }
}

__device__ __forceinline__ void conv_tile(const float* __restrict__ src, int srcN, int c0, bf16_t* __restrict__ dstrow, int K, int k0, LAS float* T, int csrc = -1) {
    const int tid = opaque_tid();
    const int cs = csrc >= 0 ? csrc : c0 + (tid & 15) * 4;
    f32x4 v[8];
#pragma unroll
    for (int ps = 0; ps < 8; ++ps) v[ps] = *(const f32x4*)(src + (size_t)(k0 + ps * 32 + (tid >> 4)) * srcN + cs);
#pragma unroll
    for (int ps = 0; ps < 8; ++ps) { LAS float* t = T + (ps * 32 + (tid >> 4)) * 65 + (tid & 15) * 4; t[0] = v[ps][0]; t[1] = v[ps][1]; t[2] = v[ps][2]; t[3] = v[ps][3]; }
    __syncthreads();
#pragma unroll
    for (int q = 0; q < 4; ++q) {
        const int item = tid + 512 * q, n = item >> 5, kg = item & 31; const LAS float* s = T + (kg * 8) * 65 + n;
        u32x4 o; o.x = cvt_pk_bf16(s[0], s[65]); o.y = cvt_pk_bf16(s[130], s[195]); o.z = cvt_pk_bf16(s[260], s[325]); o.w = cvt_pk_bf16(s[390], s[455]);
        *(u32x4*)(dstrow + (size_t)n * K + k0 + kg * 8) = o;
    }
    __syncthreads();
}

__device__ __forceinline__ void norm_rows(const Params& p, int layer, const float* xin, int item) {
    const int tid = opaque_tid(), wid = tid >> 6, lane = tid & 63;
    bf16_t* H = (bf16_t*)g_h;
    const float* mod = (const float*)(p.ws + WS_MOD) + (size_t)layer * NB * 3072;
    const float* gp = p.norm_g + (size_t)layer * DM;
#pragma unroll
    for (int h2 = 0; h2 < 2; ++h2) {
        const int row = item * 16 + h2 * 8 + wid, b = row >> 11;
        const f32x4* xr = (const f32x4*)(xin + (size_t)row * DM) + lane;
        f32x4 v[4]; float ss = 0.f;
#pragma unroll
        for (int q = 0; q < 4; ++q) { v[q] = xr[64 * q]; ss += (v[q][0] * v[q][0] + v[q][1] * v[q][1]) + (v[q][2] * v[q][2] + v[q][3] * v[q][3]); }
        const float rstd = rsqrtf(wave_sum(ss) * (1.f / DM) + EPS);
        const float* mb = mod + (size_t)b * 3072;
        u32x2* o8 = (u32x2*)(H + (size_t)row * DM) + lane;
#pragma unroll
        for (int q = 0; q < 4; ++q) {
            const int k = (lane + 64 * q) * 4;
            const f32x4 gv = *(const f32x4*)(gp + k), sh = *(const f32x4*)(mb + k), scl = *(const f32x4*)(mb + 1024 + k);
            const f32x4 hv = (v[q] * rstd * gv) * (scl + 1.f) + sh;
            u32x2 w; w.x = cvt_pk_bf16(hv[0], hv[1]); w.y = cvt_pk_bf16(hv[2], hv[3]);
            o8[64 * q] = w;
        }
    }
}
struct ConvD { const float* sp; bf16_t* dst; int srcN, K, k0; };
__device__ __forceinline__ bool conv_desc(const Params& p, int j, int it, int tid, ConvD& d) {
    constexpr int N0 = 448, N1 = N0 + 128, N2 = N1 + 128, N3 = N2 + 128, N4 = N3 + 64;
    if (it >= N4) return false;
    const float* src; int srcN, cs = (tid & 15) * 4, K, k0; bf16_t* dst;
    if (it < N0) {
        const int rt = it >> 2, kt = it & 3, r0 = rt * 64, T = r0 >> 8, q = r0 & 255;
        if (T < 16) {
            const int cg = tid & 15, bj = q >> 7, wcc = ((q >> 6) & 1) * 2 + (cg >> 3), fq4 = (cg >> 1) & 3, n = cg & 1;
            const int tbase = bj == 0 ? (n == 0 ? 2048 : 0) : (n == 0 ? 1024 : 3072);
            cs = tbase + 64 * T + 16 * wcc + 4 * fq4;
        }
        else if (T < 24) cs += (q < 128) ? (4096 + 128 * (T - 16) + q) : (6144 + 128 * (T - 16) + q - 128);
        else cs += 5120 + 256 * (T - 24) + q;
        src = p.ab_w_in + (size_t)j * DM * 7168; srcN = 7168; dst = (bf16_t*)(p.ws + WS_WIN_E) + (size_t)r0 * DM; K = DM; k0 = kt * 256;
    } else if (it < N1) {
        const int i2 = it - N0, rt = i2 >> 3, kt = i2 & 7, r0 = rt * 64;
        src = p.ab_w_out + (size_t)j * 2048 * DM; srcN = DM; cs += r0; dst = (bf16_t*)(p.ws + WS_WOUT_E) + (size_t)r0 * 2048; K = 2048; k0 = kt * 256;
    } else if (it < N2) {
        const int i2 = it - N1, rt = i2 >> 2, kt = i2 & 3, r0 = rt * 64;
        src = p.c_w_in + (size_t)j * DM * 4096; srcN = 4096; cs += 2048 + r0; dst = (bf16_t*)(p.ws + WS_WIN_O) + (size_t)((r0 >> 7) * 256 + 128 + (r0 & 127)) * DM; K = DM; k0 = kt * 256;
    } else if (it < N3) {
        const int i2 = it - N2, rt = i2 >> 3, kt = i2 & 7, r0 = rt * 64;
        src = p.c_w_out + (size_t)j * 2048 * DM; srcN = DM; cs += r0; dst = (bf16_t*)(p.ws + WS_WOUT_O) + (size_t)r0 * 2048; K = 2048; k0 = kt * 256;
    } else {
        const int i3 = it - N3, g = i3 >> 4, r = i3 & 15, rt = r >> 1, kt = r & 1, r0 = rt * 64;
        src = p.c_pool_w + ((size_t)j * 4 + g) * 512 * 512; srcN = 512; cs += r0; dst = (bf16_t*)(p.ws + WS_POOLT) + (size_t)g * 512 * 512 + (size_t)r0 * 512; K = 512; k0 = kt * 256;
    }
    d.sp = src + (size_t)(k0 + (tid >> 4)) * srcN + cs; d.dst = dst; d.srcN = srcN; d.K = K; d.k0 = k0;
    return true;
}
__device__ __forceinline__ void phase_norm_even(const Params& p, int j, const float* xin, LAS unsigned char* ldsb, int sel, int wg0, int ldsoff, int rot, int tail = 0) {
    const int tid = opaque_tid();
    LAS float* T = (LAS float*)(ldsb + ldsoff);
    bf16_t* SGU = (bf16_t*)(p.ws + WS_SGU); bf16_t* WINP = (bf16_t*)(p.ws + WS_WINP);
    constexpr int N3 = 448 + 128 + 128 + 128, N4 = N3 + 64, N5 = N4 + 32, N6 = N5 + 512;
    const int NROWS = (j == 0 ? MTOK / 16 : 0);
    const int TOTAL = sel == 1 ? 576 : sel == 2 ? 864 + NROWS : N6 + NROWS;
    const int bid = opaque_bid();
    if (bid < wg0 && tail == 0) return;
    const int stride = bid < wg0 ? wg0 : (int)gridDim.x - wg0;
    const int VEND = bid < wg0 ? TOTAL : TOTAL - tail;
#define SETUP_MAP(v) (sel == 1 ? ((v) < 64 ? N3 + (v) : N5 + ((v) - 64)) : sel == 2 ? ((v) < N3 ? (v) : (v) < 864 ? N4 + ((v) - N3) : N6 + ((v) - 864)) : (v))
    int v = bid < wg0 ? TOTAL - tail + bid : (bid - wg0 + rot) % stride;
    ConvD d; bool isc = (v < VEND) && conv_desc(p, j, SETUP_MAP(v), tid, d);
    f32x4 r[8];
    if (isc) {
#pragma unroll
        for (int ps = 0; ps < 8; ++ps) r[ps] = *(const f32x4*)(d.sp + (size_t)ps * 32 * d.srcN);
    }
    while (v < VEND) {
        const int vn = v + stride; ConvD dn; const bool iscn = (vn < VEND) && conv_desc(p, j, SETUP_MAP(vn), tid, dn);
        if (isc) {
#pragma unroll
            for (int ps = 0; ps < 8; ++ps) { LAS float* t = T + (ps * 32 + (tid >> 4)) * 65 + (tid & 15) * 4; t[0] = r[ps][0]; t[1] = r[ps][1]; t[2] = r[ps][2]; t[3] = r[ps][3]; }
            __syncthreads();
            if (iscn) {
#pragma unroll
                for (int ps = 0; ps < 8; ++ps) r[ps] = *(const f32x4*)(dn.sp + (size_t)ps * 32 * dn.srcN);
            }
#pragma unroll
            for (int q = 0; q < 4; ++q) {
                const int item = tid + 512 * q, n = item >> 5, kg = item & 31; const LAS float* s = T + (kg * 8) * 65 + n;
                u32x4 o; o.x = cvt_pk_bf16(s[0], s[65]); o.y = cvt_pk_bf16(s[130], s[195]); o.z = cvt_pk_bf16(s[260], s[325]); o.w = cvt_pk_bf16(s[390], s[455]);
                *(u32x4*)(d.dst + (size_t)n * d.K + d.k0 + kg * 8) = o;
            }
            __syncthreads();
        } else {
            if (iscn) {
#pragma unroll
                for (int ps = 0; ps < 8; ++ps) r[ps] = *(const f32x4*)(dn.sp + (size_t)ps * 32 * dn.srcN);
            }
            const int it = SETUP_MAP(v);
            if (it < N5) {
                const int e0 = (it - N4) * 4096 + tid * 8, t = (e0 >> 7) & 127, s0 = e0 & 127;
                const float* src = p.ab_sgu_w + (size_t)j * 8 * 128 * 128 + e0;
                const f32x4 a = *(const f32x4*)src, b = *(const f32x4*)(src + 4);
                float w[8] = {a[0], a[1], a[2], a[3], b[0], b[1], b[2], b[3]};
#pragma unroll
                for (int e = 0; e < 8; ++e) w[e] = (s0 + e <= t) ? w[e] : 0.f;
                u32x4 o; o.x = cvt_pk_bf16(w[0], w[1]); o.y = cvt_pk_bf16(w[2], w[3]); o.z = cvt_pk_bf16(w[4], w[5]); o.w = cvt_pk_bf16(w[6], w[7]);
                *(u32x4*)(SGU + e0) = o;
            } else if (it < N6) {
                const int e0 = (it - N5) * 4096 + tid * 8, k = e0 >> 11, c = e0 & 2047;
                const float* src = p.c_w_in + ((size_t)j * DM + k) * 4096 + c;
                const f32x4 a = *(const f32x4*)src, b = *(const f32x4*)(src + 4);
                u32x4 o; o.x = cvt_pk_bf16(a[0], a[1]); o.y = cvt_pk_bf16(a[2], a[3]); o.z = cvt_pk_bf16(b[0], b[1]); o.w = cvt_pk_bf16(b[2], b[3]);
                *(u32x4*)(WINP + e0) = o;
            } else norm_rows(p, 2 * j, xin, it - N6);
        }
        v = vn; d = dn; isc = iscn;
    }
#undef SETUP_MAP
}
__device__ __forceinline__ void phase_final(const Params& p) {
    const int tid = opaque_tid(), wid = tid >> 6, lane = tid & 63;
    for (int it = opaque_bid(); it < MTOK / 8; it += gridDim.x) {
        const int row = it * 8 + wid;
        f32x4* xr = (f32x4*)(p.out + (size_t)row * DM) + lane;
        f32x4 v[4]; float ss = 0.f;
#pragma unroll
        for (int q = 0; q < 4; ++q) { v[q] = xr[64 * q]; ss += (v[q][0] * v[q][0] + v[q][1] * v[q][1]) + (v[q][2] * v[q][2] + v[q][3] * v[q][3]); }
        const float rstd = rsqrtf(wave_sum(ss) * (1.f / DM) + EPS);
#pragma unroll
        for (int q = 0; q < 4; ++q) { const f32x4 gv = *(const f32x4*)(p.final_g + (lane + 64 * q) * 4); xr[64 * q] = v[q] * rstd * gv; }
    }
}

__device__ __forceinline__ void unpack8(const u32x4 w, float (&f)[8]) {
    f[0] = bf_lo(w.x); f[1] = bf_hi(w.x); f[2] = bf_lo(w.y); f[3] = bf_hi(w.y); f[4] = bf_lo(w.z); f[5] = bf_hi(w.z); f[6] = bf_lo(w.w); f[7] = bf_hi(w.w);
}

__device__ __forceinline__ void product_units(const Params& p, LAS unsigned char* lds) {
    Gemm g{(const bf16_t*)(p.ws + WS_POOLT), (const bf16_t*)(p.ws + WS_WINP), 512, 2048, 512, 8, 4, 512}; EpiProd E{(bf16_t*)(p.ws + WS_WIN_O)};
    gemm_phase(lds, g, E);
}
__device__ __forceinline__ void phase_mix(const Params& p, int j, LAS unsigned char* lds) {
    const int tid = opaque_tid(), wid = tid >> 6, lane = tid & 63;
    const bf16_t* CH2 = (const bf16_t*)(p.ws + WS_RP); const bf16_t* BZ = CH2 + (size_t)MTOK * 1024; const bf16_t* UZ = BZ + (size_t)MTOK * 1024; const bf16_t* V = UZ + (size_t)MTOK * 1024;
    bf16_t* Y = (bf16_t*)(p.ws + WS_RA);
    {
        const bf16_t* Wm = (const bf16_t*)(p.ws + WS_SGU);
        const int fr = lane & 15, fq = lane >> 4;
        const int rs = tid >> 4, c = tid & 15;
        const int sbid = opaque_bid();
        int it = (sbid & 7) * 128 + (sbid >> 3), par = 0;
        const int it_end = (sbid & 7) * 128 + 128;
        u32x4 vraw[4];
        if (it < it_end) { const bf16_t* vp = V + (size_t)((it >> 3) * 128 + rs) * 1024 + (it & 7) * 128 + 8 * c;
#pragma unroll
            for (int ps = 0; ps < 4; ++ps) vraw[ps] = *(const u32x4*)(vp + (size_t)ps * 32 * 1024); }
        for (; it < it_end; it += 32, par ^= 1) {
            const int hh = it & 7, cn = it >> 3;
            LAS bf16_t* vnT = (LAS bf16_t*)(lds + par * 36864);
            const int t = 16 * wid + fr; const size_t row = (size_t)cn * 128 + t;
            u32x2 uz[8];
#pragma unroll
            for (int n = 0; n < 8; ++n) uz[n] = *(const u32x2*)(UZ + row * 1024 + hh * 128 + 16 * n + 4 * fq);
            const float bias = p.ab_sgu_b[(size_t)j * 1024 + hh * 128 + t];
            const bf16_t* wrow = Wm + ((size_t)hh * 128 + 16 * wid + fr) * 128 + 8 * fq;
            bf16x8 af[4];
#pragma unroll
            for (int kk = 0; kk < 4; ++kk) af[kk] = *(const bf16x8*)(wrow + 32 * kk);
            const float* lg = p.ab_ln_g + (size_t)j * 1024 + hh * 128 + 8 * c; const float* lb = p.ab_ln_b + (size_t)j * 1024 + hh * 128 + 8 * c;
            const f32x4 g0 = *(const f32x4*)lg, g1 = *(const f32x4*)(lg + 4), b0 = *(const f32x4*)lb, b1 = *(const f32x4*)(lb + 4);
            const float gg[8] = {g0[0], g0[1], g0[2], g0[3], g1[0], g1[1], g1[2], g1[3]}, bb[8] = {b0[0], b0[1], b0[2], b0[3], b1[0], b1[1], b1[2], b1[3]};
#pragma unroll
            for (int ps = 0; ps < 4; ++ps) {
                float f[8]; unpack8(vraw[ps], f);
                float s1 = 0.f, s2 = 0.f;
#pragma unroll
                for (int e = 0; e < 8; ++e) { s1 += f[e]; s2 += f[e] * f[e]; }
#pragma unroll
                for (int o = 1; o < 16; o <<= 1) { s1 += __shfl_xor(s1, o); s2 += __shfl_xor(s2, o); }
                const float mu = s1 * (1.f / 128.f), var = fmaxf(s2 * (1.f / 128.f) - mu * mu, 0.f), rstd = rsqrtf(var + EPS);
                const int sr = ps * 32 + rs;
                LAS bf16_t* wp = vnT + (8 * c) * 136 + ((((sr >> 3) ^ c) & 15) << 3) + (sr & 7);
#pragma unroll
                for (int e = 0; e < 8; ++e) wp[e * 136] = (bf16_t)(cvt_pk_bf16((f[e] - mu) * rstd * gg[e] + bb[e], 0.f) & 0xffffu);
            }
            __syncthreads();
            {
                const int itn = it + 32;
                if (itn < it_end) { const bf16_t* vp = V + (size_t)((itn >> 3) * 128 + rs) * 1024 + (itn & 7) * 128 + 8 * c;
#pragma unroll
                    for (int ps = 0; ps < 4; ++ps) vraw[ps] = *(const u32x4*)(vp + (size_t)ps * 32 * 1024); }
            }
            f32x4 acc[8];
#pragma unroll
            for (int n = 0; n < 8; ++n) acc[n] = (f32x4){0.f, 0.f, 0.f, 0.f};
#pragma unroll
            for (int kk = 0; kk < 4; ++kk) {
                if (32 * kk <= 16 * wid + 15) {
#pragma unroll
                    for (int n = 0; n < 8; ++n) {
                        const int cd = (2 * n + (fr >> 3)) & 15;
                        const bf16x8 bfm = *(const LAS bf16x8*)(vnT + (16 * n + fr) * 136 + ((((4 * kk + fq) ^ cd) & 15) << 3));
                        acc[n] = __builtin_amdgcn_mfma_f32_16x16x32_bf16(bfm, af[kk], acc[n], 0, 0, 0);
                    }
                }
            }
#pragma unroll
            for (int n = 0; n < 8; ++n) {
                const int d = 16 * n + 4 * fq;
                u32x2 w; w.x = cvt_pk_bf16(bf_lo(uz[n].x) * (acc[n][0] + bias), bf_hi(uz[n].x) * (acc[n][1] + bias));
                w.y = cvt_pk_bf16(bf_lo(uz[n].y) * (acc[n][2] + bias), bf_hi(uz[n].y) * (acc[n][3] + bias));
                *(u32x2*)(Y + row * 2048 + 1024 + hh * 128 + d) = w;
            }
        }
        __syncthreads();
    }
    {
        const float* halo = (const float*)(p.ws + WS_HALO); const float* cw = p.ab_conv_w + (size_t)j * 3 * 1024;
        {
            const int fb = opaque_bid(), lidx = (fb >> 3) * 512 + tid, B = (fb & 7) * 16 + (lidx >> 10), c = lidx & 1023; const bool hist = ((B * 128) & (SEQ - 1)) != 0;
            const float* hb = halo + (size_t)B * 6 * 1024 + c;
            const float c6 = hist ? hb[-6 * 1024] : 0.f, c7 = hist ? hb[-5 * 1024] : 0.f, c0 = hb[2 * 1024], c1 = hb[3 * 1024], b0 = hb[4 * 1024], b1 = hb[5 * 1024];
            const float w0 = cw[c], w1 = cw[1024 + c], w2 = cw[2048 + c];
            const float y0 = b0 * (w0 * c6 + w1 * c7 + w2 * c0), y1 = b1 * (w0 * c7 + w1 * c0 + w2 * c1);
            Y[(size_t)(B * 128) * 2048 + c] = (bf16_t)(cvt_pk_bf16(y0, 0.f) & 0xffffu);
            Y[(size_t)(B * 128 + 1) * 2048 + c] = (bf16_t)(cvt_pk_bf16(y1, 0.f) & 0xffffu);
        }
    }
}

__device__ __forceinline__ void phase_pool(const Params& p) {
    const int tid = opaque_tid();
    const bf16_t* HQ = (const bf16_t*)(p.ws + WS_HQ); const bf16_t* HS = (const bf16_t*)(p.ws + WS_HS); bf16_t* Y = (bf16_t*)(p.ws + WS_RA);
    const int fb = opaque_bid(), lidx = (fb >> 3) * 512 + tid;
    if (lidx < 16 * 256) {
        const int B = (fb & 7) * 16 + (lidx >> 8), ct = lidx & 255, c0 = ct * 8, win = 2 << (ct >> 6); const bool hist = ((B * 128) & (SEQ - 1)) != 0;
        const bf16_t* tail = HQ + (size_t)(B - 1) * 32 * 2048 + c0;
        const bf16_t* head = HQ + ((size_t)B * 32 + 16) * 2048 + c0;
        const bf16_t* hs = HS + (size_t)B * 16 * 2048 + c0;
        float S[8];
#pragma unroll
        for (int e = 0; e < 8; ++e) S[e] = 0.f;
        if (hist) {
#pragma unroll
            for (int i = 1; i < 16; ++i) {
                if (i < win) { float v[8]; unpack8(*(const u32x4*)(tail + (size_t)(16 - i) * 2048), v);
#pragma unroll
                    for (int e = 0; e < 8; ++e) S[e] += v[e]; }
            }
        }
#pragma unroll 4
        for (int r = 0; r < 16; ++r) {
            float cur[8], sz[8], o[8];
            unpack8(*(const u32x4*)(head + (size_t)r * 2048), cur);
            unpack8(*(const u32x4*)(hs + (size_t)r * 2048), sz);
            const float inv = 1.f / (float)(hist ? win : min(r + 1, win));
#pragma unroll
            for (int e = 0; e < 8; ++e) { S[e] += cur[e]; o[e] = (S[e] * inv - cur[e]) * sz[e]; }
            u32x4 w; w.x = cvt_pk_bf16(o[0], o[1]); w.y = cvt_pk_bf16(o[2], o[3]); w.z = cvt_pk_bf16(o[4], o[5]); w.w = cvt_pk_bf16(o[6], o[7]);
            *(u32x4*)(Y + (size_t)(B * 128 + r) * 2048 + c0) = w;
            const int ro = r - win + 1;
            if (ro >= 0 || hist) { float old[8]; unpack8(*(const u32x4*)(ro >= 0 ? head + (size_t)ro * 2048 : tail + (size_t)(16 + ro) * 2048), old);
#pragma unroll
                for (int e = 0; e < 8; ++e) S[e] -= old[e]; }
        }
    }
}

#define XB_TMO      128
#define XB_XCNT(j)  (256  + 64 * (j))
#define XB_XSUB(j)  (1280 + 64 * (j))
#define XB_XGEN(j)  (2304 + 64 * (j))
#define XB_TOP      3328
#define XB_TOPGEN   3392
#define XCD_BAR_WORDS 3456
#define XB_SPIN_CAP (1u << 18)
__device__ __forceinline__ unsigned xb_ld(unsigned* p)              { return __hip_atomic_load(p, __ATOMIC_RELAXED, __HIP_MEMORY_SCOPE_AGENT); }
__device__ __forceinline__ unsigned xb_add(unsigned* p, unsigned v) { return __hip_atomic_fetch_add(p, v, __ATOMIC_RELAXED, __HIP_MEMORY_SCOPE_AGENT); }
__device__ __forceinline__ unsigned xb_xcc_id() { return (unsigned)__builtin_amdgcn_s_getreg((3 << 11) | 20) & 0xFu; }
#define XB_SPIN(cond, bar) do { unsigned _sp = 0; while (cond) { __builtin_amdgcn_s_sleep(1); \
    if ((++_sp & 255u) == 0u) { if (xb_ld(&(bar)[XB_TMO])) break; if (_sp > XB_SPIN_CAP) { atomicAdd(&(bar)[XB_TMO], 1u); break; } } } } while (0)
struct XcdBarrier { unsigned* bar; unsigned x; volatile LAS unsigned* st; };
__device__ __forceinline__ XcdBarrier xcd_barrier_post(unsigned* bar, volatile LAS unsigned* st) {
    XcdBarrier b; b.bar = bar; b.x = xb_xcc_id(); b.st = st;
    if (threadIdx.x == 0) (void)xb_add(&bar[XB_XCNT(b.x)], 1u);
    return b;
}
__device__ __forceinline__ void xcd_barrier_complete(unsigned* bar, unsigned x, unsigned& nloc, unsigned& nx) {
    const unsigned G = gridDim.x * gridDim.y * gridDim.z;
    unsigned sum, cnt, mine, sp = 0u;
    for (;;) {
        sum = 0u; cnt = 0u; mine = 0u;
#pragma unroll
        for (unsigned j = 0; j < 16; ++j) { const unsigned c = xb_ld(&bar[XB_XCNT(j)]); sum += c; cnt += (c > 0u) ? 1u : 0u; mine = (j == x) ? c : mine; }
        if (sum == G) break;
        __builtin_amdgcn_s_sleep(1);
        if ((++sp & 255u) == 0u) { if (xb_ld(&bar[XB_TMO])) break; if (sp > XB_SPIN_CAP) { atomicAdd(&bar[XB_TMO], 1u); break; } }
    }
    nloc = mine > 0u ? mine : 1u; nx = cnt > 0u ? cnt : 1u;
}
__device__ __forceinline__ void xcd_barrier(const XcdBarrier& b) {
    asm volatile("s_waitcnt vmcnt(0)" ::: "memory");
    __syncthreads();
    if (threadIdx.x == 0) {
        unsigned* bar = b.bar;
        __builtin_amdgcn_s_waitcnt(0);
        unsigned nloc = b.st[0], nx = b.st[1];
        if (nloc == 0u) { xcd_barrier_complete(bar, b.x, nloc, nx); b.st[0] = nloc; b.st[1] = nx; }
        const unsigned old = xb_add(&bar[XB_XSUB(b.x)], 1u);
        const unsigned gen = old / nloc;
        if (old + 1u == (gen + 1u) * nloc) {
            __builtin_amdgcn_fence(__ATOMIC_RELEASE, "agent");
            asm volatile("s_waitcnt vmcnt(0)" ::: "memory");
            const unsigned og = xb_add(&bar[XB_TOP], 1u);
            const unsigned tg = og / nx;
            if (og + 1u == (tg + 1u) * nx) xb_add(&bar[XB_TOPGEN], 1u);
            else XB_SPIN(xb_ld(&bar[XB_TOPGEN]) == tg, bar);
            __builtin_amdgcn_fence(__ATOMIC_ACQUIRE, "agent");
            xb_add(&bar[XB_XGEN(b.x)], 1u);
            asm volatile("s_waitcnt vmcnt(0)" ::: "memory");
        } else {
            XB_SPIN(xb_ld(&bar[XB_XGEN(b.x)]) == gen, bar);
            __builtin_amdgcn_fence(__ATOMIC_ACQUIRE, "agent");
            asm volatile("s_waitcnt vmcnt(0)" ::: "memory");
        }
    }
    __syncthreads();
}

__device__ __forceinline__ void local_barrier(unsigned* ctr, unsigned target, unsigned* tmo) {
    asm volatile("s_waitcnt vmcnt(0)" ::: "memory");
    __syncthreads();
    if (threadIdx.x == 0) {
        __builtin_amdgcn_s_waitcnt(0);
        (void)xb_add(ctr, 1u);
        __builtin_amdgcn_fence(__ATOMIC_ACQUIRE, "agent");
        unsigned sp = 0;
        while (xb_ld(ctr) < target) { __builtin_amdgcn_s_sleep(1); if (++sp > (1u << 22)) { atomicAdd(tmo, 1u); break; } }
        asm volatile("s_waitcnt vmcnt(0)" ::: "memory");
    }
    __syncthreads();
}

__global__ void __launch_bounds__(512, 2) mega_fwd(Params p, int ph_lo, int ph_hi) {
    extern __shared__ __attribute__((aligned(16))) unsigned char smem[];
    LAS unsigned char* lds = (LAS unsigned char*)smem;
    cg::grid_group grid = cg::this_grid();
    if (ph_hi < 0) grid.sync();
    volatile LAS unsigned* st = (volatile LAS unsigned*)(lds + STAGE_BYTES);
    if (threadIdx.x < 4) st[threadIdx.x] = 0u;
    __syncthreads();
    const XcdBarrier xb = xcd_barrier_post((unsigned*)(p.ws + WS_BAR), st);
    unsigned* ctl = (unsigned*)(p.ws + WS_BAR);
    if (threadIdx.x == 0) __hip_atomic_store(ctl + TAB_WORD0 + blockIdx.x, xb.x + 1u, __ATOMIC_RELAXED, __HIP_MEMORY_SCOPE_AGENT);
    unsigned* lctr = ctl + LOC_WORD0 + 64 * (blockIdx.x & 7);
    int ph = 0, fast = 0; unsigned lgen = 0;
#define PHASE(LOCAL, ...) do { if (ph >= ph_lo && ph < ph_hi) { __VA_ARGS__; if (ph + 1 < ph_hi) { if ((LOCAL) && fast) { ++lgen; local_barrier(lctr, 32u * lgen, ctl + XB_TMO); } else xcd_barrier(xb); } } ++ph; } while (0)
    bf16_t* RA = (bf16_t*)(p.ws + WS_RA); bf16_t* RP = (bf16_t*)(p.ws + WS_RP);
    const bf16_t* WIN_E = (const bf16_t*)(p.ws + WS_WIN_E); const bf16_t* WIN_O = (const bf16_t*)(p.ws + WS_WIN_O);
    const bf16_t* WOUT_E = (const bf16_t*)(p.ws + WS_WOUT_E); const bf16_t* WOUT_O = (const bf16_t*)(p.ws + WS_WOUT_O);
    const float* mod = (const float*)(p.ws + WS_MOD);
    float* part = (float*)(p.ws + WS_PART); unsigned* cnt = (unsigned*)(p.ws + WS_BAR) + CNT_WORD0;
    PHASE(0, { phase_mod(p, lds); phase_norm_even(p, 0, nullptr, lds, 1, 0, 49152, 64); });
    {
        int ok = 1;
        if (threadIdx.x < 256) { const unsigned a = xb_ld(ctl + TAB_WORD0 + threadIdx.x), r = xb_ld(ctl + TAB_WORD0 + (threadIdx.x & 7)); ok = (a == r && a != 0u) ? 1 : 0; }
        fast = __syncthreads_and(ok) && gridDim.x == 256;
    }
#pragma unroll 1
    for (int lp = 0; lp < 2; ++lp) {
        {
            const int layer = 2 * lp; const float* xin = (lp == 0) ? p.x : p.out;
            PHASE(0, { if (blockIdx.x < 32) product_units(p, lds); phase_norm_even(p, lp, xin, lds, 2, 32, 0, 0, lp == 0 ? 156 : 28); });
            PHASE(1, { Gemm g{(const bf16_t*)g_h, WIN_E, DM, DM, DM, MTOK / BM, 7168 / BM, 0}; EpiEven E{RP, RA, (float*)(p.ws + WS_HALO), p.ab_conv_w + (size_t)lp * 3 * 1024}; gemm_phase(lds, g, E); });
            PHASE(1, phase_mix(p, lp, lds));
            PHASE(1, { Gemm g{RA, WOUT_E, 2048, 2048, 2048, MTOK / BM, DM / BM, 0};
                       EpiResNorm E{lp == 0 ? p.x : nullptr, (const bf16_t*)g_x, (bf16_t*)g_x, p.out, mod + (size_t)layer * NB * 3072 + 2048, (bf16_t*)g_h, p.norm_g + (size_t)(layer + 1) * DM, mod + (size_t)(layer + 1) * NB * 3072,
                                    part + (size_t)layer * 4 * MTOK, cnt + layer * 64, 0};
                       gemm_phase(lds, g, E); });
        }
        {
            const int layer = 2 * lp + 1; const int last = (lp == 1) ? 1 : 0;
            PHASE(1, { Gemm g{(const bf16_t*)g_h, WIN_O, DM, DM, DM, MTOK / BM, 4096 / BM, 0}; EpiOdd E{RA, (bf16_t*)(p.ws + WS_HQ), (bf16_t*)(p.ws + WS_HS), p.c_pool_scale + (size_t)lp * 2048}; gemm_phase(lds, g, E); });
            PHASE(1, { phase_pool(p); if (lp == 0) phase_norm_even(p, 1, nullptr, lds, 1, 0, 0, 0); });
            PHASE(0, { Gemm g{RA, WOUT_O, 2048, 2048, 2048, MTOK / BM, DM / BM, 0};
                       EpiResNorm E{nullptr, (const bf16_t*)g_x, (bf16_t*)g_x, p.out, mod + (size_t)layer * NB * 3072 + 2048, (bf16_t*)g_h, last ? p.final_g : p.norm_g + (size_t)(layer + 1) * DM, mod + (size_t)(last ? layer : layer + 1) * NB * 3072,
                                    part + (size_t)layer * 4 * MTOK, cnt + layer * 64, last};
                       gemm_phase(lds, g, E); });
        }
    }
#undef PHASE
}

extern "C" void kernel_launch(void* const* d_in, const int* in_sizes, int n_in, void* d_out, int out_size, void* d_ws, size_t ws_size, hipStream_t stream) {
    static int grid = 0;
    if (grid == 0) {
        if (n_in != 17 || out_size != MTOK * DM || ws_size < WS_END2) { fprintf(stderr, "kernel_launch: unexpected shapes (n_in %d out %d ws %zu need %zu)\n", n_in, out_size, ws_size, (size_t)WS_END2); grid = -1; return; }
        int dev = 0, cus = 0, per_cu = 0;
        hipGetDevice(&dev);
        hipDeviceGetAttribute(&cus, hipDeviceAttributeMultiprocessorCount, dev);
        if (hipFuncSetAttribute((const void*)mega_fwd, hipFuncAttributeMaxDynamicSharedMemorySize, LDS_BYTES) != hipSuccess) { fprintf(stderr, "kernel_launch: hipFuncSetAttribute failed\n"); grid = -1; return; }
        hipOccupancyMaxActiveBlocksPerMultiprocessor(&per_cu, (const void*)mega_fwd, 512, LDS_BYTES);
        if (per_cu < 1) { fprintf(stderr, "kernel_launch: occupancy query says %d blocks per CU\n", per_cu); per_cu = 1; }
        (void)hipGetLastError();
        grid = cus;
        if (grid != 256) { fprintf(stderr, "kernel_launch: built for 256 CUs (one out-projection tile per workgroup), got %d\n", grid); grid = -1; return; }
    }
    if (grid < 0) return;
    Params p{};
    p.x = (const float*)d_in[0]; p.c = (const float*)d_in[1]; p.norm_g = (const float*)d_in[2]; p.ada_w = (const float*)d_in[3]; p.ada_b = (const float*)d_in[4];
    p.ab_w_in = (const float*)d_in[5]; p.ab_conv_w = (const float*)d_in[6]; p.ab_ln_g = (const float*)d_in[7]; p.ab_ln_b = (const float*)d_in[8];
    p.ab_sgu_w = (const float*)d_in[9]; p.ab_sgu_b = (const float*)d_in[10]; p.ab_w_out = (const float*)d_in[11];
    p.c_w_in = (const float*)d_in[12]; p.c_pool_w = (const float*)d_in[13]; p.c_pool_scale = (const float*)d_in[14]; p.c_w_out = (const float*)d_in[15]; p.final_g = (const float*)d_in[16];
    p.out = (float*)d_out; p.ws = (unsigned char*)d_ws;
    if (hipMemsetAsync((unsigned char*)d_ws + WS_BAR, 0, CTL_WORDS * 4, stream) != hipSuccess) { fprintf(stderr, "kernel_launch: barrier memset failed\n"); return; }
    int lo = 0, hi = 15;
    void* args[] = {&p, &lo, &hi};
    hipError_t e = hipLaunchCooperativeKernel((const void*)mega_fwd, dim3(grid), dim3(512), args, LDS_BYTES, stream);
    if (e != hipSuccess) fprintf(stderr, "kernel_launch: cooperative launch failed: %s (grid %d)\n", hipGetErrorString(e), grid);
}
```

```cpp
#include <hip/hip_runtime.h>
#include <hip/hip_cooperative_groups.h>
#include <cstdio>
namespace cg = cooperative_groups;

#define LAS __attribute__((address_space(3)))
typedef unsigned short bf16_t;
typedef short bf16x8 __attribute__((ext_vector_type(8)));
typedef float f32x4 __attribute__((ext_vector_type(4)));
typedef unsigned u32x4 __attribute__((ext_vector_type(4)));
typedef unsigned u32x2 __attribute__((ext_vector_type(2)));

constexpr int DM = 1024, NB = 8, SEQ = 2048, MTOK = NB * SEQ;
constexpr int BM = 256, BK = 64, HALF = 128, HTB = HALF * BK * 2, STAGE_BYTES = 8 * HTB, NXCD = 8, WGM = 8;
constexpr int LDS_BYTES = STAGE_BYTES + 8192;
constexpr float EPS = 1e-6f;
constexpr int REP_G1 = 1, REP_THIN = 1, REP_G2L0 = 1;

constexpr size_t WS_MOD = 0;
constexpr size_t WS_BAR = 393216;
constexpr size_t WS_WIN_E = 524288;
constexpr size_t WS_WIN_O = WS_WIN_E + (size_t)7168 * 1024 * 2;
constexpr size_t WS_WOUT_E = WS_WIN_O + (size_t)4096 * 1024 * 2;
constexpr size_t WS_WOUT_O = WS_WOUT_E + (size_t)1024 * 2048 * 2;
constexpr size_t WS_SGU = WS_WOUT_O + (size_t)1024 * 2048 * 2;
constexpr size_t WS_POOLT = WS_SGU + (size_t)8 * 128 * 128 * 2;
constexpr size_t WS_WINP = WS_POOLT + (size_t)4 * 512 * 512 * 2;
constexpr size_t WS_RA = WS_WINP + (size_t)1024 * 2048 * 2;
constexpr size_t WS_RP = WS_RA + (size_t)MTOK * 2048 * 2;
constexpr size_t WS_END = WS_RP + (size_t)MTOK * 4096 * 2;

constexpr size_t WS_PART = WS_END;
constexpr size_t WS_HALO = WS_PART + (size_t)4 * 4 * MTOK * 4;
constexpr size_t WS_END2 = WS_HALO + (size_t)128 * 6 * 1024 * 4;
constexpr size_t WS_HQ = WS_RP;
constexpr size_t WS_HS = WS_HQ + (size_t)128 * 32 * 2048 * 2;
constexpr int CNT_WORD0 = 3584;
constexpr int LOC_WORD0 = CNT_WORD0 + 256;
constexpr int TAB_WORD0 = LOC_WORD0 + 512;
constexpr int CTL_WORDS = TAB_WORD0 + 256;
constexpr int XLD = 2048;
__device__ unsigned short g_x[(size_t)MTOK * XLD];
__device__ unsigned short g_h[(size_t)MTOK * DM];

struct Params {
    const float *x, *c, *norm_g, *ada_w, *ada_b, *ab_w_in, *ab_conv_w, *ab_ln_g, *ab_ln_b, *ab_sgu_w, *ab_sgu_b, *ab_w_out,
        *c_w_in, *c_pool_w, *c_pool_scale, *c_w_out, *final_g;
    float* out;
    unsigned char* ws;
};

__host__ __device__ __forceinline__ int lds_byte(int r, int c) { const int st = (r >> 4) * 2 + (c >> 5), rr = r & 15, cc = c & 31, ob = rr * 64 + cc * 2; return st * 1024 + (ob ^ (((ob >> 9) & 1) << 5)); }
__host__ __device__ __forceinline__ void stage_rc(int b, int& R, int& C) { const int st = b / 1024, sb = b % 1024, swz = sb ^ (((sb >> 9) & 1) << 5); R = (st >> 1) * 16 + swz / 64; C = (st & 1) * 32 + (swz % 64) / 2; }
__host__ __device__ __forceinline__ int perm32(int rho) { const int n = rho >> 4, i = rho & 15; return 8 * (i >> 2) + 4 * n + (i & 3); }
__device__ __forceinline__ unsigned cvt_pk_bf16(float lo, float hi) { unsigned r; asm volatile("v_cvt_pk_bf16_f32 %0, %1, %2" : "=v"(r) : "v"(lo), "v"(hi)); return r; }
__device__ __forceinline__ float bf_lo(unsigned w) { return __uint_as_float(w << 16); }
__device__ __forceinline__ float bf_hi(unsigned w) { return __uint_as_float(w & 0xffff0000u); }
__device__ __forceinline__ float silu_f(float v) { return v * __builtin_amdgcn_rcpf(1.f + __expf(-v)); }
__device__ __forceinline__ float wave_sum(float v) {
#pragma unroll
    for (int o = 1; o < 64; o <<= 1) v += __shfl_xor(v, o);
    return v;
}

__device__ __forceinline__ int opaque_tid() { int t = threadIdx.x; asm volatile("" : "+v"(t)); return t; }
__device__ __forceinline__ int opaque_bid() { int b = blockIdx.x; asm volatile("" : "+s"(b)); return b; }
struct Unit { int pm, pn; };
struct Gemm { const bf16_t* A; const bf16_t* Bt; int lda, ldb, K, nM, nN, bk; };

__device__ __forceinline__ bool next_unit(const Gemm& g, int bid, int i, Unit& u) {
    const int nwg = g.nM * g.nN;
    if ((long)i * gridDim.x + bid >= nwg) return false;
    const int nr = nwg / (int)gridDim.x;
    const int ir = (nr > 1 && nr * (int)gridDim.x == nwg) ? (i + (bid & 7)) % nr : i;
    const long L = (long)ir * gridDim.x + bid;
    int wgid = (int)L; { const int q = nwg / NXCD, r = nwg % NXCD, xcd = wgid % NXCD, off = wgid / NXCD; wgid = (xcd < r ? xcd * (q + 1) : r * (q + 1) + (xcd - r) * q) + off; }
    const int nig = WGM * g.nN, gid = wgid / nig, fm = gid * WGM, gsz = (g.nM - fm) < WGM ? (g.nM - fm) : WGM;
    u.pm = fm + ((wgid % nig) % gsz); u.pn = (wgid % nig) / gsz; return true;
}

struct EpiEven {
    static constexpr bool PERM = true, AFTER_DRAIN = false, PERMA = true;
    bf16_t* P; bf16_t* Y; float* halo; const float* cw;
    __device__ __forceinline__ void operator()(const f32x4 (&acc)[2][2][4][2], const Unit& u, int wr, int wc, int fr, int fq) const {
        const int tok0 = u.pm * BM + 8 * (wr * 16 + fr), T = u.pn;
        if (T < 16) {
            const int ch = T * 64 + 16 * wc + 4 * fq;
            const f32x4 w0 = *(const f32x4*)(cw + ch), w1 = *(const f32x4*)(cw + 1024 + ch), w2 = *(const f32x4*)(cw + 2048 + ch);
            f32x4 c[8], pm1, pm2;
#pragma unroll
            for (int i = 0; i < 8; ++i) c[i] = acc[i >> 2][0][i & 3][0] * acc[i >> 2][0][i & 3][1];
#pragma unroll
            for (int j = 0; j < 4; ++j) {
                pm1[j] = __int_as_float(__builtin_amdgcn_update_dpp(0, __float_as_int(c[7][j]), 0x111, 0xf, 0xf, true));
                pm2[j] = __int_as_float(__builtin_amdgcn_update_dpp(0, __float_as_int(c[6][j]), 0x111, 0xf, 0xf, true));
            }
            float* hb = halo + (size_t)(u.pm * 2 + wr) * 6 * 1024 + ch;
            if (fr == 15) { *(f32x4*)(hb) = c[6]; *(f32x4*)(hb + 1024) = c[7]; }
            bf16_t* yp = Y + (size_t)tok0 * 2048 + ch;
#pragma unroll
            for (int i = 0; i < 8; ++i) {
                f32x4 bz = acc[i >> 2][1][i & 3][0]; const f32x4 z = acc[i >> 2][1][i & 3][1];
#pragma unroll
                for (int j = 0; j < 4; ++j) bz[j] *= silu_f(z[j]);
                const f32x4 cm1 = (i >= 1) ? c[i >= 1 ? i - 1 : 0] : pm1, cm2 = (i >= 2) ? c[i >= 2 ? i - 2 : 0] : (i == 1 ? pm1 : pm2);
                const f32x4 y = bz * (w0 * ((i == 1) ? pm1 : cm2) + w1 * cm1 + w2 * c[i]);
                if (i < 2 && fr == 0) { *(f32x4*)(hb + (2 + i) * 1024) = c[i]; *(f32x4*)(hb + (4 + i) * 1024) = bz; }
                else { u32x2 w; w.x = cvt_pk_bf16(y[0], y[1]); w.y = cvt_pk_bf16(y[2], y[3]); *(u32x2*)(yp + (size_t)i * 2048) = w; }
            }
        } else if (T < 24) {
            bf16_t* base = P + (size_t)2 * MTOK * 1024 + (size_t)tok0 * 1024 + (T - 16) * 128 + wc * 32 + 8 * fq;
#pragma unroll
            for (int i = 0; i < 8; ++i) {
                f32x4 x0 = acc[i >> 2][0][i & 3][0], x1 = acc[i >> 2][0][i & 3][1]; const f32x4 y0 = acc[i >> 2][1][i & 3][0], y1 = acc[i >> 2][1][i & 3][1];
#pragma unroll
                for (int j = 0; j < 4; ++j) { x0[j] *= silu_f(y0[j]); x1[j] *= silu_f(y1[j]); }
                u32x4 w; w.x = cvt_pk_bf16(x0[0], x0[1]); w.y = cvt_pk_bf16(x0[2], x0[3]); w.z = cvt_pk_bf16(x1[0], x1[1]); w.w = cvt_pk_bf16(x1[2], x1[3]);
                *(u32x4*)(base + (size_t)i * 1024) = w;
            }
        } else {
            bf16_t* base = P + (size_t)3 * MTOK * 1024 + (size_t)tok0 * 1024 + (T - 24) * 256 + wc * 32 + 8 * fq;
#pragma unroll
            for (int i = 0; i < 8; ++i)
#pragma unroll
                for (int bj = 0; bj < 2; ++bj) {
                    const f32x4 v0 = acc[i >> 2][bj][i & 3][0], v1 = acc[i >> 2][bj][i & 3][1];
                    u32x4 w; w.x = cvt_pk_bf16(v0[0], v0[1]); w.y = cvt_pk_bf16(v0[2], v0[3]); w.z = cvt_pk_bf16(v1[0], v1[1]); w.w = cvt_pk_bf16(v1[2], v1[3]);
                    *(u32x4*)(base + (size_t)i * 1024 + bj * HALF) = w;
                }
        }
    }
};
template <int WIN> __device__ __forceinline__ void pool_quad(const f32x4 (&acc)[2][2][4][2], int n, const f32x4 ps, unsigned (&yq)[8][2], unsigned (&qq)[8][2], unsigned (&sq)[8][2]) {
    float y[8][4], szv[8][4];
#pragma unroll
    for (int j = 0; j < 4; ++j) {
        float h[23], PS[24];
#pragma unroll
        for (int k = 0; k < 8; ++k) h[15 + k] = acc[k >> 2][0][k & 3][n][j];
#pragma unroll
        for (int k = 0; k < 8; ++k) h[7 + k] = __int_as_float(__builtin_amdgcn_update_dpp(0, __float_as_int(h[15 + k]), 0x111, 0xf, 0xf, true));
#pragma unroll
        for (int k = 1; k < 8; ++k) h[k - 1] = __int_as_float(__builtin_amdgcn_update_dpp(0, __float_as_int(h[15 + k]), 0x112, 0xf, 0xf, true));
        constexpr int LO = 16 - WIN;
#pragma unroll
        for (int x = 0; x <= LO; ++x) PS[x] = 0.f;
#pragma unroll
        for (int x = LO; x < 23; ++x) PS[x + 1] = PS[x] + h[x];
#pragma unroll
        for (int i = 0; i < 8; ++i) {
            const float w = PS[16 + i] - PS[16 + i - WIN];
            const float z = acc[i >> 2][1][i & 3][n][j];
            szv[i][j] = silu_f(z) * ps[j];
            y[i][j] = (w * (1.f / WIN) - h[15 + i]) * szv[i][j];
        }
    }
#pragma unroll
    for (int i = 0; i < 8; ++i) {
        yq[i][0] = cvt_pk_bf16(y[i][0], y[i][1]); yq[i][1] = cvt_pk_bf16(y[i][2], y[i][3]);
        qq[i][0] = cvt_pk_bf16(acc[i >> 2][0][i & 3][n][0], acc[i >> 2][0][i & 3][n][1]); qq[i][1] = cvt_pk_bf16(acc[i >> 2][0][i & 3][n][2], acc[i >> 2][0][i & 3][n][3]);
        sq[i][0] = cvt_pk_bf16(szv[i][0], szv[i][1]); sq[i][1] = cvt_pk_bf16(szv[i][2], szv[i][3]);
    }
}
struct EpiOdd {
    static constexpr bool PERM = true, AFTER_DRAIN = false, PERMA = true;
    bf16_t* Y; bf16_t* HQ; bf16_t* HS; const float* pscale;
    __device__ __forceinline__ void operator()(const f32x4 (&acc)[2][2][4][2], const Unit& u, int wr, int wc, int fr, int fq) const {
        const int T = u.pn, g = T >> 2, B = u.pm * 2 + wr;
        const int tok0 = u.pm * BM + 8 * (wr * 16 + fr);
        const int ch = T * 128 + wc * 32 + 8 * fq;
        unsigned yq[2][8][2];
#pragma unroll
        for (int n = 0; n < 2; ++n) {
            const f32x4 ps = *(const f32x4*)(pscale + ch + 4 * n);
            unsigned qq[8][2], sq[8][2];
            if (g == 0) pool_quad<2>(acc, n, ps, yq[n], qq, sq);
            else if (g == 1) pool_quad<4>(acc, n, ps, yq[n], qq, sq);
            else if (g == 2) pool_quad<8>(acc, n, ps, yq[n], qq, sq);
            else pool_quad<16>(acc, n, ps, yq[n], qq, sq);
            if (fr >= 14) {
                bf16_t* hp = HQ + ((size_t)B * 32 + (fr - 14) * 8) * 2048 + ch + 4 * n;
#pragma unroll
                for (int i = 0; i < 8; ++i) { u32x2 w; w.x = qq[i][0]; w.y = qq[i][1]; *(u32x2*)(hp + (size_t)i * 2048) = w; }
            }
            if (fr <= 1) {
                bf16_t* hp = HQ + ((size_t)B * 32 + 16 + fr * 8) * 2048 + ch + 4 * n; bf16_t* sp = HS + ((size_t)B * 16 + fr * 8) * 2048 + ch + 4 * n;
#pragma unroll
                for (int i = 0; i < 8; ++i) { u32x2 w; w.x = qq[i][0]; w.y = qq[i][1]; *(u32x2*)(hp + (size_t)i * 2048) = w; u32x2 v; v.x = sq[i][0]; v.y = sq[i][1]; *(u32x2*)(sp + (size_t)i * 2048) = v; }
            }
        }
        bf16_t* yp = Y + (size_t)tok0 * 2048 + ch;
#pragma unroll
        for (int i = 0; i < 8; ++i) { u32x4 w; w.x = yq[0][i][0]; w.y = yq[0][i][1]; w.z = yq[1][i][0]; w.w = yq[1][i][1]; *(u32x4*)(yp + (size_t)i * 2048) = w; }
    }
};
struct EpiProd {
    static constexpr bool PERM = true, AFTER_DRAIN = false, PERMA = false;
    bf16_t* O;
    __device__ __forceinline__ void operator()(const f32x4 (&acc)[2][2][4][2], const Unit& u, int wr, int wc, int fr, int fq) const {
        const int col0 = u.pn * BM + wc * 32 + 8 * fq;
#pragma unroll
        for (int ai = 0; ai < 2; ++ai)
#pragma unroll
            for (int m = 0; m < 4; ++m) {
                bf16_t* rowp = O + (size_t)((u.pm * 2 + ai) * 256 + wr * 64 + m * 16 + fr) * DM + col0;
#pragma unroll
                for (int bj = 0; bj < 2; ++bj) {
                    const f32x4 v0 = acc[ai][bj][m][0], v1 = acc[ai][bj][m][1];
                    u32x4 w; w.x = cvt_pk_bf16(v0[0], v0[1]); w.y = cvt_pk_bf16(v0[2], v0[3]); w.z = cvt_pk_bf16(v1[0], v1[1]); w.w = cvt_pk_bf16(v1[2], v1[3]);
                    *(u32x4*)(rowp + bj * HALF) = w;
                }
            }
    }
};
struct EpiBf {
    static constexpr bool PERM = true, AFTER_DRAIN = false, PERMA = false;
    bf16_t* O; int ld;
    __device__ __forceinline__ void operator()(const f32x4 (&acc)[2][2][4][2], const Unit& u, int wr, int wc, int fr, int fq) const {
        const int row0 = u.pm * BM + wr * 64 + fr, col0 = u.pn * BM + wc * 32 + 8 * fq;
#pragma unroll
        for (int ai = 0; ai < 2; ++ai)
#pragma unroll
            for (int m = 0; m < 4; ++m) {
                bf16_t* rowp = O + (size_t)(row0 + ai * HALF + m * 16) * ld + col0;
#pragma unroll
                for (int bj = 0; bj < 2; ++bj) {
                    const f32x4 v0 = acc[ai][bj][m][0], v1 = acc[ai][bj][m][1];
                    u32x4 w; w.x = cvt_pk_bf16(v0[0], v0[1]); w.y = cvt_pk_bf16(v0[2], v0[3]); w.z = cvt_pk_bf16(v1[0], v1[1]); w.w = cvt_pk_bf16(v1[2], v1[3]);
                    *(u32x4*)(rowp + bj * HALF) = w;
                }
            }
    }
};
struct EpiRes {
    static constexpr bool PERM = false, AFTER_DRAIN = false, PERMA = false;
    const float* xin; float* xout; const float* gate;
    __device__ __forceinline__ void operator()(const f32x4 (&acc)[2][2][4][2], const Unit& u, int wr, int wc, int fr, int fq) const {
        const int row0 = u.pm * BM + wr * 64 + fr, col0 = u.pn * BM + wc * 32 + 4 * fq;
        const float* gp = gate + (size_t)(u.pm >> 3) * 3072 + col0;
        f32x4 gv[2][2];
#pragma unroll
        for (int bj = 0; bj < 2; ++bj)
#pragma unroll
            for (int n = 0; n < 2; ++n) gv[bj][n] = *(const f32x4*)(gp + bj * HALF + n * 16);
#pragma unroll
        for (int ai = 0; ai < 2; ++ai)
#pragma unroll
            for (int m = 0; m < 4; ++m) {
                const size_t ro = (size_t)(row0 + ai * HALF + m * 16) * DM + col0;
#pragma unroll
                for (int bj = 0; bj < 2; ++bj)
#pragma unroll
                    for (int n = 0; n < 2; ++n) {
                        const f32x4 xv = *(const f32x4*)(xin + ro + bj * HALF + n * 16);
                        *(f32x4*)(xout + ro + bj * HALF + n * 16) = xv + gv[bj][n] * acc[ai][bj][m][n];
                    }
            }
    }
};

struct EpiResNorm {
    static constexpr bool PERM = true, AFTER_DRAIN = true, PERMA = false;
    __device__ __forceinline__ bool xpre() const { return xin32 == nullptr; }
    const float* xin32; const bf16_t* xin16; bf16_t* xout16; float* out32; const float* gate; bf16_t* H; const float* ng; const float* modn; float* part; unsigned* cnt; int last;
    __device__ __forceinline__ void fused(f32x4 (&acc)[2][2][4][2], const Unit& u, int wr, int wc, int fr, int fq, LAS unsigned char* lds, int tid) const {
        const int row0 = u.pm * BM + wr * 64 + fr, col0 = u.pn * BM + wc * 32 + 8 * fq, b = u.pm >> 3;
        LAS float* lss = (LAS float*)(lds + STAGE_BYTES + 1024);
        LAS float* lrs = (LAS float*)(lds + STAGE_BYTES + 1024 + 4096);
        {
            const float* gp = gate + (size_t)b * 3072 + col0;
            f32x4 gv[2][2];
#pragma unroll
            for (int bj = 0; bj < 2; ++bj)
#pragma unroll
                for (int n = 0; n < 2; ++n) gv[bj][n] = *(const f32x4*)(gp + bj * HALF + 4 * n);
#pragma unroll
            for (int ai = 0; ai < 2; ++ai)
#pragma unroll
                for (int m = 0; m < 4; ++m) {
                    const size_t ro = (size_t)(row0 + ai * HALF + m * 16) * DM + col0, rox = (size_t)(row0 + ai * HALF + m * 16) * XLD + col0;
                    float ss = 0.f;
#pragma unroll
                    for (int bj = 0; bj < 2; ++bj) {
                        f32x4 x0, x1;
                        if (xin32) { x0 = *(const f32x4*)(xin32 + ro + bj * HALF); x1 = *(const f32x4*)(xin32 + ro + bj * HALF + 4); }
                        else { u32x4 w;
                            if (ai == 1 && bj == 1 && wc >= 2) w = *(const u32x4*)(xin16 + rox + bj * HALF);
                            else {
                                const int cb = 2 * bj + (wc >> 1), slot = (cb & 1) ? (ai * 2 + (cb >> 1)) : (4 + ai * 2 + (cb >> 1));
                                w = *(const LAS u32x4*)(lds + slot * HTB + lds_byte(wr * 64 + m * 16 + fr, (wc & 1) * 32 + 8 * fq));
                            } x0 = (f32x4){bf_lo(w.x), bf_hi(w.x), bf_lo(w.y), bf_hi(w.y)}; x1 = (f32x4){bf_lo(w.z), bf_hi(w.z), bf_lo(w.w), bf_hi(w.w)}; }
                        const f32x4 v0 = x0 + gv[bj][0] * acc[ai][bj][m][0], v1 = x1 + gv[bj][1] * acc[ai][bj][m][1];
                        acc[ai][bj][m][0] = v0; acc[ai][bj][m][1] = v1;
                        ss += ((v0[0] * v0[0] + v0[1] * v0[1]) + (v0[2] * v0[2] + v0[3] * v0[3])) + ((v1[0] * v1[0] + v1[1] * v1[1]) + (v1[2] * v1[2] + v1[3] * v1[3]));
                    }
                    ss += __shfl_xor(ss, 16); ss += __shfl_xor(ss, 32);
                    if (fq == 0) lss[(ai * HALF + wr * 64 + m * 16 + fr) * 4 + wc] = ss;
                }
        }
        __syncthreads();
        if (tid < 256) {
            const float t = (lss[tid * 4] + lss[tid * 4 + 1]) + (lss[tid * 4 + 2] + lss[tid * 4 + 3]);
            __hip_atomic_store(part + (size_t)u.pn * MTOK + u.pm * BM + tid, t, __ATOMIC_RELAXED, __HIP_MEMORY_SCOPE_AGENT);
        }
        asm volatile("s_waitcnt vmcnt(0)" ::: "memory");
        __syncthreads();
        unsigned* c = cnt + u.pm;
        if (tid == 0) __hip_atomic_fetch_add(c, 1u, __ATOMIC_RELAXED, __HIP_MEMORY_SCOPE_AGENT);
        if (!last) {
#pragma unroll
            for (int ai = 0; ai < 2; ++ai)
#pragma unroll
                for (int m = 0; m < 4; ++m) {
                    const size_t rox = (size_t)(row0 + ai * HALF + m * 16) * XLD + col0;
#pragma unroll
                    for (int bj = 0; bj < 2; ++bj) {
                        const f32x4 v0 = acc[ai][bj][m][0], v1 = acc[ai][bj][m][1];
                        u32x4 w; w.x = cvt_pk_bf16(v0[0], v0[1]); w.y = cvt_pk_bf16(v0[2], v0[3]); w.z = cvt_pk_bf16(v1[0], v1[1]); w.w = cvt_pk_bf16(v1[2], v1[3]);
                        *(u32x4*)(xout16 + rox + bj * HALF) = w;
                    }
                }
        }
        if (tid == 0) {
            unsigned spins = 0;
            while (__hip_atomic_load(c, __ATOMIC_RELAXED, __HIP_MEMORY_SCOPE_AGENT) < 4u && ++spins < (1u << 22)) __builtin_amdgcn_s_sleep(1);
            __builtin_amdgcn_fence(__ATOMIC_ACQUIRE, "agent");
            asm volatile("s_waitcnt vmcnt(0)" ::: "memory");
        }
        __syncthreads();
        if (tid < 256) {
            float t = 0.f;
#pragma unroll
            for (int q = 0; q < 4; ++q) t += __hip_atomic_load(part + (size_t)q * MTOK + u.pm * BM + tid, __ATOMIC_RELAXED, __HIP_MEMORY_SCOPE_AGENT);
            lrs[tid] = rsqrtf(t * (1.f / DM) + EPS);
        }
        __syncthreads();
        const float* mb = modn + (size_t)b * 3072;
#pragma unroll
        for (int bj = 0; bj < 2; ++bj) {
            const int c = col0 + bj * HALF;
            const f32x4 g0 = *(const f32x4*)(ng + c), g1 = *(const f32x4*)(ng + c + 4);
            f32x4 sh0 = {0.f, 0.f, 0.f, 0.f}, sh1 = sh0, sc0 = sh0, sc1 = sh0;
            if (!last) { sh0 = *(const f32x4*)(mb + c); sh1 = *(const f32x4*)(mb + c + 4); sc0 = *(const f32x4*)(mb + 1024 + c); sc1 = *(const f32x4*)(mb + 1024 + c + 4); }
            const f32x4 a0 = g0 * (sc0 + 1.f), a1 = g1 * (sc1 + 1.f);
#pragma unroll
            for (int ai = 0; ai < 2; ++ai)
#pragma unroll
                for (int m = 0; m < 4; ++m) {
                    const int rl = ai * HALF + wr * 64 + m * 16 + fr;
                    const float rstd = lrs[rl];
                    const size_t ro = (size_t)(u.pm * BM + rl) * DM + c;
                    const f32x4 h0 = (acc[ai][bj][m][0] * rstd) * a0 + sh0, h1 = (acc[ai][bj][m][1] * rstd) * a1 + sh1;
                    if (last) { *(f32x4*)(out32 + ro) = h0; *(f32x4*)(out32 + ro + 4) = h1; }
                    else { u32x4 w; w.x = cvt_pk_bf16(h0[0], h0[1]); w.y = cvt_pk_bf16(h0[2], h0[3]); w.z = cvt_pk_bf16(h1[0], h1[1]); w.w = cvt_pk_bf16(h1[2], h1[3]); *(u32x4*)(H + ro) = w; }
                }
        }
    }
};

template <class Epi>
__device__ __forceinline__ void gemm_phase(LAS unsigned char* lds, const Gemm g, const Epi& E) {
    const int tid = opaque_tid(), wid = __builtin_amdgcn_readfirstlane(tid >> 6), lane = tid & 63, wr = wid >> 2, wc = wid & 3, fr = lane & 15, fq = lane >> 4;
    const int nt = g.K / BK;
    unsigned voffA[2], voffB[2];
#pragma unroll
    for (int i = 0; i < 2; ++i) { int R, C; stage_rc(tid * 16 + i * 8192, R, C); const int Rb = Epi::PERM ? ((R & ~31) + perm32(R & 31)) : R;
        const int Ra = Epi::PERMA ? (8 * ((R >> 6) * 16 + (R & 15)) + ((R >> 4) & 3)) : R;
        voffA[i] = (unsigned)(Ra * g.lda + C) * 2u; voffB[i] = (unsigned)(Rb * g.ldb + C) * 2u; }
    const size_t kstep = (size_t)(BK * 2);
    const size_t hstepA = (size_t)(Epi::PERMA ? 4 : HALF) * g.lda * 2, hstepB = (size_t)HALF * g.ldb * 2, tstepA = (size_t)BM * g.lda * 2;
    const unsigned ldsw = (unsigned)wid * 1024u;
    const int aoff = lds_byte(wr * 64 + fr, fq * 8), boff = lds_byte(wc * 32 + fr, fq * 8);
#define PG8_SA(b, h) (((b) * 2 + (h)) * HTB)
#define PG8_SB(b, h) ((4 + (b) * 2 + (h)) * HTB)
#define PG8_STAGE(bufoff, gbase, voff) do { _Pragma("unroll") for (int _i = 0; _i < 2; ++_i) \
        __builtin_amdgcn_global_load_lds((const unsigned*)((const char*)(gbase) + (voff)[_i]), (LAS unsigned*)(lds + (bufoff) + ldsw + _i * 8192), 16, 0, 0); } while (0)
#define PG8_LDA(dst, b, h) do { _Pragma("unroll") for (int m = 0; m < 4; ++m) _Pragma("unroll") for (int k = 0; k < 2; ++k) dst[m][k] = *(const LAS bf16x8*)(lds + PG8_SA(b, h) + aoff + m * 2048 + k * 1024); } while (0)
#define PG8_LDB(dst, b, h) do { _Pragma("unroll") for (int n = 0; n < 2; ++n) _Pragma("unroll") for (int k = 0; k < 2; ++k) dst[n][k] = *(const LAS bf16x8*)(lds + PG8_SB(b, h) + boff + n * 2048 + k * 1024); } while (0)
#define PG8_MMA(ai, bj, At, Bt) do { __builtin_amdgcn_s_setprio(1); _Pragma("unroll") for (int m = 0; m < 4; ++m) _Pragma("unroll") for (int n = 0; n < 2; ++n) _Pragma("unroll") for (int k = 0; k < 2; ++k) \
        acc[ai][bj][m][n] = __builtin_amdgcn_mfma_f32_16x16x32_bf16(Bt[n][k], At[m][k], acc[ai][bj][m][n], 0, 0, 0); __builtin_amdgcn_s_setprio(0); } while (0)
#define PG8_WAIT_V(n) asm volatile("s_waitcnt vmcnt(" #n ")" ::: "memory")
#define PG8_WAIT_L(n) asm volatile("s_waitcnt lgkmcnt(" #n ")" ::: "memory")
#define PG8_BAR __builtin_amdgcn_s_barrier()
#define PG8_SCHED __builtin_amdgcn_sched_barrier(0)
    Unit cur, nxt; int ui = 0;
    const int bid = opaque_bid();
    if (!next_unit(g, bid, 0, cur)) return;
    f32x4 acc[2][2][4][2];
#pragma unroll
    for (int a = 0; a < 2; ++a)
#pragma unroll
        for (int b = 0; b < 2; ++b)
#pragma unroll
            for (int m = 0; m < 4; ++m)
#pragma unroll
                for (int n = 0; n < 2; ++n) acc[a][b][m][n] = (f32x4){0.f, 0.f, 0.f, 0.f};
    bf16x8 At[4][2], B0[2][2], B1[2][2];
    const char* cA = (const char*)g.A + (size_t)cur.pm * tstepA; const char* cB = (const char*)g.Bt + (size_t)cur.pn * 2 * hstepB + (size_t)(cur.pm >> 1) * g.bk * 2;
    PG8_STAGE(PG8_SB(0, 0), cB, voffB); PG8_STAGE(PG8_SA(0, 0), cA, voffA); PG8_STAGE(PG8_SB(0, 1), cB + hstepB, voffB); PG8_STAGE(PG8_SA(0, 1), cA + hstepA, voffA);
    if (wr == 1) PG8_BAR;
    PG8_WAIT_V(4); PG8_BAR;
    PG8_STAGE(PG8_SB(1, 0), cB + kstep, voffB); PG8_STAGE(PG8_SA(1, 0), cA + kstep, voffA); PG8_STAGE(PG8_SB(1, 1), cB + hstepB + kstep, voffB);
    PG8_WAIT_V(6); PG8_BAR;
    for (;;) {
        const bool has_next = next_unit(g, bid, ui + 1, nxt);
        const char* nA = has_next ? (const char*)g.A + (size_t)nxt.pm * tstepA : cA;
        const char* nB = has_next ? (const char*)g.Bt + (size_t)nxt.pn * 2 * hstepB + (size_t)(nxt.pm >> 1) * g.bk * 2 : cB;
#define PG8_ITER(S2, S3, S4, S5, S6, S7, S8) do { \
              PG8_LDB(B0, 0, 0); PG8_SCHED; PG8_LDA(At, 0, 0); PG8_STAGE(PG8_SA(1, 1), a1 + hstepA, voffA); \
            PG8_WAIT_L(8); PG8_BAR; PG8_WAIT_L(0); PG8_MMA(0, 0, At, B0); PG8_BAR; PG8_SCHED; \
              PG8_LDB(B1, 0, 1); S2; \
            PG8_BAR; PG8_WAIT_L(0); PG8_MMA(0, 1, At, B1); PG8_BAR; \
              PG8_LDA(At, 0, 1); S3; \
            PG8_BAR; PG8_WAIT_L(0); PG8_MMA(1, 0, At, B0); PG8_BAR; PG8_SCHED; \
              S4; \
            PG8_WAIT_V(6); PG8_BAR; PG8_MMA(1, 1, At, B1); PG8_BAR; \
              PG8_LDB(B0, 1, 0); PG8_SCHED; PG8_LDA(At, 1, 0); S5; \
            PG8_WAIT_L(8); PG8_BAR; PG8_WAIT_L(0); PG8_MMA(0, 0, At, B0); PG8_BAR; PG8_SCHED; \
              PG8_LDB(B1, 1, 1); S6; \
            PG8_BAR; PG8_WAIT_L(0); PG8_MMA(0, 1, At, B1); PG8_BAR; \
              PG8_LDA(At, 1, 1); S7; \
            PG8_BAR; PG8_WAIT_L(0); PG8_MMA(1, 0, At, B0); PG8_BAR; PG8_SCHED; \
              S8; \
            PG8_WAIT_V(6); PG8_BAR; PG8_MMA(1, 1, At, B1); PG8_BAR; } while (0)
        bool xpre = false;
        if constexpr (Epi::AFTER_DRAIN) xpre = !has_next && E.xpre();
        const int nt_main = xpre ? nt - 2 : nt;
        for (int t = 0; t < nt_main; t += 2) {
            const bool last = (t == nt - 2);
            const char* a1 = cA + (size_t)(t + 1) * kstep;
            const char* a2 = last ? nA : cA + (size_t)(t + 2) * kstep; const char* b2 = last ? nB : cB + (size_t)(t + 2) * kstep;
            const char* a3 = a2 + kstep; const char* b3 = b2 + kstep;
            PG8_ITER(PG8_STAGE(PG8_SB(0, 0), b2, voffB), PG8_STAGE(PG8_SA(0, 0), a2, voffA), PG8_STAGE(PG8_SB(0, 1), b2 + hstepB, voffB), PG8_STAGE(PG8_SA(0, 1), a2 + hstepA, voffA),
                     PG8_STAGE(PG8_SB(1, 0), b3, voffB), PG8_STAGE(PG8_SA(1, 0), a3, voffA), PG8_STAGE(PG8_SB(1, 1), b3 + hstepB, voffB));
        }
        if constexpr (Epi::AFTER_DRAIN) {
            if (xpre) {
                const char* a1 = cA + (size_t)(nt - 1) * kstep;
                const char* xq = (const char*)E.xin16 + ((size_t)cur.pm * BM * XLD + (size_t)cur.pn * BM) * 2;
                const size_t xh = (size_t)HALF * XLD * 2;
                PG8_ITER(PG8_STAGE(PG8_SB(0, 0), xq, voffA), PG8_STAGE(PG8_SA(0, 0), xq + 128, voffA), PG8_STAGE(PG8_SB(0, 1), xq + 256, voffA), PG8_STAGE(PG8_SA(0, 1), xq + 384, voffA),
                         PG8_STAGE(PG8_SB(1, 0), xq + xh, voffA), PG8_STAGE(PG8_SA(1, 0), xq + xh + 128, voffA), PG8_STAGE(PG8_SB(1, 1), xq + xh + 256, voffA));
            }
        }
#undef PG8_ITER
        if constexpr (!Epi::AFTER_DRAIN) E(acc, cur, wr, wc, fr, fq);
        if (!has_next) break;
#pragma unroll
        for (int a = 0; a < 2; ++a)
#pragma unroll
            for (int b = 0; b < 2; ++b)
#pragma unroll
                for (int m = 0; m < 4; ++m)
#pragma unroll
                    for (int n = 0; n < 2; ++n) acc[a][b][m][n] = (f32x4){0.f, 0.f, 0.f, 0.f};
        cur = nxt; cA = nA; cB = nB; ++ui;
    }
    PG8_WAIT_V(0);
    if (wr == 0) PG8_BAR;
    PG8_BAR;
    if constexpr (Epi::AFTER_DRAIN) E.fused(acc, cur, wr, wc, fr, fq, lds, tid);
#undef PG8_SA
#undef PG8_SB
#undef PG8_STAGE
#undef PG8_LDA
#undef PG8_LDB
#undef PG8_MMA
#undef PG8_WAIT_V
#undef PG8_WAIT_L
#undef PG8_BAR
#undef PG8_SCHED
}

__device__ __forceinline__ void phase_mod(const Params& p, LAS unsigned char* lds) {
    const int tid = opaque_tid(), wid = tid >> 6, lane = tid & 63;
    LAS float* sc = (LAS float*)lds;
    LAS float* red = (LAS float*)(lds + 32768);
    float* mod = (float*)(p.ws + WS_MOD);
    for (int t = tid; t < NB * DM; t += 512) sc[t] = silu_f(p.c[t]);
    __syncthreads();
    for (int it = opaque_bid(); it < 192; it += gridDim.x) {
        const int col = it * 64 + lane, i = col / 3072, j = col - i * 3072;
        const float* w = p.ada_w + ((size_t)i * DM + wid * 128) * 3072 + j;
        float a[8];
#pragma unroll
        for (int b = 0; b < 8; ++b) a[b] = 0.f;
#pragma unroll 32
        for (int k = 0; k < 128; ++k) {
            const float wv = w[(size_t)k * 3072];
#pragma unroll
            for (int b = 0; b < 8; ++b) a[b] += sc[b * DM + wid * 128 + k] * wv;
        }
#pragma unroll
        for (int b = 0; b < 8; ++b) red[(wid * 8 + b) * 64 + lane] = a[b];
        __syncthreads();
        {
            const int b = tid >> 6; float s = 0.f;
#pragma unroll
            for (int w8 = 0; w8 < 8; ++w8) s += red[(w8 * 8 + b) * 64 + lane];
            mod[((size_t)i * NB + b) * 3072 + j] = s + p.ada_b[i * 3072 + j];
        }
        __syncthreads();
    }
}

__device__ __forceinline__ void conv_tile(const float* __restrict__ src, int srcN, int c0, bf16_t* __restrict__ dstrow, int K, int k0, LAS float* T, int csrc = -1) {
    const int tid = opaque_tid();
    const int cs = csrc >= 0 ? csrc : c0 + (tid & 15) * 4;
    f32x4 v[8];
#pragma unroll
    for (int ps = 0; ps < 8; ++ps) v[ps] = *(const f32x4*)(src + (size_t)(k0 + ps * 32 + (tid >> 4)) * srcN + cs);
#pragma unroll
    for (int ps = 0; ps < 8; ++ps) { LAS float* t = T + (ps * 32 + (tid >> 4)) * 65 + (tid & 15) * 4; t[0] = v[ps][0]; t[1] = v[ps][1]; t[2] = v[ps][2]; t[3] = v[ps][3]; }
    __syncthreads();
#pragma unroll
    for (int q = 0; q < 4; ++q) {
        const int item = tid + 512 * q, n = item >> 5, kg = item & 31; const LAS float* s = T + (kg * 8) * 65 + n;
        u32x4 o; o.x = cvt_pk_bf16(s[0], s[65]); o.y = cvt_pk_bf16(s[130], s[195]); o.z = cvt_pk_bf16(s[260], s[325]); o.w = cvt_pk_bf16(s[390], s[455]);
        *(u32x4*)(dstrow + (size_t)n * K + k0 + kg * 8) = o;
    }
    __syncthreads();
}

__device__ __forceinline__ void norm_rows(const Params& p, int layer, const float* xin, int item) {
    const int tid = opaque_tid(), wid = tid >> 6, lane = tid & 63;
    bf16_t* H = (bf16_t*)g_h;
    const float* mod = (const float*)(p.ws + WS_MOD) + (size_t)layer * NB * 3072;
    const float* gp = p.norm_g + (size_t)layer * DM;
#pragma unroll
    for (int h2 = 0; h2 < 2; ++h2) {
        const int row = item * 16 + h2 * 8 + wid, b = row >> 11;
        const f32x4* xr = (const f32x4*)(xin + (size_t)row * DM) + lane;
        f32x4 v[4]; float ss = 0.f;
#pragma unroll
        for (int q = 0; q < 4; ++q) { v[q] = xr[64 * q]; ss += (v[q][0] * v[q][0] + v[q][1] * v[q][1]) + (v[q][2] * v[q][2] + v[q][3] * v[q][3]); }
        const float rstd = rsqrtf(wave_sum(ss) * (1.f / DM) + EPS);
        const float* mb = mod + (size_t)b * 3072;
        u32x2* o8 = (u32x2*)(H + (size_t)row * DM) + lane;
#pragma unroll
        for (int q = 0; q < 4; ++q) {
            const int k = (lane + 64 * q) * 4;
            const f32x4 gv = *(const f32x4*)(gp + k), sh = *(const f32x4*)(mb + k), scl = *(const f32x4*)(mb + 1024 + k);
            const f32x4 hv = (v[q] * rstd * gv) * (scl + 1.f) + sh;
            u32x2 w; w.x = cvt_pk_bf16(hv[0], hv[1]); w.y = cvt_pk_bf16(hv[2], hv[3]);
            o8[64 * q] = w;
        }
    }
}
struct ConvD { const float* sp; bf16_t* dst; int srcN, K, k0; };
__device__ __forceinline__ bool conv_desc(const Params& p, int j, int it, int tid, ConvD& d) {
    constexpr int N0 = 448, N1 = N0 + 128, N2 = N1 + 128, N3 = N2 + 128, N4 = N3 + 64;
    if (it >= N4) return false;
    const float* src; int srcN, cs = (tid & 15) * 4, K, k0; bf16_t* dst;
    if (it < N0) {
        const int rt = it >> 2, kt = it & 3, r0 = rt * 64, T = r0 >> 8, q = r0 & 255;
        if (T < 16) {
            const int cg = tid & 15, bj = q >> 7, wcc = ((q >> 6) & 1) * 2 + (cg >> 3), fq4 = (cg >> 1) & 3, n = cg & 1;
            const int tbase = bj == 0 ? (n == 0 ? 2048 : 0) : (n == 0 ? 1024 : 3072);
            cs = tbase + 64 * T + 16 * wcc + 4 * fq4;
        }
        else if (T < 24) cs += (q < 128) ? (4096 + 128 * (T - 16) + q) : (6144 + 128 * (T - 16) + q - 128);
        else cs += 5120 + 256 * (T - 24) + q;
        src = p.ab_w_in + (size_t)j * DM * 7168; srcN = 7168; dst = (bf16_t*)(p.ws + WS_WIN_E) + (size_t)r0 * DM; K = DM; k0 = kt * 256;
    } else if (it < N1) {
        const int i2 = it - N0, rt = i2 >> 3, kt = i2 & 7, r0 = rt * 64;
        src = p.ab_w_out + (size_t)j * 2048 * DM; srcN = DM; cs += r0; dst = (bf16_t*)(p.ws + WS_WOUT_E) + (size_t)r0 * 2048; K = 2048; k0 = kt * 256;
    } else if (it < N2) {
        const int i2 = it - N1, rt = i2 >> 2, kt = i2 & 3, r0 = rt * 64;
        src = p.c_w_in + (size_t)j * DM * 4096; srcN = 4096; cs += 2048 + r0; dst = (bf16_t*)(p.ws + WS_WIN_O) + (size_t)((r0 >> 7) * 256 + 128 + (r0 & 127)) * DM; K = DM; k0 = kt * 256;
    } else if (it < N3) {
        const int i2 = it - N2, rt = i2 >> 3, kt = i2 & 7, r0 = rt * 64;
        src = p.c_w_out + (size_t)j * 2048 * DM; srcN = DM; cs += r0; dst = (bf16_t*)(p.ws + WS_WOUT_O) + (size_t)r0 * 2048; K = 2048; k0 = kt * 256;
    } else {
        const int i3 = it - N3, g = i3 >> 4, r = i3 & 15, rt = r >> 1, kt = r & 1, r0 = rt * 64;
        src = p.c_pool_w + ((size_t)j * 4 + g) * 512 * 512; srcN = 512; cs += r0; dst = (bf16_t*)(p.ws + WS_POOLT) + (size_t)g * 512 * 512 + (size_t)r0 * 512; K = 512; k0 = kt * 256;
    }
    d.sp = src + (size_t)(k0 + (tid >> 4)) * srcN + cs; d.dst = dst; d.srcN = srcN; d.K = K; d.k0 = k0;
    return true;
}
__device__ __forceinline__ void phase_norm_even(const Params& p, int j, const float* xin, LAS unsigned char* ldsb, int sel, int wg0, int ldsoff, int rot, int tail = 0) {
    const int tid = opaque_tid();
    LAS float* T = (LAS float*)(ldsb + ldsoff);
    bf16_t* SGU = (bf16_t*)(p.ws + WS_SGU); bf16_t* WINP = (bf16_t*)(p.ws + WS_WINP);
    constexpr int N3 = 448 + 128 + 128 + 128, N4 = N3 + 64, N5 = N4 + 32, N6 = N5 + 512;
    const int NROWS = (j == 0 ? MTOK / 16 : 0);
    const int TOTAL = sel == 1 ? 576 : sel == 2 ? 864 + NROWS : N6 + NROWS;
    const int bid = opaque_bid();
    if (bid < wg0 && tail == 0) return;
    const int stride = bid < wg0 ? wg0 : (int)gridDim.x - wg0;
    const int VEND = bid < wg0 ? TOTAL : TOTAL - tail;
#define SETUP_MAP(v) (sel == 1 ? ((v) < 64 ? N3 + (v) : N5 + ((v) - 64)) : sel == 2 ? ((v) < N3 ? (v) : (v) < 864 ? N4 + ((v) - N3) : N6 + ((v) - 864)) : (v))
    int v = bid < wg0 ? TOTAL - tail + bid : (bid - wg0 + rot) % stride;
    ConvD d; bool isc = (v < VEND) && conv_desc(p, j, SETUP_MAP(v), tid, d);
    f32x4 r[8];
    if (isc) {
#pragma unroll
        for (int ps = 0; ps < 8; ++ps) r[ps] = *(const f32x4*)(d.sp + (size_t)ps * 32 * d.srcN);
    }
    while (v < VEND) {
        const int vn = v + stride; ConvD dn; const bool iscn = (vn < VEND) && conv_desc(p, j, SETUP_MAP(vn), tid, dn);
        if (isc) {
#pragma unroll
            for (int ps = 0; ps < 8; ++ps) { LAS float* t = T + (ps * 32 + (tid >> 4)) * 65 + (tid & 15) * 4; t[0] = r[ps][0]; t[1] = r[ps][1]; t[2] = r[ps][2]; t[3] = r[ps][3]; }
            __syncthreads();
            if (iscn) {
#pragma unroll
                for (int ps = 0; ps < 8; ++ps) r[ps] = *(const f32x4*)(dn.sp + (size_t)ps * 32 * dn.srcN);
            }
#pragma unroll
            for (int q = 0; q < 4; ++q) {
                const int item = tid + 512 * q, n = item >> 5, kg = item & 31; const LAS float* s = T + (kg * 8) * 65 + n;
                u32x4 o; o.x = cvt_pk_bf16(s[0], s[65]); o.y = cvt_pk_bf16(s[130], s[195]); o.z = cvt_pk_bf16(s[260], s[325]); o.w = cvt_pk_bf16(s[390], s[455]);
                *(u32x4*)(d.dst + (size_t)n * d.K + d.k0 + kg * 8) = o;
            }
            __syncthreads();
        } else {
            if (iscn) {
#pragma unroll
                for (int ps = 0; ps < 8; ++ps) r[ps] = *(const f32x4*)(dn.sp + (size_t)ps * 32 * dn.srcN);
            }
            const int it = SETUP_MAP(v);
            if (it < N5) {
                const int e0 = (it - N4) * 4096 + tid * 8, t = (e0 >> 7) & 127, s0 = e0 & 127;
                const float* src = p.ab_sgu_w + (size_t)j * 8 * 128 * 128 + e0;
                const f32x4 a = *(const f32x4*)src, b = *(const f32x4*)(src + 4);
                float w[8] = {a[0], a[1], a[2], a[3], b[0], b[1], b[2], b[3]};
#pragma unroll
                for (int e = 0; e < 8; ++e) w[e] = (s0 + e <= t) ? w[e] : 0.f;
                u32x4 o; o.x = cvt_pk_bf16(w[0], w[1]); o.y = cvt_pk_bf16(w[2], w[3]); o.z = cvt_pk_bf16(w[4], w[5]); o.w = cvt_pk_bf16(w[6], w[7]);
                *(u32x4*)(SGU + e0) = o;
            } else if (it < N6) {
                const int e0 = (it - N5) * 4096 + tid * 8, k = e0 >> 11, c = e0 & 2047;
                const float* src = p.c_w_in + ((size_t)j * DM + k) * 4096 + c;
                const f32x4 a = *(const f32x4*)src, b = *(const f32x4*)(src + 4);
                u32x4 o; o.x = cvt_pk_bf16(a[0], a[1]); o.y = cvt_pk_bf16(a[2], a[3]); o.z = cvt_pk_bf16(b[0], b[1]); o.w = cvt_pk_bf16(b[2], b[3]);
                *(u32x4*)(WINP + e0) = o;
            } else norm_rows(p, 2 * j, xin, it - N6);
        }
        v = vn; d = dn; isc = iscn;
    }
#undef SETUP_MAP
}
__device__ __forceinline__ void phase_final(const Params& p) {
    const int tid = opaque_tid(), wid = tid >> 6, lane = tid & 63;
    for (int it = opaque_bid(); it < MTOK / 8; it += gridDim.x) {
        const int row = it * 8 + wid;
        f32x4* xr = (f32x4*)(p.out + (size_t)row * DM) + lane;
        f32x4 v[4]; float ss = 0.f;
#pragma unroll
        for (int q = 0; q < 4; ++q) { v[q] = xr[64 * q]; ss += (v[q][0] * v[q][0] + v[q][1] * v[q][1]) + (v[q][2] * v[q][2] + v[q][3] * v[q][3]); }
        const float rstd = rsqrtf(wave_sum(ss) * (1.f / DM) + EPS);
#pragma unroll
        for (int q = 0; q < 4; ++q) { const f32x4 gv = *(const f32x4*)(p.final_g + (lane + 64 * q) * 4); xr[64 * q] = v[q] * rstd * gv; }
    }
}

__device__ __forceinline__ void unpack8(const u32x4 w, float (&f)[8]) {
    f[0] = bf_lo(w.x); f[1] = bf_hi(w.x); f[2] = bf_lo(w.y); f[3] = bf_hi(w.y); f[4] = bf_lo(w.z); f[5] = bf_hi(w.z); f[6] = bf_lo(w.w); f[7] = bf_hi(w.w);
}

__device__ __forceinline__ void product_units(const Params& p, LAS unsigned char* lds) {
    Gemm g{(const bf16_t*)(p.ws + WS_POOLT), (const bf16_t*)(p.ws + WS_WINP), 512, 2048, 512, 8, 4, 512}; EpiProd E{(bf16_t*)(p.ws + WS_WIN_O)};
    gemm_phase(lds, g, E);
}
__device__ __forceinline__ void phase_mix(const Params& p, int j, LAS unsigned char* lds) {
    const int tid = opaque_tid(), wid = tid >> 6, lane = tid & 63;
    const bf16_t* CH2 = (const bf16_t*)(p.ws + WS_RP); const bf16_t* BZ = CH2 + (size_t)MTOK * 1024; const bf16_t* UZ = BZ + (size_t)MTOK * 1024; const bf16_t* V = UZ + (size_t)MTOK * 1024;
    bf16_t* Y = (bf16_t*)(p.ws + WS_RA);
    {
        const bf16_t* Wm = (const bf16_t*)(p.ws + WS_SGU);
        const int fr = lane & 15, fq = lane >> 4;
        const int rs = tid >> 4, c = tid & 15;
        const int sbid = opaque_bid();
        int it = (sbid & 7) * 128 + (sbid >> 3), par = 0;
        const int it_end = (sbid & 7) * 128 + 128;
        u32x4 vraw[4];
        if (it < it_end) { const bf16_t* vp = V + (size_t)((it >> 3) * 128 + rs) * 1024 + (it & 7) * 128 + 8 * c;
#pragma unroll
            for (int ps = 0; ps < 4; ++ps) vraw[ps] = *(const u32x4*)(vp + (size_t)ps * 32 * 1024); }
        for (; it < it_end; it += 32, par ^= 1) {
            const int hh = it & 7, cn = it >> 3;
            LAS bf16_t* vnT = (LAS bf16_t*)(lds + par * 36864);
            const int t = 16 * wid + fr; const size_t row = (size_t)cn * 128 + t;
            u32x2 uz[8];
#pragma unroll
            for (int n = 0; n < 8; ++n) uz[n] = *(const u32x2*)(UZ + row * 1024 + hh * 128 + 16 * n + 4 * fq);
            const float bias = p.ab_sgu_b[(size_t)j * 1024 + hh * 128 + t];
            const bf16_t* wrow = Wm + ((size_t)hh * 128 + 16 * wid + fr) * 128 + 8 * fq;
            bf16x8 af[4];
#pragma unroll
            for (int kk = 0; kk < 4; ++kk) af[kk] = *(const bf16x8*)(wrow + 32 * kk);
            const float* lg = p.ab_ln_g + (size_t)j * 1024 + hh * 128 + 8 * c; const float* lb = p.ab_ln_b + (size_t)j * 1024 + hh * 128 + 8 * c;
            const f32x4 g0 = *(const f32x4*)lg, g1 = *(const f32x4*)(lg + 4), b0 = *(const f32x4*)lb, b1 = *(const f32x4*)(lb + 4);
            const float gg[8] = {g0[0], g0[1], g0[2], g0[3], g1[0], g1[1], g1[2], g1[3]}, bb[8] = {b0[0], b0[1], b0[2], b0[3], b1[0], b1[1], b1[2], b1[3]};
#pragma unroll
            for (int ps = 0; ps < 4; ++ps) {
                float f[8]; unpack8(vraw[ps], f);
                float s1 = 0.f, s2 = 0.f;
#pragma unroll
                for (int e = 0; e < 8; ++e) { s1 += f[e]; s2 += f[e] * f[e]; }
#pragma unroll
                for (int o = 1; o < 16; o <<= 1) { s1 += __shfl_xor(s1, o); s2 += __shfl_xor(s2, o); }
                const float mu = s1 * (1.f / 128.f), var = fmaxf(s2 * (1.f / 128.f) - mu * mu, 0.f), rstd = rsqrtf(var + EPS);
                const int sr = ps * 32 + rs;
                LAS bf16_t* wp = vnT + (8 * c) * 136 + ((((sr >> 3) ^ c) & 15) << 3) + (sr & 7);
#pragma unroll
                for (int e = 0; e < 8; ++e) wp[e * 136] = (bf16_t)(cvt_pk_bf16((f[e] - mu) * rstd * gg[e] + bb[e], 0.f) & 0xffffu);
            }
            __syncthreads();
            {
                const int itn = it + 32;
                if (itn < it_end) { const bf16_t* vp = V + (size_t)((itn >> 3) * 128 + rs) * 1024 + (itn & 7) * 128 + 8 * c;
#pragma unroll
                    for (int ps = 0; ps < 4; ++ps) vraw[ps] = *(const u32x4*)(vp + (size_t)ps * 32 * 1024); }
            }
            f32x4 acc[8];
#pragma unroll
            for (int n = 0; n < 8; ++n) acc[n] = (f32x4){0.f, 0.f, 0.f, 0.f};
#pragma unroll
            for (int kk = 0; kk < 4; ++kk) {
                if (32 * kk <= 16 * wid + 15) {
#pragma unroll
                    for (int n = 0; n < 8; ++n) {
                        const int cd = (2 * n + (fr >> 3)) & 15;
                        const bf16x8 bfm = *(const LAS bf16x8*)(vnT + (16 * n + fr) * 136 + ((((4 * kk + fq) ^ cd) & 15) << 3));
                        acc[n] = __builtin_amdgcn_mfma_f32_16x16x32_bf16(bfm, af[kk], acc[n], 0, 0, 0);
                    }
                }
            }
#pragma unroll
            for (int n = 0; n < 8; ++n) {
                const int d = 16 * n + 4 * fq;
                u32x2 w; w.x = cvt_pk_bf16(bf_lo(uz[n].x) * (acc[n][0] + bias), bf_hi(uz[n].x) * (acc[n][1] + bias));
                w.y = cvt_pk_bf16(bf_lo(uz[n].y) * (acc[n][2] + bias), bf_hi(uz[n].y) * (acc[n][3] + bias));
                *(u32x2*)(Y + row * 2048 + 1024 + hh * 128 + d) = w;
            }
        }
        __syncthreads();
    }
    {
        const float* halo = (const float*)(p.ws + WS_HALO); const float* cw = p.ab_conv_w + (size_t)j * 3 * 1024;
        {
            const int fb = opaque_bid(), lidx = (fb >> 3) * 512 + tid, B = (fb & 7) * 16 + (lidx >> 10), c = lidx & 1023; const bool hist = ((B * 128) & (SEQ - 1)) != 0;
            const float* hb = halo + (size_t)B * 6 * 1024 + c;
            const float c6 = hist ? hb[-6 * 1024] : 0.f, c7 = hist ? hb[-5 * 1024] : 0.f, c0 = hb[2 * 1024], c1 = hb[3 * 1024], b0 = hb[4 * 1024], b1 = hb[5 * 1024];
            const float w0 = cw[c], w1 = cw[1024 + c], w2 = cw[2048 + c];
            const float y0 = b0 * (w0 * c6 + w1 * c7 + w2 * c0), y1 = b1 * (w0 * c7 + w1 * c0 + w2 * c1);
            Y[(size_t)(B * 128) * 2048 + c] = (bf16_t)(cvt_pk_bf16(y0, 0.f) & 0xffffu);
            Y[(size_t)(B * 128 + 1) * 2048 + c] = (bf16_t)(cvt_pk_bf16(y1, 0.f) & 0xffffu);
        }
    }
}

__device__ __forceinline__ void phase_pool(const Params& p) {
    const int tid = opaque_tid();
    const bf16_t* HQ = (const bf16_t*)(p.ws + WS_HQ); const bf16_t* HS = (const bf16_t*)(p.ws + WS_HS); bf16_t* Y = (bf16_t*)(p.ws + WS_RA);
    const int fb = opaque_bid(), lidx = (fb >> 3) * 512 + tid;
    if (lidx < 16 * 256) {
        const int B = (fb & 7) * 16 + (lidx >> 8), ct = lidx & 255, c0 = ct * 8, win = 2 << (ct >> 6); const bool hist = ((B * 128) & (SEQ - 1)) != 0;
        const bf16_t* tail = HQ + (size_t)(B - 1) * 32 * 2048 + c0;
        const bf16_t* head = HQ + ((size_t)B * 32 + 16) * 2048 + c0;
        const bf16_t* hs = HS + (size_t)B * 16 * 2048 + c0;
        float S[8];
#pragma unroll
        for (int e = 0; e < 8; ++e) S[e] = 0.f;
        if (hist) {
#pragma unroll
            for (int i = 1; i < 16; ++i) {
                if (i < win) { float v[8]; unpack8(*(const u32x4*)(tail + (size_t)(16 - i) * 2048), v);
#pragma unroll
                    for (int e = 0; e < 8; ++e) S[e] += v[e]; }
            }
        }
#pragma unroll 4
        for (int r = 0; r < 16; ++r) {
            float cur[8], sz[8], o[8];
            unpack8(*(const u32x4*)(head + (size_t)r * 2048), cur);
            unpack8(*(const u32x4*)(hs + (size_t)r * 2048), sz);
            const float inv = 1.f / (float)(hist ? win : min(r + 1, win));
#pragma unroll
            for (int e = 0; e < 8; ++e) { S[e] += cur[e]; o[e] = (S[e] * inv - cur[e]) * sz[e]; }
            u32x4 w; w.x = cvt_pk_bf16(o[0], o[1]); w.y = cvt_pk_bf16(o[2], o[3]); w.z = cvt_pk_bf16(o[4], o[5]); w.w = cvt_pk_bf16(o[6], o[7]);
            *(u32x4*)(Y + (size_t)(B * 128 + r) * 2048 + c0) = w;
            const int ro = r - win + 1;
            if (ro >= 0 || hist) { float old[8]; unpack8(*(const u32x4*)(ro >= 0 ? head + (size_t)ro * 2048 : tail + (size_t)(16 + ro) * 2048), old);
#pragma unroll
                for (int e = 0; e < 8; ++e) S[e] -= old[e]; }
        }
    }
}

#define XB_TMO      128
#define XB_XCNT(j)  (256  + 64 * (j))
#define XB_XSUB(j)  (1280 + 64 * (j))
#define XB_XGEN(j)  (2304 + 64 * (j))
#define XB_TOP      3328
#define XB_TOPGEN   3392
#define XCD_BAR_WORDS 3456
#define XB_SPIN_CAP (1u << 18)
__device__ __forceinline__ unsigned xb_ld(unsigned* p)              { return __hip_atomic_load(p, __ATOMIC_RELAXED, __HIP_MEMORY_SCOPE_AGENT); }
__device__ __forceinline__ unsigned xb_add(unsigned* p, unsigned v) { return __hip_atomic_fetch_add(p, v, __ATOMIC_RELAXED, __HIP_MEMORY_SCOPE_AGENT); }
__device__ __forceinline__ unsigned xb_xcc_id() { return (unsigned)__builtin_amdgcn_s_getreg((3 << 11) | 20) & 0xFu; }
#define XB_SPIN(cond, bar) do { unsigned _sp = 0; while (cond) { __builtin_amdgcn_s_sleep(1); \
    if ((++_sp & 255u) == 0u) { if (xb_ld(&(bar)[XB_TMO])) break; if (_sp > XB_SPIN_CAP) { atomicAdd(&(bar)[XB_TMO], 1u); break; } } } } while (0)
struct XcdBarrier { unsigned* bar; unsigned x; volatile LAS unsigned* st; };
__device__ __forceinline__ XcdBarrier xcd_barrier_post(unsigned* bar, volatile LAS unsigned* st) {
    XcdBarrier b; b.bar = bar; b.x = xb_xcc_id(); b.st = st;
    if (threadIdx.x == 0) (void)xb_add(&bar[XB_XCNT(b.x)], 1u);
    return b;
}
__device__ __forceinline__ void xcd_barrier_complete(unsigned* bar, unsigned x, unsigned& nloc, unsigned& nx) {
    const unsigned G = gridDim.x * gridDim.y * gridDim.z;
    unsigned sum, cnt, mine, sp = 0u;
    for (;;) {
        sum = 0u; cnt = 0u; mine = 0u;
#pragma unroll
        for (unsigned j = 0; j < 16; ++j) { const unsigned c = xb_ld(&bar[XB_XCNT(j)]); sum += c; cnt += (c > 0u) ? 1u : 0u; mine = (j == x) ? c : mine; }
        if (sum == G) break;
        __builtin_amdgcn_s_sleep(1);
        if ((++sp & 255u) == 0u) { if (xb_ld(&bar[XB_TMO])) break; if (sp > XB_SPIN_CAP) { atomicAdd(&bar[XB_TMO], 1u); break; } }
    }
    nloc = mine > 0u ? mine : 1u; nx = cnt > 0u ? cnt : 1u;
}
__device__ __forceinline__ void xcd_barrier(const XcdBarrier& b) {
    asm volatile("s_waitcnt vmcnt(0)" ::: "memory");
    __syncthreads();
    if (threadIdx.x == 0) {
        unsigned* bar = b.bar;
        __builtin_amdgcn_s_waitcnt(0);
        unsigned nloc = b.st[0], nx = b.st[1];
        if (nloc == 0u) { xcd_barrier_complete(bar, b.x, nloc, nx); b.st[0] = nloc; b.st[1] = nx; }
        const unsigned old = xb_add(&bar[XB_XSUB(b.x)], 1u);
        const unsigned gen = old / nloc;
        if (old + 1u == (gen + 1u) * nloc) {
            __builtin_amdgcn_fence(__ATOMIC_RELEASE, "agent");
            asm volatile("s_waitcnt vmcnt(0)" ::: "memory");
            const unsigned og = xb_add(&bar[XB_TOP], 1u);
            const unsigned tg = og / nx;
            if (og + 1u == (tg + 1u) * nx) xb_add(&bar[XB_TOPGEN], 1u);
            else XB_SPIN(xb_ld(&bar[XB_TOPGEN]) == tg, bar);
            __builtin_amdgcn_fence(__ATOMIC_ACQUIRE, "agent");
            xb_add(&bar[XB_XGEN(b.x)], 1u);
            asm volatile("s_waitcnt vmcnt(0)" ::: "memory");
        } else {
            XB_SPIN(xb_ld(&bar[XB_XGEN(b.x)]) == gen, bar);
            __builtin_amdgcn_fence(__ATOMIC_ACQUIRE, "agent");
            asm volatile("s_waitcnt vmcnt(0)" ::: "memory");
        }
    }
    __syncthreads();
}

__device__ __forceinline__ void local_barrier(unsigned* ctr, unsigned target, unsigned* tmo) {
    asm volatile("s_waitcnt vmcnt(0)" ::: "memory");
    __syncthreads();
    if (threadIdx.x == 0) {
        __builtin_amdgcn_s_waitcnt(0);
        (void)xb_add(ctr, 1u);
        __builtin_amdgcn_fence(__ATOMIC_ACQUIRE, "agent");
        unsigned sp = 0;
        while (xb_ld(ctr) < target) { __builtin_amdgcn_s_sleep(1); if (++sp > (1u << 22)) { atomicAdd(tmo, 1u); break; } }
        asm volatile("s_waitcnt vmcnt(0)" ::: "memory");
    }
    __syncthreads();
}

__global__ void __launch_bounds__(512, 2) mega_fwd(Params p, int ph_lo, int ph_hi) {
    extern __shared__ __attribute__((aligned(16))) unsigned char smem[];
    LAS unsigned char* lds = (LAS unsigned char*)smem;
    cg::grid_group grid = cg::this_grid();
    if (ph_hi < 0) grid.sync();
    volatile LAS unsigned* st = (volatile LAS unsigned*)(lds + STAGE_BYTES);
    if (threadIdx.x < 4) st[threadIdx.x] = 0u;
    __syncthreads();
    const XcdBarrier xb = xcd_barrier_post((unsigned*)(p.ws + WS_BAR), st);
    unsigned* ctl = (unsigned*)(p.ws + WS_BAR);
    if (threadIdx.x == 0) __hip_atomic_store(ctl + TAB_WORD0 + blockIdx.x, xb.x + 1u, __ATOMIC_RELAXED, __HIP_MEMORY_SCOPE_AGENT);
    unsigned* lctr = ctl + LOC_WORD0 + 64 * (blockIdx.x & 7);
    int ph = 0, fast = 0; unsigned lgen = 0;
#define PHASE(LOCAL, ...) do { if (ph >= ph_lo && ph < ph_hi) { __VA_ARGS__; if (ph + 1 < ph_hi) { if ((LOCAL) && fast) { ++lgen; local_barrier(lctr, 32u * lgen, ctl + XB_TMO); } else xcd_barrier(xb); } } ++ph; } while (0)
    bf16_t* RA = (bf16_t*)(p.ws + WS_RA); bf16_t* RP = (bf16_t*)(p.ws + WS_RP);
    const bf16_t* WIN_E = (const bf16_t*)(p.ws + WS_WIN_E); const bf16_t* WIN_O = (const bf16_t*)(p.ws + WS_WIN_O);
    const bf16_t* WOUT_E = (const bf16_t*)(p.ws + WS_WOUT_E); const bf16_t* WOUT_O = (const bf16_t*)(p.ws + WS_WOUT_O);
    const float* mod = (const float*)(p.ws + WS_MOD);
    float* part = (float*)(p.ws + WS_PART); unsigned* cnt = (unsigned*)(p.ws + WS_BAR) + CNT_WORD0;
    PHASE(0, { phase_mod(p, lds); phase_norm_even(p, 0, nullptr, lds, 1, 0, 49152, 64); });
    {
        int ok = 1;
        if (threadIdx.x < 256) { const unsigned a = xb_ld(ctl + TAB_WORD0 + threadIdx.x), r = xb_ld(ctl + TAB_WORD0 + (threadIdx.x & 7)); ok = (a == r && a != 0u) ? 1 : 0; }
        fast = __syncthreads_and(ok) && gridDim.x == 256;
    }
#pragma unroll 1
    for (int lp = 0; lp < 2; ++lp) {
        {
            const int layer = 2 * lp; const float* xin = (lp == 0) ? p.x : p.out;
            PHASE(0, { if (blockIdx.x < 32) product_units(p, lds); phase_norm_even(p, lp, xin, lds, 2, 32, 0, 0, lp == 0 ? 156 : 28); });
            PHASE(1, { Gemm g{(const bf16_t*)g_h, WIN_E, DM, DM, DM, MTOK / BM, 7168 / BM, 0}; EpiEven E{RP, RA, (float*)(p.ws + WS_HALO), p.ab_conv_w + (size_t)lp * 3 * 1024}; gemm_phase(lds, g, E); });
            PHASE(1, phase_mix(p, lp, lds));
            PHASE(1, { Gemm g{RA, WOUT_E, 2048, 2048, 2048, MTOK / BM, DM / BM, 0};
                       EpiResNorm E{lp == 0 ? p.x : nullptr, (const bf16_t*)g_x, (bf16_t*)g_x, p.out, mod + (size_t)layer * NB * 3072 + 2048, (bf16_t*)g_h, p.norm_g + (size_t)(layer + 1) * DM, mod + (size_t)(layer + 1) * NB * 3072,
                                    part + (size_t)layer * 4 * MTOK, cnt + layer * 64, 0};
                       gemm_phase(lds, g, E); });
        }
        {
            const int layer = 2 * lp + 1; const int last = (lp == 1) ? 1 : 0;
            PHASE(1, { Gemm g{(const bf16_t*)g_h, WIN_O, DM, DM, DM, MTOK / BM, 4096 / BM, 0}; EpiOdd E{RA, (bf16_t*)(p.ws + WS_HQ), (bf16_t*)(p.ws + WS_HS), p.c_pool_scale + (size_t)lp * 2048}; gemm_phase(lds, g, E); });
            PHASE(1, { phase_pool(p); if (lp == 0) phase_norm_even(p, 1, nullptr, lds, 1, 0, 0, 0); });
            PHASE(0, { Gemm g{RA, WOUT_O, 2048, 2048, 2048, MTOK / BM, DM / BM, 0};
                       EpiResNorm E{nullptr, (const bf16_t*)g_x, (bf16_t*)g_x, p.out, mod + (size_t)layer * NB * 3072 + 2048, (bf16_t*)g_h, last ? p.final_g : p.norm_g + (size_t)(layer + 1) * DM, mod + (size_t)(last ? layer : layer + 1) * NB * 3072,
                                    part + (size_t)layer * 4 * MTOK, cnt + layer * 64, last};
                       gemm_phase(lds, g, E); });
        }
    }
#undef PHASE
}

extern "C" void kernel_launch(void* const* d_in, const int* in_sizes, int n_in, void* d_out, int out_size, void* d_ws, size_t ws_size, hipStream_t stream) {
    static int grid = 0;
    if (grid == 0) {
        if (n_in != 17 || out_size != MTOK * DM || ws_size < WS_END2) { fprintf(stderr, "kernel_launch: unexpected shapes (n_in %d out %d ws %zu need %zu)\n", n_in, out_size, ws_size, (size_t)WS_END2); grid = -1; return; }
        int dev = 0, cus = 0, per_cu = 0;
        hipGetDevice(&dev);
        hipDeviceGetAttribute(&cus, hipDeviceAttributeMultiprocessorCount, dev);
        if (hipFuncSetAttribute((const void*)mega_fwd, hipFuncAttributeMaxDynamicSharedMemorySize, LDS_BYTES) != hipSuccess) { fprintf(stderr, "kernel_launch: hipFuncSetAttribute failed\n"); grid = -1; return; }
        hipOccupancyMaxActiveBlocksPerMultiprocessor(&per_cu, (const void*)mega_fwd, 512, LDS_BYTES);
        if (per_cu < 1) { fprintf(stderr, "kernel_launch: occupancy query says %d blocks per CU\n", per_cu); per_cu = 1; }
        (void)hipGetLastError();
        grid = cus;
        if (grid != 256) { fprintf(stderr, "kernel_launch: built for 256 CUs (one out-projection tile per workgroup), got %d\n", grid); grid = -1; return; }
    }
    if (grid < 0) return;
    Params p{};
    p.x = (const float*)d_in[0]; p.c = (const float*)d_in[1]; p.norm_g = (const float*)d_in[2]; p.ada_w = (const float*)d_in[3]; p.ada_b = (const float*)d_in[4];
    p.ab_w_in = (const float*)d_in[5]; p.ab_conv_w = (const float*)d_in[6]; p.ab_ln_g = (const float*)d_in[7]; p.ab_ln_b = (const float*)d_in[8];
    p.ab_sgu_w = (const float*)d_in[9]; p.ab_sgu_b = (const float*)d_in[10]; p.ab_w_out = (const float*)d_in[11];
    p.c_w_in = (const float*)d_in[12]; p.c_pool_w = (const float*)d_in[13]; p.c_pool_scale = (const float*)d_in[14]; p.c_w_out = (const float*)d_in[15]; p.final_g = (const float*)d_in[16];
    p.out = (float*)d_out; p.ws = (unsigned char*)d_ws;
    if (hipMemsetAsync((unsigned char*)d_ws + WS_BAR, 0, CTL_WORDS * 4, stream) != hipSuccess) { fprintf(stderr, "kernel_launch: barrier memset failed\n"); return; }
    int lo = 0, hi = 15;
    void* args[] = {&p, &lo, &hi};
    hipError_t e = hipLaunchCooperativeKernel((const void*)mega_fwd, dim3(grid), dim3(512), args, LDS_BYTES, stream);
    if (e != hipSuccess) fprintf(stderr, "kernel_launch: cooperative launch failed: %s (grid %d)\n", hipGetErrorString(e), grid);
}
```

```cpp
#include <hip/hip_runtime.h>
#include <hip/hip_cooperative_groups.h>
#include <cstdio>
namespace cg = cooperative_groups;

#define LAS __attribute__((address_space(3)))
typedef unsigned short bf16_t;
typedef short bf16x8 __attribute__((ext_vector_type(8)));
typedef float f32x4 __attribute__((ext_vector_type(4)));
typedef unsigned u32x4 __attribute__((ext_vector_type(4)));
typedef unsigned u32x2 __attribute__((ext_vector_type(2)));

constexpr int DM = 1024, NB = 8, SEQ = 2048, MTOK = NB * SEQ;
constexpr int BM = 256, BK = 64, HALF = 128, HTB = HALF * BK * 2, STAGE_BYTES = 8 * HTB, NXCD = 8, WGM = 8;
constexpr int LDS_BYTES = STAGE_BYTES + 8192;
constexpr float EPS = 1e-6f;
constexpr int REP_G1 = 1, REP_THIN = 1, REP_G2L0 = 1;

constexpr size_t WS_MOD = 0;
constexpr size_t WS_BAR = 393216;
constexpr size_t WS_WIN_E = 524288;
constexpr size_t WS_WIN_O = WS_WIN_E + (size_t)7168 * 1024 * 2;
constexpr size_t WS_WOUT_E = WS_WIN_O + (size_t)4096 * 1024 * 2;
constexpr size_t WS_WOUT_O = WS_WOUT_E + (size_t)1024 * 2048 * 2;
constexpr size_t WS_SGU = WS_WOUT_O + (size_t)1024 * 2048 * 2;
constexpr size_t WS_POOLT = WS_SGU + (size_t)8 * 128 * 128 * 2;
constexpr size_t WS_WINP = WS_POOLT + (size_t)4 * 512 * 512 * 2;
constexpr size_t WS_RA = WS_WINP + (size_t)1024 * 2048 * 2;
constexpr size_t WS_RP = WS_RA + (size_t)MTOK * 2048 * 2;
constexpr size_t WS_END = WS_RP + (size_t)MTOK * 4096 * 2;

constexpr size_t WS_PART = WS_END;
constexpr size_t WS_HALO = WS_PART + (size_t)4 * 4 * MTOK * 4;
constexpr size_t WS_END2 = WS_HALO + (size_t)128 * 6 * 1024 * 4;
constexpr size_t WS_HQ = WS_RP;
constexpr size_t WS_HS = WS_HQ + (size_t)128 * 32 * 2048 * 2;
constexpr int CNT_WORD0 = 3584;
constexpr int LOC_WORD0 = CNT_WORD0 + 256;
constexpr int TAB_WORD0 = LOC_WORD0 + 512;
constexpr int CTL_WORDS = TAB_WORD0 + 256;
constexpr int XLD = 2048;
__device__ unsigned short g_x[(size_t)MTOK * XLD];
__device__ unsigned short g_h[(size_t)MTOK * DM];

constexpr size_t WS_W1 = WS_HS + (size_t)128 * 16 * 2048 * 2;
static_assert(WS_W1 + (WS_RA - WS_WIN_E) <= WS_RP + (size_t)2 * MTOK * 1024 * 2, "pair 1 weight images must fit in front of the UZ / V slabs");
__host__ __device__ __forceinline__ size_t wofs(int j) { return (size_t)j * (size_t)(WS_W1 - WS_WIN_E); }

struct Params {
    const float *x, *c, *norm_g, *ada_w, *ada_b, *ab_w_in, *ab_conv_w, *ab_ln_g, *ab_ln_b, *ab_sgu_w, *ab_sgu_b, *ab_w_out,
        *c_w_in, *c_pool_w, *c_pool_scale, *c_w_out, *final_g;
    float* out;
    unsigned char* ws;
};

__host__ __device__ __forceinline__ int lds_byte(int r, int c) { const int st = (r >> 4) * 2 + (c >> 5), rr = r & 15, cc = c & 31, ob = rr * 64 + cc * 2; return st * 1024 + (ob ^ (((ob >> 9) & 1) << 5)); }
__host__ __device__ __forceinline__ void stage_rc(int b, int& R, int& C) { const int st = b / 1024, sb = b % 1024, swz = sb ^ (((sb >> 9) & 1) << 5); R = (st >> 1) * 16 + swz / 64; C = (st & 1) * 32 + (swz % 64) / 2; }
__host__ __device__ __forceinline__ int perm32(int rho) { const int n = rho >> 4, i = rho & 15; return 8 * (i >> 2) + 4 * n + (i & 3); }
__device__ __forceinline__ unsigned cvt_pk_bf16(float lo, float hi) { unsigned r; asm volatile("v_cvt_pk_bf16_f32 %0, %1, %2" : "=v"(r) : "v"(lo), "v"(hi)); return r; }
__device__ __forceinline__ float bf_lo(unsigned w) { return __uint_as_float(w << 16); }
__device__ __forceinline__ float bf_hi(unsigned w) { return __uint_as_float(w & 0xffff0000u); }
__device__ __forceinline__ float silu_f(float v) { return v * __builtin_amdgcn_rcpf(1.f + __expf(-v)); }
__device__ __forceinline__ float wave_sum(float v) {
#pragma unroll
    for (int o = 1; o < 64; o <<= 1) v += __shfl_xor(v, o);
    return v;
}

__device__ __forceinline__ int opaque_tid() { int t = threadIdx.x; asm volatile("" : "+v"(t)); return t; }
__device__ __forceinline__ int opaque_bid() { int b = blockIdx.x; asm volatile("" : "+s"(b)); return b; }
struct Unit { int pm, pn; };
struct Gemm { const bf16_t* A; const bf16_t* Bt; int lda, ldb, K, nM, nN, bk; };

__device__ __forceinline__ bool next_unit(const Gemm& g, int bid, int i, Unit& u) {
    const int nwg = g.nM * g.nN;
    if ((long)i * gridDim.x + bid >= nwg) return false;
    const int nr = nwg / (int)gridDim.x;
    const int ir = (nr > 1 && nr * (int)gridDim.x == nwg) ? (i + (bid & 7)) % nr : i;
    const long L = (long)ir * gridDim.x + bid;
    int wgid = (int)L; { const int q = nwg / NXCD, r = nwg % NXCD, xcd = wgid % NXCD, off = wgid / NXCD; wgid = (xcd < r ? xcd * (q + 1) : r * (q + 1) + (xcd - r) * q) + off; }
    const int nig = WGM * g.nN, gid = wgid / nig, fm = gid * WGM, gsz = (g.nM - fm) < WGM ? (g.nM - fm) : WGM;
    u.pm = fm + ((wgid % nig) % gsz); u.pn = (wgid % nig) / gsz; return true;
}

struct EpiEven {
    static constexpr bool PERM = true, AFTER_DRAIN = false, PERMA = true;
    bf16_t* P; bf16_t* Y; float* halo; const float* cw;
    __device__ __forceinline__ void operator()(const f32x4 (&acc)[2][2][4][2], const Unit& u, int wr, int wc, int fr, int fq) const {
        const int tok0 = u.pm * BM + 8 * (wr * 16 + fr), T = u.pn;
        if (T < 16) {
            const int ch = T * 64 + 16 * wc + 4 * fq;
            const f32x4 w0 = *(const f32x4*)(cw + ch), w1 = *(const f32x4*)(cw + 1024 + ch), w2 = *(const f32x4*)(cw + 2048 + ch);
            f32x4 c[8], pm1, pm2;
#pragma unroll
            for (int i = 0; i < 8; ++i) c[i] = acc[i >> 2][0][i & 3][0] * acc[i >> 2][0][i & 3][1];
#pragma unroll
            for (int j = 0; j < 4; ++j) {
                pm1[j] = __int_as_float(__builtin_amdgcn_update_dpp(0, __float_as_int(c[7][j]), 0x111, 0xf, 0xf, true));
                pm2[j] = __int_as_float(__builtin_amdgcn_update_dpp(0, __float_as_int(c[6][j]), 0x111, 0xf, 0xf, true));
            }
            float* hb = halo + (size_t)(u.pm * 2 + wr) * 6 * 1024 + ch;
            if (fr == 15) { *(f32x4*)(hb) = c[6]; *(f32x4*)(hb + 1024) = c[7]; }
            bf16_t* yp = Y + (size_t)tok0 * 2048 + ch;
#pragma unroll
            for (int i = 0; i < 8; ++i) {
                f32x4 bz = acc[i >> 2][1][i & 3][0]; const f32x4 z = acc[i >> 2][1][i & 3][1];
#pragma unroll
                for (int j = 0; j < 4; ++j) bz[j] *= silu_f(z[j]);
                const f32x4 cm1 = (i >= 1) ? c[i >= 1 ? i - 1 : 0] : pm1, cm2 = (i >= 2) ? c[i >= 2 ? i - 2 : 0] : (i == 1 ? pm1 : pm2);
                const f32x4 y = bz * (w0 * ((i == 1) ? pm1 : cm2) + w1 * cm1 + w2 * c[i]);
                if (i < 2 && fr == 0) { *(f32x4*)(hb + (2 + i) * 1024) = c[i]; *(f32x4*)(hb + (4 + i) * 1024) = bz; }
                else { u32x2 w; w.x = cvt_pk_bf16(y[0], y[1]); w.y = cvt_pk_bf16(y[2], y[3]); *(u32x2*)(yp + (size_t)i * 2048) = w; }
            }
        } else if (T < 24) {
            bf16_t* base = P + (size_t)2 * MTOK * 1024 + (size_t)tok0 * 1024 + (T - 16) * 128 + wc * 32 + 8 * fq;
#pragma unroll
            for (int i = 0; i < 8; ++i) {
                f32x4 x0 = acc[i >> 2][0][i & 3][0], x1 = acc[i >> 2][0][i & 3][1]; const f32x4 y0 = acc[i >> 2][1][i & 3][0], y1 = acc[i >> 2][1][i & 3][1];
#pragma unroll
                for (int j = 0; j < 4; ++j) { x0[j] *= silu_f(y0[j]); x1[j] *= silu_f(y1[j]); }
                u32x4 w; w.x = cvt_pk_bf16(x0[0], x0[1]); w.y = cvt_pk_bf16(x0[2], x0[3]); w.z = cvt_pk_bf16(x1[0], x1[1]); w.w = cvt_pk_bf16(x1[2], x1[3]);
                *(u32x4*)(base + (size_t)i * 1024) = w;
            }
        } else {
            bf16_t* base = P + (size_t)3 * MTOK * 1024 + (size_t)tok0 * 1024 + (T - 24) * 256 + wc * 32 + 8 * fq;
#pragma unroll
            for (int i = 0; i < 8; ++i)
#pragma unroll
                for (int bj = 0; bj < 2; ++bj) {
                    const f32x4 v0 = acc[i >> 2][bj][i & 3][0], v1 = acc[i >> 2][bj][i & 3][1];
                    u32x4 w; w.x = cvt_pk_bf16(v0[0], v0[1]); w.y = cvt_pk_bf16(v0[2], v0[3]); w.z = cvt_pk_bf16(v1[0], v1[1]); w.w = cvt_pk_bf16(v1[2], v1[3]);
                    *(u32x4*)(base + (size_t)i * 1024 + bj * HALF) = w;
                }
        }
    }
};
template <int WIN> __device__ __forceinline__ void pool_quad(const f32x4 (&acc)[2][2][4][2], int n, const f32x4 ps, unsigned (&yq)[8][2], unsigned (&qq)[8][2], unsigned (&sq)[8][2]) {
    float y[8][4], szv[8][4];
#pragma unroll
    for (int j = 0; j < 4; ++j) {
        float h[23], PS[24];
#pragma unroll
        for (int k = 0; k < 8; ++k) h[15 + k] = acc[k >> 2][0][k & 3][n][j];
#pragma unroll
        for (int k = 0; k < 8; ++k) h[7 + k] = __int_as_float(__builtin_amdgcn_update_dpp(0, __float_as_int(h[15 + k]), 0x111, 0xf, 0xf, true));
#pragma unroll
        for (int k = 1; k < 8; ++k) h[k - 1] = __int_as_float(__builtin_amdgcn_update_dpp(0, __float_as_int(h[15 + k]), 0x112, 0xf, 0xf, true));
        constexpr int LO = 16 - WIN;
#pragma unroll
        for (int x = 0; x <= LO; ++x) PS[x] = 0.f;
#pragma unroll
        for (int x = LO; x < 23; ++x) PS[x + 1] = PS[x] + h[x];
#pragma unroll
        for (int i = 0; i < 8; ++i) {
            const float w = PS[16 + i] - PS[16 + i - WIN];
            const float z = acc[i >> 2][1][i & 3][n][j];
            szv[i][j] = silu_f(z) * ps[j];
            y[i][j] = (w * (1.f / WIN) - h[15 + i]) * szv[i][j];
        }
    }
#pragma unroll
    for (int i = 0; i < 8; ++i) {
        yq[i][0] = cvt_pk_bf16(y[i][0], y[i][1]); yq[i][1] = cvt_pk_bf16(y[i][2], y[i][3]);
        qq[i][0] = cvt_pk_bf16(acc[i >> 2][0][i & 3][n][0], acc[i >> 2][0][i & 3][n][1]); qq[i][1] = cvt_pk_bf16(acc[i >> 2][0][i & 3][n][2], acc[i >> 2][0][i & 3][n][3]);
        sq[i][0] = cvt_pk_bf16(szv[i][0], szv[i][1]); sq[i][1] = cvt_pk_bf16(szv[i][2], szv[i][3]);
    }
}
struct EpiOdd {
    static constexpr bool PERM = true, AFTER_DRAIN = false, PERMA = true;
    bf16_t* Y; bf16_t* HQ; bf16_t* HS; const float* pscale;
    __device__ __forceinline__ void operator()(const f32x4 (&acc)[2][2][4][2], const Unit& u, int wr, int wc, int fr, int fq) const {
        const int T = u.pn, g = T >> 2, B = u.pm * 2 + wr;
        const int tok0 = u.pm * BM + 8 * (wr * 16 + fr);
        const int ch = T * 128 + wc * 32 + 8 * fq;
        unsigned yq[2][8][2];
#pragma unroll
        for (int n = 0; n < 2; ++n) {
            const f32x4 ps = *(const f32x4*)(pscale + ch + 4 * n);
            unsigned qq[8][2], sq[8][2];
            if (g == 0) pool_quad<2>(acc, n, ps, yq[n], qq, sq);
            else if (g == 1) pool_quad<4>(acc, n, ps, yq[n], qq, sq);
            else if (g == 2) pool_quad<8>(acc, n, ps, yq[n], qq, sq);
            else pool_quad<16>(acc, n, ps, yq[n], qq, sq);
            if (fr >= 14) {
                bf16_t* hp = HQ + ((size_t)B * 32 + (fr - 14) * 8) * 2048 + ch + 4 * n;
#pragma unroll
                for (int i = 0; i < 8; ++i) { u32x2 w; w.x = qq[i][0]; w.y = qq[i][1]; *(u32x2*)(hp + (size_t)i * 2048) = w; }
            }
            if (fr <= 1) {
                bf16_t* hp = HQ + ((size_t)B * 32 + 16 + fr * 8) * 2048 + ch + 4 * n; bf16_t* sp = HS + ((size_t)B * 16 + fr * 8) * 2048 + ch + 4 * n;
#pragma unroll
                for (int i = 0; i < 8; ++i) { u32x2 w; w.x = qq[i][0]; w.y = qq[i][1]; *(u32x2*)(hp + (size_t)i * 2048) = w; u32x2 v; v.x = sq[i][0]; v.y = sq[i][1]; *(u32x2*)(sp + (size_t)i * 2048) = v; }
            }
        }
        bf16_t* yp = Y + (size_t)tok0 * 2048 + ch;
#pragma unroll
        for (int i = 0; i < 8; ++i) { u32x4 w; w.x = yq[0][i][0]; w.y = yq[0][i][1]; w.z = yq[1][i][0]; w.w = yq[1][i][1]; *(u32x4*)(yp + (size_t)i * 2048) = w; }
    }
};
struct EpiProd {
    static constexpr bool PERM = true, AFTER_DRAIN = false, PERMA = false;
    bf16_t* O;
    __device__ __forceinline__ void operator()(const f32x4 (&acc)[2][2][4][2], const Unit& u, int wr, int wc, int fr, int fq) const {
        const int col0 = u.pn * BM + wc * 32 + 8 * fq;
#pragma unroll
        for (int ai = 0; ai < 2; ++ai)
#pragma unroll
            for (int m = 0; m < 4; ++m) {
                bf16_t* rowp = O + (size_t)((u.pm * 2 + ai) * 256 + wr * 64 + m * 16 + fr) * DM + col0;
#pragma unroll
                for (int bj = 0; bj < 2; ++bj) {
                    const f32x4 v0 = acc[ai][bj][m][0], v1 = acc[ai][bj][m][1];
                    u32x4 w; w.x = cvt_pk_bf16(v0[0], v0[1]); w.y = cvt_pk_bf16(v0[2], v0[3]); w.z = cvt_pk_bf16(v1[0], v1[1]); w.w = cvt_pk_bf16(v1[2], v1[3]);
                    *(u32x4*)(rowp + bj * HALF) = w;
                }
            }
    }
};
struct EpiBf {
    static constexpr bool PERM = true, AFTER_DRAIN = false, PERMA = false;
    bf16_t* O; int ld;
    __device__ __forceinline__ void operator()(const f32x4 (&acc)[2][2][4][2], const Unit& u, int wr, int wc, int fr, int fq) const {
        const int row0 = u.pm * BM + wr * 64 + fr, col0 = u.pn * BM + wc * 32 + 8 * fq;
#pragma unroll
        for (int ai = 0; ai < 2; ++ai)
#pragma unroll
            for (int m = 0; m < 4; ++m) {
                bf16_t* rowp = O + (size_t)(row0 + ai * HALF + m * 16) * ld + col0;
#pragma unroll
                for (int bj = 0; bj < 2; ++bj) {
                    const f32x4 v0 = acc[ai][bj][m][0], v1 = acc[ai][bj][m][1];
                    u32x4 w; w.x = cvt_pk_bf16(v0[0], v0[1]); w.y = cvt_pk_bf16(v0[2], v0[3]); w.z = cvt_pk_bf16(v1[0], v1[1]); w.w = cvt_pk_bf16(v1[2], v1[3]);
                    *(u32x4*)(rowp + bj * HALF) = w;
                }
            }
    }
};
struct EpiRes {
    static constexpr bool PERM = false, AFTER_DRAIN = false, PERMA = false;
    const float* xin; float* xout; const float* gate;
    __device__ __forceinline__ void operator()(const f32x4 (&acc)[2][2][4][2], const Unit& u, int wr, int wc, int fr, int fq) const {
        const int row0 = u.pm * BM + wr * 64 + fr, col0 = u.pn * BM + wc * 32 + 4 * fq;
        const float* gp = gate + (size_t)(u.pm >> 3) * 3072 + col0;
        f32x4 gv[2][2];
#pragma unroll
        for (int bj = 0; bj < 2; ++bj)
#pragma unroll
            for (int n = 0; n < 2; ++n) gv[bj][n] = *(const f32x4*)(gp + bj * HALF + n * 16);
#pragma unroll
        for (int ai = 0; ai < 2; ++ai)
#pragma unroll
            for (int m = 0; m < 4; ++m) {
                const size_t ro = (size_t)(row0 + ai * HALF + m * 16) * DM + col0;
#pragma unroll
                for (int bj = 0; bj < 2; ++bj)
#pragma unroll
                    for (int n = 0; n < 2; ++n) {
                        const f32x4 xv = *(const f32x4*)(xin + ro + bj * HALF + n * 16);
                        *(f32x4*)(xout + ro + bj * HALF + n * 16) = xv + gv[bj][n] * acc[ai][bj][m][n];
                    }
            }
    }
};

struct EpiResNorm {
    static constexpr bool PERM = true, AFTER_DRAIN = true, PERMA = false;
    __device__ __forceinline__ bool xpre() const { return xin32 == nullptr; }
    const float* xin32; const bf16_t* xin16; bf16_t* xout16; float* out32; const float* gate; bf16_t* H; const float* ng; const float* modn; float* part; unsigned* cnt; int last;
    __device__ __forceinline__ void fused(f32x4 (&acc)[2][2][4][2], const Unit& u, int wr, int wc, int fr, int fq, LAS unsigned char* lds, int tid) const {
        const int row0 = u.pm * BM + wr * 64 + fr, col0 = u.pn * BM + wc * 32 + 8 * fq, b = u.pm >> 3;
        LAS float* lss = (LAS float*)(lds + STAGE_BYTES + 1024);
        LAS float* lrs = (LAS float*)(lds + STAGE_BYTES + 1024 + 4096);
        {
            const float* gp = gate + (size_t)b * 3072 + col0;
            f32x4 gv[2][2];
#pragma unroll
            for (int bj = 0; bj < 2; ++bj)
#pragma unroll
                for (int n = 0; n < 2; ++n) gv[bj][n] = *(const f32x4*)(gp + bj * HALF + 4 * n);
#pragma unroll
            for (int ai = 0; ai < 2; ++ai)
#pragma unroll
                for (int m = 0; m < 4; ++m) {
                    const size_t ro = (size_t)(row0 + ai * HALF + m * 16) * DM + col0, rox = (size_t)(row0 + ai * HALF + m * 16) * XLD + col0;
                    float ss = 0.f;
#pragma unroll
                    for (int bj = 0; bj < 2; ++bj) {
                        f32x4 x0, x1;
                        if (xin32) { x0 = *(const f32x4*)(xin32 + ro + bj * HALF); x1 = *(const f32x4*)(xin32 + ro + bj * HALF + 4); }
                        else { u32x4 w;
                            if (ai == 1 && bj == 1 && wc >= 2) w = *(const u32x4*)(xin16 + rox + bj * HALF);
                            else {
                                const int cb = 2 * bj + (wc >> 1), slot = (cb & 1) ? (ai * 2 + (cb >> 1)) : (4 + ai * 2 + (cb >> 1));
                                w = *(const LAS u32x4*)(lds + slot * HTB + lds_byte(wr * 64 + m * 16 + fr, (wc & 1) * 32 + 8 * fq));
                            } x0 = (f32x4){bf_lo(w.x), bf_hi(w.x), bf_lo(w.y), bf_hi(w.y)}; x1 = (f32x4){bf_lo(w.z), bf_hi(w.z), bf_lo(w.w), bf_hi(w.w)}; }
                        const f32x4 v0 = x0 + gv[bj][0] * acc[ai][bj][m][0], v1 = x1 + gv[bj][1] * acc[ai][bj][m][1];
                        acc[ai][bj][m][0] = v0; acc[ai][bj][m][1] = v1;
                        ss += ((v0[0] * v0[0] + v0[1] * v0[1]) + (v0[2] * v0[2] + v0[3] * v0[3])) + ((v1[0] * v1[0] + v1[1] * v1[1]) + (v1[2] * v1[2] + v1[3] * v1[3]));
                    }
                    ss += __shfl_xor(ss, 16); ss += __shfl_xor(ss, 32);
                    if (fq == 0) lss[(ai * HALF + wr * 64 + m * 16 + fr) * 4 + wc] = ss;
                }
        }
        __syncthreads();
        if (tid < 256) {
            const float t = (lss[tid * 4] + lss[tid * 4 + 1]) + (lss[tid * 4 + 2] + lss[tid * 4 + 3]);
            __hip_atomic_store(part + (size_t)u.pn * MTOK + u.pm * BM + tid, t, __ATOMIC_RELAXED, __HIP_MEMORY_SCOPE_AGENT);
        }
        asm volatile("s_waitcnt vmcnt(0)" ::: "memory");
        __syncthreads();
        unsigned* c = cnt + u.pm;
        if (tid == 0) __hip_atomic_fetch_add(c, 1u, __ATOMIC_RELAXED, __HIP_MEMORY_SCOPE_AGENT);
        if (!last) {
#pragma unroll
            for (int ai = 0; ai < 2; ++ai)
#pragma unroll
                for (int m = 0; m < 4; ++m) {
                    const size_t rox = (size_t)(row0 + ai * HALF + m * 16) * XLD + col0;
#pragma unroll
                    for (int bj = 0; bj < 2; ++bj) {
                        const f32x4 v0 = acc[ai][bj][m][0], v1 = acc[ai][bj][m][1];
                        u32x4 w; w.x = cvt_pk_bf16(v0[0], v0[1]); w.y = cvt_pk_bf16(v0[2], v0[3]); w.z = cvt_pk_bf16(v1[0], v1[1]); w.w = cvt_pk_bf16(v1[2], v1[3]);
                        *(u32x4*)(xout16 + rox + bj * HALF) = w;
                    }
                }
        }
        if (tid == 0) {
            unsigned spins = 0;
            while (__hip_atomic_load(c, __ATOMIC_RELAXED, __HIP_MEMORY_SCOPE_AGENT) < 4u && ++spins < (1u << 22)) __builtin_amdgcn_s_sleep(1);
            __builtin_amdgcn_fence(__ATOMIC_ACQUIRE, "agent");
            asm volatile("s_waitcnt vmcnt(0)" ::: "memory");
        }
        __syncthreads();
        if (tid < 256) {
            float t = 0.f;
#pragma unroll
            for (int q = 0; q < 4; ++q) t += __hip_atomic_load(part + (size_t)q * MTOK + u.pm * BM + tid, __ATOMIC_RELAXED, __HIP_MEMORY_SCOPE_AGENT);
            lrs[tid] = rsqrtf(t * (1.f / DM) + EPS);
        }
        __syncthreads();
        const float* mb = modn + (size_t)b * 3072;
#pragma unroll
        for (int bj = 0; bj < 2; ++bj) {
            const int c = col0 + bj * HALF;
            const f32x4 g0 = *(const f32x4*)(ng + c), g1 = *(const f32x4*)(ng + c + 4);
            f32x4 sh0 = {0.f, 0.f, 0.f, 0.f}, sh1 = sh0, sc0 = sh0, sc1 = sh0;
            if (!last) { sh0 = *(const f32x4*)(mb + c); sh1 = *(const f32x4*)(mb + c + 4); sc0 = *(const f32x4*)(mb + 1024 + c); sc1 = *(const f32x4*)(mb + 1024 + c + 4); }
            const f32x4 a0 = g0 * (sc0 + 1.f), a1 = g1 * (sc1 + 1.f);
#pragma unroll
            for (int ai = 0; ai < 2; ++ai)
#pragma unroll
                for (int m = 0; m < 4; ++m) {
                    const int rl = ai * HALF + wr * 64 + m * 16 + fr;
                    const float rstd = lrs[rl];
                    const size_t ro = (size_t)(u.pm * BM + rl) * DM + c;
                    const f32x4 h0 = (acc[ai][bj][m][0] * rstd) * a0 + sh0, h1 = (acc[ai][bj][m][1] * rstd) * a1 + sh1;
                    if (last) { *(f32x4*)(out32 + ro) = h0; *(f32x4*)(out32 + ro + 4) = h1; }
                    else { u32x4 w; w.x = cvt_pk_bf16(h0[0], h0[1]); w.y = cvt_pk_bf16(h0[2], h0[3]); w.z = cvt_pk_bf16(h1[0], h1[1]); w.w = cvt_pk_bf16(h1[2], h1[3]); *(u32x4*)(H + ro) = w; }
                }
        }
    }
};

template <class Epi>
__device__ __forceinline__ void gemm_phase(LAS unsigned char* lds, const Gemm g, const Epi& E) {
    const int tid = opaque_tid(), wid = __builtin_amdgcn_readfirstlane(tid >> 6), lane = tid & 63, wr = wid >> 2, wc = wid & 3, fr = lane & 15, fq = lane >> 4;
    const int nt = g.K / BK;
    unsigned voffA[2], voffB[2];
#pragma unroll
    for (int i = 0; i < 2; ++i) { int R, C; stage_rc(tid * 16 + i * 8192, R, C); const int Rb = Epi::PERM ? ((R & ~31) + perm32(R & 31)) : R;
        const int Ra = Epi::PERMA ? (8 * ((R >> 6) * 16 + (R & 15)) + ((R >> 4) & 3)) : R;
        voffA[i] = (unsigned)(Ra * g.lda + C) * 2u; voffB[i] = (unsigned)(Rb * g.ldb + C) * 2u; }
    const size_t kstep = (size_t)(BK * 2);
    const size_t hstepA = (size_t)(Epi::PERMA ? 4 : HALF) * g.lda * 2, hstepB = (size_t)HALF * g.ldb * 2, tstepA = (size_t)BM * g.lda * 2;
    const unsigned ldsw = (unsigned)wid * 1024u;
    const int aoff = lds_byte(wr * 64 + fr, fq * 8), boff = lds_byte(wc * 32 + fr, fq * 8);
#define PG8_SA(b, h) (((b) * 2 + (h)) * HTB)
#define PG8_SB(b, h) ((4 + (b) * 2 + (h)) * HTB)
#define PG8_STAGE(bufoff, gbase, voff) do { _Pragma("unroll") for (int _i = 0; _i < 2; ++_i) \
        __builtin_amdgcn_global_load_lds((const unsigned*)((const char*)(gbase) + (voff)[_i]), (LAS unsigned*)(lds + (bufoff) + ldsw + _i * 8192), 16, 0, 0); } while (0)
#define PG8_LDA(dst, b, h) do { _Pragma("unroll") for (int m = 0; m < 4; ++m) _Pragma("unroll") for (int k = 0; k < 2; ++k) dst[m][k] = *(const LAS bf16x8*)(lds + PG8_SA(b, h) + aoff + m * 2048 + k * 1024); } while (0)
#define PG8_LDB(dst, b, h) do { _Pragma("unroll") for (int n = 0; n < 2; ++n) _Pragma("unroll") for (int k = 0; k < 2; ++k) dst[n][k] = *(const LAS bf16x8*)(lds + PG8_SB(b, h) + boff + n * 2048 + k * 1024); } while (0)
#define PG8_MMA(ai, bj, At, Bt) do { __builtin_amdgcn_s_setprio(1); _Pragma("unroll") for (int m = 0; m < 4; ++m) _Pragma("unroll") for (int n = 0; n < 2; ++n) _Pragma("unroll") for (int k = 0; k < 2; ++k) \
        acc[ai][bj][m][n] = __builtin_amdgcn_mfma_f32_16x16x32_bf16(Bt[n][k], At[m][k], acc[ai][bj][m][n], 0, 0, 0); __builtin_amdgcn_s_setprio(0); } while (0)
#define PG8_WAIT_V(n) asm volatile("s_waitcnt vmcnt(" #n ")" ::: "memory")
#define PG8_WAIT_L(n) asm volatile("s_waitcnt lgkmcnt(" #n ")" ::: "memory")
#define PG8_BAR __builtin_amdgcn_s_barrier()
#define PG8_SCHED __builtin_amdgcn_sched_barrier(0)
    Unit cur, nxt; int ui = 0;
    const int bid = opaque_bid();
    if (!next_unit(g, bid, 0, cur)) return;
    f32x4 acc[2][2][4][2];
#pragma unroll
    for (int a = 0; a < 2; ++a)
#pragma unroll
        for (int b = 0; b < 2; ++b)
#pragma unroll
            for (int m = 0; m < 4; ++m)
#pragma unroll
                for (int n = 0; n < 2; ++n) acc[a][b][m][n] = (f32x4){0.f, 0.f, 0.f, 0.f};
    bf16x8 At[4][2], B0[2][2], B1[2][2];
    const char* cA = (const char*)g.A + (size_t)cur.pm * tstepA; const char* cB = (const char*)g.Bt + (size_t)cur.pn * 2 * hstepB + (size_t)(cur.pm >> 1) * g.bk * 2;
    PG8_STAGE(PG8_SB(0, 0), cB, voffB); PG8_STAGE(PG8_SA(0, 0), cA, voffA); PG8_STAGE(PG8_SB(0, 1), cB + hstepB, voffB); PG8_STAGE(PG8_SA(0, 1), cA + hstepA, voffA);
    if (wr == 1) PG8_BAR;
    PG8_WAIT_V(4); PG8_BAR;
    PG8_STAGE(PG8_SB(1, 0), cB + kstep, voffB); PG8_STAGE(PG8_SA(1, 0), cA + kstep, voffA); PG8_STAGE(PG8_SB(1, 1), cB + hstepB + kstep, voffB);
    PG8_WAIT_V(6); PG8_BAR;
    for (;;) {
        const bool has_next = next_unit(g, bid, ui + 1, nxt);
        const char* nA = has_next ? (const char*)g.A + (size_t)nxt.pm * tstepA : cA;
        const char* nB = has_next ? (const char*)g.Bt + (size_t)nxt.pn * 2 * hstepB + (size_t)(nxt.pm >> 1) * g.bk * 2 : cB;
#define PG8_ITER(S2, S3, S4, S5, S6, S7, S8) do { \
              PG8_LDB(B0, 0, 0); PG8_SCHED; PG8_LDA(At, 0, 0); PG8_STAGE(PG8_SA(1, 1), a1 + hstepA, voffA); \
            PG8_WAIT_L(8); PG8_BAR; PG8_WAIT_L(0); PG8_MMA(0, 0, At, B0); PG8_BAR; PG8_SCHED; \
              PG8_LDB(B1, 0, 1); S2; \
            PG8_BAR; PG8_WAIT_L(0); PG8_MMA(0, 1, At, B1); PG8_BAR; \
              PG8_LDA(At, 0, 1); S3; \
            PG8_BAR; PG8_WAIT_L(0); PG8_MMA(1, 0, At, B0); PG8_BAR; PG8_SCHED; \
              S4; \
            PG8_WAIT_V(6); PG8_BAR; PG8_MMA(1, 1, At, B1); PG8_BAR; \
              PG8_LDB(B0, 1, 0); PG8_SCHED; PG8_LDA(At, 1, 0); S5; \
            PG8_WAIT_L(8); PG8_BAR; PG8_WAIT_L(0); PG8_MMA(0, 0, At, B0); PG8_BAR; PG8_SCHED; \
              PG8_LDB(B1, 1, 1); S6; \
            PG8_BAR; PG8_WAIT_L(0); PG8_MMA(0, 1, At, B1); PG8_BAR; \
              PG8_LDA(At, 1, 1); S7; \
            PG8_BAR; PG8_WAIT_L(0); PG8_MMA(1, 0, At, B0); PG8_BAR; PG8_SCHED; \
              S8; \
            PG8_WAIT_V(6); PG8_BAR; PG8_MMA(1, 1, At, B1); PG8_BAR; } while (0)
        bool xpre = false;
        if constexpr (Epi::AFTER_DRAIN) xpre = !has_next && E.xpre();
        const int nt_main = xpre ? nt - 2 : nt;
        for (int t = 0; t < nt_main; t += 2) {
            const bool last = (t == nt - 2);
            const char* a1 = cA + (size_t)(t + 1) * kstep;
            const char* a2 = last ? nA : cA + (size_t)(t + 2) * kstep; const char* b2 = last ? nB : cB + (size_t)(t + 2) * kstep;
            const char* a3 = a2 + kstep; const char* b3 = b2 + kstep;
            PG8_ITER(PG8_STAGE(PG8_SB(0, 0), b2, voffB), PG8_STAGE(PG8_SA(0, 0), a2, voffA), PG8_STAGE(PG8_SB(0, 1), b2 + hstepB, voffB), PG8_STAGE(PG8_SA(0, 1), a2 + hstepA, voffA),
                     PG8_STAGE(PG8_SB(1, 0), b3, voffB), PG8_STAGE(PG8_SA(1, 0), a3, voffA), PG8_STAGE(PG8_SB(1, 1), b3 + hstepB, voffB));
        }
        if constexpr (Epi::AFTER_DRAIN) {
            if (xpre) {
                const char* a1 = cA + (size_t)(nt - 1) * kstep;
                const char* xq = (const char*)E.xin16 + ((size_t)cur.pm * BM * XLD + (size_t)cur.pn * BM) * 2;
                const size_t xh = (size_t)HALF * XLD * 2;
                PG8_ITER(PG8_STAGE(PG8_SB(0, 0), xq, voffA), PG8_STAGE(PG8_SA(0, 0), xq + 128, voffA), PG8_STAGE(PG8_SB(0, 1), xq + 256, voffA), PG8_STAGE(PG8_SA(0, 1), xq + 384, voffA),
                         PG8_STAGE(PG8_SB(1, 0), xq + xh, voffA), PG8_STAGE(PG8_SA(1, 0), xq + xh + 128, voffA), PG8_STAGE(PG8_SB(1, 1), xq + xh + 256, voffA));
            }
        }
#undef PG8_ITER
        if constexpr (!Epi::AFTER_DRAIN) E(acc, cur, wr, wc, fr, fq);
        if (!has_next) break;
#pragma unroll
        for (int a = 0; a < 2; ++a)
#pragma unroll
            for (int b = 0; b < 2; ++b)
#pragma unroll
                for (int m = 0; m < 4; ++m)
#pragma unroll
                    for (int n = 0; n < 2; ++n) acc[a][b][m][n] = (f32x4){0.f, 0.f, 0.f, 0.f};
        cur = nxt; cA = nA; cB = nB; ++ui;
    }
    PG8_WAIT_V(0);
    if (wr == 0) PG8_BAR;
    PG8_BAR;
    if constexpr (Epi::AFTER_DRAIN) E.fused(acc, cur, wr, wc, fr, fq, lds, tid);
#undef PG8_SA
#undef PG8_SB
#undef PG8_STAGE
#undef PG8_LDA
#undef PG8_LDB
#undef PG8_MMA
#undef PG8_WAIT_V
#undef PG8_WAIT_L
#undef PG8_BAR
#undef PG8_SCHED
}

__device__ __forceinline__ void phase_mod(const Params& p, LAS unsigned char* lds) {
    const int tid = opaque_tid(), wid = tid >> 6, lane = tid & 63;
    LAS float* sc = (LAS float*)lds;
    LAS float* red = (LAS float*)(lds + 32768);
    float* mod = (float*)(p.ws + WS_MOD);
    for (int t = tid; t < NB * DM; t += 512) sc[t] = silu_f(p.c[t]);
    __syncthreads();
    for (int it = opaque_bid(); it < 192; it += gridDim.x) {
        const int col = it * 64 + lane, i = col / 3072, j = col - i * 3072;
        const float* w = p.ada_w + ((size_t)i * DM + wid * 128) * 3072 + j;
        float a[8];
#pragma unroll
        for (int b = 0; b < 8; ++b) a[b] = 0.f;
#pragma unroll 32
        for (int k = 0; k < 128; ++k) {
            const float wv = w[(size_t)k * 3072];
#pragma unroll
            for (int b = 0; b < 8; ++b) a[b] += sc[b * DM + wid * 128 + k] * wv;
        }
#pragma unroll
        for (int b = 0; b < 8; ++b) red[(wid * 8 + b) * 64 + lane] = a[b];
        __syncthreads();
        {
            const int b = tid >> 6; float s = 0.f;
#pragma unroll
            for (int w8 = 0; w8 < 8; ++w8) s += red[(w8 * 8 + b) * 64 + lane];
            mod[((size_t)i * NB + b) * 3072 + j] = s + p.ada_b[i * 3072 + j];
        }
        __syncthreads();
    }
}

__device__ __forceinline__ void conv_tile(const float* __restrict__ src, int srcN, int c0, bf16_t* __restrict__ dstrow, int K, int k0, LAS float* T, int csrc = -1) {
    const int tid = opaque_tid();
    const int cs = csrc >= 0 ? csrc : c0 + (tid & 15) * 4;
    f32x4 v[8];
#pragma unroll
    for (int ps = 0; ps < 8; ++ps) v[ps] = *(const f32x4*)(src + (size_t)(k0 + ps * 32 + (tid >> 4)) * srcN + cs);
#pragma unroll
    for (int ps = 0; ps < 8; ++ps) { LAS float* t = T + (ps * 32 + (tid >> 4)) * 65 + (tid & 15) * 4; t[0] = v[ps][0]; t[1] = v[ps][1]; t[2] = v[ps][2]; t[3] = v[ps][3]; }
    __syncthreads();
#pragma unroll
    for (int q = 0; q < 4; ++q) {
        const int item = tid + 512 * q, n = item >> 5, kg = item & 31; const LAS float* s = T + (kg * 8) * 65 + n;
        u32x4 o; o.x = cvt_pk_bf16(s[0], s[65]); o.y = cvt_pk_bf16(s[130], s[195]); o.z = cvt_pk_bf16(s[260], s[325]); o.w = cvt_pk_bf16(s[390], s[455]);
        *(u32x4*)(dstrow + (size_t)n * K + k0 + kg * 8) = o;
    }
    __syncthreads();
}

__device__ __forceinline__ void norm_rows(const Params& p, int layer, const float* xin, int item) {
    const int tid = opaque_tid(), wid = tid >> 6, lane = tid & 63;
    bf16_t* H = (bf16_t*)g_h;
    const float* mod = (const float*)(p.ws + WS_MOD) + (size_t)layer * NB * 3072;
    const float* gp = p.norm_g + (size_t)layer * DM;
#pragma unroll
    for (int h2 = 0; h2 < 2; ++h2) {
        const int row = item * 16 + h2 * 8 + wid, b = row >> 11;
        const f32x4* xr = (const f32x4*)(xin + (size_t)row * DM) + lane;
        f32x4 v[4]; float ss = 0.f;
#pragma unroll
        for (int q = 0; q < 4; ++q) { v[q] = xr[64 * q]; ss += (v[q][0] * v[q][0] + v[q][1] * v[q][1]) + (v[q][2] * v[q][2] + v[q][3] * v[q][3]); }
        const float rstd = rsqrtf(wave_sum(ss) * (1.f / DM) + EPS);
        const float* mb = mod + (size_t)b * 3072;
        u32x2* o8 = (u32x2*)(H + (size_t)row * DM) + lane;
#pragma unroll
        for (int q = 0; q < 4; ++q) {
            const int k = (lane + 64 * q) * 4;
            const f32x4 gv = *(const f32x4*)(gp + k), sh = *(const f32x4*)(mb + k), scl = *(const f32x4*)(mb + 1024 + k);
            const f32x4 hv = (v[q] * rstd * gv) * (scl + 1.f) + sh;
            u32x2 w; w.x = cvt_pk_bf16(hv[0], hv[1]); w.y = cvt_pk_bf16(hv[2], hv[3]);
            o8[64 * q] = w;
        }
    }
}
struct ConvD { const float* sp; bf16_t* dst; int srcN, K, k0; };
__device__ __forceinline__ bool conv_desc(const Params& p, int j, int it, int tid, ConvD& d) {
    constexpr int N0 = 448, N1 = N0 + 128, N2 = N1 + 128, N3 = N2 + 128, N4 = N3 + 64;
    if (it >= N4) return false;
    const float* src; int srcN, cs = (tid & 15) * 4, K, k0; bf16_t* dst;
    if (it < N0) {
        const int rt = it >> 2, kt = it & 3, r0 = rt * 64, T = r0 >> 8, q = r0 & 255;
        if (T < 16) {
            const int cg = tid & 15, bj = q >> 7, wcc = ((q >> 6) & 1) * 2 + (cg >> 3), fq4 = (cg >> 1) & 3, n = cg & 1;
            const int tbase = bj == 0 ? (n == 0 ? 2048 : 0) : (n == 0 ? 1024 : 3072);
            cs = tbase + 64 * T + 16 * wcc + 4 * fq4;
        }
        else if (T < 24) cs += (q < 128) ? (4096 + 128 * (T - 16) + q) : (6144 + 128 * (T - 16) + q - 128);
        else cs += 5120 + 256 * (T - 24) + q;
        src = p.ab_w_in + (size_t)j * DM * 7168; srcN = 7168; dst = (bf16_t*)(p.ws + wofs(j) + WS_WIN_E) + (size_t)r0 * DM; K = DM; k0 = kt * 256;
    } else if (it < N1) {
        const int i2 = it - N0, rt = i2 >> 3, kt = i2 & 7, r0 = rt * 64;
        src = p.ab_w_out + (size_t)j * 2048 * DM; srcN = DM; cs += r0; dst = (bf16_t*)(p.ws + wofs(j) + WS_WOUT_E) + (size_t)r0 * 2048; K = 2048; k0 = kt * 256;
    } else if (it < N2) {
        const int i2 = it - N1, rt = i2 >> 2, kt = i2 & 3, r0 = rt * 64;
        src = p.c_w_in + (size_t)j * DM * 4096; srcN = 4096; cs += 2048 + r0; dst = (bf16_t*)(p.ws + wofs(j) + WS_WIN_O) + (size_t)((r0 >> 7) * 256 + 128 + (r0 & 127)) * DM; K = DM; k0 = kt * 256;
    } else if (it < N3) {
        const int i2 = it - N2, rt = i2 >> 3, kt = i2 & 7, r0 = rt * 64;
        src = p.c_w_out + (size_t)j * 2048 * DM; srcN = DM; cs += r0; dst = (bf16_t*)(p.ws + wofs(j) + WS_WOUT_O) + (size_t)r0 * 2048; K = 2048; k0 = kt * 256;
    } else {
        const int i3 = it - N3, g = i3 >> 4, r = i3 & 15, rt = r >> 1, kt = r & 1, r0 = rt * 64;
        src = p.c_pool_w + ((size_t)j * 4 + g) * 512 * 512; srcN = 512; cs += r0; dst = (bf16_t*)(p.ws + wofs(j) + WS_POOLT) + (size_t)g * 512 * 512 + (size_t)r0 * 512; K = 512; k0 = kt * 256;
    }
    d.sp = src + (size_t)(k0 + (tid >> 4)) * srcN + cs; d.dst = dst; d.srcN = srcN; d.K = K; d.k0 = k0;
    return true;
}
__device__ __forceinline__ void phase_norm_even(const Params& p, int j, const float* xin, LAS unsigned char* ldsb, int sel, int wg0, int ldsoff, int rot, int tail = 0) {
    const int tid = opaque_tid();
    LAS float* T = (LAS float*)(ldsb + ldsoff);
    bf16_t* SGU = (bf16_t*)(p.ws + wofs(j) + WS_SGU); bf16_t* WINP = (bf16_t*)(p.ws + wofs(j) + WS_WINP);
    constexpr int N3 = 448 + 128 + 128 + 128, N4 = N3 + 64, N5 = N4 + 32, N6 = N5 + 512;
    const int NROWS = (j == 0 ? MTOK / 16 : 0);
    const int TOTAL = sel == 1 ? 576 : sel == 2 ? 864 + NROWS : N6 + NROWS;
    const int bid = opaque_bid();
    if (bid < wg0 && tail == 0) return;
    const int stride = bid < wg0 ? wg0 : (int)gridDim.x - wg0;
    const int VEND = bid < wg0 ? TOTAL : TOTAL - tail;
#define SETUP_MAP(v) (sel == 1 ? ((v) < 64 ? N3 + (v) : N5 + ((v) - 64)) : sel == 2 ? ((v) < N3 ? (v) : (v) < 864 ? N4 + ((v) - N3) : N6 + ((v) - 864)) : (v))
    int v = bid < wg0 ? TOTAL - tail + bid : (bid - wg0 + rot) % stride;
    ConvD d; bool isc = (v < VEND) && conv_desc(p, j, SETUP_MAP(v), tid, d);
    f32x4 r[8];
    if (isc) {
#pragma unroll
        for (int ps = 0; ps < 8; ++ps) r[ps] = *(const f32x4*)(d.sp + (size_t)ps * 32 * d.srcN);
    }
    while (v < VEND) {
        const int vn = v + stride; ConvD dn; const bool iscn = (vn < VEND) && conv_desc(p, j, SETUP_MAP(vn), tid, dn);
        if (isc) {
#pragma unroll
            for (int ps = 0; ps < 8; ++ps) { LAS float* t = T + (ps * 32 + (tid >> 4)) * 65 + (tid & 15) * 4; t[0] = r[ps][0]; t[1] = r[ps][1]; t[2] = r[ps][2]; t[3] = r[ps][3]; }
            __syncthreads();
            if (iscn) {
#pragma unroll
                for (int ps = 0; ps < 8; ++ps) r[ps] = *(const f32x4*)(dn.sp + (size_t)ps * 32 * dn.srcN);
            }
#pragma unroll
            for (int q = 0; q < 4; ++q) {
                const int item = tid + 512 * q, n = item >> 5, kg = item & 31; const LAS float* s = T + (kg * 8) * 65 + n;
                u32x4 o; o.x = cvt_pk_bf16(s[0], s[65]); o.y = cvt_pk_bf16(s[130], s[195]); o.z = cvt_pk_bf16(s[260], s[325]); o.w = cvt_pk_bf16(s[390], s[455]);
                *(u32x4*)(d.dst + (size_t)n * d.K + d.k0 + kg * 8) = o;
            }
            __syncthreads();
        } else {
            if (iscn) {
#pragma unroll
                for (int ps = 0; ps < 8; ++ps) r[ps] = *(const f32x4*)(dn.sp + (size_t)ps * 32 * dn.srcN);
            }
            const int it = SETUP_MAP(v);
            if (it < N5) {
                const int e0 = (it - N4) * 4096 + tid * 8, t = (e0 >> 7) & 127, s0 = e0 & 127;
                const float* src = p.ab_sgu_w + (size_t)j * 8 * 128 * 128 + e0;
                const f32x4 a = *(const f32x4*)src, b = *(const f32x4*)(src + 4);
                float w[8] = {a[0], a[1], a[2], a[3], b[0], b[1], b[2], b[3]};
#pragma unroll
                for (int e = 0; e < 8; ++e) w[e] = (s0 + e <= t) ? w[e] : 0.f;
                u32x4 o; o.x = cvt_pk_bf16(w[0], w[1]); o.y = cvt_pk_bf16(w[2], w[3]); o.z = cvt_pk_bf16(w[4], w[5]); o.w = cvt_pk_bf16(w[6], w[7]);
                *(u32x4*)(SGU + e0) = o;
            } else if (it < N6) {
                const int e0 = (it - N5) * 4096 + tid * 8, k = e0 >> 11, c = e0 & 2047;
                const float* src = p.c_w_in + ((size_t)j * DM + k) * 4096 + c;
                const f32x4 a = *(const f32x4*)src, b = *(const f32x4*)(src + 4);
                u32x4 o; o.x = cvt_pk_bf16(a[0], a[1]); o.y = cvt_pk_bf16(a[2], a[3]); o.z = cvt_pk_bf16(b[0], b[1]); o.w = cvt_pk_bf16(b[2], b[3]);
                *(u32x4*)(WINP + e0) = o;
            } else norm_rows(p, 2 * j, xin, it - N6);
        }
        v = vn; d = dn; isc = iscn;
    }
#undef SETUP_MAP
}
__device__ __forceinline__ void phase_final(const Params& p) {
    const int tid = opaque_tid(), wid = tid >> 6, lane = tid & 63;
    for (int it = opaque_bid(); it < MTOK / 8; it += gridDim.x) {
        const int row = it * 8 + wid;
        f32x4* xr = (f32x4*)(p.out + (size_t)row * DM) + lane;
        f32x4 v[4]; float ss = 0.f;
#pragma unroll
        for (int q = 0; q < 4; ++q) { v[q] = xr[64 * q]; ss += (v[q][0] * v[q][0] + v[q][1] * v[q][1]) + (v[q][2] * v[q][2] + v[q][3] * v[q][3]); }
        const float rstd = rsqrtf(wave_sum(ss) * (1.f / DM) + EPS);
#pragma unroll
        for (int q = 0; q < 4; ++q) { const f32x4 gv = *(const f32x4*)(p.final_g + (lane + 64 * q) * 4); xr[64 * q] = v[q] * rstd * gv; }
    }
}

__device__ __forceinline__ void unpack8(const u32x4 w, float (&f)[8]) {
    f[0] = bf_lo(w.x); f[1] = bf_hi(w.x); f[2] = bf_lo(w.y); f[3] = bf_hi(w.y); f[4] = bf_lo(w.z); f[5] = bf_hi(w.z); f[6] = bf_lo(w.w); f[7] = bf_hi(w.w);
}

__device__ __forceinline__ void product_units(const Params& p, int j, LAS unsigned char* lds) {
    Gemm g{(const bf16_t*)(p.ws + wofs(j) + WS_POOLT), (const bf16_t*)(p.ws + wofs(j) + WS_WINP), 512, 2048, 512, 8, 4, 512}; EpiProd E{(bf16_t*)(p.ws + wofs(j) + WS_WIN_O)};
    gemm_phase(lds, g, E);
}
__device__ __forceinline__ void phase_mix(const Params& p, int j, LAS unsigned char* lds) {
    const int tid = opaque_tid(), wid = tid >> 6, lane = tid & 63;
    const bf16_t* CH2 = (const bf16_t*)(p.ws + WS_RP); const bf16_t* BZ = CH2 + (size_t)MTOK * 1024; const bf16_t* UZ = BZ + (size_t)MTOK * 1024; const bf16_t* V = UZ + (size_t)MTOK * 1024;
    bf16_t* Y = (bf16_t*)(p.ws + WS_RA);
    {
        const bf16_t* Wm = (const bf16_t*)(p.ws + wofs(j) + WS_SGU);
        const int fr = lane & 15, fq = lane >> 4;
        const int rs = tid >> 4, c = tid & 15;
        const int sbid = opaque_bid();
        int it = (sbid & 7) * 128 + (sbid >> 3), par = 0;
        const int it_end = (sbid & 7) * 128 + 128;
        u32x4 vraw[4];
        if (it < it_end) { const bf16_t* vp = V + (size_t)((it >> 3) * 128 + rs) * 1024 + (it & 7) * 128 + 8 * c;
#pragma unroll
            for (int ps = 0; ps < 4; ++ps) vraw[ps] = *(const u32x4*)(vp + (size_t)ps * 32 * 1024); }
        for (; it < it_end; it += 32, par ^= 1) {
            const int hh = it & 7, cn = it >> 3;
            LAS bf16_t* vnT = (LAS bf16_t*)(lds + par * 36864);
            const int t = 16 * wid + fr; const size_t row = (size_t)cn * 128 + t;
            u32x2 uz[8];
#pragma unroll
            for (int n = 0; n < 8; ++n) uz[n] = *(const u32x2*)(UZ + row * 1024 + hh * 128 + 16 * n + 4 * fq);
            const float bias = p.ab_sgu_b[(size_t)j * 1024 + hh * 128 + t];
            const bf16_t* wrow = Wm + ((size_t)hh * 128 + 16 * wid + fr) * 128 + 8 * fq;
            bf16x8 af[4];
#pragma unroll
            for (int kk = 0; kk < 4; ++kk) af[kk] = *(const bf16x8*)(wrow + 32 * kk);
            const float* lg = p.ab_ln_g + (size_t)j * 1024 + hh * 128 + 8 * c; const float* lb = p.ab_ln_b + (size_t)j * 1024 + hh * 128 + 8 * c;
            const f32x4 g0 = *(const f32x4*)lg, g1 = *(const f32x4*)(lg + 4), b0 = *(const f32x4*)lb, b1 = *(const f32x4*)(lb + 4);
            const float gg[8] = {g0[0], g0[1], g0[2], g0[3], g1[0], g1[1], g1[2], g1[3]}, bb[8] = {b0[0], b0[1], b0[2], b0[3], b1[0], b1[1], b1[2], b1[3]};
#pragma unroll
            for (int ps = 0; ps < 4; ++ps) {
                float f[8]; unpack8(vraw[ps], f);
                float s1 = 0.f, s2 = 0.f;
#pragma unroll
                for (int e = 0; e < 8; ++e) { s1 += f[e]; s2 += f[e] * f[e]; }
#pragma unroll
                for (int o = 1; o < 16; o <<= 1) { s1 += __shfl_xor(s1, o); s2 += __shfl_xor(s2, o); }
                const float mu = s1 * (1.f / 128.f), var = fmaxf(s2 * (1.f / 128.f) - mu * mu, 0.f), rstd = rsqrtf(var + EPS);
                const int sr = ps * 32 + rs;
                LAS bf16_t* wp = vnT + (8 * c) * 136 + ((((sr >> 3) ^ c) & 15) << 3) + (sr & 7);
#pragma unroll
                for (int e = 0; e < 8; ++e) wp[e * 136] = (bf16_t)(cvt_pk_bf16((f[e] - mu) * rstd * gg[e] + bb[e], 0.f) & 0xffffu);
            }
            __syncthreads();
            {
                const int itn = it + 32;
                if (itn < it_end) { const bf16_t* vp = V + (size_t)((itn >> 3) * 128 + rs) * 1024 + (itn & 7) * 128 + 8 * c;
#pragma unroll
                    for (int ps = 0; ps < 4; ++ps) vraw[ps] = *(const u32x4*)(vp + (size_t)ps * 32 * 1024); }
            }
            f32x4 acc[8];
#pragma unroll
            for (int n = 0; n < 8; ++n) acc[n] = (f32x4){0.f, 0.f, 0.f, 0.f};
#pragma unroll
            for (int kk = 0; kk < 4; ++kk) {
                if (32 * kk <= 16 * wid + 15) {
#pragma unroll
                    for (int n = 0; n < 8; ++n) {
                        const int cd = (2 * n + (fr >> 3)) & 15;
                        const bf16x8 bfm = *(const LAS bf16x8*)(vnT + (16 * n + fr) * 136 + ((((4 * kk + fq) ^ cd) & 15) << 3));
                        acc[n] = __builtin_amdgcn_mfma_f32_16x16x32_bf16(bfm, af[kk], acc[n], 0, 0, 0);
                    }
                }
            }
#pragma unroll
            for (int n = 0; n < 8; ++n) {
                const int d = 16 * n + 4 * fq;
                u32x2 w; w.x = cvt_pk_bf16(bf_lo(uz[n].x) * (acc[n][0] + bias), bf_hi(uz[n].x) * (acc[n][1] + bias));
                w.y = cvt_pk_bf16(bf_lo(uz[n].y) * (acc[n][2] + bias), bf_hi(uz[n].y) * (acc[n][3] + bias));
                *(u32x2*)(Y + row * 2048 + 1024 + hh * 128 + d) = w;
            }
        }
        __syncthreads();
    }
    {
        const float* halo = (const float*)(p.ws + WS_HALO); const float* cw = p.ab_conv_w + (size_t)j * 3 * 1024;
        {
            const int fb = opaque_bid(), lidx = (fb >> 3) * 512 + tid, B = (fb & 7) * 16 + (lidx >> 10), c = lidx & 1023; const bool hist = ((B * 128) & (SEQ - 1)) != 0;
            const float* hb = halo + (size_t)B * 6 * 1024 + c;
            const float c6 = hist ? hb[-6 * 1024] : 0.f, c7 = hist ? hb[-5 * 1024] : 0.f, c0 = hb[2 * 1024], c1 = hb[3 * 1024], b0 = hb[4 * 1024], b1 = hb[5 * 1024];
            const float w0 = cw[c], w1 = cw[1024 + c], w2 = cw[2048 + c];
            const float y0 = b0 * (w0 * c6 + w1 * c7 + w2 * c0), y1 = b1 * (w0 * c7 + w1 * c0 + w2 * c1);
            Y[(size_t)(B * 128) * 2048 + c] = (bf16_t)(cvt_pk_bf16(y0, 0.f) & 0xffffu);
            Y[(size_t)(B * 128 + 1) * 2048 + c] = (bf16_t)(cvt_pk_bf16(y1, 0.f) & 0xffffu);
        }
    }
}

__device__ __forceinline__ void phase_pool(const Params& p) {
    const int tid = opaque_tid();
    const bf16_t* HQ = (const bf16_t*)(p.ws + WS_HQ); const bf16_t* HS = (const bf16_t*)(p.ws + WS_HS); bf16_t* Y = (bf16_t*)(p.ws + WS_RA);
    const int fb = opaque_bid(), lidx = (fb >> 3) * 512 + tid;
    if (lidx < 16 * 256) {
        const int B = (fb & 7) * 16 + (lidx >> 8), ct = lidx & 255, c0 = ct * 8, win = 2 << (ct >> 6); const bool hist = ((B * 128) & (SEQ - 1)) != 0;
        const bf16_t* tail = HQ + (size_t)(B - 1) * 32 * 2048 + c0;
        const bf16_t* head = HQ + ((size_t)B * 32 + 16) * 2048 + c0;
        const bf16_t* hs = HS + (size_t)B * 16 * 2048 + c0;
        float S[8];
#pragma unroll
        for (int e = 0; e < 8; ++e) S[e] = 0.f;
        if (hist) {
#pragma unroll
            for (int i = 1; i < 16; ++i) {
                if (i < win) { float v[8]; unpack8(*(const u32x4*)(tail + (size_t)(16 - i) * 2048), v);
#pragma unroll
                    for (int e = 0; e < 8; ++e) S[e] += v[e]; }
            }
        }
#pragma unroll 4
        for (int r = 0; r < 16; ++r) {
            float cur[8], sz[8], o[8];
            unpack8(*(const u32x4*)(head + (size_t)r * 2048), cur);
            unpack8(*(const u32x4*)(hs + (size_t)r * 2048), sz);
            const float inv = 1.f / (float)(hist ? win : min(r + 1, win));
#pragma unroll
            for (int e = 0; e < 8; ++e) { S[e] += cur[e]; o[e] = (S[e] * inv - cur[e]) * sz[e]; }
            u32x4 w; w.x = cvt_pk_bf16(o[0], o[1]); w.y = cvt_pk_bf16(o[2], o[3]); w.z = cvt_pk_bf16(o[4], o[5]); w.w = cvt_pk_bf16(o[6], o[7]);
            *(u32x4*)(Y + (size_t)(B * 128 + r) * 2048 + c0) = w;
            const int ro = r - win + 1;
            if (ro >= 0 || hist) { float old[8]; unpack8(*(const u32x4*)(ro >= 0 ? head + (size_t)ro * 2048 : tail + (size_t)(16 + ro) * 2048), old);
#pragma unroll
                for (int e = 0; e < 8; ++e) S[e] -= old[e]; }
        }
    }
}

#define XB_TMO      128
#define XB_XCNT(j)  (256  + 64 * (j))
#define XB_XSUB(j)  (1280 + 64 * (j))
#define XB_XGEN(j)  (2304 + 64 * (j))
#define XB_TOP      3328
#define XB_TOPGEN   3392
#define XCD_BAR_WORDS 3456
#define XB_SPIN_CAP (1u << 18)
__device__ __forceinline__ unsigned xb_ld(unsigned* p)              { return __hip_atomic_load(p, __ATOMIC_RELAXED, __HIP_MEMORY_SCOPE_AGENT); }
__device__ __forceinline__ unsigned xb_add(unsigned* p, unsigned v) { return __hip_atomic_fetch_add(p, v, __ATOMIC_RELAXED, __HIP_MEMORY_SCOPE_AGENT); }
__device__ __forceinline__ unsigned xb_xcc_id() { return (unsigned)__builtin_amdgcn_s_getreg((3 << 11) | 20) & 0xFu; }
#define XB_SPIN(cond, bar) do { unsigned _sp = 0; while (cond) { __builtin_amdgcn_s_sleep(1); \
    if ((++_sp & 255u) == 0u) { if (xb_ld(&(bar)[XB_TMO])) break; if (_sp > XB_SPIN_CAP) { atomicAdd(&(bar)[XB_TMO], 1u); break; } } } } while (0)
struct XcdBarrier { unsigned* bar; unsigned x; volatile LAS unsigned* st; };
__device__ __forceinline__ XcdBarrier xcd_barrier_post(unsigned* bar, volatile LAS unsigned* st) {
    XcdBarrier b; b.bar = bar; b.x = xb_xcc_id(); b.st = st;
    if (threadIdx.x == 0) (void)xb_add(&bar[XB_XCNT(b.x)], 1u);
    return b;
}
__device__ __forceinline__ void xcd_barrier_complete(unsigned* bar, unsigned x, unsigned& nloc, unsigned& nx) {
    const unsigned G = gridDim.x * gridDim.y * gridDim.z;
    unsigned sum, cnt, mine, sp = 0u;
    for (;;) {
        sum = 0u; cnt = 0u; mine = 0u;
#pragma unroll
        for (unsigned j = 0; j < 16; ++j) { const unsigned c = xb_ld(&bar[XB_XCNT(j)]); sum += c; cnt += (c > 0u) ? 1u : 0u; mine = (j == x) ? c : mine; }
        if (sum == G) break;
        __builtin_amdgcn_s_sleep(1);
        if ((++sp & 255u) == 0u) { if (xb_ld(&bar[XB_TMO])) break; if (sp > XB_SPIN_CAP) { atomicAdd(&bar[XB_TMO], 1u); break; } }
    }
    nloc = mine > 0u ? mine : 1u; nx = cnt > 0u ? cnt : 1u;
}
__device__ __forceinline__ void xcd_barrier(const XcdBarrier& b) {
    asm volatile("s_waitcnt vmcnt(0)" ::: "memory");
    __syncthreads();
    if (threadIdx.x == 0) {
        unsigned* bar = b.bar;
        __builtin_amdgcn_s_waitcnt(0);
        unsigned nloc = b.st[0], nx = b.st[1];
        if (nloc == 0u) { xcd_barrier_complete(bar, b.x, nloc, nx); b.st[0] = nloc; b.st[1] = nx; }
        const unsigned old = xb_add(&bar[XB_XSUB(b.x)], 1u);
        const unsigned gen = old / nloc;
        if (old + 1u == (gen + 1u) * nloc) {
            __builtin_amdgcn_fence(__ATOMIC_RELEASE, "agent");
            asm volatile("s_waitcnt vmcnt(0)" ::: "memory");
            const unsigned og = xb_add(&bar[XB_TOP], 1u);
            const unsigned tg = og / nx;
            if (og + 1u == (tg + 1u) * nx) xb_add(&bar[XB_TOPGEN], 1u);
            else XB_SPIN(xb_ld(&bar[XB_TOPGEN]) == tg, bar);
            __builtin_amdgcn_fence(__ATOMIC_ACQUIRE, "agent");
            xb_add(&bar[XB_XGEN(b.x)], 1u);
            asm volatile("s_waitcnt vmcnt(0)" ::: "memory");
        } else {
            XB_SPIN(xb_ld(&bar[XB_XGEN(b.x)]) == gen, bar);
            __builtin_amdgcn_fence(__ATOMIC_ACQUIRE, "agent");
            asm volatile("s_waitcnt vmcnt(0)" ::: "memory");
        }
    }
    __syncthreads();
}

__device__ __forceinline__ void local_barrier(unsigned* ctr, unsigned target, unsigned* tmo) {
    asm volatile("s_waitcnt vmcnt(0)" ::: "memory");
    __syncthreads();
    if (threadIdx.x == 0) {
        __builtin_amdgcn_s_waitcnt(0);
        (void)xb_add(ctr, 1u);
        __builtin_amdgcn_fence(__ATOMIC_ACQUIRE, "agent");
        unsigned sp = 0;
        while (xb_ld(ctr) < target) { __builtin_amdgcn_s_sleep(1); if (++sp > (1u << 22)) { atomicAdd(tmo, 1u); break; } }
        asm volatile("s_waitcnt vmcnt(0)" ::: "memory");
    }
    __syncthreads();
}

__global__ void __launch_bounds__(512, 2) mega_fwd(Params p, int ph_lo, int ph_hi) {
    extern __shared__ __attribute__((aligned(16))) unsigned char smem[];
    LAS unsigned char* lds = (LAS unsigned char*)smem;
    cg::grid_group grid = cg::this_grid();
    if (ph_hi < 0) grid.sync();
    volatile LAS unsigned* st = (volatile LAS unsigned*)(lds + STAGE_BYTES);
    if (threadIdx.x < 4) st[threadIdx.x] = 0u;
    __syncthreads();
    const XcdBarrier xb = xcd_barrier_post((unsigned*)(p.ws + WS_BAR), st);
    unsigned* ctl = (unsigned*)(p.ws + WS_BAR);
    if (threadIdx.x == 0) __hip_atomic_store(ctl + TAB_WORD0 + blockIdx.x, xb.x + 1u, __ATOMIC_RELAXED, __HIP_MEMORY_SCOPE_AGENT);
    unsigned* lctr = ctl + LOC_WORD0 + 64 * (blockIdx.x & 7);
    int ph = 0, fast = 0; unsigned lgen = 0;
#define PHASE(LOCAL, ...) do { if (ph >= ph_lo && ph < ph_hi) { __VA_ARGS__; if (ph + 1 < ph_hi && (LOCAL) >= 0) { if ((LOCAL) && fast) { ++lgen; local_barrier(lctr, 32u * lgen, ctl + XB_TMO); } else xcd_barrier(xb); } } ++ph; } while (0)
    bf16_t* RA = (bf16_t*)(p.ws + WS_RA); bf16_t* RP = (bf16_t*)(p.ws + WS_RP);
    const float* mod = (const float*)(p.ws + WS_MOD);
    float* part = (float*)(p.ws + WS_PART); unsigned* cnt = (unsigned*)(p.ws + WS_BAR) + CNT_WORD0;
    PHASE(0, { phase_mod(p, lds); phase_norm_even(p, 0, nullptr, lds, 1, 0, 49152, 64); });
    {
        int ok = 1;
        if (threadIdx.x < 256) { const unsigned a = xb_ld(ctl + TAB_WORD0 + threadIdx.x), r = xb_ld(ctl + TAB_WORD0 + (threadIdx.x & 7)); ok = (a == r && a != 0u) ? 1 : 0; }
        fast = __syncthreads_and(ok) && gridDim.x == 256;
    }
#pragma unroll 1
    for (int lp = 0; lp < 2; ++lp) {
        {
            const int layer = 2 * lp; const float* xin = (lp == 0) ? p.x : p.out;
            PHASE(0, { if (blockIdx.x < 32) product_units(p, lp, lds); phase_norm_even(p, lp, xin, lds, 2, 32, 0, 0, lp == 0 ? 156 : 28); if (lp == 0) phase_norm_even(p, 1, nullptr, lds, 1, 0, 0, 0); });
            PHASE(1, { Gemm g{(const bf16_t*)g_h, (const bf16_t*)(p.ws + wofs(lp) + WS_WIN_E), DM, DM, DM, MTOK / BM, 7168 / BM, 0}; EpiEven E{RP, RA, (float*)(p.ws + WS_HALO), p.ab_conv_w + (size_t)lp * 3 * 1024}; gemm_phase(lds, g, E); });
            PHASE(1, phase_mix(p, lp, lds));
            PHASE(1, { Gemm g{RA, (const bf16_t*)(p.ws + wofs(lp) + WS_WOUT_E), 2048, 2048, 2048, MTOK / BM, DM / BM, 0};
                       EpiResNorm E{lp == 0 ? p.x : nullptr, (const bf16_t*)g_x, (bf16_t*)g_x, p.out, mod + (size_t)layer * NB * 3072 + 2048, (bf16_t*)g_h, p.norm_g + (size_t)(layer + 1) * DM, mod + (size_t)(layer + 1) * NB * 3072,
                                    part + (size_t)layer * 4 * MTOK, cnt + layer * 64, 0};
                       gemm_phase(lds, g, E); });
        }
        {
            const int layer = 2 * lp + 1; const int last = (lp == 1) ? 1 : 0;
            PHASE(1, { Gemm g{(const bf16_t*)g_h, (const bf16_t*)(p.ws + wofs(lp) + WS_WIN_O), DM, DM, DM, MTOK / BM, 4096 / BM, 0}; EpiOdd E{RA, (bf16_t*)(p.ws + WS_HQ), (bf16_t*)(p.ws + WS_HS), p.c_pool_scale + (size_t)lp * 2048}; gemm_phase(lds, g, E); });
            PHASE(1, phase_pool(p));
            PHASE(-1, { Gemm g{RA, (const bf16_t*)(p.ws + wofs(lp) + WS_WOUT_O), 2048, 2048, 2048, MTOK / BM, DM / BM, 0};
                       EpiResNorm E{nullptr, (const bf16_t*)g_x, (bf16_t*)g_x, p.out, mod + (size_t)layer * NB * 3072 + 2048, (bf16_t*)g_h, last ? p.final_g : p.norm_g + (size_t)(layer + 1) * DM, mod + (size_t)(last ? layer : layer + 1) * NB * 3072,
                                    part + (size_t)layer * 4 * MTOK, cnt + layer * 64, last};
                       gemm_phase(lds, g, E); });
        }
    }
#undef PHASE
}

extern "C" void kernel_launch(void* const* d_in, const int* in_sizes, int n_in, void* d_out, int out_size, void* d_ws, size_t ws_size, hipStream_t stream) {
    static int grid = 0;
    if (grid == 0) {
        if (n_in != 17 || out_size != MTOK * DM || ws_size < WS_END2) { fprintf(stderr, "kernel_launch: unexpected shapes (n_in %d out %d ws %zu need %zu)\n", n_in, out_size, ws_size, (size_t)WS_END2); grid = -1; return; }
        int dev = 0, cus = 0, per_cu = 0;
        hipGetDevice(&dev);
        hipDeviceGetAttribute(&cus, hipDeviceAttributeMultiprocessorCount, dev);
        if (hipFuncSetAttribute((const void*)mega_fwd, hipFuncAttributeMaxDynamicSharedMemorySize, LDS_BYTES) != hipSuccess) { fprintf(stderr, "kernel_launch: hipFuncSetAttribute failed\n"); grid = -1; return; }
        hipOccupancyMaxActiveBlocksPerMultiprocessor(&per_cu, (const void*)mega_fwd, 512, LDS_BYTES);
        if (per_cu < 1) { fprintf(stderr, "kernel_launch: occupancy query says %d blocks per CU\n", per_cu); per_cu = 1; }
        (void)hipGetLastError();
        grid = cus;
        if (grid != 256) { fprintf(stderr, "kernel_launch: built for 256 CUs (one out-projection tile per workgroup), got %d\n", grid); grid = -1; return; }
    }
    if (grid < 0) return;
    Params p{};
    p.x = (const float*)d_in[0]; p.c = (const float*)d_in[1]; p.norm_g = (const float*)d_in[2]; p.ada_w = (const float*)d_in[3]; p.ada_b = (const float*)d_in[4];
    p.ab_w_in = (const float*)d_in[5]; p.ab_conv_w = (const float*)d_in[6]; p.ab_ln_g = (const float*)d_in[7]; p.ab_ln_b = (const float*)d_in[8];
    p.ab_sgu_w = (const float*)d_in[9]; p.ab_sgu_b = (const float*)d_in[10]; p.ab_w_out = (const float*)d_in[11];
    p.c_w_in = (const float*)d_in[12]; p.c_pool_w = (const float*)d_in[13]; p.c_pool_scale = (const float*)d_in[14]; p.c_w_out = (const float*)d_in[15]; p.final_g = (const float*)d_in[16];
    p.out = (float*)d_out; p.ws = (unsigned char*)d_ws;
    if (hipMemsetAsync((unsigned char*)d_ws + WS_BAR, 0, CTL_WORDS * 4, stream) != hipSuccess) { fprintf(stderr, "kernel_launch: barrier memset failed\n"); return; }
    int lo = 0, hi = 15;
    void* args[] = {&p, &lo, &hi};
    hipError_t e = hipLaunchCooperativeKernel((const void*)mega_fwd, dim3(grid), dim3(512), args, LDS_BYTES, stream);
    if (e != hipSuccess) fprintf(stderr, "kernel_launch: cooperative launch failed: %s (grid %d)\n", hipGetErrorString(e), grid);
}
```

```cpp
#include <hip/hip_runtime.h>
#include <hip/hip_cooperative_groups.h>
#include <cstdio>
namespace cg = cooperative_groups;

#define LAS __attribute__((address_space(3)))
typedef unsigned short bf16_t;
typedef short bf16x8 __attribute__((ext_vector_type(8)));
typedef float f32x4 __attribute__((ext_vector_type(4)));
typedef unsigned u32x4 __attribute__((ext_vector_type(4)));
typedef unsigned u32x2 __attribute__((ext_vector_type(2)));

constexpr int DM = 1024, NB = 8, SEQ = 2048, MTOK = NB * SEQ;
constexpr int BM = 256, BK = 64, HALF = 128, HTB = HALF * BK * 2, STAGE_BYTES = 8 * HTB, NXCD = 8, WGM = 8;
constexpr int LDS_BYTES = STAGE_BYTES + 8192;
constexpr float EPS = 1e-6f;
constexpr int REP_G1 = 1, REP_THIN = 1, REP_G2L0 = 1;

constexpr size_t WS_MOD = 0;
constexpr size_t WS_BAR = 393216;
constexpr size_t WS_WIN_E = 524288;
constexpr size_t WS_WIN_O = WS_WIN_E + (size_t)7168 * 1024 * 2;
constexpr size_t WS_WOUT_E = WS_WIN_O + (size_t)4096 * 1024 * 2;
constexpr size_t WS_WOUT_O = WS_WOUT_E + (size_t)1024 * 2048 * 2;
constexpr size_t WS_SGU = WS_WOUT_O + (size_t)1024 * 2048 * 2;
constexpr size_t WS_POOLT = WS_SGU + (size_t)8 * 128 * 128 * 2;
constexpr size_t WS_WINP = WS_POOLT + (size_t)4 * 512 * 512 * 2;
constexpr size_t WS_RA = WS_WINP + (size_t)1024 * 2048 * 2;
constexpr size_t WS_RP = WS_RA + (size_t)MTOK * 2048 * 2;
constexpr size_t WS_END = WS_RP + (size_t)MTOK * 4096 * 2;

constexpr size_t WS_PART = WS_END;
constexpr size_t WS_HALO = WS_PART + (size_t)4 * 4 * MTOK * 4;
constexpr size_t WS_END2 = WS_HALO + (size_t)128 * 6 * 1024 * 4;
constexpr size_t WS_HQ = WS_RP;
constexpr size_t WS_HS = WS_HQ + (size_t)128 * 32 * 2048 * 2;
constexpr int CNT_WORD0 = 3584;
constexpr int LOC_WORD0 = CNT_WORD0 + 256;
constexpr int TAB_WORD0 = LOC_WORD0 + 512;
constexpr int CTL_WORDS = TAB_WORD0 + 256;
constexpr int XLD = 2048;
__device__ unsigned short g_x[(size_t)MTOK * XLD];
__device__ unsigned short g_h[(size_t)MTOK * DM];

constexpr size_t WS_W1 = WS_HS + (size_t)128 * 16 * 2048 * 2;
static_assert(WS_W1 + (WS_RA - WS_WIN_E) <= WS_RP + (size_t)2 * MTOK * 1024 * 2, "pair 1 weight images must fit in front of the UZ / V slabs");
__host__ __device__ __forceinline__ size_t wofs(int j) { return (size_t)j * (size_t)(WS_W1 - WS_WIN_E); }

struct Params {
    const float *x, *c, *norm_g, *ada_w, *ada_b, *ab_w_in, *ab_conv_w, *ab_ln_g, *ab_ln_b, *ab_sgu_w, *ab_sgu_b, *ab_w_out,
        *c_w_in, *c_pool_w, *c_pool_scale, *c_w_out, *final_g;
    float* out;
    unsigned char* ws;
};

__host__ __device__ __forceinline__ int lds_byte(int r, int c) { const int st = (r >> 4) * 2 + (c >> 5), rr = r & 15, cc = c & 31, ob = rr * 64 + cc * 2; return st * 1024 + (ob ^ (((ob >> 9) & 1) << 5)); }
__host__ __device__ __forceinline__ void stage_rc(int b, int& R, int& C) { const int st = b / 1024, sb = b % 1024, swz = sb ^ (((sb >> 9) & 1) << 5); R = (st >> 1) * 16 + swz / 64; C = (st & 1) * 32 + (swz % 64) / 2; }
__host__ __device__ __forceinline__ int perm32(int rho) { const int n = rho >> 4, i = rho & 15; return 8 * (i >> 2) + 4 * n + (i & 3); }
__device__ __forceinline__ unsigned cvt_pk_bf16(float lo, float hi) { unsigned r; asm volatile("v_cvt_pk_bf16_f32 %0, %1, %2" : "=v"(r) : "v"(lo), "v"(hi)); return r; }
__device__ __forceinline__ float bf_lo(unsigned w) { return __uint_as_float(w << 16); }
__device__ __forceinline__ float bf_hi(unsigned w) { return __uint_as_float(w & 0xffff0000u); }
__device__ __forceinline__ float silu_f(float v) { return v * __builtin_amdgcn_rcpf(1.f + __expf(-v)); }
__device__ __forceinline__ float wave_sum(float v) {
#pragma unroll
    for (int o = 1; o < 64; o <<= 1) v += __shfl_xor(v, o);
    return v;
}

__device__ __forceinline__ int opaque_tid() { int t = threadIdx.x; asm volatile("" : "+v"(t)); return t; }
__device__ __forceinline__ int opaque_bid() { int b = blockIdx.x; asm volatile("" : "+s"(b)); return b; }
struct Unit { int pm, pn; };
struct Gemm { const bf16_t* A; const bf16_t* Bt; int lda, ldb, K, nM, nN, bk; };

__device__ __forceinline__ bool next_unit(const Gemm& g, int bid, int i, Unit& u) {
    const int nwg = g.nM * g.nN;
    if ((long)i * gridDim.x + bid >= nwg) return false;
    const int nr = nwg / (int)gridDim.x;
    const int ir = (nr > 1 && nr * (int)gridDim.x == nwg) ? (i + (bid & 7)) % nr : i;
    const long L = (long)ir * gridDim.x + bid;
    int wgid = (int)L; { const int q = nwg / NXCD, r = nwg % NXCD, xcd = wgid % NXCD, off = wgid / NXCD; wgid = (xcd < r ? xcd * (q + 1) : r * (q + 1) + (xcd - r) * q) + off; }
    const int nig = WGM * g.nN, gid = wgid / nig, fm = gid * WGM, gsz = (g.nM - fm) < WGM ? (g.nM - fm) : WGM;
    u.pm = fm + ((wgid % nig) % gsz); u.pn = (wgid % nig) / gsz; return true;
}

struct EpiEven {
    static constexpr bool PERM = true, AFTER_DRAIN = false, PERMA = true;
    bf16_t* P; bf16_t* Y; float* halo; const float* cw;
    __device__ __forceinline__ void operator()(const f32x4 (&acc)[2][2][4][2], const Unit& u, int wr, int wc, int fr, int fq) const {
        const int tok0 = u.pm * BM + 8 * (wr * 16 + fr), T = u.pn;
        if (T < 16) {
            const int ch = T * 64 + 16 * wc + 4 * fq;
            const f32x4 w0 = *(const f32x4*)(cw + ch), w1 = *(const f32x4*)(cw + 1024 + ch), w2 = *(const f32x4*)(cw + 2048 + ch);
            f32x4 c[8], pm1, pm2;
#pragma unroll
            for (int i = 0; i < 8; ++i) c[i] = acc[i >> 2][0][i & 3][0] * acc[i >> 2][0][i & 3][1];
#pragma unroll
            for (int j = 0; j < 4; ++j) {
                pm1[j] = __int_as_float(__builtin_amdgcn_update_dpp(0, __float_as_int(c[7][j]), 0x111, 0xf, 0xf, true));
                pm2[j] = __int_as_float(__builtin_amdgcn_update_dpp(0, __float_as_int(c[6][j]), 0x111, 0xf, 0xf, true));
            }
            float* hb = halo + (size_t)(u.pm * 2 + wr) * 6 * 1024 + ch;
            if (fr == 15) { *(f32x4*)(hb) = c[6]; *(f32x4*)(hb + 1024) = c[7]; }
            bf16_t* yp = Y + (size_t)tok0 * 2048 + ch;
#pragma unroll
            for (int i = 0; i < 8; ++i) {
                f32x4 bz = acc[i >> 2][1][i & 3][0]; const f32x4 z = acc[i >> 2][1][i & 3][1];
#pragma unroll
                for (int j = 0; j < 4; ++j) bz[j] *= silu_f(z[j]);
                const f32x4 cm1 = (i >= 1) ? c[i >= 1 ? i - 1 : 0] : pm1, cm2 = (i >= 2) ? c[i >= 2 ? i - 2 : 0] : (i == 1 ? pm1 : pm2);
                const f32x4 y = bz * (w0 * ((i == 1) ? pm1 : cm2) + w1 * cm1 + w2 * c[i]);
                if (i < 2 && fr == 0) { *(f32x4*)(hb + (2 + i) * 1024) = c[i]; *(f32x4*)(hb + (4 + i) * 1024) = bz; }
                else { u32x2 w; w.x = cvt_pk_bf16(y[0], y[1]); w.y = cvt_pk_bf16(y[2], y[3]); *(u32x2*)(yp + (size_t)i * 2048) = w; }
            }
        } else if (T < 24) {
            bf16_t* base = P + (size_t)2 * MTOK * 1024 + (size_t)tok0 * 1024 + (T - 16) * 128 + wc * 32 + 8 * fq;
#pragma unroll
            for (int i = 0; i < 8; ++i) {
                f32x4 x0 = acc[i >> 2][0][i & 3][0], x1 = acc[i >> 2][0][i & 3][1]; const f32x4 y0 = acc[i >> 2][1][i & 3][0], y1 = acc[i >> 2][1][i & 3][1];
#pragma unroll
                for (int j = 0; j < 4; ++j) { x0[j] *= silu_f(y0[j]); x1[j] *= silu_f(y1[j]); }
                u32x4 w; w.x = cvt_pk_bf16(x0[0], x0[1]); w.y = cvt_pk_bf16(x0[2], x0[3]); w.z = cvt_pk_bf16(x1[0], x1[1]); w.w = cvt_pk_bf16(x1[2], x1[3]);
                *(u32x4*)(base + (size_t)i * 1024) = w;
            }
        } else {
            bf16_t* base = P + (size_t)3 * MTOK * 1024 + (size_t)tok0 * 1024 + (T - 24) * 256 + wc * 32 + 8 * fq;
#pragma unroll
            for (int i = 0; i < 8; ++i)
#pragma unroll
                for (int bj = 0; bj < 2; ++bj) {
                    const f32x4 v0 = acc[i >> 2][bj][i & 3][0], v1 = acc[i >> 2][bj][i & 3][1];
                    u32x4 w; w.x = cvt_pk_bf16(v0[0], v0[1]); w.y = cvt_pk_bf16(v0[2], v0[3]); w.z = cvt_pk_bf16(v1[0], v1[1]); w.w = cvt_pk_bf16(v1[2], v1[3]);
                    *(u32x4*)(base + (size_t)i * 1024 + bj * HALF) = w;
                }
        }
    }
};
template <int WIN> __device__ __forceinline__ void pool_quad(const f32x4 (&acc)[2][2][4][2], int n, const f32x4 ps, unsigned (&yq)[8][2], unsigned (&qq)[8][2], unsigned (&sq)[8][2]) {
    float y[8][4], szv[8][4];
#pragma unroll
    for (int j = 0; j < 4; ++j) {
        float h[23], PS[24];
#pragma unroll
        for (int k = 0; k < 8; ++k) h[15 + k] = acc[k >> 2][0][k & 3][n][j];
#pragma unroll
        for (int k = 0; k < 8; ++k) h[7 + k] = __int_as_float(__builtin_amdgcn_update_dpp(0, __float_as_int(h[15 + k]), 0x111, 0xf, 0xf, true));
#pragma unroll
        for (int k = 1; k < 8; ++k) h[k - 1] = __int_as_float(__builtin_amdgcn_update_dpp(0, __float_as_int(h[15 + k]), 0x112, 0xf, 0xf, true));
        constexpr int LO = 16 - WIN;
#pragma unroll
        for (int x = 0; x <= LO; ++x) PS[x] = 0.f;
#pragma unroll
        for (int x = LO; x < 23; ++x) PS[x + 1] = PS[x] + h[x];
#pragma unroll
        for (int i = 0; i < 8; ++i) {
            const float w = PS[16 + i] - PS[16 + i - WIN];
            const float z = acc[i >> 2][1][i & 3][n][j];
            szv[i][j] = silu_f(z) * ps[j];
            y[i][j] = (w * (1.f / WIN) - h[15 + i]) * szv[i][j];
        }
    }
#pragma unroll
    for (int i = 0; i < 8; ++i) {
        yq[i][0] = cvt_pk_bf16(y[i][0], y[i][1]); yq[i][1] = cvt_pk_bf16(y[i][2], y[i][3]);
        qq[i][0] = cvt_pk_bf16(acc[i >> 2][0][i & 3][n][0], acc[i >> 2][0][i & 3][n][1]); qq[i][1] = cvt_pk_bf16(acc[i >> 2][0][i & 3][n][2], acc[i >> 2][0][i & 3][n][3]);
        sq[i][0] = cvt_pk_bf16(szv[i][0], szv[i][1]); sq[i][1] = cvt_pk_bf16(szv[i][2], szv[i][3]);
    }
}
struct EpiOdd {
    static constexpr bool PERM = true, AFTER_DRAIN = false, PERMA = true;
    bf16_t* Y; bf16_t* HQ; bf16_t* HS; const float* pscale;
    __device__ __forceinline__ void operator()(const f32x4 (&acc)[2][2][4][2], const Unit& u, int wr, int wc, int fr, int fq) const {
        const int T = u.pn, g = T >> 2, B = u.pm * 2 + wr;
        const int tok0 = u.pm * BM + 8 * (wr * 16 + fr);
        const int ch = T * 128 + wc * 32 + 8 * fq;
        unsigned yq[2][8][2];
#pragma unroll
        for (int n = 0; n < 2; ++n) {
            const f32x4 ps = *(const f32x4*)(pscale + ch + 4 * n);
            unsigned qq[8][2], sq[8][2];
            if (g == 0) pool_quad<2>(acc, n, ps, yq[n], qq, sq);
            else if (g == 1) pool_quad<4>(acc, n, ps, yq[n], qq, sq);
            else if (g == 2) pool_quad<8>(acc, n, ps, yq[n], qq, sq);
            else pool_quad<16>(acc, n, ps, yq[n], qq, sq);
            if (fr >= 14) {
                bf16_t* hp = HQ + ((size_t)B * 32 + (fr - 14) * 8) * 2048 + ch + 4 * n;
#pragma unroll
                for (int i = 0; i < 8; ++i) { u32x2 w; w.x = qq[i][0]; w.y = qq[i][1]; *(u32x2*)(hp + (size_t)i * 2048) = w; }
            }
            if (fr <= 1) {
                bf16_t* hp = HQ + ((size_t)B * 32 + 16 + fr * 8) * 2048 + ch + 4 * n; bf16_t* sp = HS + ((size_t)B * 16 + fr * 8) * 2048 + ch + 4 * n;
#pragma unroll
                for (int i = 0; i < 8; ++i) { u32x2 w; w.x = qq[i][0]; w.y = qq[i][1]; *(u32x2*)(hp + (size_t)i * 2048) = w; u32x2 v; v.x = sq[i][0]; v.y = sq[i][1]; *(u32x2*)(sp + (size_t)i * 2048) = v; }
            }
        }
        bf16_t* yp = Y + (size_t)tok0 * 2048 + ch;
#pragma unroll
        for (int i = 0; i < 8; ++i) { u32x4 w; w.x = yq[0][i][0]; w.y = yq[0][i][1]; w.z = yq[1][i][0]; w.w = yq[1][i][1]; *(u32x4*)(yp + (size_t)i * 2048) = w; }
    }
};
struct EpiProd {
    static constexpr bool PERM = true, AFTER_DRAIN = false, PERMA = false;
    bf16_t* O;
    __device__ __forceinline__ void operator()(const f32x4 (&acc)[2][2][4][2], const Unit& u, int wr, int wc, int fr, int fq) const {
        const int col0 = u.pn * BM + wc * 32 + 8 * fq;
#pragma unroll
        for (int ai = 0; ai < 2; ++ai)
#pragma unroll
            for (int m = 0; m < 4; ++m) {
                bf16_t* rowp = O + (size_t)((u.pm * 2 + ai) * 256 + wr * 64 + m * 16 + fr) * DM + col0;
#pragma unroll
                for (int bj = 0; bj < 2; ++bj) {
                    const f32x4 v0 = acc[ai][bj][m][0], v1 = acc[ai][bj][m][1];
                    u32x4 w; w.x = cvt_pk_bf16(v0[0], v0[1]); w.y = cvt_pk_bf16(v0[2], v0[3]); w.z = cvt_pk_bf16(v1[0], v1[1]); w.w = cvt_pk_bf16(v1[2], v1[3]);
                    *(u32x4*)(rowp + bj * HALF) = w;
                }
            }
    }
};
struct EpiBf {
    static constexpr bool PERM = true, AFTER_DRAIN = false, PERMA = false;
    bf16_t* O; int ld;
    __device__ __forceinline__ void operator()(const f32x4 (&acc)[2][2][4][2], const Unit& u, int wr, int wc, int fr, int fq) const {
        const int row0 = u.pm * BM + wr * 64 + fr, col0 = u.pn * BM + wc * 32 + 8 * fq;
#pragma unroll
        for (int ai = 0; ai < 2; ++ai)
#pragma unroll
            for (int m = 0; m < 4; ++m) {
                bf16_t* rowp = O + (size_t)(row0 + ai * HALF + m * 16) * ld + col0;
#pragma unroll
                for (int bj = 0; bj < 2; ++bj) {
                    const f32x4 v0 = acc[ai][bj][m][0], v1 = acc[ai][bj][m][1];
                    u32x4 w; w.x = cvt_pk_bf16(v0[0], v0[1]); w.y = cvt_pk_bf16(v0[2], v0[3]); w.z = cvt_pk_bf16(v1[0], v1[1]); w.w = cvt_pk_bf16(v1[2], v1[3]);
                    *(u32x4*)(rowp + bj * HALF) = w;
                }
            }
    }
};
struct EpiRes {
    static constexpr bool PERM = false, AFTER_DRAIN = false, PERMA = false;
    const float* xin; float* xout; const float* gate;
    __device__ __forceinline__ void operator()(const f32x4 (&acc)[2][2][4][2], const Unit& u, int wr, int wc, int fr, int fq) const {
        const int row0 = u.pm * BM + wr * 64 + fr, col0 = u.pn * BM + wc * 32 + 4 * fq;
        const float* gp = gate + (size_t)(u.pm >> 3) * 3072 + col0;
        f32x4 gv[2][2];
#pragma unroll
        for (int bj = 0; bj < 2; ++bj)
#pragma unroll
            for (int n = 0; n < 2; ++n) gv[bj][n] = *(const f32x4*)(gp + bj * HALF + n * 16);
#pragma unroll
        for (int ai = 0; ai < 2; ++ai)
#pragma unroll
            for (int m = 0; m < 4; ++m) {
                const size_t ro = (size_t)(row0 + ai * HALF + m * 16) * DM + col0;
#pragma unroll
                for (int bj = 0; bj < 2; ++bj)
#pragma unroll
                    for (int n = 0; n < 2; ++n) {
                        const f32x4 xv = *(const f32x4*)(xin + ro + bj * HALF + n * 16);
                        *(f32x4*)(xout + ro + bj * HALF + n * 16) = xv + gv[bj][n] * acc[ai][bj][m][n];
                    }
            }
    }
};

struct EpiResNorm {
    static constexpr bool PERM = true, AFTER_DRAIN = true, PERMA = false;
    __device__ __forceinline__ bool xpre() const { return xin32 == nullptr; }
    const float* xin32; const bf16_t* xin16; bf16_t* xout16; float* out32; const float* gate; bf16_t* H; const float* ng; const float* modn; float* part; unsigned* cnt; int last;
    __device__ __forceinline__ void fused(f32x4 (&acc)[2][2][4][2], const Unit& u, int wr, int wc, int fr, int fq, LAS unsigned char* lds, int tid) const {
        const int row0 = u.pm * BM + wr * 64 + fr, col0 = u.pn * BM + wc * 32 + 8 * fq, b = u.pm >> 3;
        LAS float* lss = (LAS float*)(lds + STAGE_BYTES + 1024);
        LAS float* lrs = (LAS float*)(lds + STAGE_BYTES + 1024 + 4096);
        {
            const float* gp = gate + (size_t)b * 3072 + col0;
            f32x4 gv[2][2];
#pragma unroll
            for (int bj = 0; bj < 2; ++bj)
#pragma unroll
                for (int n = 0; n < 2; ++n) gv[bj][n] = *(const f32x4*)(gp + bj * HALF + 4 * n);
#pragma unroll
            for (int ai = 0; ai < 2; ++ai)
#pragma unroll
                for (int m = 0; m < 4; ++m) {
                    const size_t ro = (size_t)(row0 + ai * HALF + m * 16) * DM + col0, rox = (size_t)(row0 + ai * HALF + m * 16) * XLD + col0;
                    float ss = 0.f;
#pragma unroll
                    for (int bj = 0; bj < 2; ++bj) {
                        f32x4 x0, x1;
                        if (xin32) { x0 = *(const f32x4*)(xin32 + ro + bj * HALF); x1 = *(const f32x4*)(xin32 + ro + bj * HALF + 4); }
                        else { u32x4 w;
                            if (ai == 1 && bj == 1 && wc >= 2) w = *(const u32x4*)(xin16 + rox + bj * HALF);
                            else {
                                const int cb = 2 * bj + (wc >> 1), slot = (cb & 1) ? (ai * 2 + (cb >> 1)) : (4 + ai * 2 + (cb >> 1));
                                w = *(const LAS u32x4*)(lds + slot * HTB + lds_byte(wr * 64 + m * 16 + fr, (wc & 1) * 32 + 8 * fq));
                            } x0 = (f32x4){bf_lo(w.x), bf_hi(w.x), bf_lo(w.y), bf_hi(w.y)}; x1 = (f32x4){bf_lo(w.z), bf_hi(w.z), bf_lo(w.w), bf_hi(w.w)}; }
                        const f32x4 v0 = x0 + gv[bj][0] * acc[ai][bj][m][0], v1 = x1 + gv[bj][1] * acc[ai][bj][m][1];
                        acc[ai][bj][m][0] = v0; acc[ai][bj][m][1] = v1;
                        ss += ((v0[0] * v0[0] + v0[1] * v0[1]) + (v0[2] * v0[2] + v0[3] * v0[3])) + ((v1[0] * v1[0] + v1[1] * v1[1]) + (v1[2] * v1[2] + v1[3] * v1[3]));
                    }
                    ss += __shfl_xor(ss, 16); ss += __shfl_xor(ss, 32);
                    if (fq == 0) lss[(ai * HALF + wr * 64 + m * 16 + fr) * 4 + wc] = ss;
                }
        }
        __syncthreads();
        if (tid < 256) {
            const float t = (lss[tid * 4] + lss[tid * 4 + 1]) + (lss[tid * 4 + 2] + lss[tid * 4 + 3]);
            __hip_atomic_store(part + (size_t)u.pn * MTOK + u.pm * BM + tid, t, __ATOMIC_RELAXED, __HIP_MEMORY_SCOPE_AGENT);
        }
        asm volatile("s_waitcnt vmcnt(0)" ::: "memory");
        __syncthreads();
        unsigned* c = cnt + u.pm;
        if (tid == 0) __hip_atomic_fetch_add(c, 1u, __ATOMIC_RELAXED, __HIP_MEMORY_SCOPE_AGENT);
        if (!last) {
#pragma unroll
            for (int ai = 0; ai < 2; ++ai)
#pragma unroll
                for (int m = 0; m < 4; ++m) {
                    const size_t rox = (size_t)(row0 + ai * HALF + m * 16) * XLD + col0;
#pragma unroll
                    for (int bj = 0; bj < 2; ++bj) {
                        const f32x4 v0 = acc[ai][bj][m][0], v1 = acc[ai][bj][m][1];
                        u32x4 w; w.x = cvt_pk_bf16(v0[0], v0[1]); w.y = cvt_pk_bf16(v0[2], v0[3]); w.z = cvt_pk_bf16(v1[0], v1[1]); w.w = cvt_pk_bf16(v1[2], v1[3]);
                        *(u32x4*)(xout16 + rox + bj * HALF) = w;
                    }
                }
        }
        if (tid == 0) {
            unsigned spins = 0;
            while (__hip_atomic_load(c, __ATOMIC_RELAXED, __HIP_MEMORY_SCOPE_AGENT) < 4u && ++spins < (1u << 22)) __builtin_amdgcn_s_sleep(1);
            __builtin_amdgcn_fence(__ATOMIC_ACQUIRE, "agent");
            asm volatile("s_waitcnt vmcnt(0)" ::: "memory");
        }
        __syncthreads();
        if (tid < 256) {
            float t = 0.f;
#pragma unroll
            for (int q = 0; q < 4; ++q) t += __hip_atomic_load(part + (size_t)q * MTOK + u.pm * BM + tid, __ATOMIC_RELAXED, __HIP_MEMORY_SCOPE_AGENT);
            lrs[tid] = rsqrtf(t * (1.f / DM) + EPS);
        }
        __syncthreads();
        const float* mb = modn + (size_t)b * 3072;
#pragma unroll
        for (int bj = 0; bj < 2; ++bj) {
            const int c = col0 + bj * HALF;
            const f32x4 g0 = *(const f32x4*)(ng + c), g1 = *(const f32x4*)(ng + c + 4);
            f32x4 sh0 = {0.f, 0.f, 0.f, 0.f}, sh1 = sh0, sc0 = sh0, sc1 = sh0;
            if (!last) { sh0 = *(const f32x4*)(mb + c); sh1 = *(const f32x4*)(mb + c + 4); sc0 = *(const f32x4*)(mb + 1024 + c); sc1 = *(const f32x4*)(mb + 1024 + c + 4); }
            const f32x4 a0 = g0 * (sc0 + 1.f), a1 = g1 * (sc1 + 1.f);
#pragma unroll
            for (int ai = 0; ai < 2; ++ai)
#pragma unroll
                for (int m = 0; m < 4; ++m) {
                    const int rl = ai * HALF + wr * 64 + m * 16 + fr;
                    const float rstd = lrs[rl];
                    const size_t ro = (size_t)(u.pm * BM + rl) * DM + c;
                    const f32x4 h0 = (acc[ai][bj][m][0] * rstd) * a0 + sh0, h1 = (acc[ai][bj][m][1] * rstd) * a1 + sh1;
                    if (last) { *(f32x4*)(out32 + ro) = h0; *(f32x4*)(out32 + ro + 4) = h1; }
                    else { u32x4 w; w.x = cvt_pk_bf16(h0[0], h0[1]); w.y = cvt_pk_bf16(h0[2], h0[3]); w.z = cvt_pk_bf16(h1[0], h1[1]); w.w = cvt_pk_bf16(h1[2], h1[3]); *(u32x4*)(H + ro) = w; }
                }
        }
    }
};

template <class Epi>
__device__ __forceinline__ void gemm_phase(LAS unsigned char* lds, const Gemm g, const Epi& E) {
    const int tid = opaque_tid(), wid = __builtin_amdgcn_readfirstlane(tid >> 6), lane = tid & 63, wr = wid >> 2, wc = wid & 3, fr = lane & 15, fq = lane >> 4;
    const int nt = g.K / BK;
    unsigned voffA[2], voffB[2];
#pragma unroll
    for (int i = 0; i < 2; ++i) { int R, C; stage_rc(tid * 16 + i * 8192, R, C); const int Rb = Epi::PERM ? ((R & ~31) + perm32(R & 31)) : R;
        const int Ra = Epi::PERMA ? (8 * ((R >> 6) * 16 + (R & 15)) + ((R >> 4) & 3)) : R;
        voffA[i] = (unsigned)(Ra * g.lda + C) * 2u; voffB[i] = (unsigned)(Rb * g.ldb + C) * 2u; }
    const size_t kstep = (size_t)(BK * 2);
    const size_t hstepA = (size_t)(Epi::PERMA ? 4 : HALF) * g.lda * 2, hstepB = (size_t)HALF * g.ldb * 2, tstepA = (size_t)BM * g.lda * 2;
    const unsigned ldsw = (unsigned)wid * 1024u;
    const int aoff = lds_byte(wr * 64 + fr, fq * 8), boff = lds_byte(wc * 32 + fr, fq * 8);
#define PG8_SA(b, h) (((b) * 2 + (h)) * HTB)
#define PG8_SB(b, h) ((4 + (b) * 2 + (h)) * HTB)
#define PG8_STAGE(bufoff, gbase, voff) do { _Pragma("unroll") for (int _i = 0; _i < 2; ++_i) \
        __builtin_amdgcn_global_load_lds((const unsigned*)((const char*)(gbase) + (voff)[_i]), (LAS unsigned*)(lds + (bufoff) + ldsw + _i * 8192), 16, 0, 0); } while (0)
#define PG8_LDA(dst, b, h) do { _Pragma("unroll") for (int m = 0; m < 4; ++m) _Pragma("unroll") for (int k = 0; k < 2; ++k) dst[m][k] = *(const LAS bf16x8*)(lds + PG8_SA(b, h) + aoff + m * 2048 + k * 1024); } while (0)
#define PG8_LDB(dst, b, h) do { _Pragma("unroll") for (int n = 0; n < 2; ++n) _Pragma("unroll") for (int k = 0; k < 2; ++k) dst[n][k] = *(const LAS bf16x8*)(lds + PG8_SB(b, h) + boff + n * 2048 + k * 1024); } while (0)
#define PG8_MMA(ai, bj, At, Bt) do { __builtin_amdgcn_s_setprio(1); _Pragma("unroll") for (int m = 0; m < 4; ++m) _Pragma("unroll") for (int n = 0; n < 2; ++n) _Pragma("unroll") for (int k = 0; k < 2; ++k) \
        acc[ai][bj][m][n] = __builtin_amdgcn_mfma_f32_16x16x32_bf16(Bt[n][k], At[m][k], acc[ai][bj][m][n], 0, 0, 0); __builtin_amdgcn_s_setprio(0); } while (0)
#define PG8_WAIT_V(n) asm volatile("s_waitcnt vmcnt(" #n ")" ::: "memory")
#define PG8_WAIT_L(n) asm volatile("s_waitcnt lgkmcnt(" #n ")" ::: "memory")
#define PG8_BAR __builtin_amdgcn_s_barrier()
#define PG8_SCHED __builtin_amdgcn_sched_barrier(0)
    Unit cur, nxt; int ui = 0;
    const int bid = opaque_bid();
    if (!next_unit(g, bid, 0, cur)) return;
    f32x4 acc[2][2][4][2];
#pragma unroll
    for (int a = 0; a < 2; ++a)
#pragma unroll
        for (int b = 0; b < 2; ++b)
#pragma unroll
            for (int m = 0; m < 4; ++m)
#pragma unroll
                for (int n = 0; n < 2; ++n) acc[a][b][m][n] = (f32x4){0.f, 0.f, 0.f, 0.f};
    bf16x8 At[4][2], B0[2][2], B1[2][2];
    const char* cA = (const char*)g.A + (size_t)cur.pm * tstepA; const char* cB = (const char*)g.Bt + (size_t)cur.pn * 2 * hstepB + (size_t)(cur.pm >> 1) * g.bk * 2;
    PG8_STAGE(PG8_SB(0, 0), cB, voffB); PG8_STAGE(PG8_SA(0, 0), cA, voffA); PG8_STAGE(PG8_SB(0, 1), cB + hstepB, voffB); PG8_STAGE(PG8_SA(0, 1), cA + hstepA, voffA);
    if (wr == 1) PG8_BAR;
    PG8_WAIT_V(4); PG8_BAR;
    PG8_STAGE(PG8_SB(1, 0), cB + kstep, voffB); PG8_STAGE(PG8_SA(1, 0), cA + kstep, voffA); PG8_STAGE(PG8_SB(1, 1), cB + hstepB + kstep, voffB);
    PG8_WAIT_V(6); PG8_BAR;
    for (;;) {
        const bool has_next = next_unit(g, bid, ui + 1, nxt);
        const char* nA = has_next ? (const char*)g.A + (size_t)nxt.pm * tstepA : cA;
        const char* nB = has_next ? (const char*)g.Bt + (size_t)nxt.pn * 2 * hstepB + (size_t)(nxt.pm >> 1) * g.bk * 2 : cB;
#define PG8_ITER(S2, S3, S4, S5, S6, S7, S8) do { \
              PG8_LDB(B0, 0, 0); PG8_SCHED; PG8_LDA(At, 0, 0); PG8_STAGE(PG8_SA(1, 1), a1 + hstepA, voffA); \
            PG8_WAIT_L(8); PG8_BAR; PG8_WAIT_L(0); PG8_MMA(0, 0, At, B0); PG8_BAR; PG8_SCHED; \
              PG8_LDB(B1, 0, 1); S2; \
            PG8_BAR; PG8_WAIT_L(0); PG8_MMA(0, 1, At, B1); PG8_BAR; \
              PG8_LDA(At, 0, 1); S3; \
            PG8_BAR; PG8_WAIT_L(0); PG8_MMA(1, 0, At, B0); PG8_BAR; PG8_SCHED; \
              S4; \
            PG8_WAIT_V(6); PG8_BAR; PG8_MMA(1, 1, At, B1); PG8_BAR; \
              PG8_LDB(B0, 1, 0); PG8_SCHED; PG8_LDA(At, 1, 0); S5; \
            PG8_WAIT_L(8); PG8_BAR; PG8_WAIT_L(0); PG8_MMA(0, 0, At, B0); PG8_BAR; PG8_SCHED; \
              PG8_LDB(B1, 1, 1); S6; \
            PG8_BAR; PG8_WAIT_L(0); PG8_MMA(0, 1, At, B1); PG8_BAR; \
              PG8_LDA(At, 1, 1); S7; \
            PG8_BAR; PG8_WAIT_L(0); PG8_MMA(1, 0, At, B0); PG8_BAR; PG8_SCHED; \
              S8; \
            PG8_WAIT_V(6); PG8_BAR; PG8_MMA(1, 1, At, B1); PG8_BAR; } while (0)
        bool xpre = false;
        if constexpr (Epi::AFTER_DRAIN) xpre = !has_next && E.xpre();
        const int nt_main = xpre ? nt - 2 : nt;
        for (int t = 0; t < nt_main; t += 2) {
            const bool last = (t == nt - 2);
            const char* a1 = cA + (size_t)(t + 1) * kstep;
            const char* a2 = last ? nA : cA + (size_t)(t + 2) * kstep; const char* b2 = last ? nB : cB + (size_t)(t + 2) * kstep;
            const char* a3 = a2 + kstep; const char* b3 = b2 + kstep;
            PG8_ITER(PG8_STAGE(PG8_SB(0, 0), b2, voffB), PG8_STAGE(PG8_SA(0, 0), a2, voffA), PG8_STAGE(PG8_SB(0, 1), b2 + hstepB, voffB), PG8_STAGE(PG8_SA(0, 1), a2 + hstepA, voffA),
                     PG8_STAGE(PG8_SB(1, 0), b3, voffB), PG8_STAGE(PG8_SA(1, 0), a3, voffA), PG8_STAGE(PG8_SB(1, 1), b3 + hstepB, voffB));
        }
        if constexpr (Epi::AFTER_DRAIN) {
            if (xpre) {
                const char* a1 = cA + (size_t)(nt - 1) * kstep;
                const char* xq = (const char*)E.xin16 + ((size_t)cur.pm * BM * XLD + (size_t)cur.pn * BM) * 2;
                const size_t xh = (size_t)HALF * XLD * 2;
                PG8_ITER(PG8_STAGE(PG8_SB(0, 0), xq, voffA), PG8_STAGE(PG8_SA(0, 0), xq + 128, voffA), PG8_STAGE(PG8_SB(0, 1), xq + 256, voffA), PG8_STAGE(PG8_SA(0, 1), xq + 384, voffA),
                         PG8_STAGE(PG8_SB(1, 0), xq + xh, voffA), PG8_STAGE(PG8_SA(1, 0), xq + xh + 128, voffA), PG8_STAGE(PG8_SB(1, 1), xq + xh + 256, voffA));
            }
        }
#undef PG8_ITER
        if constexpr (!Epi::AFTER_DRAIN) E(acc, cur, wr, wc, fr, fq);
        if (!has_next) break;
#pragma unroll
        for (int a = 0; a < 2; ++a)
#pragma unroll
            for (int b = 0; b < 2; ++b)
#pragma unroll
                for (int m = 0; m < 4; ++m)
#pragma unroll
                    for (int n = 0; n < 2; ++n) acc[a][b][m][n] = (f32x4){0.f, 0.f, 0.f, 0.f};
        cur = nxt; cA = nA; cB = nB; ++ui;
    }
    PG8_WAIT_V(0);
    if (wr == 0) PG8_BAR;
    PG8_BAR;
    if constexpr (Epi::AFTER_DRAIN) E.fused(acc, cur, wr, wc, fr, fq, lds, tid);
#undef PG8_SA
#undef PG8_SB
#undef PG8_STAGE
#undef PG8_LDA
#undef PG8_LDB
#undef PG8_MMA
#undef PG8_WAIT_V
#undef PG8_WAIT_L
#undef PG8_BAR
#undef PG8_SCHED
}

__device__ __forceinline__ void phase_mod(const Params& p, LAS unsigned char* lds) {
    const int tid = opaque_tid(), wid = tid >> 6, lane = tid & 63;
    LAS float* sc = (LAS float*)lds;
    LAS float* red = (LAS float*)(lds + 32768);
    float* mod = (float*)(p.ws + WS_MOD);
    for (int t = tid; t < NB * DM; t += 512) sc[t] = silu_f(p.c[t]);
    __syncthreads();
    for (int it = opaque_bid(); it < 192; it += gridDim.x) {
        const int col = it * 64 + lane, i = col / 3072, j = col - i * 3072;
        const float* w = p.ada_w + ((size_t)i * DM + wid * 128) * 3072 + j;
        float a[8];
#pragma unroll
        for (int b = 0; b < 8; ++b) a[b] = 0.f;
#pragma unroll 32
        for (int k = 0; k < 128; ++k) {
            const float wv = w[(size_t)k * 3072];
#pragma unroll
            for (int b = 0; b < 8; ++b) a[b] += sc[b * DM + wid * 128 + k] * wv;
        }
#pragma unroll
        for (int b = 0; b < 8; ++b) red[(wid * 8 + b) * 64 + lane] = a[b];
        __syncthreads();
        {
            const int b = tid >> 6; float s = 0.f;
#pragma unroll
            for (int w8 = 0; w8 < 8; ++w8) s += red[(w8 * 8 + b) * 64 + lane];
            mod[((size_t)i * NB + b) * 3072 + j] = s + p.ada_b[i * 3072 + j];
        }
        __syncthreads();
    }
}

__device__ __forceinline__ void conv_tile(const float* __restrict__ src, int srcN, int c0, bf16_t* __restrict__ dstrow, int K, int k0, LAS float* T, int csrc = -1) {
    const int tid = opaque_tid();
    const int cs = csrc >= 0 ? csrc : c0 + (tid & 15) * 4;
    f32x4 v[8];
#pragma unroll
    for (int ps = 0; ps < 8; ++ps) v[ps] = *(const f32x4*)(src + (size_t)(k0 + ps * 32 + (tid >> 4)) * srcN + cs);
#pragma unroll
    for (int ps = 0; ps < 8; ++ps) { LAS float* t = T + (ps * 32 + (tid >> 4)) * 65 + (tid & 15) * 4; t[0] = v[ps][0]; t[1] = v[ps][1]; t[2] = v[ps][2]; t[3] = v[ps][3]; }
    __syncthreads();
#pragma unroll
    for (int q = 0; q < 4; ++q) {
        const int item = tid + 512 * q, n = item >> 5, kg = item & 31; const LAS float* s = T + (kg * 8) * 65 + n;
        u32x4 o; o.x = cvt_pk_bf16(s[0], s[65]); o.y = cvt_pk_bf16(s[130], s[195]); o.z = cvt_pk_bf16(s[260], s[325]); o.w = cvt_pk_bf16(s[390], s[455]);
        *(u32x4*)(dstrow + (size_t)n * K + k0 + kg * 8) = o;
    }
    __syncthreads();
}

__device__ __forceinline__ void norm_rows(const Params& p, int layer, const float* xin, int item) {
    const int tid = opaque_tid(), wid = tid >> 6, lane = tid & 63;
    bf16_t* H = (bf16_t*)g_h;
    const float* mod = (const float*)(p.ws + WS_MOD) + (size_t)layer * NB * 3072;
    const float* gp = p.norm_g + (size_t)layer * DM;
#pragma unroll
    for (int h2 = 0; h2 < 2; ++h2) {
        const int row = item * 16 + h2 * 8 + wid, b = row >> 11;
        const f32x4* xr = (const f32x4*)(xin + (size_t)row * DM) + lane;
        f32x4 v[4]; float ss = 0.f;
#pragma unroll
        for (int q = 0; q < 4; ++q) { v[q] = xr[64 * q]; ss += (v[q][0] * v[q][0] + v[q][1] * v[q][1]) + (v[q][2] * v[q][2] + v[q][3] * v[q][3]); }
        const float rstd = rsqrtf(wave_sum(ss) * (1.f / DM) + EPS);
        const float* mb = mod + (size_t)b * 3072;
        u32x2* o8 = (u32x2*)(H + (size_t)row * DM) + lane;
#pragma unroll
        for (int q = 0; q < 4; ++q) {
            const int k = (lane + 64 * q) * 4;
            const f32x4 gv = *(const f32x4*)(gp + k), sh = *(const f32x4*)(mb + k), scl = *(const f32x4*)(mb + 1024 + k);
            const f32x4 hv = (v[q] * rstd * gv) * (scl + 1.f) + sh;
            u32x2 w; w.x = cvt_pk_bf16(hv[0], hv[1]); w.y = cvt_pk_bf16(hv[2], hv[3]);
            o8[64 * q] = w;
        }
    }
}
struct ConvD { const float* sp; bf16_t* dst; int srcN, K, k0; };
__device__ __forceinline__ bool conv_desc(const Params& p, int j, int it, int tid, ConvD& d) {
    constexpr int N0 = 448, N1 = N0 + 128, N2 = N1 + 128, N3 = N2 + 128, N4 = N3 + 64;
    if (it >= N4) return false;
    const float* src; int srcN, cs = (tid & 15) * 4, K, k0; bf16_t* dst;
    if (it < N0) {
        const int rt = it >> 2, kt = it & 3, r0 = rt * 64, T = r0 >> 8, q = r0 & 255;
        if (T < 16) {
            const int cg = tid & 15, bj = q >> 7, wcc = ((q >> 6) & 1) * 2 + (cg >> 3), fq4 = (cg >> 1) & 3, n = cg & 1;
            const int tbase = bj == 0 ? (n == 0 ? 2048 : 0) : (n == 0 ? 1024 : 3072);
            cs = tbase + 64 * T + 16 * wcc + 4 * fq4;
        }
        else if (T < 24) cs += (q < 128) ? (4096 + 128 * (T - 16) + q) : (6144 + 128 * (T - 16) + q - 128);
        else cs += 5120 + 256 * (T - 24) + q;
        src = p.ab_w_in + (size_t)j * DM * 7168; srcN = 7168; dst = (bf16_t*)(p.ws + wofs(j) + WS_WIN_E) + (size_t)r0 * DM; K = DM; k0 = kt * 256;
    } else if (it < N1) {
        const int i2 = it - N0, rt = i2 >> 3, kt = i2 & 7, r0 = rt * 64;
        src = p.ab_w_out + (size_t)j * 2048 * DM; srcN = DM; cs += r0; dst = (bf16_t*)(p.ws + wofs(j) + WS_WOUT_E) + (size_t)r0 * 2048; K = 2048; k0 = kt * 256;
    } else if (it < N2) {
        const int i2 = it - N1, rt = i2 >> 2, kt = i2 & 3, r0 = rt * 64;
        src = p.c_w_in + (size_t)j * DM * 4096; srcN = 4096; cs += 2048 + r0; dst = (bf16_t*)(p.ws + wofs(j) + WS_WIN_O) + (size_t)((r0 >> 7) * 256 + 128 + (r0 & 127)) * DM; K = DM; k0 = kt * 256;
    } else if (it < N3) {
        const int i2 = it - N2, rt = i2 >> 3, kt = i2 & 7, r0 = rt * 64;
        src = p.c_w_out + (size_t)j * 2048 * DM; srcN = DM; cs += r0; dst = (bf16_t*)(p.ws + wofs(j) + WS_WOUT_O) + (size_t)r0 * 2048; K = 2048; k0 = kt * 256;
    } else {
        const int i3 = it - N3, g = i3 >> 4, r = i3 & 15, rt = r >> 1, kt = r & 1, r0 = rt * 64;
        src = p.c_pool_w + ((size_t)j * 4 + g) * 512 * 512; srcN = 512; cs += r0; dst = (bf16_t*)(p.ws + wofs(j) + WS_POOLT) + (size_t)g * 512 * 512 + (size_t)r0 * 512; K = 512; k0 = kt * 256;
    }
    d.sp = src + (size_t)(k0 + (tid >> 4)) * srcN + cs; d.dst = dst; d.srcN = srcN; d.K = K; d.k0 = k0;
    return true;
}
__device__ __forceinline__ void phase_norm_even(const Params& p, int j, const float* xin, LAS unsigned char* ldsb, int sel, int wg0, int ldsoff, int rot, int tail = 0) {
    const int tid = opaque_tid();
    LAS float* T = (LAS float*)(ldsb + ldsoff);
    bf16_t* SGU = (bf16_t*)(p.ws + wofs(j) + WS_SGU); bf16_t* WINP = (bf16_t*)(p.ws + wofs(j) + WS_WINP);
    constexpr int N3 = 448 + 128 + 128 + 128, N4 = N3 + 64, N5 = N4 + 32, N6 = N5 + 512;
    const int NROWS = (j == 0 ? MTOK / 16 : 0);
    const int TOTAL = sel == 1 ? 576 : sel == 2 ? 864 + NROWS : N6 + NROWS;
    const int bid = opaque_bid();
    if (bid < wg0 && tail == 0) return;
    const int stride = bid < wg0 ? wg0 : (int)gridDim.x - wg0;
    const int VEND = bid < wg0 ? TOTAL : TOTAL - tail;
#define SETUP_MAP(v) (sel == 1 ? ((v) < 64 ? N3 + (v) : N5 + ((v) - 64)) : sel == 2 ? ((v) < N3 ? (v) : (v) < 864 ? N4 + ((v) - N3) : N6 + ((v) - 864)) : (v))
    int v = bid < wg0 ? TOTAL - tail + bid : (bid - wg0 + rot) % stride;
    ConvD d; bool isc = (v < VEND) && conv_desc(p, j, SETUP_MAP(v), tid, d);
    f32x4 r[8];
    if (isc) {
#pragma unroll
        for (int ps = 0; ps < 8; ++ps) r[ps] = *(const f32x4*)(d.sp + (size_t)ps * 32 * d.srcN);
    }
    while (v < VEND) {
        const int vn = v + stride; ConvD dn; const bool iscn = (vn < VEND) && conv_desc(p, j, SETUP_MAP(vn), tid, dn);
        if (isc) {
#pragma unroll
            for (int ps = 0; ps < 8; ++ps) { LAS float* t = T + (ps * 32 + (tid >> 4)) * 65 + (tid & 15) * 4; t[0] = r[ps][0]; t[1] = r[ps][1]; t[2] = r[ps][2]; t[3] = r[ps][3]; }
            __syncthreads();
            if (iscn) {
#pragma unroll
                for (int ps = 0; ps < 8; ++ps) r[ps] = *(const f32x4*)(dn.sp + (size_t)ps * 32 * dn.srcN);
            }
#pragma unroll
            for (int q = 0; q < 4; ++q) {
                const int item = tid + 512 * q, n = item >> 5, kg = item & 31; const LAS float* s = T + (kg * 8) * 65 + n;
                u32x4 o; o.x = cvt_pk_bf16(s[0], s[65]); o.y = cvt_pk_bf16(s[130], s[195]); o.z = cvt_pk_bf16(s[260], s[325]); o.w = cvt_pk_bf16(s[390], s[455]);
                *(u32x4*)(d.dst + (size_t)n * d.K + d.k0 + kg * 8) = o;
            }
            __syncthreads();
        } else {
            if (iscn) {
#pragma unroll
                for (int ps = 0; ps < 8; ++ps) r[ps] = *(const f32x4*)(dn.sp + (size_t)ps * 32 * dn.srcN);
            }
            const int it = SETUP_MAP(v);
            if (it < N5) {
                const int e0 = (it - N4) * 4096 + tid * 8, t = (e0 >> 7) & 127, s0 = e0 & 127;
                const float* src = p.ab_sgu_w + (size_t)j * 8 * 128 * 128 + e0;
                const f32x4 a = *(const f32x4*)src, b = *(const f32x4*)(src + 4);
                float w[8] = {a[0], a[1], a[2], a[3], b[0], b[1], b[2], b[3]};
#pragma unroll
                for (int e = 0; e < 8; ++e) w[e] = (s0 + e <= t) ? w[e] : 0.f;
                u32x4 o; o.x = cvt_pk_bf16(w[0], w[1]); o.y = cvt_pk_bf16(w[2], w[3]); o.z = cvt_pk_bf16(w[4], w[5]); o.w = cvt_pk_bf16(w[6], w[7]);
                *(u32x4*)(SGU + e0) = o;
            } else if (it < N6) {
                const int e0 = (it - N5) * 4096 + tid * 8, k = e0 >> 11, c = e0 & 2047;
                const float* src = p.c_w_in + ((size_t)j * DM + k) * 4096 + c;
                const f32x4 a = *(const f32x4*)src, b = *(const f32x4*)(src + 4);
                u32x4 o; o.x = cvt_pk_bf16(a[0], a[1]); o.y = cvt_pk_bf16(a[2], a[3]); o.z = cvt_pk_bf16(b[0], b[1]); o.w = cvt_pk_bf16(b[2], b[3]);
                *(u32x4*)(WINP + e0) = o;
            } else norm_rows(p, 2 * j, xin, it - N6);
        }
        v = vn; d = dn; isc = iscn;
    }
#undef SETUP_MAP
}
__device__ __forceinline__ void phase_final(const Params& p) {
    const int tid = opaque_tid(), wid = tid >> 6, lane = tid & 63;
    for (int it = opaque_bid(); it < MTOK / 8; it += gridDim.x) {
        const int row = it * 8 + wid;
        f32x4* xr = (f32x4*)(p.out + (size_t)row * DM) + lane;
        f32x4 v[4]; float ss = 0.f;
#pragma unroll
        for (int q = 0; q < 4; ++q) { v[q] = xr[64 * q]; ss += (v[q][0] * v[q][0] + v[q][1] * v[q][1]) + (v[q][2] * v[q][2] + v[q][3] * v[q][3]); }
        const float rstd = rsqrtf(wave_sum(ss) * (1.f / DM) + EPS);
#pragma unroll
        for (int q = 0; q < 4; ++q) { const f32x4 gv = *(const f32x4*)(p.final_g + (lane + 64 * q) * 4); xr[64 * q] = v[q] * rstd * gv; }
    }
}

__device__ __forceinline__ void unpack8(const u32x4 w, float (&f)[8]) {
    f[0] = bf_lo(w.x); f[1] = bf_hi(w.x); f[2] = bf_lo(w.y); f[3] = bf_hi(w.y); f[4] = bf_lo(w.z); f[5] = bf_hi(w.z); f[6] = bf_lo(w.w); f[7] = bf_hi(w.w);
}

__device__ __forceinline__ void product_units(const Params& p, int j, LAS unsigned char* lds) {
    Gemm g{(const bf16_t*)(p.ws + wofs(j) + WS_POOLT), (const bf16_t*)(p.ws + wofs(j) + WS_WINP), 512, 2048, 512, 8, 4, 512}; EpiProd E{(bf16_t*)(p.ws + wofs(j) + WS_WIN_O)};
    gemm_phase(lds, g, E);
}
__device__ __forceinline__ void phase_mix(const Params& p, int j, LAS unsigned char* lds) {
    const int tid = opaque_tid(), wid = tid >> 6, lane = tid & 63;
    const bf16_t* CH2 = (const bf16_t*)(p.ws + WS_RP); const bf16_t* BZ = CH2 + (size_t)MTOK * 1024; const bf16_t* UZ = BZ + (size_t)MTOK * 1024; const bf16_t* V = UZ + (size_t)MTOK * 1024;
    bf16_t* Y = (bf16_t*)(p.ws + WS_RA);
    {
        const bf16_t* Wm = (const bf16_t*)(p.ws + wofs(j) + WS_SGU);
        const int fr = lane & 15, fq = lane >> 4;
        const int rs = tid >> 4, c = tid & 15;
        const int sbid = opaque_bid();
        int it = (sbid & 7) * 128 + (sbid >> 3), par = 0;
        const int it_end = (sbid & 7) * 128 + 128;
        u32x4 vraw[4];
        if (it < it_end) { const bf16_t* vp = V + (size_t)((it >> 3) * 128 + rs) * 1024 + (it & 7) * 128 + 8 * c;
#pragma unroll
            for (int ps = 0; ps < 4; ++ps) vraw[ps] = *(const u32x4*)(vp + (size_t)ps * 32 * 1024); }
        for (; it < it_end; it += 32, par ^= 1) {
            const int hh = it & 7, cn = it >> 3;
            LAS bf16_t* vnT = (LAS bf16_t*)(lds + par * 36864);
            const int t = 16 * wid + fr; const size_t row = (size_t)cn * 128 + t;
            u32x2 uz[8];
#pragma unroll
            for (int n = 0; n < 8; ++n) uz[n] = *(const u32x2*)(UZ + row * 1024 + hh * 128 + 16 * n + 4 * fq);
            const float bias = p.ab_sgu_b[(size_t)j * 1024 + hh * 128 + t];
            const bf16_t* wrow = Wm + ((size_t)hh * 128 + 16 * wid + fr) * 128 + 8 * fq;
            bf16x8 af[4];
#pragma unroll
            for (int kk = 0; kk < 4; ++kk) af[kk] = *(const bf16x8*)(wrow + 32 * kk);
            const float* lg = p.ab_ln_g + (size_t)j * 1024 + hh * 128 + 8 * c; const float* lb = p.ab_ln_b + (size_t)j * 1024 + hh * 128 + 8 * c;
            const f32x4 g0 = *(const f32x4*)lg, g1 = *(const f32x4*)(lg + 4), b0 = *(const f32x4*)lb, b1 = *(const f32x4*)(lb + 4);
            const float gg[8] = {g0[0], g0[1], g0[2], g0[3], g1[0], g1[1], g1[2], g1[3]}, bb[8] = {b0[0], b0[1], b0[2], b0[3], b1[0], b1[1], b1[2], b1[3]};
#pragma unroll
            for (int ps = 0; ps < 4; ++ps) {
                float f[8]; unpack8(vraw[ps], f);
                float s1 = 0.f, s2 = 0.f;
#pragma unroll
                for (int e = 0; e < 8; ++e) { s1 += f[e]; s2 += f[e] * f[e]; }
#pragma unroll
                for (int o = 1; o < 16; o <<= 1) { s1 += __shfl_xor(s1, o); s2 += __shfl_xor(s2, o); }
                const float mu = s1 * (1.f / 128.f), var = fmaxf(s2 * (1.f / 128.f) - mu * mu, 0.f), rstd = rsqrtf(var + EPS);
                const int sr = ps * 32 + rs;
                LAS bf16_t* wp = vnT + (8 * c) * 136 + ((((sr >> 3) ^ c) & 15) << 3) + (sr & 7);
#pragma unroll
                for (int e = 0; e < 8; ++e) wp[e * 136] = (bf16_t)(cvt_pk_bf16((f[e] - mu) * rstd * gg[e] + bb[e], 0.f) & 0xffffu);
            }
            __syncthreads();
            {
                const int itn = it + 32;
                if (itn < it_end) { const bf16_t* vp = V + (size_t)((itn >> 3) * 128 + rs) * 1024 + (itn & 7) * 128 + 8 * c;
#pragma unroll
                    for (int ps = 0; ps < 4; ++ps) vraw[ps] = *(const u32x4*)(vp + (size_t)ps * 32 * 1024); }
            }
            f32x4 acc[8];
#pragma unroll
            for (int n = 0; n < 8; ++n) acc[n] = (f32x4){0.f, 0.f, 0.f, 0.f};
#pragma unroll
            for (int kk = 0; kk < 4; ++kk) {
                if (32 * kk <= 16 * wid + 15) {
#pragma unroll
                    for (int n = 0; n < 8; ++n) {
                        const int cd = (2 * n + (fr >> 3)) & 15;
                        const bf16x8 bfm = *(const LAS bf16x8*)(vnT + (16 * n + fr) * 136 + ((((4 * kk + fq) ^ cd) & 15) << 3));
                        acc[n] = __builtin_amdgcn_mfma_f32_16x16x32_bf16(bfm, af[kk], acc[n], 0, 0, 0);
                    }
                }
            }
#pragma unroll
            for (int n = 0; n < 8; ++n) {
                const int d = 16 * n + 4 * fq;
                u32x2 w; w.x = cvt_pk_bf16(bf_lo(uz[n].x) * (acc[n][0] + bias), bf_hi(uz[n].x) * (acc[n][1] + bias));
                w.y = cvt_pk_bf16(bf_lo(uz[n].y) * (acc[n][2] + bias), bf_hi(uz[n].y) * (acc[n][3] + bias));
                *(u32x2*)(Y + row * 2048 + 1024 + hh * 128 + d) = w;
            }
        }
        __syncthreads();
    }
    {
        const float* halo = (const float*)(p.ws + WS_HALO); const float* cw = p.ab_conv_w + (size_t)j * 3 * 1024;
        {
            const int fb = opaque_bid(), lidx = (fb >> 3) * 512 + tid, B = (fb & 7) * 16 + (lidx >> 10), c = lidx & 1023; const bool hist = ((B * 128) & (SEQ - 1)) != 0;
            const float* hb = halo + (size_t)B * 6 * 1024 + c;
            const float c6 = hist ? hb[-6 * 1024] : 0.f, c7 = hist ? hb[-5 * 1024] : 0.f, c0 = hb[2 * 1024], c1 = hb[3 * 1024], b0 = hb[4 * 1024], b1 = hb[5 * 1024];
            const float w0 = cw[c], w1 = cw[1024 + c], w2 = cw[2048 + c];
            const float y0 = b0 * (w0 * c6 + w1 * c7 + w2 * c0), y1 = b1 * (w0 * c7 + w1 * c0 + w2 * c1);
            Y[(size_t)(B * 128) * 2048 + c] = (bf16_t)(cvt_pk_bf16(y0, 0.f) & 0xffffu);
            Y[(size_t)(B * 128 + 1) * 2048 + c] = (bf16_t)(cvt_pk_bf16(y1, 0.f) & 0xffffu);
        }
    }
}

__device__ __forceinline__ void phase_pool(const Params& p) {
    const int tid = opaque_tid();
    const bf16_t* HQ = (const bf16_t*)(p.ws + WS_HQ); const bf16_t* HS = (const bf16_t*)(p.ws + WS_HS); bf16_t* Y = (bf16_t*)(p.ws + WS_RA);
    const int fb = opaque_bid(), lidx = (fb >> 3) * 512 + tid;
    if (lidx < 16 * 256) {
        const int B = (fb & 7) * 16 + (lidx >> 8), ct = lidx & 255, c0 = ct * 8, win = 2 << (ct >> 6); const bool hist = ((B * 128) & (SEQ - 1)) != 0;
        const bf16_t* tail = HQ + (size_t)(B - 1) * 32 * 2048 + c0;
        const bf16_t* head = HQ + ((size_t)B * 32 + 16) * 2048 + c0;
        const bf16_t* hs = HS + (size_t)B * 16 * 2048 + c0;
        float S[8];
#pragma unroll
        for (int e = 0; e < 8; ++e) S[e] = 0.f;
        if (hist) {
#pragma unroll
            for (int i = 1; i < 16; ++i) {
                if (i < win) { float v[8]; unpack8(*(const u32x4*)(tail + (size_t)(16 - i) * 2048), v);
#pragma unroll
                    for (int e = 0; e < 8; ++e) S[e] += v[e]; }
            }
        }
#pragma unroll 4
        for (int r = 0; r < 16; ++r) {
            float cur[8], sz[8], o[8];
            unpack8(*(const u32x4*)(head + (size_t)r * 2048), cur);
            unpack8(*(const u32x4*)(hs + (size_t)r * 2048), sz);
            const float inv = 1.f / (float)(hist ? win : min(r + 1, win));
#pragma unroll
            for (int e = 0; e < 8; ++e) { S[e] += cur[e]; o[e] = (S[e] * inv - cur[e]) * sz[e]; }
            u32x4 w; w.x = cvt_pk_bf16(o[0], o[1]); w.y = cvt_pk_bf16(o[2], o[3]); w.z = cvt_pk_bf16(o[4], o[5]); w.w = cvt_pk_bf16(o[6], o[7]);
            *(u32x4*)(Y + (size_t)(B * 128 + r) * 2048 + c0) = w;
            const int ro = r - win + 1;
            if (ro >= 0 || hist) { float old[8]; unpack8(*(const u32x4*)(ro >= 0 ? head + (size_t)ro * 2048 : tail + (size_t)(16 + ro) * 2048), old);
#pragma unroll
                for (int e = 0; e < 8; ++e) S[e] -= old[e]; }
        }
    }
}

#define XB_TMO      128
#define XB_XCNT(j)  (256  + 64 * (j))
#define XB_XSUB(j)  (1280 + 64 * (j))
#define XB_XGEN(j)  (2304 + 64 * (j))
#define XB_TOP      3328
#define XB_TOPGEN   3392
#define XCD_BAR_WORDS 3456
#define XB_SPIN_CAP (1u << 18)
__device__ __forceinline__ unsigned xb_ld(unsigned* p)              { return __hip_atomic_load(p, __ATOMIC_RELAXED, __HIP_MEMORY_SCOPE_AGENT); }
__device__ __forceinline__ unsigned xb_add(unsigned* p, unsigned v) { return __hip_atomic_fetch_add(p, v, __ATOMIC_RELAXED, __HIP_MEMORY_SCOPE_AGENT); }
__device__ __forceinline__ unsigned xb_xcc_id() { return (unsigned)__builtin_amdgcn_s_getreg((3 << 11) | 20) & 0xFu; }
#define XB_SPIN(cond, bar) do { unsigned _sp = 0; while (cond) { __builtin_amdgcn_s_sleep(1); \
    if ((++_sp & 255u) == 0u) { if (xb_ld(&(bar)[XB_TMO])) break; if (_sp > XB_SPIN_CAP) { atomicAdd(&(bar)[XB_TMO], 1u); break; } } } } while (0)
struct XcdBarrier { unsigned* bar; unsigned x; volatile LAS unsigned* st; };
__device__ __forceinline__ XcdBarrier xcd_barrier_post(unsigned* bar, volatile LAS unsigned* st) {
    XcdBarrier b; b.bar = bar; b.x = xb_xcc_id(); b.st = st;
    if (threadIdx.x == 0) (void)xb_add(&bar[XB_XCNT(b.x)], 1u);
    return b;
}
__device__ __forceinline__ void xcd_barrier_complete(unsigned* bar, unsigned x, unsigned& nloc, unsigned& nx) {
    const unsigned G = gridDim.x * gridDim.y * gridDim.z;
    unsigned sum, cnt, mine, sp = 0u;
    for (;;) {
        sum = 0u; cnt = 0u; mine = 0u;
#pragma unroll
        for (unsigned j = 0; j < 16; ++j) { const unsigned c = xb_ld(&bar[XB_XCNT(j)]); sum += c; cnt += (c > 0u) ? 1u : 0u; mine = (j == x) ? c : mine; }
        if (sum == G) break;
        __builtin_amdgcn_s_sleep(1);
        if ((++sp & 255u) == 0u) { if (xb_ld(&bar[XB_TMO])) break; if (sp > XB_SPIN_CAP) { atomicAdd(&bar[XB_TMO], 1u); break; } }
    }
    nloc = mine > 0u ? mine : 1u; nx = cnt > 0u ? cnt : 1u;
}
__device__ __forceinline__ void xcd_barrier(const XcdBarrier& b) {
    asm volatile("s_waitcnt vmcnt(0)" ::: "memory");
    __syncthreads();
    if (threadIdx.x == 0) {
        unsigned* bar = b.bar;
        __builtin_amdgcn_s_waitcnt(0);
        unsigned nloc = b.st[0], nx = b.st[1];
        if (nloc == 0u) { xcd_barrier_complete(bar, b.x, nloc, nx); b.st[0] = nloc; b.st[1] = nx; }
        const unsigned old = xb_add(&bar[XB_XSUB(b.x)], 1u);
        const unsigned gen = old / nloc;
        if (old + 1u == gen * nloc + (nloc >> 1)) {
            __builtin_amdgcn_fence(__ATOMIC_RELEASE, "agent");
            asm volatile("s_waitcnt vmcnt(0)" ::: "memory");
        }
        if (old + 1u == (gen + 1u) * nloc) {
            __builtin_amdgcn_fence(__ATOMIC_RELEASE, "agent");
            asm volatile("s_waitcnt vmcnt(0)" ::: "memory");
            const unsigned og = xb_add(&bar[XB_TOP], 1u);
            const unsigned tg = og / nx;
            if (og + 1u == (tg + 1u) * nx) xb_add(&bar[XB_TOPGEN], 1u);
            else XB_SPIN(xb_ld(&bar[XB_TOPGEN]) == tg, bar);
            __builtin_amdgcn_fence(__ATOMIC_ACQUIRE, "agent");
            xb_add(&bar[XB_XGEN(b.x)], 1u);
            asm volatile("s_waitcnt vmcnt(0)" ::: "memory");
        } else {
            XB_SPIN(xb_ld(&bar[XB_XGEN(b.x)]) == gen, bar);
            __builtin_amdgcn_fence(__ATOMIC_ACQUIRE, "agent");
            asm volatile("s_waitcnt vmcnt(0)" ::: "memory");
        }
    }
    __syncthreads();
}

__device__ __forceinline__ void local_barrier(unsigned* ctr, unsigned target, unsigned* tmo) {
    asm volatile("s_waitcnt vmcnt(0)" ::: "memory");
    __syncthreads();
    if (threadIdx.x == 0) {
        __builtin_amdgcn_s_waitcnt(0);
        (void)xb_add(ctr, 1u);
        __builtin_amdgcn_fence(__ATOMIC_ACQUIRE, "agent");
        unsigned sp = 0;
        while (xb_ld(ctr) < target) { __builtin_amdgcn_s_sleep(1); if (++sp > (1u << 22)) { atomicAdd(tmo, 1u); break; } }
        asm volatile("s_waitcnt vmcnt(0)" ::: "memory");
    }
    __syncthreads();
}

__global__ void __launch_bounds__(512, 2) mega_fwd(Params p, int ph_lo, int ph_hi) {
    extern __shared__ __attribute__((aligned(16))) unsigned char smem[];
    LAS unsigned char* lds = (LAS unsigned char*)smem;
    cg::grid_group grid = cg::this_grid();
    if (ph_hi < 0) grid.sync();
    volatile LAS unsigned* st = (volatile LAS unsigned*)(lds + STAGE_BYTES);
    if (threadIdx.x < 4) st[threadIdx.x] = 0u;
    __syncthreads();
    const XcdBarrier xb = xcd_barrier_post((unsigned*)(p.ws + WS_BAR), st);
    unsigned* ctl = (unsigned*)(p.ws + WS_BAR);
    if (threadIdx.x == 0) __hip_atomic_store(ctl + TAB_WORD0 + blockIdx.x, xb.x + 1u, __ATOMIC_RELAXED, __HIP_MEMORY_SCOPE_AGENT);
    unsigned* lctr = ctl + LOC_WORD0 + 64 * (blockIdx.x & 7);
    int ph = 0, fast = 0; unsigned lgen = 0;
#define PHASE(LOCAL, ...) do { if (ph >= ph_lo && ph < ph_hi) { __VA_ARGS__; if (ph + 1 < ph_hi && (LOCAL) >= 0) { if ((LOCAL) && fast) { ++lgen; local_barrier(lctr, 32u * lgen, ctl + XB_TMO); } else xcd_barrier(xb); } } ++ph; } while (0)
    bf16_t* RA = (bf16_t*)(p.ws + WS_RA); bf16_t* RP = (bf16_t*)(p.ws + WS_RP);
    const float* mod = (const float*)(p.ws + WS_MOD);
    float* part = (float*)(p.ws + WS_PART); unsigned* cnt = (unsigned*)(p.ws + WS_BAR) + CNT_WORD0;
    PHASE(0, { phase_mod(p, lds); phase_norm_even(p, 0, nullptr, lds, 1, 0, 49152, 64); });
    {
        int ok = 1;
        if (threadIdx.x < 256) { const unsigned a = xb_ld(ctl + TAB_WORD0 + threadIdx.x), r = xb_ld(ctl + TAB_WORD0 + (threadIdx.x & 7)); ok = (a == r && a != 0u) ? 1 : 0; }
        fast = __syncthreads_and(ok) && gridDim.x == 256;
    }
#pragma unroll 1
    for (int lp = 0; lp < 2; ++lp) {
        {
            const int layer = 2 * lp; const float* xin = (lp == 0) ? p.x : p.out;
            PHASE(0, { if (blockIdx.x < 32) product_units(p, lp, lds); phase_norm_even(p, lp, xin, lds, 2, 32, 0, 0, lp == 0 ? 156 : 28); if (lp == 0) phase_norm_even(p, 1, nullptr, lds, 1, 0, 0, 0); });
            PHASE(1, { Gemm g{(const bf16_t*)g_h, (const bf16_t*)(p.ws + wofs(lp) + WS_WIN_E), DM, DM, DM, MTOK / BM, 7168 / BM, 0}; EpiEven E{RP, RA, (float*)(p.ws + WS_HALO), p.ab_conv_w + (size_t)lp * 3 * 1024}; gemm_phase(lds, g, E); });
            PHASE(1, phase_mix(p, lp, lds));
            PHASE(1, { Gemm g{RA, (const bf16_t*)(p.ws + wofs(lp) + WS_WOUT_E), 2048, 2048, 2048, MTOK / BM, DM / BM, 0};
                       EpiResNorm E{lp == 0 ? p.x : nullptr, (const bf16_t*)g_x, (bf16_t*)g_x, p.out, mod + (size_t)layer * NB * 3072 + 2048, (bf16_t*)g_h, p.norm_g + (size_t)(layer + 1) * DM, mod + (size_t)(layer + 1) * NB * 3072,
                                    part + (size_t)layer * 4 * MTOK, cnt + layer * 64, 0};
                       gemm_phase(lds, g, E); });
        }
        {
            const int layer = 2 * lp + 1; const int last = (lp == 1) ? 1 : 0;
            PHASE(1, { Gemm g{(const bf16_t*)g_h, (const bf16_t*)(p.ws + wofs(lp) + WS_WIN_O), DM, DM, DM, MTOK / BM, 4096 / BM, 0}; EpiOdd E{RA, (bf16_t*)(p.ws + WS_HQ), (bf16_t*)(p.ws + WS_HS), p.c_pool_scale + (size_t)lp * 2048}; gemm_phase(lds, g, E); });
            PHASE(1, phase_pool(p));
            PHASE(-1, { Gemm g{RA, (const bf16_t*)(p.ws + wofs(lp) + WS_WOUT_O), 2048, 2048, 2048, MTOK / BM, DM / BM, 0};
                       EpiResNorm E{nullptr, (const bf16_t*)g_x, (bf16_t*)g_x, p.out, mod + (size_t)layer * NB * 3072 + 2048, (bf16_t*)g_h, last ? p.final_g : p.norm_g + (size_t)(layer + 1) * DM, mod + (size_t)(last ? layer : layer + 1) * NB * 3072,
                                    part + (size_t)layer * 4 * MTOK, cnt + layer * 64, last};
                       gemm_phase(lds, g, E); });
        }
    }
#undef PHASE
}

extern "C" void kernel_launch(void* const* d_in, const int* in_sizes, int n_in, void* d_out, int out_size, void* d_ws, size_t ws_size, hipStream_t stream) {
    static int grid = 0;
    if (grid == 0) {
        if (n_in != 17 || out_size != MTOK * DM || ws_size < WS_END2) { fprintf(stderr, "kernel_launch: unexpected shapes (n_in %d out %d ws %zu need %zu)\n", n_in, out_size, ws_size, (size_t)WS_END2); grid = -1; return; }
        int dev = 0, cus = 0, per_cu = 0;
        hipGetDevice(&dev);
        hipDeviceGetAttribute(&cus, hipDeviceAttributeMultiprocessorCount, dev);
        if (hipFuncSetAttribute((const void*)mega_fwd, hipFuncAttributeMaxDynamicSharedMemorySize, LDS_BYTES) != hipSuccess) { fprintf(stderr, "kernel_launch: hipFuncSetAttribute failed\n"); grid = -1; return; }
        hipOccupancyMaxActiveBlocksPerMultiprocessor(&per_cu, (const void*)mega_fwd, 512, LDS_BYTES);
        if (per_cu < 1) { fprintf(stderr, "kernel_launch: occupancy query says %d blocks per CU\n", per_cu); per_cu = 1; }
        (void)hipGetLastError();
        grid = cus;
        if (grid != 256) { fprintf(stderr, "kernel_launch: built for 256 CUs (one out-projection tile per workgroup), got %d\n", grid); grid = -1; return; }
    }
    if (grid < 0) return;
    Params p{};
    p.x = (const float*)d_in[0]; p.c = (const float*)d_in[1]; p.norm_g = (const float*)d_in[2]; p.ada_w = (const float*)d_in[3]; p.ada_b = (const float*)d_in[4];
    p.ab_w_in = (const float*)d_in[5]; p.ab_conv_w = (const float*)d_in[6]; p.ab_ln_g = (const float*)d_in[7]; p.ab_ln_b = (const float*)d_in[8];
    p.ab_sgu_w = (const float*)d_in[9]; p.ab_sgu_b = (const float*)d_in[10]; p.ab_w_out = (const float*)d_in[11];
    p.c_w_in = (const float*)d_in[12]; p.c_pool_w = (const float*)d_in[13]; p.c_pool_scale = (const float*)d_in[14]; p.c_w_out = (const float*)d_in[15]; p.final_g = (const float*)d_in[16];
    p.out = (float*)d_out; p.ws = (unsigned char*)d_ws;
    if (hipMemsetAsync((unsigned char*)d_ws + WS_BAR, 0, CTL_WORDS * 4, stream) != hipSuccess) { fprintf(stderr, "kernel_launch: barrier memset failed\n"); return; }
    int lo = 0, hi = 15;
    void* args[] = {&p, &lo, &hi};
    hipError_t e = hipLaunchCooperativeKernel((const void*)mega_fwd, dim3(grid), dim3(512), args, LDS_BYTES, stream);
    if (e != hipSuccess) fprintf(stderr, "kernel_launch: cooperative launch failed: %s (grid %d)\n", hipGetErrorString(e), grid);
}
```
